# Optimizing an MI355X kernel written in HIP

```python
import jax, jax.numpy as jnp
from jax import lax
import numpy as np

D_MODEL = 2048
BATCH = 4
SEQ = 4096
DEPTH = 1

HEAD_DIM = 128
MOBA_HEADS = 8
MOBA_WIDTH = MOBA_HEADS * HEAD_DIM
MOBA_BLOCK = 256
MOBA_TOPK = 3
MOBA_Q_CHUNK = 32
ROPE_THETA = 10000.0
GLA_HEADS = 4
GLA_VALUE_WIDTH = D_MODEL - MOBA_WIDTH
GLA_KEY_WIDTH = GLA_VALUE_WIDTH // 2
GLA_DK = GLA_KEY_WIDTH // GLA_HEADS
GLA_DV = GLA_VALUE_WIDTH // GLA_HEADS
GLA_GATE_RANK = 16
GLA_GATE_NORMALIZER = 16.0
GLA_CHUNK = 64
IN_SPLITS = [MOBA_WIDTH, 2 * MOBA_WIDTH, 3 * MOBA_WIDTH,
             3 * MOBA_WIDTH + GLA_KEY_WIDTH,
             3 * MOBA_WIDTH + 2 * GLA_KEY_WIDTH,
             3 * MOBA_WIDTH + 2 * GLA_KEY_WIDTH + GLA_VALUE_WIDTH,
             3 * MOBA_WIDTH + 2 * GLA_KEY_WIDTH + 2 * GLA_VALUE_WIDTH]
IN_WIDTH = 3 * MOBA_WIDTH + 2 * GLA_KEY_WIDTH + 2 * GLA_VALUE_WIDTH + GLA_GATE_RANK
N_EXPERTS = 32
TOP_K = 4
EXPERT_FF = D_MODEL
SWIGLU_ALPHA = 1.702
SWIGLU_LIMIT = 7.0
MOE_ROW_BLOCK = 256
NORM_EPS = 1e-5

kernel_name = 'hybrid_moba_gla_moe'


def rms_norm(x, w):
    x32 = x.astype(jnp.float32)
    y = x32 * lax.rsqrt(jnp.mean(x32 * x32, axis=-1, keepdims=True) + NORM_EPS)
    return (y * w.astype(jnp.float32)).astype(x.dtype)


def rope_tables(seq_len):
    inv_freq = 1.0 / (ROPE_THETA ** (jnp.arange(0, HEAD_DIM, 2, dtype=jnp.float32) / HEAD_DIM))
    ang = jnp.arange(seq_len, dtype=jnp.float32)[:, None] * inv_freq[None, :]
    return jnp.cos(ang), jnp.sin(ang)


def apply_rope(t, cos, sin):
    t32 = t.astype(jnp.float32)
    t1, t2 = jnp.split(t32, 2, axis=-1)
    c = cos[None, :, None, :]
    s = sin[None, :, None, :]
    return jnp.concatenate([t1 * c - t2 * s, t2 * c + t1 * s], axis=-1).astype(t.dtype)


def moba_attention(q, k, v):
    B, S, H, hd = q.shape
    nb = -(-S // MOBA_BLOCK)
    s_pad = nb * MOBA_BLOCK
    n_sel = min(MOBA_TOPK, nb)
    scale = hd ** -0.5

    def prep(t):
        t = jnp.swapaxes(t, 1, 2)
        return jnp.pad(t, ((0, 0), (0, 0), (0, s_pad - S), (0, 0)))

    q, k, v = prep(q), prep(k), prep(v)
    kb = k.reshape(B, H, nb, MOBA_BLOCK, hd)
    vb = v.reshape(B, H, nb, MOBA_BLOCK, hd)
    k_mean = jnp.mean(kb.astype(jnp.float32), axis=3)
    gate = jnp.einsum('bhsd,bhnd->bhsn', q.astype(jnp.float32), k_mean)
    q_block = jnp.arange(s_pad) // MOBA_BLOCK
    fully_past = jnp.arange(nb)[None, :] < q_block[:, None]
    gate = jnp.where(fully_past, gate, -jnp.inf)
    _, sel = lax.top_k(gate, n_sel)
    sel_valid = sel < q_block[:, None]

    n_qc = s_pad // MOBA_Q_CHUNK

    def chunks(t):
        return jnp.moveaxis(t.reshape(B, H, n_qc, MOBA_Q_CHUNK, t.shape[-1]), 2, 0)

    b_idx = jnp.arange(B)[:, None, None, None]
    h_idx = jnp.arange(H)[None, :, None, None]

    def attend(args):
        c, qc, sc, sv = args
        q_start = c * MOBA_Q_CHUNK
        q_pos = q_start + jnp.arange(MOBA_Q_CHUNK)
        blk = q_start // MOBA_BLOCK
        k_own = lax.dynamic_index_in_dim(kb, blk, axis=2, keepdims=False)
        v_own = lax.dynamic_index_in_dim(vb, blk, axis=2, keepdims=False)
        k_sel = kb[b_idx, h_idx, sc]
        v_sel = vb[b_idx, h_idx, sc]
        s_sel = jnp.einsum('bhqd,bhqnkd->bhqnk', qc, k_sel).astype(jnp.float32) * scale
        s_sel = jnp.where(sv[..., None], s_sel, -jnp.inf).reshape(B, H, MOBA_Q_CHUNK, n_sel * MOBA_BLOCK)
        s_own = jnp.einsum('bhqd,bhkd->bhqk', qc, k_own).astype(jnp.float32) * scale
        k_pos = blk * MOBA_BLOCK + jnp.arange(MOBA_BLOCK)
        s_own = jnp.where(k_pos[None, :] <= q_pos[:, None], s_own, -jnp.inf)
        p = jax.nn.softmax(jnp.concatenate([s_sel, s_own], axis=-1), axis=-1).astype(v.dtype)
        p_sel = p[..., :n_sel * MOBA_BLOCK].reshape(B, H, MOBA_Q_CHUNK, n_sel, MOBA_BLOCK)
        p_own = p[..., n_sel * MOBA_BLOCK:]
        return (jnp.einsum('bhqnk,bhqnkd->bhqd', p_sel, v_sel)
                + jnp.einsum('bhqk,bhkd->bhqd', p_own, v_own))

    out = lax.map(attend, (jnp.arange(n_qc), chunks(q), chunks(sel), chunks(sel_valid)))
    out = jnp.moveaxis(out, 0, 2).reshape(B, H, s_pad, hd)[:, :, :S]
    return jnp.swapaxes(out, 1, 2).reshape(B, S, H * hd)


def gla_chunked(q, k, v, log_a):
    B, S, H, dk = q.shape
    dv = v.shape[-1]
    nc = S // GLA_CHUNK

    def to_chunks(t):
        return t.astype(jnp.float32).reshape(B, nc, GLA_CHUNK, H, t.shape[-1]).transpose(1, 0, 3, 2, 4)

    causal = jnp.tril(jnp.ones((GLA_CHUNK, GLA_CHUNK), dtype=bool))

    def step(state, inp):
        qc, kc, vc, ac = inp
        b = jnp.cumsum(ac, axis=2)
        diff = b[:, :, :, None, :] - b[:, :, None, :, :]
        decay = jnp.exp(jnp.where(causal[:, :, None], diff, -jnp.inf))
        scores = jnp.einsum('bhtk,bhsk,bhtsk->bhts', qc, kc, decay)
        o = (jnp.einsum('bhts,bhsv->bhtv', scores, vc)
             + jnp.einsum('bhtk,bhkv->bhtv', qc * jnp.exp(b), state))
        b_last = b[:, :, -1:, :]
        state = (state * jnp.exp(b_last)[:, :, 0, :, None]
                 + jnp.einsum('bhsk,bhsv->bhkv', kc * jnp.exp(b_last - b), vc))
        return state, o

    state0 = jnp.zeros((B, H, dk, dv), jnp.float32)
    _, o = lax.scan(step, state0, (to_chunks(q), to_chunks(k), to_chunks(v), to_chunks(log_a)))
    return o.transpose(1, 0, 3, 2, 4).reshape(B, S, H, dv).astype(v.dtype)


def moe_ffn(h, router_w, router_b, w_gate_up, b_gate_up, w_down, b_down):
    T, D = h.shape
    A = T * TOP_K
    G = MOE_ROW_BLOCK
    logits = (h @ router_w + router_b).astype(jnp.float32)
    top_vals, top_idx = lax.top_k(logits, TOP_K)
    gates = jax.nn.softmax(top_vals, axis=-1).astype(h.dtype)
    flat_e = top_idx.reshape(-1).astype(jnp.int32)
    flat_tok = jnp.arange(A, dtype=jnp.int32) // TOP_K
    flat_g = gates.reshape(-1)
    order = jnp.argsort(flat_e)
    se = flat_e[order]
    counts = jnp.bincount(flat_e, length=N_EXPERTS)
    starts = jnp.cumsum(counts) - counts
    pcounts = (counts + G - 1) // G * G
    pends = jnp.cumsum(pcounts)
    pstarts = pends - pcounts
    dest = pstarts[se] + (jnp.arange(A) - starts[se])
    n_blocks = (A + N_EXPERTS * (G - 1)) // G
    P = n_blocks * G
    row_tok = jnp.full((P,), T, jnp.int32).at[dest].set(flat_tok[order])
    row_gate = jnp.zeros((P,), h.dtype).at[dest].set(flat_g[order])
    block_start = jnp.arange(n_blocks) * G
    block_e = jnp.minimum(jnp.sum(block_start[:, None] >= pends[None, :], axis=1), N_EXPERTS - 1)
    h_pad = jnp.concatenate([h, jnp.zeros((1, D), h.dtype)], axis=0)

    def expert_block(args):
        e, toks = args
        xb = h_pad[toks]
        gu = xb @ w_gate_up[e] + b_gate_up[e]
        g, u = gu[:, :EXPERT_FF], gu[:, EXPERT_FF:]
        g = jnp.minimum(g, SWIGLU_LIMIT)
        u = jnp.clip(u, -SWIGLU_LIMIT, SWIGLU_LIMIT)
        act = (u + 1.0) * (g * jax.nn.sigmoid(SWIGLU_ALPHA * g))
        return act @ w_down[e] + b_down[e]

    y_rows = lax.map(expert_block, (block_e, row_tok.reshape(n_blocks, G))).reshape(P, D)
    y = jax.ops.segment_sum(y_rows * row_gate[:, None], row_tok, num_segments=T + 1)
    return y[:T]


def setup_inputs(seed: int = 0) -> dict:
    key = jax.random.key(seed)
    ks = jax.random.split(key, 16)
    f32 = jnp.float32
    L, D, E, F = DEPTH, D_MODEL, N_EXPERTS, EXPERT_FF

    def nrm(k, shape, scale):
        return jax.random.normal(k, shape, f32) * scale

    return {
        'x': nrm(ks[0], (BATCH, SEQ, D), 1.0),
        'attn_norm_w': 1.0 + nrm(ks[1], (L, D), 0.02),
        'w_in': nrm(ks[2], (L, D, IN_WIDTH), D ** -0.5),
        'gla_gate_w2': nrm(ks[3], (L, GLA_GATE_RANK, GLA_KEY_WIDTH), GLA_GATE_RANK ** -0.5),
        'gla_gate_b': nrm(ks[4], (L, GLA_KEY_WIDTH), 0.1),
        'gla_norm_w': 1.0 + nrm(ks[5], (L, GLA_DV), 0.02),
        'w_out': nrm(ks[6], (L, D, D), D ** -0.5),
        'ffn_norm_w': 1.0 + nrm(ks[7], (L, D), 0.02),
        'router_w': nrm(ks[8], (L, D, E), D ** -0.5),
        'router_b': nrm(ks[9], (L, E), 0.01),
        'w_gate_up': nrm(ks[10], (L, E, D, 2 * F), D ** -0.5),
        'b_gate_up': nrm(ks[11], (L, E, 2 * F), 0.01),
        'w_down': nrm(ks[12], (L, E, F, D), F ** -0.5),
        'b_down': nrm(ks[13], (L, E, D), 0.01),
        'final_norm_w': 1.0 + nrm(ks[14], (D,), 0.02),
    }


def reference(x, attn_norm_w, w_in, gla_gate_w2, gla_gate_b, gla_norm_w, w_out,
              ffn_norm_w, router_w, router_b, w_gate_up, b_gate_up, w_down, b_down,
              final_norm_w):
    B, S, D = x.shape
    cos, sin = rope_tables(S)
    for l in range(DEPTH):
        h = rms_norm(x, attn_norm_w[l])
        proj = jnp.einsum('bsd,de->bse', h, w_in[l])
        mq, mk, mv, gq, gk, gv, gg, gz = jnp.split(proj, IN_SPLITS, axis=-1)
        mq = apply_rope(mq.reshape(B, S, MOBA_HEADS, HEAD_DIM), cos, sin)
        mk = apply_rope(mk.reshape(B, S, MOBA_HEADS, HEAD_DIM), cos, sin)
        mv = mv.reshape(B, S, MOBA_HEADS, HEAD_DIM)
        moba_out = moba_attention(mq, mk, mv)

        gate_logits = (gz @ gla_gate_w2[l] + gla_gate_b[l]).astype(jnp.float32)
        log_a = jax.nn.log_sigmoid(gate_logits) / GLA_GATE_NORMALIZER
        gla_o = gla_chunked(
            gq.reshape(B, S, GLA_HEADS, GLA_DK) * (GLA_DK ** -0.5),
            gk.reshape(B, S, GLA_HEADS, GLA_DK),
            gv.reshape(B, S, GLA_HEADS, GLA_DV),
            log_a.reshape(B, S, GLA_HEADS, GLA_DK))
        gla_o = rms_norm(gla_o, gla_norm_w[l]) * jax.nn.silu(gg.reshape(B, S, GLA_HEADS, GLA_DV))
        mixed = jnp.concatenate([moba_out, gla_o.reshape(B, S, GLA_VALUE_WIDTH)], axis=-1)
        x = x + jnp.einsum('bse,ed->bsd', mixed, w_out[l])

        h = rms_norm(x, ffn_norm_w[l])
        y = moe_ffn(h.reshape(B * S, D), router_w[l], router_b[l], w_gate_up[l],
                    b_gate_up[l], w_down[l], b_down[l])
        x = x + y.reshape(B, S, D)
    return rms_norm(x, final_norm_w)
```

```cpp
#include <hip/hip_runtime.h>
#include <stdint.h>
#include <stdio.h>

#define LAS __attribute__((address_space(3)))
typedef unsigned short bf16_t;
typedef short bf16x8 __attribute__((ext_vector_type(8)));
typedef short s16x4 __attribute__((ext_vector_type(4)));
typedef float f32x2 __attribute__((ext_vector_type(2)));
typedef float f32x4 __attribute__((ext_vector_type(4)));
typedef float f32x16 __attribute__((ext_vector_type(16)));
typedef unsigned u32x2 __attribute__((ext_vector_type(2)));
typedef unsigned u32x4 __attribute__((ext_vector_type(4)));
typedef int i32x8 __attribute__((ext_vector_type(8)));

constexpr int NBATCH = 4, SEQ = 4096, T = NBATCH * SEQ, DM = 2048;
constexpr int HD = 128, MH = 8, MBLK = 256, NBLK = SEQ / MBLK;
constexpr int GH = 4, GDK = 128, GDV = 256;
constexpr int LDW_IN = 6160, NPROJ = 6144;
constexpr int C_MQ = 0, C_MK = 1024, C_MV = 2048, C_GQ = 3072, C_GK = 3584, C_GV = 4096, C_GG = 5120, C_GZ = 6144;
constexpr int NE = 32, TOPK = 4, FF = 2048, NASSIGN = T * TOPK;
constexpr int MAXBLK = (NASSIGN + NE * 255) / 256, PROWS = MAXBLK * 256;
constexpr float EPS = 1e-5f;
constexpr float ACT_SCALE = 4.0f, W_SCALE = 64.0f, F8_UNSCALE = 1.0f / (ACT_SCALE * W_SCALE);
constexpr float Y_SCALE = 16.0f;

constexpr size_t MiB = (size_t)1 << 20;
constexpr size_t WS_CTL = 0, CTL_BYTES = 64 * 1024;
constexpr size_t WS_WIN = 16 * MiB;
constexpr size_t WS_WOUT = 40 * MiB;
constexpr size_t WS_ROPE = 48 * MiB;
constexpr size_t WS_RSTD1 = 50 * MiB;
constexpr size_t WS_GZ = 51 * MiB;
constexpr size_t WS_KMEAN = 52 * MiB;
constexpr size_t WS_DEND = 52 * MiB + 512 * 1024;
constexpr size_t WS_RSTD2 = 53 * MiB;
constexpr size_t WS_SEL = 54 * MiB;
constexpr size_t WS_TOPI = 55 * MiB;
constexpr size_t WS_TOPG = 55 * MiB + 512 * 1024;
constexpr size_t WS_HIST = 56 * MiB;
constexpr size_t WS_DEST = 56 * MiB + 512 * 1024;
constexpr size_t WS_ROWTOK = 57 * MiB;
constexpr size_t WS_ROWRSTD = 57 * MiB + 512 * 1024;
constexpr size_t WS_BLKE = 58 * MiB;
constexpr size_t WS_H = 64 * MiB;
constexpr size_t WS_PROJ = 128 * MiB;
constexpr size_t WS_MIXED = 320 * MiB;
constexpr size_t WS_X1 = 384 * MiB;
constexpr size_t WS_U = 512 * MiB;
constexpr size_t WS_SJ = 544 * MiB;
constexpr size_t WS_KC = 560 * MiB;
constexpr size_t WS_VC = 592 * MiB;
constexpr size_t WS_WGU = 640 * MiB;
constexpr size_t WS_WD = 1152 * MiB;
constexpr size_t WS_ACT = 1408 * MiB;
constexpr size_t WS_Y = 1696 * MiB;
constexpr size_t WS_H8 = WS_ACT;
constexpr size_t WS_WIN8 = 8 * MiB;
constexpr int NPROJ8 = 0;
constexpr size_t WS_END = 1984 * MiB;

constexpr int NTHREADS = 512, NWAVES = 8;
constexpr int LDS_BYTES = 149504;
constexpr int LDS_MISC = LDS_BYTES - 256;

struct Params {
    const float* x; const float* attn_norm_w; const float* w_in; const float* gate_w2; const float* gate_b; const float* gla_norm_w;
    const float* w_out; const float* ffn_norm_w; const float* router_w; const float* router_b; const float* w_gu; const float* b_gu;
    const float* w_d; const float* b_d; const float* final_norm_w;
    float* out; unsigned char* ws;
};

__device__ __forceinline__ unsigned cvt_pk_bf16(float lo, float hi) { unsigned r; asm volatile("v_cvt_pk_bf16_f32 %0, %1, %2" : "=v"(r) : "v"(lo), "v"(hi)); return r; }
__device__ __forceinline__ unsigned cvt4_fp8(float a, float b, float c, float d) { unsigned w = 0u; w = __builtin_amdgcn_cvt_pk_fp8_f32(a, b, w, false); w = __builtin_amdgcn_cvt_pk_fp8_f32(c, d, w, true); return w; }
__device__ __forceinline__ float bf2f(unsigned short b) { return __uint_as_float(((unsigned)b) << 16); }
__device__ __forceinline__ float bflo(unsigned w) { return __uint_as_float(w << 16); }
__device__ __forceinline__ float bfhi(unsigned w) { return __uint_as_float(w & 0xffff0000u); }
__device__ __forceinline__ bf16x8 pack8(f32x4 a, f32x4 b) {
    u32x4 w = {cvt_pk_bf16(a[0], a[1]), cvt_pk_bf16(a[2], a[3]), cvt_pk_bf16(b[0], b[1]), cvt_pk_bf16(b[2], b[3])};
    return __builtin_bit_cast(bf16x8, w);
}
__device__ __forceinline__ float wave_sum(float v) {
#pragma unroll
    for (int o = 1; o < 64; o <<= 1) v += __shfl_xor(v, o);
    return v;
}
#define LDS_WAIT() asm volatile("s_waitcnt lgkmcnt(0)" ::: "memory")
#define VM_WAIT() asm volatile("s_waitcnt vmcnt(0)" ::: "memory")
#define SBAR() __builtin_amdgcn_sched_barrier(0)
#define XB_TMO      128
#define XB_XCNT(j)  (256  + 64 * (j))
#define XB_XSUB(j)  (1280 + 64 * (j))
#define XB_XGEN(j)  (2304 + 64 * (j))
#define XB_TOP      3328
#define XB_TOPGEN   3392
#define XCD_BAR_WORDS 3456
#define XB_SPIN_CAP (1u << 18)

__device__ __forceinline__ unsigned xb_ld(unsigned* p)              { return __hip_atomic_load(p, __ATOMIC_RELAXED, __HIP_MEMORY_SCOPE_AGENT); }
__device__ __forceinline__ unsigned xb_add(unsigned* p, unsigned v) { return __hip_atomic_fetch_add(p, v, __ATOMIC_RELAXED, __HIP_MEMORY_SCOPE_AGENT); }
__device__ __forceinline__ unsigned xb_xcc_id() { return (unsigned)__builtin_amdgcn_s_getreg((3 << 11) | 20) & 0xFu; }
#define XB_SPIN(cond, bar) do { unsigned _sp = 0; while (cond) { __builtin_amdgcn_s_sleep(1); \
    if ((++_sp & 255u) == 0u) { if (xb_ld(&(bar)[XB_TMO])) break; if (_sp > XB_SPIN_CAP) { atomicAdd(&(bar)[XB_TMO], 1u); break; } } } } while (0)

struct XcdBarrier {
    unsigned* bar; unsigned x;
    volatile LAS unsigned* st;
};

__device__ __forceinline__ XcdBarrier xcd_barrier_post(unsigned* bar, volatile LAS unsigned* st) {
    XcdBarrier b; b.bar = bar; b.x = xb_xcc_id(); b.st = st;
    if (threadIdx.x == 0) (void)xb_add(&bar[XB_XCNT(b.x)], 1u);
    return b;
}
__device__ __forceinline__ void xcd_barrier_complete(unsigned* bar, unsigned x, unsigned& nloc, unsigned& nx) {
    const unsigned G = gridDim.x * gridDim.y * gridDim.z;
    unsigned sum, cnt, mine, sp = 0u;
    for (;;) {
        sum = 0u; cnt = 0u; mine = 0u;
#pragma unroll
        for (unsigned j = 0; j < 16; ++j) { const unsigned c = xb_ld(&bar[XB_XCNT(j)]); sum += c; cnt += (c > 0u) ? 1u : 0u; mine = (j == x) ? c : mine; }
        if (sum == G) break;
        __builtin_amdgcn_s_sleep(1);
        if ((++sp & 255u) == 0u) { if (xb_ld(&bar[XB_TMO])) break; if (sp > XB_SPIN_CAP) { atomicAdd(&bar[XB_TMO], 1u); break; } }
    }
    nloc = mine > 0u ? mine : 1u; nx = cnt > 0u ? cnt : 1u;
}

__device__ __forceinline__ void xcd_barrier(const XcdBarrier& b) {
    asm volatile("s_waitcnt vmcnt(0)" ::: "memory");
    __syncthreads();
    if (threadIdx.x == 0) {
        unsigned* bar = b.bar;
        __builtin_amdgcn_s_waitcnt(0);
        unsigned nloc = b.st[0], nx = b.st[1];
        if (nloc == 0u) { xcd_barrier_complete(bar, b.x, nloc, nx); b.st[0] = nloc; b.st[1] = nx; }
        const unsigned old = xb_add(&bar[XB_XSUB(b.x)], 1u);
        const unsigned gen = old / nloc;
        if (old + 1u == (gen + 1u) * nloc) {
            __builtin_amdgcn_fence(__ATOMIC_RELEASE, "agent");
            asm volatile("s_waitcnt vmcnt(0)" ::: "memory");
            const unsigned og = xb_add(&bar[XB_TOP], 1u);
            const unsigned tg = og / nx;
            if (og + 1u == (tg + 1u) * nx) xb_add(&bar[XB_TOPGEN], 1u);
            else XB_SPIN(xb_ld(&bar[XB_TOPGEN]) == tg, bar);
            __builtin_amdgcn_fence(__ATOMIC_ACQUIRE, "agent");
            xb_add(&bar[XB_XGEN(b.x)], 1u);
            asm volatile("s_waitcnt vmcnt(0)" ::: "memory");
        } else {
            XB_SPIN(xb_ld(&bar[XB_XGEN(b.x)]) == gen, bar);
            __builtin_amdgcn_fence(__ATOMIC_ACQUIRE, "agent");
            asm volatile("s_waitcnt vmcnt(0)" ::: "memory");
        }
    }
    __syncthreads();
}

namespace g8 {
constexpr int BM = 256, BK = 64, HALF = 128, HTB = HALF * BK * 2, STAGE_BYTES = 8 * HTB, NXCD = 8, WGM = 8;
__host__ __device__ __forceinline__ int lds_byte(int r, int c) { const int st = (r >> 4) * 2 + (c >> 5), rr = r & 15, cc = c & 31, ob = rr * 64 + cc * 2; return st * 1024 + (ob ^ (((ob >> 9) & 1) << 5)); }
__host__ __device__ __forceinline__ void stage_rc(int b, int& R, int& C) { const int st = b / 1024, sb = b % 1024, swz = sb ^ (((sb >> 9) & 1) << 5); R = (st >> 1) * 16 + swz / 64; C = (st & 1) * 32 + (swz % 64) / 2; }
__host__ __device__ __forceinline__ int perm32(int rho) { const int n = rho >> 4, i = rho & 15; return 8 * (i >> 2) + 4 * n + (i & 3); }

struct Unit { int pm, pn, e; };

__device__ __forceinline__ bool static_next(int i, int nM, int nN, int G, int c, Unit& u) {
    const int nwg = nM * nN; const long L = (long)i * G + c; if (L >= nwg) return false;
    int wgid = (int)L; { const int q = nwg / NXCD, r = nwg % NXCD, xcd = wgid % NXCD, off = wgid / NXCD; wgid = (xcd < r ? xcd * (q + 1) : r * (q + 1) + (xcd - r) * q) + off; }
    const int nig = WGM * nN, gid = wgid / nig, fm = gid * WGM, gsz = (nM - fm) < WGM ? (nM - fm) : WGM;
    u.pm = fm + ((wgid % nig) % gsz); u.pn = (wgid % nig) / gsz; u.e = 0; return true;
}

template <class Prob, class Epi>
__device__ __forceinline__ void gemm_phase(LAS unsigned char* lds, const Prob& P, const Epi& E) {
    int tid = threadIdx.x; asm volatile("" : "+v"(tid));
    const int wid = __builtin_amdgcn_readfirstlane(tid >> 6), lane = tid & 63, wr = wid >> 2, wc = wid & 3, fr = lane & 15, fq = lane >> 4;
    const int K = P.K, nt = K / BK;
    int RA[2], CA[2]; unsigned voffB[2];
#pragma unroll
    for (int i = 0; i < 2; ++i) { int R, C; stage_rc(tid * 16 + i * 8192, R, C); const int Rb = Epi::PERM ? ((R & ~31) + perm32(R & 31)) : R;
        RA[i] = R; CA[i] = C; voffB[i] = (unsigned)(Rb * K + C) * 2u; }
    const size_t kstep = (size_t)(BK * 2);
    const size_t hstep = (size_t)HALF * K * 2;
    const unsigned ldsw = (unsigned)wid * 1024u;
    const int aoff = lds_byte(wr * 64 + fr, fq * 8), boff = lds_byte(wc * 32 + fr, fq * 8);
#define G8_SA(b, h) (((b) * 2 + (h)) * HTB)
#define G8_SB(b, h) ((4 + (b) * 2 + (h)) * HTB)
#define G8_STAGE_B(bufoff, gbase) do { _Pragma("unroll") for (int _i = 0; _i < 2; ++_i) \
        __builtin_amdgcn_global_load_lds((const unsigned*)((const char*)(gbase) + voffB[_i]), (LAS unsigned*)(lds + (bufoff) + ldsw + _i * 8192), 16, 0, 0); } while (0)
#define G8_STAGE_A(bufoff, o0, o1) do { \
        __builtin_amdgcn_global_load_lds((const unsigned*)(Ab + (o0)), (LAS unsigned*)(lds + (bufoff) + ldsw), 16, 0, 0); \
        __builtin_amdgcn_global_load_lds((const unsigned*)(Ab + (o1)), (LAS unsigned*)(lds + (bufoff) + ldsw + 8192), 16, 0, 0); } while (0)
#define G8_CAT(lo, hi) __builtin_bit_cast(i32x8, __builtin_shufflevector(lo, hi, 0, 1, 2, 3, 4, 5, 6, 7))
#define G8_LO(v) __builtin_bit_cast(bf16x8, __builtin_shufflevector(v, v, 0, 1, 2, 3))
#define G8_HI(v) __builtin_bit_cast(bf16x8, __builtin_shufflevector(v, v, 4, 5, 6, 7))
#define G8_LDA(dst, b, h) do { _Pragma("unroll") for (int m = 0; m < 4; ++m) { const u32x4 _l = *(const LAS u32x4*)(lds + G8_SA(b, h) + aoff + m * 2048), _h = *(const LAS u32x4*)(lds + G8_SA(b, h) + aoff + m * 2048 + 1024); dst[m] = G8_CAT(_l, _h); } } while (0)
#define G8_LDB(dst, b, h) do { _Pragma("unroll") for (int n = 0; n < 2; ++n) { const u32x4 _l = *(const LAS u32x4*)(lds + G8_SB(b, h) + boff + n * 2048), _h = *(const LAS u32x4*)(lds + G8_SB(b, h) + boff + n * 2048 + 1024); dst[n] = G8_CAT(_l, _h); } } while (0)
#define G8_MMA(ai, bj, At, Bt) do { __builtin_amdgcn_s_setprio(1); \
        if constexpr (Prob::FP8) { _Pragma("unroll") for (int m = 0; m < 4; ++m) _Pragma("unroll") for (int n = 0; n < 2; ++n) \
            asm volatile("v_mfma_scale_f32_16x16x128_f8f6f4 %0, %1, %2, %0, %3, %3 op_sel_hi:[0,0,0]" : "+v"(acc[ai][bj][m][n]) : "v"(Bt[n]), "v"(At[m]), "v"(f8scale)); } \
        else { _Pragma("unroll") for (int m = 0; m < 4; ++m) _Pragma("unroll") for (int n = 0; n < 2; ++n) { \
            acc[ai][bj][m][n] = __builtin_amdgcn_mfma_f32_16x16x32_bf16(G8_LO(Bt[n]), G8_LO(At[m]), acc[ai][bj][m][n], 0, 0, 0); \
            acc[ai][bj][m][n] = __builtin_amdgcn_mfma_f32_16x16x32_bf16(G8_HI(Bt[n]), G8_HI(At[m]), acc[ai][bj][m][n], 0, 0, 0); } } \
        __builtin_amdgcn_s_setprio(0); } while (0)
#define G8_WAIT_V(n) asm volatile("s_waitcnt vmcnt(" #n ")" ::: "memory")
#define G8_WAIT_L(n) asm volatile("s_waitcnt lgkmcnt(" #n ")" ::: "memory")
#define G8_BAR __builtin_amdgcn_s_barrier()
#define G8_SCHED __builtin_amdgcn_sched_barrier(0)
    Unit cur, nxt, nn; int ui = 0;
    if (!P.next(0, cur)) return;
    const int f8scale = 0x7f7f7f7f;
    f32x4 acc[2][2][4][2];
#pragma unroll
    for (int a = 0; a < 2; ++a)
#pragma unroll
        for (int b = 0; b < 2; ++b)
#pragma unroll
            for (int m = 0; m < 4; ++m)
#pragma unroll
                for (int n = 0; n < 2; ++n) acc[a][b][m][n] = (f32x4){0.f, 0.f, 0.f, 0.f};
    i32x8 At[4], B0[2], B1[2];
    const char* Ab = (const char*)P.a_base();
    unsigned aoc[2][2], aon[2][2]; int raw[2][2];
    P.a_fetch(cur, RA, raw); P.a_finish(raw, CA, aoc);
    bool has_next = P.next(1, nxt);
    if (has_next) { P.a_fetch(nxt, RA, raw); P.a_finish(raw, CA, aon); }
    else { aon[0][0] = aoc[0][0]; aon[0][1] = aoc[0][1]; aon[1][0] = aoc[1][0]; aon[1][1] = aoc[1][1]; }
    const char* cB = (const char*)P.b_ptr(cur);
    const char* nB = has_next ? (const char*)P.b_ptr(nxt) : cB;
    typename Epi::Pre pre = E.fetch(cur, wr, wc, fr, fq);
    G8_STAGE_B(G8_SB(0, 0), cB); G8_STAGE_B(G8_SB(0, 1), cB + hstep); G8_STAGE_A(G8_SA(0, 0), aoc[0][0], aoc[0][1]); G8_STAGE_A(G8_SA(0, 1), aoc[1][0], aoc[1][1]);
    if (wr == 1) G8_BAR;
    G8_WAIT_V(2); G8_BAR;
    G8_STAGE_B(G8_SB(1, 0), cB + kstep); G8_STAGE_A(G8_SA(1, 0), aoc[0][0] + 128u, aoc[0][1] + 128u); G8_STAGE_B(G8_SB(1, 1), cB + hstep + kstep);
    G8_WAIT_V(6); G8_BAR;
    for (;;) {
        for (int t = 0; t < nt; t += 2) {
            const bool last = (t == nt - 2);
            const unsigned k1 = (unsigned)(t + 1) * 128u;
            const unsigned k2 = last ? 0u : (unsigned)(t + 2) * 128u;
            const unsigned a2_00 = (last ? aon[0][0] : aoc[0][0]) + k2, a2_01 = (last ? aon[0][1] : aoc[0][1]) + k2;
            const unsigned a2_10 = (last ? aon[1][0] : aoc[1][0]) + k2, a2_11 = (last ? aon[1][1] : aoc[1][1]) + k2;
            const char* b2 = last ? nB : cB + (size_t)(t + 2) * kstep;
            const char* b3 = b2 + kstep;
            G8_LDB(B0, 0, 0); G8_LDB(B1, 0, 1); G8_SCHED; G8_LDA(At, 0, 0); G8_STAGE_A(G8_SA(1, 1), aoc[1][0] + k1, aoc[1][1] + k1);
            G8_WAIT_V(8); G8_WAIT_L(0); G8_BAR; G8_MMA(0, 0, At, B0); G8_MMA(0, 1, At, B1); G8_BAR; G8_SCHED;
            G8_LDA(At, 0, 1); G8_STAGE_B(G8_SB(0, 0), b2); G8_STAGE_B(G8_SB(0, 1), b2 + hstep); G8_STAGE_A(G8_SA(0, 0), a2_00, a2_01);
            G8_WAIT_V(8); G8_WAIT_L(0); G8_BAR; G8_MMA(1, 0, At, B0); G8_MMA(1, 1, At, B1); G8_BAR; G8_SCHED;
            G8_LDB(B0, 1, 0); G8_LDB(B1, 1, 1); G8_SCHED; G8_LDA(At, 1, 0); G8_STAGE_A(G8_SA(0, 1), a2_10, a2_11);
            G8_WAIT_V(8); G8_WAIT_L(0); G8_BAR; G8_MMA(0, 0, At, B0); G8_MMA(0, 1, At, B1); G8_BAR; G8_SCHED;
            G8_LDA(At, 1, 1); G8_STAGE_B(G8_SB(1, 0), b3); G8_STAGE_B(G8_SB(1, 1), b3 + hstep); G8_STAGE_A(G8_SA(1, 0), a2_00 + 128u, a2_01 + 128u);
            G8_WAIT_V(8); G8_WAIT_L(0); G8_BAR; G8_MMA(1, 0, At, B0); G8_MMA(1, 1, At, B1); G8_BAR; G8_SCHED;
        }
        if (wr == 0) G8_BAR;
        if constexpr (Prob::FP8) asm volatile("s_nop 15\n\ts_nop 15" ::: "memory");
        const bool has_nn = has_next && P.next(ui + 2, nn);
        if (has_nn) P.a_fetch(nn, RA, raw);
        typename Epi::Pre pren = pre; if (has_next) pren = E.fetch(nxt, wr, wc, fr, fq);
        E(acc, cur, pre, wr, wc, fr, fq); pre = pren;
        if (!has_next) break;
#pragma unroll
        for (int a = 0; a < 2; ++a)
#pragma unroll
            for (int b = 0; b < 2; ++b)
#pragma unroll
                for (int m = 0; m < 4; ++m)
#pragma unroll
                    for (int n = 0; n < 2; ++n) acc[a][b][m][n] = (f32x4){0.f, 0.f, 0.f, 0.f};
        cur = nxt; cB = nB; ++ui;
        aoc[0][0] = aon[0][0]; aoc[0][1] = aon[0][1]; aoc[1][0] = aon[1][0]; aoc[1][1] = aon[1][1];
        nxt = nn; has_next = has_nn;
        if (has_next) { P.a_finish(raw, CA, aon); nB = (const char*)P.b_ptr(nxt); }
        else { nB = cB; }
        if (wr == 1) G8_BAR;
    }
    G8_WAIT_V(0);
    G8_BAR;
#undef G8_SA
#undef G8_SB
#undef G8_STAGE_A
#undef G8_STAGE_B
#undef G8_LDA
#undef G8_LDB
#undef G8_MMA
#undef G8_CAT
#undef G8_LO
#undef G8_HI
#undef G8_WAIT_V
#undef G8_WAIT_L
#undef G8_BAR
#undef G8_SCHED
}
}
namespace g8 {
template <bool F8> struct DenseProbT {
    static constexpr bool FP8 = F8;
    const bf16_t* A; const bf16_t* Bt; int nM, nN, K, G, c, i0, i1;
    __device__ __forceinline__ bool next(int i, Unit& u) const { return (i0 + i < i1) && static_next(i0 + i, nM, nN, G, c, u); }
    __device__ __forceinline__ const void* a_base() const { return A; }
    __device__ __forceinline__ void a_fetch(const Unit& u, const int (&RA)[2], int (&raw)[2][2]) const {
#pragma unroll
        for (int h = 0; h < 2; ++h)
#pragma unroll
            for (int i = 0; i < 2; ++i) raw[h][i] = u.pm * BM + h * HALF + RA[i];
    }
    __device__ __forceinline__ void a_finish(const int (&raw)[2][2], const int (&CA)[2], unsigned (&ao)[2][2]) const {
#pragma unroll
        for (int h = 0; h < 2; ++h)
#pragma unroll
            for (int i = 0; i < 2; ++i) ao[h][i] = (unsigned)((raw[h][i] * K + CA[i]) * 2);
    }
    __device__ __forceinline__ const void* b_ptr(const Unit& u) const { return Bt + (size_t)u.pn * BM * K; }
};
typedef DenseProbT<false> DenseProb;
struct MoeProb1 {
    static constexpr bool FP8 = true;
    const bf16_t* A; const bf16_t* Bt; const int* row_tok; const int* blk; int K; int nM; int i0, i1;
    __device__ __forceinline__ bool next(int i, Unit& u) const {
        if (i0 + i >= i1 || !static_next(i0 + i, nM, 2 * FF / BM, gridDim.x, blockIdx.x, u)) return false;
        u.e = blk[64 + u.pm]; return true; }
    __device__ __forceinline__ const void* a_base() const { return A; }
    __device__ __forceinline__ void a_fetch(const Unit& u, const int (&RA)[2], int (&raw)[2][2]) const {
#pragma unroll
        for (int h = 0; h < 2; ++h)
#pragma unroll
            for (int i = 0; i < 2; ++i) raw[h][i] = row_tok[u.pm * BM + h * HALF + RA[i]];
    }
    __device__ __forceinline__ void a_finish(const int (&raw)[2][2], const int (&CA)[2], unsigned (&ao)[2][2]) const {
#pragma unroll
        for (int h = 0; h < 2; ++h)
#pragma unroll
            for (int i = 0; i < 2; ++i) ao[h][i] = (unsigned)((raw[h][i] * K + CA[i]) * 2);
    }
    __device__ __forceinline__ const void* b_ptr(const Unit& u) const { return Bt + ((size_t)__builtin_amdgcn_readfirstlane(u.e) * (2 * FF) + (size_t)u.pn * BM) * K; }
};
struct MoeProb2 {
    static constexpr bool FP8 = true;
    const bf16_t* A; const bf16_t* Bt; const int* blk; int K; int nM;
    __device__ __forceinline__ bool next(int i, Unit& u) const {
        if (!static_next(i, nM, DM / BM, gridDim.x, blockIdx.x, u)) return false;
        u.e = blk[64 + u.pm]; return true; }
    __device__ __forceinline__ const void* a_base() const { return A; }
    __device__ __forceinline__ void a_fetch(const Unit& u, const int (&RA)[2], int (&raw)[2][2]) const {
#pragma unroll
        for (int h = 0; h < 2; ++h)
#pragma unroll
            for (int i = 0; i < 2; ++i) raw[h][i] = u.pm * BM + h * HALF + RA[i];
    }
    __device__ __forceinline__ void a_finish(const int (&raw)[2][2], const int (&CA)[2], unsigned (&ao)[2][2]) const {
#pragma unroll
        for (int h = 0; h < 2; ++h)
#pragma unroll
            for (int i = 0; i < 2; ++i) ao[h][i] = (unsigned)((raw[h][i] * K + CA[i]) * 2);
    }
    __device__ __forceinline__ const void* b_ptr(const Unit& u) const { return Bt + ((size_t)__builtin_amdgcn_readfirstlane(u.e) * DM + (size_t)u.pn * BM) * K; }
};

struct EpiProj {
    static constexpr bool PERM = true;
    bf16_t* __restrict__ O; const float* __restrict__ rstd; float scale; int colbase;
    struct Pre { float rs[2][4]; };
    __device__ __forceinline__ Pre fetch(const Unit& u, int wr, int wc, int fr, int fq) const {
        Pre q; const int row0 = u.pm * BM + wr * 64 + fr;
#pragma unroll
        for (int ai = 0; ai < 2; ++ai)
#pragma unroll
            for (int m = 0; m < 4; ++m) q.rs[ai][m] = rstd[row0 + ai * HALF + m * 16];
        return q; }
    __device__ __forceinline__ void operator()(const f32x4 (&acc)[2][2][4][2], const Unit& u, const Pre& q, int wr, int wc, int fr, int fq) const {
        const int row0 = u.pm * BM + wr * 64 + fr, col0 = colbase + u.pn * BM + wc * 32 + 8 * fq;
#pragma unroll
        for (int ai = 0; ai < 2; ++ai)
#pragma unroll
            for (int m = 0; m < 4; ++m) { const int row = row0 + ai * HALF + m * 16; bf16_t* rowp = O + (size_t)row * NPROJ + col0; const float rsc = q.rs[ai][m] * scale;
#pragma unroll
                for (int bj = 0; bj < 2; ++bj) { const f32x4 v0 = acc[ai][bj][m][0] * rsc, v1 = acc[ai][bj][m][1] * rsc;
                    u32x4 w; w.x = cvt_pk_bf16(v0[0], v0[1]); w.y = cvt_pk_bf16(v0[2], v0[3]); w.z = cvt_pk_bf16(v1[0], v1[1]); w.w = cvt_pk_bf16(v1[2], v1[3]);
                    *(u32x4*)(rowp + bj * HALF) = w; } }
    }
};
struct EpiX1 {
    static constexpr bool PERM = false;
    const float* __restrict__ X; float* __restrict__ O;
    struct Pre {};
    __device__ __forceinline__ Pre fetch(const Unit&, int, int, int, int) const { return Pre{}; }
    __device__ __forceinline__ void operator()(const f32x4 (&acc)[2][2][4][2], const Unit& u, const Pre&, int wr, int wc, int fr, int fq) const {
        const int row0 = u.pm * BM + wr * 64 + fr, col0 = u.pn * BM + wc * 32 + 4 * fq;
#pragma unroll
        for (int ai = 0; ai < 2; ++ai) {
            f32x4 xv[4][2][2];
#pragma unroll
            for (int m = 0; m < 4; ++m) { const size_t off = (size_t)(row0 + ai * HALF + m * 16) * DM + col0;
#pragma unroll
                for (int bj = 0; bj < 2; ++bj)
#pragma unroll
                    for (int n = 0; n < 2; ++n) xv[m][bj][n] = __builtin_nontemporal_load((const f32x4*)(X + off + bj * HALF + n * 16)); }
#pragma unroll
            for (int m = 0; m < 4; ++m) { const size_t off = (size_t)(row0 + ai * HALF + m * 16) * DM + col0;
#pragma unroll
                for (int bj = 0; bj < 2; ++bj)
#pragma unroll
                    for (int n = 0; n < 2; ++n) *(f32x4*)(O + off + bj * HALF + n * 16) = xv[m][bj][n] + acc[ai][bj][m][n]; }
        }
    }
};
struct EpiSwiglu {
    static constexpr bool PERM = true;
    unsigned char* __restrict__ O; const float* __restrict__ row_rstd; const float* __restrict__ bgu;
    struct Pre { float rsv[2][4]; };
    __device__ __forceinline__ Pre fetch(const Unit& u, int wr, int wc, int fr, int fq) const {
        Pre q; const int row0 = u.pm * BM + wr * 64 + fr;
#pragma unroll
        for (int ai = 0; ai < 2; ++ai)
#pragma unroll
            for (int m = 0; m < 4; ++m) q.rsv[ai][m] = row_rstd[row0 + ai * HALF + m * 16];
        return q; }
    __device__ __forceinline__ void operator()(const f32x4 (&acc)[2][2][4][2], const Unit& u, const Pre& q, int wr, int wc, int fr, int fq) const {
        const int row0 = u.pm * BM + wr * 64 + fr, colg = u.pn * HALF + wc * 32 + 8 * fq;
        const float* bg = bgu + (size_t)__builtin_amdgcn_readfirstlane(u.e) * (2 * FF) + colg; const float* bu = bg + FF;
        const f32x4 bg0 = *(const f32x4*)bg, bg1 = *(const f32x4*)(bg + 4), bu0 = *(const f32x4*)bu, bu1 = *(const f32x4*)(bu + 4);
#pragma unroll
        for (int ai = 0; ai < 2; ++ai)
#pragma unroll
            for (int m = 0; m < 4; ++m) { const int row = row0 + ai * HALF + m * 16; const float rs = q.rsv[ai][m] * F8_UNSCALE;
                f32x4 g0 = acc[ai][0][m][0] * rs + bg0, g1 = acc[ai][0][m][1] * rs + bg1, u0 = acc[ai][1][m][0] * rs + bu0, u1 = acc[ai][1][m][1] * rs + bu1;
                float o[8];
#pragma unroll
                for (int j = 0; j < 8; ++j) { float g = j < 4 ? g0[j] : g1[j - 4], uu = j < 4 ? u0[j] : u1[j - 4];
                    g = fminf(g, 7.0f); uu = __builtin_amdgcn_fmed3f(uu, -7.0f, 7.0f);
                    const float sg = __builtin_amdgcn_rcpf(1.0f + __builtin_amdgcn_exp2f(g * (-1.702f * 1.4426950408889634f)));
                    o[j] = (uu * ACT_SCALE + ACT_SCALE) * (g * sg); }
                u32x2 w; w.x = cvt4_fp8(o[0], o[1], o[2], o[3]); w.y = cvt4_fp8(o[4], o[5], o[6], o[7]);
                *(u32x2*)(O + (size_t)row * FF + colg) = w; }
    }
};
struct EpiDown {
    static constexpr bool PERM = true;
    unsigned char* __restrict__ O; const float* __restrict__ bd;
    struct Pre { f32x4 bv[2][2]; };
    __device__ __forceinline__ Pre fetch(const Unit& u, int wr, int wc, int fr, int fq) const {
        Pre q; const int col0 = u.pn * BM + wc * 32 + 8 * fq;
        const float* bp = bd + (size_t)__builtin_amdgcn_readfirstlane(u.e) * DM + col0;
#pragma unroll
        for (int bj = 0; bj < 2; ++bj)
#pragma unroll
            for (int n = 0; n < 2; ++n) q.bv[bj][n] = *(const f32x4*)(bp + bj * HALF + 4 * n) * Y_SCALE;
        return q; }
    __device__ __forceinline__ void operator()(const f32x4 (&acc)[2][2][4][2], const Unit& u, const Pre& q, int wr, int wc, int fr, int fq) const {
        const int row0 = u.pm * BM + wr * 64 + fr, col0 = u.pn * BM + wc * 32 + 8 * fq;
#pragma unroll
        for (int ai = 0; ai < 2; ++ai)
#pragma unroll
            for (int m = 0; m < 4; ++m) { unsigned char* rowp = O + (size_t)(row0 + ai * HALF + m * 16) * DM + col0;
#pragma unroll
                for (int bj = 0; bj < 2; ++bj) { const f32x4 v0 = acc[ai][bj][m][0] * (F8_UNSCALE * Y_SCALE) + q.bv[bj][0], v1 = acc[ai][bj][m][1] * (F8_UNSCALE * Y_SCALE) + q.bv[bj][1];
                    u32x2 w; w.x = cvt4_fp8(v0[0], v0[1], v0[2], v0[3]); w.y = cvt4_fp8(v1[0], v1[1], v1[2], v1[3]);
                    *(u32x2*)(rowp + bj * HALF) = w; } }
    }
};
}
struct Ctx { LAS unsigned char* lds; int tid, lane, wave; };
__device__ __forceinline__ Ctx fresh_ctx(const Ctx& c0) { Ctx c; c.lds = c0.lds; int t = threadIdx.x; asm volatile("" : "+v"(t)); c.tid = t; c.lane = t & 63; c.wave = __builtin_amdgcn_readfirstlane(t >> 6); return c; }

__device__ __forceinline__ void transpose_item(const float* W, int ld, int K, int k0, int n0, bf16_t* WT_row0  , LAS float* scr, int lane) {
    float tv[32];
#pragma unroll
    for (int i = 0; i < 32; ++i) { const int kk = 2 * i + (lane >> 5); tv[i] = __builtin_nontemporal_load(W + (size_t)(k0 + kk) * ld + n0 + (lane & 31)); }
#pragma unroll
    for (int i = 0; i < 32; ++i) { const int kk = 2 * i + (lane >> 5); scr[kk * 33 + (lane & 31)] = tv[i]; }
    LDS_WAIT(); asm volatile("" ::: "memory");
    const int c = lane & 7;
#pragma unroll
    for (int j = 0; j < 4; ++j) { const int n = (lane >> 3) + 8 * j; const LAS float* s = scr + (8 * c) * 33 + n;
        u32x4 o; o.x = cvt_pk_bf16(s[0 * 33], s[1 * 33]); o.y = cvt_pk_bf16(s[2 * 33], s[3 * 33]); o.z = cvt_pk_bf16(s[4 * 33], s[5 * 33]); o.w = cvt_pk_bf16(s[6 * 33], s[7 * 33]);
        *(u32x4*)(WT_row0 + (size_t)n * K + k0 + 8 * c) = o; }
    LDS_WAIT(); asm volatile("" ::: "memory");
}
struct ConvItem { const float* src; unsigned char* dst; int ld; };
constexpr int CV_KB8 = DM / 128, CV_GU1 = CV_KB8 * (2 * FF / 32), CV_D1 = CV_KB8 * (DM / 32), CV_GU = NE * CV_GU1, CV_D = NE * CV_D1, CV_TOTAL = CV_GU + CV_D;
constexpr int CV_IN8 = CV_KB8 * (NPROJ8 / 32);
constexpr int CV_EARLY = CV_TOTAL / 4;
__device__ __forceinline__ ConvItem conv_decode(const Params& p, int r) {
    ConvItem it;
    if (r < CV_GU) { const int e = r / CV_GU1, q = r % CV_GU1, nb = q % (2 * FF / 32), kb = q / (2 * FF / 32); const int n0 = 32 * nb;
        const int nn = n0 < FF ? n0 : n0 - FF; const int orow = 256 * (nn / 128) + (nn % 128) + (n0 < FF ? 0 : 128);
        it.src = p.w_gu + (size_t)e * DM * (2 * FF) + (size_t)(128 * kb) * (2 * FF) + n0; it.ld = 2 * FF;
        it.dst = (unsigned char*)(p.ws + WS_WGU) + ((size_t)e * (2 * FF) + orow) * DM + 128 * kb; }
    else if (r >= CV_TOTAL) { r -= CV_TOTAL; const int nb = r % (NPROJ8 / 32), kb = r / (NPROJ8 / 32);
        it.src = p.w_in + (size_t)(128 * kb) * LDW_IN + 32 * nb; it.ld = LDW_IN;
        it.dst = (unsigned char*)(p.ws + WS_WIN8) + (size_t)(32 * nb) * DM + 128 * kb; }
    else { r -= CV_GU; const int e = r / CV_D1, q = r % CV_D1, nb = q % (DM / 32), kb = q / (DM / 32);
        it.src = p.w_d + (size_t)e * FF * DM + (size_t)(128 * kb) * DM + 32 * nb; it.ld = DM;
        it.dst = (unsigned char*)(p.ws + WS_WD) + ((size_t)e * DM + 32 * nb) * FF + 128 * kb; }
    return it;
}
__device__ __forceinline__ void conv_load(const ConvItem& it, f32x4 (&tv)[16], int lane) {
    const float* s = it.src + (size_t)((lane >> 3) * 8) * it.ld + (lane & 7) * 4;
#pragma unroll
    for (int a = 0; a < 2; ++a)
#pragma unroll
        for (int b = 0; b < 8; ++b) tv[8 * a + b] = __builtin_nontemporal_load((const f32x4*)(s + (size_t)(64 * a + b) * it.ld));
}
__device__ __forceinline__ void conv_store(const ConvItem& it, const f32x4 (&tv)[16], LAS float*, int lane) {
    unsigned char* d = it.dst + (size_t)((lane & 7) * 4) * DM + (lane >> 3) * 8;
#pragma unroll
    for (int a = 0; a < 2; ++a)
#pragma unroll
        for (int i = 0; i < 4; ++i) { u32x2 o;
            o.x = cvt4_fp8(tv[8 * a + 0][i] * W_SCALE, tv[8 * a + 1][i] * W_SCALE, tv[8 * a + 2][i] * W_SCALE, tv[8 * a + 3][i] * W_SCALE);
            o.y = cvt4_fp8(tv[8 * a + 4][i] * W_SCALE, tv[8 * a + 5][i] * W_SCALE, tv[8 * a + 6][i] * W_SCALE, tv[8 * a + 7][i] * W_SCALE);
            *(u32x2*)(d + (size_t)i * DM + 64 * a) = o; }
}
__device__ __forceinline__ void conv_range(const Params& p, int lo, int hi, int w, int nw, LAS float* scr, int lane) {
    for (int it = lo + w; it < hi; it += 2 * nw) {
        const int i1 = it + nw < hi ? it + nw : it;
        f32x4 ta[16], tb[16];
        const ConvItem A = conv_decode(p, it), B = conv_decode(p, i1);
        conv_load(A, ta, lane); conv_load(B, tb, lane);
        __builtin_amdgcn_sched_barrier(0);
        conv_store(A, ta, scr, lane); conv_store(B, tb, scr, lane);
        __builtin_amdgcn_sched_barrier(0);
    }
}
__device__ __forceinline__ void phase_convert(const Params& p, const Ctx& c0) { const Ctx c = fresh_ctx(c0);
    LAS float* scr = (LAS float*)(c.lds + c.wave * 18432);
    const int gw = blockIdx.x * NWAVES + c.wave, NGW = gridDim.x * NWAVES;
    bf16_t* WinT = (bf16_t*)(p.ws + WS_WIN); bf16_t* WoutT = (bf16_t*)(p.ws + WS_WOUT);
    constexpr int KB = DM / 64;
    constexpr int I_IN = KB * ((NPROJ - NPROJ8) / 32), I_OUT = KB * (DM / 32), NITEMS = I_IN + I_OUT;
    for (int it = gw; it < NITEMS; it += NGW) {
        int r = it;
        if (r < I_IN) { const int nb = r % ((NPROJ - NPROJ8) / 32), kb = r / ((NPROJ - NPROJ8) / 32); transpose_item(p.w_in, LDW_IN, DM, 64 * kb, NPROJ8 + 32 * nb, WinT + (size_t)(NPROJ8 + 32 * nb) * DM, scr, c.lane); continue; } r -= I_IN;
        { const int nb = r % (DM / 32), kb = r / (DM / 32); transpose_item(p.w_out, DM, DM, 64 * kb, 32 * nb, WoutT + (size_t)(32 * nb) * DM, scr, c.lane); }
    }
    conv_range(p, CV_TOTAL, CV_TOTAL + CV_IN8, gw, NGW, scr, c.lane);
    float* rc = (float*)(p.ws + WS_ROPE); float* rs = rc + SEQ * 64;
    for (int i = blockIdx.x * NTHREADS + c.tid; i < SEQ * 64; i += gridDim.x * NTHREADS) {
        const int pos = i >> 6, j = i & 63;
        const float inv = 1.0f / powf(10000.0f, (float)(2 * j) / 128.0f);
        const float ang = (float)pos * inv; float sn, cs; sincosf(ang, &sn, &cs); rc[i] = cs; rs[i] = sn; }
}
constexpr int CT_GU1 = (DM / 128) * (2 * FF / 256), CT_D1 = (FF / 128) * (DM / 256), CT_GU = NE * CT_GU1, CT_D = NE * CT_D1, CT_TOTAL = CT_GU + CT_D;
struct ConvTile { const float* src; unsigned char* dst; int ld; int gu; };
__device__ __forceinline__ ConvTile ctile_decode(const Params& p, int r) {
    ConvTile t;
    if (r < CT_GU) { const int e = r / CT_GU1, q = r % CT_GU1, nt = q % (2 * FF / 256), kt = q / (2 * FF / 256);
        t.src = p.w_gu + (size_t)e * DM * (2 * FF) + (size_t)(128 * kt) * (2 * FF) + 256 * nt; t.ld = 2 * FF; t.gu = 256 * nt;
        t.dst = (unsigned char*)(p.ws + WS_WGU) + (size_t)e * (2 * FF) * DM + 128 * kt; }
    else { r -= CT_GU; const int e = r / CT_D1, q = r % CT_D1, nt = q % (DM / 256), kt = q / (DM / 256);
        t.src = p.w_d + (size_t)e * FF * DM + (size_t)(128 * kt) * DM + 256 * nt; t.ld = DM; t.gu = -1;
        t.dst = (unsigned char*)(p.ws + WS_WD) + ((size_t)e * DM + 256 * nt) * FF + 128 * kt; }
    return t;
}
__device__ __forceinline__ void ctile_load(const ConvTile& t, f32x4 (&tv)[16], int wave, int lane) {
    const float* s = t.src + (size_t)(16 * wave) * t.ld + 4 * lane;
#pragma unroll
    for (int i = 0; i < 16; ++i) tv[i] = __builtin_nontemporal_load((const f32x4*)(s + (size_t)i * t.ld));
}
__device__ __forceinline__ void ctile_store(const ConvTile& t, const f32x4 (&tv)[16], LAS unsigned char* lds, int tid, int wave, int lane) {
#pragma unroll
    for (int c = 0; c < 4; ++c) { u32x4 o;
#pragma unroll
        for (int q = 0; q < 4; ++q) o[q] = cvt4_fp8(tv[4 * q][c] * W_SCALE, tv[4 * q + 1][c] * W_SCALE, tv[4 * q + 2][c] * W_SCALE, tv[4 * q + 3][c] * W_SCALE);
        const int n = 4 * lane + c; *(LAS u32x4*)(lds + n * 128 + ((wave ^ (lane & 7)) << 4)) = o; }
    __syncthreads();
#pragma unroll
    for (int j = 0; j < 4; ++j) { const int n = 64 * j + (tid >> 3), ch = tid & 7;
        const u32x4 o = *(const LAS u32x4*)(lds + n * 128 + ((ch ^ ((n >> 2) & 7)) << 4));
        int orow = n;
        if (t.gu >= 0) { const int ng = t.gu + n; const int nn = ng < FF ? ng : ng - FF; orow = 256 * (nn / 128) + (nn % 128) + (ng < FF ? 0 : 128); }
        *(u32x4*)(t.dst + (size_t)orow * DM + 16 * ch) = o; }
    __syncthreads();
}
__device__ __forceinline__ void phase_convert_share(const Params& p, const Ctx& c0, int lo, int hi, int G, int w) { const Ctx c = fresh_ctx(c0);
    for (int it = lo + w; it < hi; it += 2 * G) {
        const int i1 = it + G < hi ? it + G : it;
        f32x4 ta[16], tb[16];
        const ConvTile A = ctile_decode(p, it), B = ctile_decode(p, i1);
        ctile_load(A, ta, c.wave, c.lane); ctile_load(B, tb, c.wave, c.lane);
        __builtin_amdgcn_sched_barrier(0);
        ctile_store(A, ta, c.lds, c.tid, c.wave, c.lane); ctile_store(B, tb, c.lds, c.tid, c.wave, c.lane);
        __builtin_amdgcn_sched_barrier(0);
    }
}

template <int NTL, int OUT8  >
__device__ __forceinline__ void norm_skinny_half(const float* xrows, const float* wn, const float* Wsk, int ldw, void* hrows_, void* hrows8_, int hk, int lane, f32x4 (&acc)[NTL], float& ss) {
    const int row = lane & 15, kq = lane >> 4;
    ss = 0.f;
#pragma unroll
    for (int t = 0; t < NTL; ++t) acc[t] = (f32x4){0.f, 0.f, 0.f, 0.f};
#pragma unroll 4
    for (int ks = 0; ks < 32; ++ks) {
        const int d0 = 1024 * hk + 32 * ks + 8 * kq;
        f32x4 xa = *(const f32x4*)(xrows + (size_t)row * DM + d0), xb = *(const f32x4*)(xrows + (size_t)row * DM + d0 + 4);
        const f32x4 wa = *(const f32x4*)(wn + d0), wb = *(const f32x4*)(wn + d0 + 4);
        ss += (xa[0] * xa[0] + xa[1] * xa[1]) + (xa[2] * xa[2] + xa[3] * xa[3]) + (xb[0] * xb[0] + xb[1] * xb[1]) + (xb[2] * xb[2] + xb[3] * xb[3]);
        xa = xa * wa; xb = xb * wb;
        u32x4 hw; hw.x = cvt_pk_bf16(xa[0], xa[1]); hw.y = cvt_pk_bf16(xa[2], xa[3]); hw.z = cvt_pk_bf16(xb[0], xb[1]); hw.w = cvt_pk_bf16(xb[2], xb[3]);
        if constexpr (OUT8 >= 1) { u32x2 q; q.x = cvt4_fp8(xa[0] * ACT_SCALE, xa[1] * ACT_SCALE, xa[2] * ACT_SCALE, xa[3] * ACT_SCALE); q.y = cvt4_fp8(xb[0] * ACT_SCALE, xb[1] * ACT_SCALE, xb[2] * ACT_SCALE, xb[3] * ACT_SCALE);
            *(u32x2*)((unsigned char*)hrows8_ + (size_t)row * DM + d0) = q; }
        if constexpr (OUT8 != 1) *(u32x4*)((bf16_t*)hrows_ + (size_t)row * DM + d0) = hw;
        const f32x4 ra = {xa[0] - bflo(hw.x), xa[1] - bfhi(hw.x), xa[2] - bflo(hw.y), xa[3] - bfhi(hw.y)}, rb = {xb[0] - bflo(hw.z), xb[1] - bfhi(hw.z), xb[2] - bflo(hw.w), xb[3] - bfhi(hw.w)};
        const bf16x8 ah = __builtin_bit_cast(bf16x8, hw), al = pack8(ra, rb);
#pragma unroll
        for (int t = 0; t < NTL; ++t) {
            float wv[8];
#pragma unroll
            for (int i = 0; i < 8; ++i) wv[i] = Wsk[(size_t)(d0 + i) * ldw + t * 16 + row];
            u32x4 bw; bw.x = cvt_pk_bf16(wv[0], wv[1]); bw.y = cvt_pk_bf16(wv[2], wv[3]); bw.z = cvt_pk_bf16(wv[4], wv[5]); bw.w = cvt_pk_bf16(wv[6], wv[7]);
            const f32x4 r0 = {wv[0] - bflo(bw.x), wv[1] - bfhi(bw.x), wv[2] - bflo(bw.y), wv[3] - bfhi(bw.y)}, r1 = {wv[4] - bflo(bw.z), wv[5] - bfhi(bw.z), wv[6] - bflo(bw.w), wv[7] - bfhi(bw.w)};
            const bf16x8 bh = __builtin_bit_cast(bf16x8, bw), bl = pack8(r0, r1);
            acc[t] = __builtin_amdgcn_mfma_f32_16x16x32_bf16(ah, bh, acc[t], 0, 0, 0);
            acc[t] = __builtin_amdgcn_mfma_f32_16x16x32_bf16(al, bh, acc[t], 0, 0, 0);
            acc[t] = __builtin_amdgcn_mfma_f32_16x16x32_bf16(ah, bl, acc[t], 0, 0, 0);
        }
    }
    ss += __shfl_xor(ss, 16); ss += __shfl_xor(ss, 32);
}

__device__ __forceinline__ void phase_norm1(const Params& p, const Ctx& c0) { const Ctx c = fresh_ctx(c0);
    bf16_t* H = (bf16_t*)(p.ws + WS_H); float* rstd = (float*)(p.ws + WS_RSTD1); float* gz = (float*)(p.ws + WS_GZ);
    const int pair = c.wave >> 1, hk = c.wave & 1;
    LAS float* scr = (LAS float*)(c.lds + pair * 4096);
    for (int u = blockIdx.x * 4 + pair; u < T / 16; u += gridDim.x * 4) {
        f32x4 acc[1]; float ss;
        norm_skinny_half<1, (NPROJ8 > 0 ? 2 : 0)>(p.x + (size_t)u * 16 * DM, p.attn_norm_w, p.w_in + C_GZ, LDW_IN, H + (size_t)u * 16 * DM, (unsigned char*)(p.ws + WS_H8) + (size_t)u * 16 * DM, hk, c.lane, acc, ss);
        if (hk == 1) { *(LAS f32x4*)(scr + c.lane * 4) = acc[0]; if (c.lane < 16) scr[256 + c.lane] = ss; }
        __syncthreads();
        if (hk == 0) {
            const f32x4 o = *(LAS f32x4*)(scr + c.lane * 4); const float tot = ss + scr[256 + (c.lane & 15)];
            const float rs = 1.0f / sqrtf(tot * (1.0f / DM) + EPS);
            if (c.lane < 16) { rstd[u * 16 + c.lane] = rs; scr[512 + c.lane] = rs; }
            LDS_WAIT();
#pragma unroll
            for (int r = 0; r < 4; ++r) { const int row = (c.lane >> 4) * 4 + r; gz[(size_t)(u * 16 + row) * 16 + (c.lane & 15)] = (acc[0][r] + o[r]) * scr[512 + row]; }
        }
        __syncthreads();
    }
}

__device__ __forceinline__ void phase_norm2_router(const Params& p, const Ctx& c0) { const Ctx c = fresh_ctx(c0);
    bf16_t* H = (bf16_t*)(p.ws + WS_H); float* rstd = (float*)(p.ws + WS_RSTD2); const float* X1 = (const float*)(p.ws + WS_X1);
    int* topi = (int*)(p.ws + WS_TOPI); float* topg = (float*)(p.ws + WS_TOPG); int* hist = (int*)(p.ws + WS_HIST); int* row_tok = (int*)(p.ws + WS_ROWTOK);
    const int pair = c.wave >> 1, hk = c.wave & 1;
    LAS float* scr = (LAS float*)(c.lds + pair * 8192);
    LAS int* hcnt = (LAS int*)(c.lds + 65536);
    { float* row_rstd = (float*)(p.ws + WS_ROWRSTD);
      for (int i = blockIdx.x * NTHREADS + c.tid; i < PROWS; i += gridDim.x * NTHREADS) { row_tok[i] = 0; row_rstd[i] = 0.f; } }
    for (int g = blockIdx.x; g < T / 64; g += gridDim.x) {
        if (c.tid < 32) hcnt[c.tid] = 0;
        __syncthreads();
        const int u = g * 4 + pair;
        f32x4 acc[2]; float ss;
        norm_skinny_half<2, 1>(X1 + (size_t)u * 16 * DM, p.ffn_norm_w, p.router_w, NE, nullptr, (unsigned char*)H + (size_t)u * 16 * DM, hk, c.lane, acc, ss);
        if (hk == 1) { *(LAS f32x4*)(scr + c.lane * 4) = acc[0]; *(LAS f32x4*)(scr + 256 + c.lane * 4) = acc[1]; if (c.lane < 16) scr[512 + c.lane] = ss; }
        __syncthreads();
        if (hk == 0) {
            const f32x4 o0 = *(LAS f32x4*)(scr + c.lane * 4), o1 = *(LAS f32x4*)(scr + 256 + c.lane * 4); const float tot = ss + scr[512 + (c.lane & 15)];
            const float rs = 1.0f / sqrtf(tot * (1.0f / DM) + EPS);
            if (c.lane < 16) { rstd[u * 16 + c.lane] = rs; scr[528 + c.lane] = rs; }
            LDS_WAIT();
            const float b0 = p.router_b[c.lane & 15], b1 = p.router_b[16 + (c.lane & 15)];
#pragma unroll
            for (int r = 0; r < 4; ++r) { const int row = (c.lane >> 4) * 4 + r; const float rr = scr[528 + row];
                scr[1024 + row * 32 + (c.lane & 15)] = (acc[0][r] + o0[r]) * rr + b0; scr[1024 + row * 32 + 16 + (c.lane & 15)] = (acc[1][r] + o1[r]) * rr + b1; }
            LDS_WAIT();
            if (c.lane < 16) {
                float lv[32];
#pragma unroll
                for (int j = 0; j < 32; ++j) lv[j] = scr[1024 + c.lane * 32 + j];
                int bi[4]; float bv[4];
#pragma unroll
                for (int k = 0; k < 4; ++k) { float best = -__builtin_inff(); int bidx = 0;
#pragma unroll
                    for (int j = 0; j < 32; ++j) { const bool tk = lv[j] > best; best = tk ? lv[j] : best; bidx = tk ? j : bidx; }
                    bi[k] = bidx; bv[k] = best;
#pragma unroll
                    for (int j = 0; j < 32; ++j) lv[j] = (j == bidx) ? -__builtin_inff() : lv[j]; }
                const float e1 = __expf(bv[1] - bv[0]), e2 = __expf(bv[2] - bv[0]), e3 = __expf(bv[3] - bv[0]); const float inv = 1.0f / (1.0f + e1 + e2 + e3);
                const int tok = u * 16 + c.lane;
                *(int4*)(topi + (size_t)tok * 4) = make_int4(bi[0], bi[1], bi[2], bi[3]);
                *(float4*)(topg + (size_t)tok * 4) = make_float4(inv, e1 * inv, e2 * inv, e3 * inv);
#pragma unroll
                for (int k = 0; k < 4; ++k) atomicAdd((int*)&hcnt[bi[k]], 1);
            }
        }
        __syncthreads();
        if (c.tid < 32) hist[g * 32 + c.tid] = hcnt[c.tid];
        __syncthreads();
    }
}

__device__ __forceinline__ void phase_rope_kmean(const Params& p, const Ctx& c0) { const Ctx c = fresh_ctx(c0);
    bf16_t* proj = (bf16_t*)(p.ws + WS_PROJ); const float* rc = (const float*)(p.ws + WS_ROPE); const float* rsn = rc + SEQ * 64; float* kmean = (float*)(p.ws + WS_KMEAN);
    LAS float* red = (LAS float*)c.lds;
    const int cg = c.tid & 7, tk = c.tid >> 3;
    for (int u = blockIdx.x; u < NBATCH * MH * NBLK; u += gridDim.x) {
        const int b = u / (MH * NBLK), h = (u / NBLK) % MH, blk = u % NBLK;
        float s1[8], s2[8];
#pragma unroll
        for (int j = 0; j < 8; ++j) { s1[j] = 0.f; s2[j] = 0.f; }
#pragma unroll
        for (int ps = 0; ps < 4; ++ps) {
            const int pos = blk * MBLK + ps * 64 + tk; const size_t row = (size_t)(b * SEQ + pos) * NPROJ;
            const f32x4 ca = *(const f32x4*)(rc + pos * 64 + 8 * cg), cb = *(const f32x4*)(rc + pos * 64 + 8 * cg + 4), sa = *(const f32x4*)(rsn + pos * 64 + 8 * cg), sb = *(const f32x4*)(rsn + pos * 64 + 8 * cg + 4);
            const float cs[8] = {ca[0], ca[1], ca[2], ca[3], cb[0], cb[1], cb[2], cb[3]}, sn[8] = {sa[0], sa[1], sa[2], sa[3], sb[0], sb[1], sb[2], sb[3]};
#pragma unroll
            for (int qk = 0; qk < 2; ++qk) {
                bf16_t* base = proj + row + (qk ? C_MK : C_MQ) + h * HD + 8 * cg;
                const u32x4 t1 = *(const u32x4*)base, t2 = *(const u32x4*)(base + 64);
                float a[8], bb[8];
#pragma unroll
                for (int j = 0; j < 4; ++j) { a[2 * j] = bflo(t1[j]); a[2 * j + 1] = bfhi(t1[j]); bb[2 * j] = bflo(t2[j]); bb[2 * j + 1] = bfhi(t2[j]); }
                float o1[8], o2[8];
#pragma unroll
                for (int j = 0; j < 8; ++j) { o1[j] = a[j] * cs[j] - bb[j] * sn[j]; o2[j] = bb[j] * cs[j] + a[j] * sn[j]; }
                u32x4 w1, w2;
#pragma unroll
                for (int j = 0; j < 4; ++j) { w1[j] = cvt_pk_bf16(o1[2 * j], o1[2 * j + 1]); w2[j] = cvt_pk_bf16(o2[2 * j], o2[2 * j + 1]); }
                if (qk) { bf16_t* kc = (bf16_t*)(p.ws + WS_KC) + ((size_t)(b * MH + h) * SEQ + pos) * HD + 8 * cg; *(u32x4*)kc = w1; *(u32x4*)(kc + 64) = w2;
                    const bf16_t* vs = proj + row + C_MV + h * HD + 8 * cg; bf16_t* vc = (bf16_t*)(p.ws + WS_VC) + ((size_t)(b * MH + h) * SEQ + pos) * HD + 8 * cg;
                    *(u32x4*)vc = *(const u32x4*)vs; *(u32x4*)(vc + 64) = *(const u32x4*)(vs + 64); }
                else { *(u32x4*)base = w1; *(u32x4*)(base + 64) = w2; }
                if (qk) {
#pragma unroll
                    for (int j = 0; j < 8; ++j) { s1[j] += o1[j]; s2[j] += o2[j]; } }
            }
        }
#pragma unroll
        for (int j = 0; j < 8; ++j) {
#pragma unroll
            for (int o = 8; o < 64; o <<= 1) { s1[j] += __shfl_xor(s1[j], o); s2[j] += __shfl_xor(s2[j], o); } }
        if (c.lane < 8) {
#pragma unroll
            for (int j = 0; j < 8; ++j) { red[c.wave * 128 + 8 * cg + j] = s1[j]; red[c.wave * 128 + 64 + 8 * cg + j] = s2[j]; } }
        __syncthreads();
        if (c.tid < 128) { float s = 0.f;
#pragma unroll
            for (int w = 0; w < 8; ++w) s += red[w * 128 + c.tid];
            kmean[(size_t)u * HD + c.tid] = s * (1.0f / MBLK); }
        __syncthreads();
    }
}

__device__ __forceinline__ void phase_gla_prep(const Params& p, const Ctx& c0) { const Ctx c = fresh_ctx(c0);
    bf16_t* proj = (bf16_t*)(p.ws + WS_PROJ); const float* gz = (const float*)(p.ws + WS_GZ); float* dend = (float*)(p.ws + WS_DEND);
    LAS float* gzl = (LAS float*)c.lds;
    LAS float* seg = (LAS float*)(c.lds + 16384);
    const int ch = c.tid & 127, tq = __builtin_amdgcn_readfirstlane(c.tid >> 7);
    for (int u = blockIdx.x; u < NBATCH * GH * NBLK; u += gridDim.x) {
        const int b = u / (GH * NBLK), h = (u / NBLK) % GH, j = u % NBLK;
        const int tok0 = b * SEQ + j * MBLK;
        for (int i = c.tid; i < 256 * 4; i += NTHREADS) *(LAS f32x4*)(gzl + i * 4) = *(const f32x4*)(gz + (size_t)tok0 * 16 + i * 4);
        float w2[16];
#pragma unroll
        for (int r = 0; r < 16; ++r) w2[r] = p.gate_w2[r * 512 + h * GDK + ch];
        const float bias = p.gate_b[h * GDK + ch];
        __syncthreads();
        float run = 0.f; float Bv[64];
#pragma unroll
        for (int i = 0; i < 64; ++i) {
            const LAS float* g = gzl + (tq * 64 + i) * 16;
            const f32x4 g0 = *(const LAS f32x4*)g, g1 = *(const LAS f32x4*)(g + 4), g2 = *(const LAS f32x4*)(g + 8), g3 = *(const LAS f32x4*)(g + 12);
            float lg = bias;
            lg += g0[0] * w2[0] + g0[1] * w2[1] + g0[2] * w2[2] + g0[3] * w2[3]; lg += g1[0] * w2[4] + g1[1] * w2[5] + g1[2] * w2[6] + g1[3] * w2[7];
            lg += g2[0] * w2[8] + g2[1] * w2[9] + g2[2] * w2[10] + g2[3] * w2[11]; lg += g3[0] * w2[12] + g3[1] * w2[13] + g3[2] * w2[14] + g3[3] * w2[15];
            const float ls = fminf(lg, 0.f) - __logf(1.0f + __expf(-fabsf(lg)));
            run += ls * (1.0f / 16.0f); Bv[i] = run; }
        seg[tq * 128 + ch] = run;
        __syncthreads();
        float off = 0.f, tot = 0.f;
#pragma unroll
        for (int s = 0; s < 4; ++s) { const float v = seg[s * 128 + ch]; tot += v; off += (s < tq) ? v : 0.f; }
        if (tq == 0) dend[(size_t)u * GDK + ch] = __expf(tot);
        bf16_t* qp = proj + (size_t)(tok0 + tq * 64) * NPROJ + C_GQ + h * GDK + ch; bf16_t* kp = proj + (size_t)(tok0 + tq * 64) * NPROJ + C_GK + h * GDK + ch;
#pragma unroll
        for (int i = 0; i < 64; ++i) { const float Bt = off + Bv[i];
            const float q = bf2f(qp[(size_t)i * NPROJ]), k = bf2f(kp[(size_t)i * NPROJ]);
            const float qt = q * __expf(Bt) * 0.08838834764831845f, kt = k * __expf(-Bt);
            qp[(size_t)i * NPROJ] = (bf16_t)(cvt_pk_bf16(qt, 0.f) & 0xffffu); kp[(size_t)i * NPROJ] = (bf16_t)(cvt_pk_bf16(kt, 0.f) & 0xffffu); }
        __syncthreads();
    }
}
namespace att {
constexpr int NW = 8, QBLK = 32, KVBLK = 64, QB = 256, D = 128;
constexpr int SHM_V = KVBLK * D * 2, SHM_K = KVBLK * D * 2;
constexpr int ATT_LDS = 2 * SHM_V + 2 * SHM_K + NW * 64 * 4;
constexpr float SCALE = 0.08838834764831845f;
constexpr float THR = 8.f;
constexpr int APITCH = NPROJ, OPITCH = DM, KVPITCH = HD;
typedef LAS char* lptr;
typedef const LAS char* lcptr;

#define KSWZ(row, colB) ((row) * 256 + ((colB) ^ (((row) & 7) << 4)))
__device__ __forceinline__ int v_st(int k, int c) { const int kk = (k & ~0xC) | ((k & 4) << 1) | ((k & 8) >> 1); return ((kk >> 3) * 4 + (c >> 5)) * 512 + ((kk & 7) * 32 + (c & 31)) * 2; }
__device__ __forceinline__ int v_rd_base(int lane) { return ((lane & 3) << 3) | (((lane >> 2) & 3) << 6) | (((lane >> 4) & 1) << 5) | (((lane >> 5) & 1) << 8); }
constexpr int v_rd_off(int d0, int ks, int half) { return d0 * 512 + ks * 4096 + half * 2048; }
__device__ __forceinline__ int crow(int r, int hi) { return (r & 3) + 8 * (r >> 2) + 4 * hi; }
__device__ __forceinline__ bf16x8 load8(const bf16_t* p) { return *reinterpret_cast<const bf16x8*>(p); }

__device__ __forceinline__ void pack_p(const f32x16& p0, const f32x16& p1, bf16x8& pa0, bf16x8& pa1, bf16x8& pa2, bf16x8& pa3) {
#define PK4(P, B_, OUT) do { unsigned a0 = cvt_pk_bf16(P[B_+0], P[B_+1]), a1 = cvt_pk_bf16(P[B_+2], P[B_+3]);                          \
        unsigned b0 = cvt_pk_bf16(P[B_+4], P[B_+5]), b1 = cvt_pk_bf16(P[B_+6], P[B_+7]);                                             \
        auto r0 = __builtin_amdgcn_permlane32_swap(a0, b0, false, false); auto r1 = __builtin_amdgcn_permlane32_swap(a1, b1, false, false); \
        u32x4 w = {r0[0], r1[0], r0[1], r1[1]}; OUT = __builtin_bit_cast(bf16x8, w); } while (0)
    PK4(p0, 0, pa0); PK4(p0, 8, pa1); PK4(p1, 0, pa2); PK4(p1, 8, pa3);
#undef PK4
}
__device__ __forceinline__ void partialSM(f32x16& p0, f32x16& p1, float& m_reg, float& mn, float& alpha) {
    float pmax = p0[0];
#pragma unroll
    for (int r = 1; r < 16; ++r) pmax = fmaxf(pmax, p0[r]);
#pragma unroll
    for (int r = 0; r < 16; ++r) pmax = fmaxf(pmax, p1[r]);
    { auto rr = __builtin_amdgcn_permlane32_swap(__float_as_uint(pmax), __float_as_uint(pmax), false, false);
      pmax = fmaxf(__uint_as_float(rr[0]), __uint_as_float(rr[1])); }
    constexpr float C2 = 1.4426950408889634f * SCALE;
    if (__builtin_expect(__all((pmax - m_reg) * SCALE <= THR), 1)) { mn = m_reg; alpha = 1.f; }
    else { mn = fmaxf(m_reg, pmax); alpha = __builtin_amdgcn_exp2f((m_reg - mn) * C2); m_reg = mn; }
    const float mnL = -mn * C2;
#pragma unroll
    for (int r = 0; r < 16; ++r) p0[r] = fmaf(p0[r], C2, mnL);
#pragma unroll
    for (int r = 0; r < 16; ++r) p1[r] = fmaf(p1[r], C2, mnL);
#pragma unroll
    for (int r = 0; r < 16; ++r) p0[r] = __builtin_amdgcn_exp2f(p0[r]);
}
__device__ __forceinline__ void finishSM(f32x16& p0, f32x16& p1, float alpha, float& l_reg, bf16x8& pa0, bf16x8& pa1, bf16x8& pa2, bf16x8& pa3) {
#pragma unroll
    for (int r = 0; r < 16; ++r) p1[r] = __builtin_amdgcn_exp2f(p1[r]);
    float ps = 0;
#pragma unroll
    for (int r = 0; r < 16; ++r) ps += p0[r];
#pragma unroll
    for (int r = 0; r < 16; ++r) ps += p1[r];
    { auto rr = __builtin_amdgcn_permlane32_swap(__float_as_uint(ps), __float_as_uint(ps), false, false);
      ps = __uint_as_float(rr[0]) + __uint_as_float(rr[1]); }
    l_reg = l_reg * alpha + ps;
    pack_p(p0, p1, pa0, pa1, pa2, pa3);
}
template <int KB>
__device__ __forceinline__ void qkt(f32x16& p0, f32x16& p1, lcptr K_lds, int r32, int hi, const bf16x8* qr) {
    p0 = f32x16{}; p1 = f32x16{};
    lcptr kb[4];
#pragma unroll
    for (int dd = 0; dd < 4; ++dd) kb[dd] = K_lds + KB * SHM_K + KSWZ(r32, (dd * 16 + hi * 8) * 2);
#pragma unroll
    for (int d0 = 0; d0 < 8; ++d0) { lcptr a = kb[d0 & 3] + (d0 >> 2) * 128;
        bf16x8 b0 = *reinterpret_cast<const LAS bf16x8*>(a);
        bf16x8 b1 = *reinterpret_cast<const LAS bf16x8*>(a + 32 * 256);
        p0 = __builtin_amdgcn_mfma_f32_32x32x16_bf16(b0, qr[d0], p0, 0, 0, 0);
        p1 = __builtin_amdgcn_mfma_f32_32x32x16_bf16(b1, qr[d0], p1, 0, 0, 0); }
}
#define TRRD(dst, vb, off) asm volatile("ds_read_b64_tr_b16 %0, %1 offset:%2" : "=&v"(dst) : "v"(vb), "i"(off) : "memory")
template <int VOFF>
__device__ __forceinline__ void pv_tile(f32x16* o, int vb0, bf16x8 pa0, bf16x8 pa1, bf16x8 pa2, bf16x8 pa3) {
#define PV_D0(d0) do { s16x4 l0, l1, l2, l3, h0, h1, h2, h3; constexpr int b_ = VOFF + v_rd_off(d0, 0, 0); \
        TRRD(l0, vb0, b_); TRRD(h0, vb0, b_ + 2048); TRRD(l1, vb0, b_ + 4096); TRRD(h1, vb0, b_ + 6144); TRRD(l2, vb0, b_ + 8192); TRRD(h2, vb0, b_ + 10240); TRRD(l3, vb0, b_ + 12288); TRRD(h3, vb0, b_ + 14336); \
        asm volatile("s_waitcnt lgkmcnt(0)" ::: "memory"); SBAR(); \
        o[d0] = __builtin_amdgcn_mfma_f32_32x32x16_bf16(pa0, (bf16x8){l0[0], l0[1], l0[2], l0[3], h0[0], h0[1], h0[2], h0[3]}, o[d0], 0, 0, 0);   \
        o[d0] = __builtin_amdgcn_mfma_f32_32x32x16_bf16(pa1, (bf16x8){l1[0], l1[1], l1[2], l1[3], h1[0], h1[1], h1[2], h1[3]}, o[d0], 0, 0, 0);   \
        o[d0] = __builtin_amdgcn_mfma_f32_32x32x16_bf16(pa2, (bf16x8){l2[0], l2[1], l2[2], l2[3], h2[0], h2[1], h2[2], h2[3]}, o[d0], 0, 0, 0);   \
        o[d0] = __builtin_amdgcn_mfma_f32_32x32x16_bf16(pa3, (bf16x8){l3[0], l3[1], l3[2], l3[3], h3[0], h3[1], h3[2], h3[3]}, o[d0], 0, 0, 0); } while (0)
    PV_D0(0); PV_D0(1); PV_D0(2); PV_D0(3);
#undef PV_D0
}
template <int VOFF, int D0>
__device__ __forceinline__ void tr_frags(int vb0, bf16x8& f0, bf16x8& f1, bf16x8& f2, bf16x8& f3) {
    s16x4 l0, l1, l2, l3, h0, h1, h2, h3; constexpr int b_ = VOFF + v_rd_off(D0, 0, 0);
    TRRD(l0, vb0, b_); TRRD(h0, vb0, b_ + 2048); TRRD(l1, vb0, b_ + 4096); TRRD(h1, vb0, b_ + 6144); TRRD(l2, vb0, b_ + 8192); TRRD(h2, vb0, b_ + 10240); TRRD(l3, vb0, b_ + 12288); TRRD(h3, vb0, b_ + 14336);
    asm volatile("s_waitcnt lgkmcnt(0)" ::: "memory"); SBAR();
    f0 = (bf16x8){l0[0], l0[1], l0[2], l0[3], h0[0], h0[1], h0[2], h0[3]}; f1 = (bf16x8){l1[0], l1[1], l1[2], l1[3], h1[0], h1[1], h1[2], h1[3]};
    f2 = (bf16x8){l2[0], l2[1], l2[2], l2[3], h2[0], h2[1], h2[2], h2[3]}; f3 = (bf16x8){l3[0], l3[1], l3[2], l3[3], h3[0], h3[1], h3[2], h3[3]};
}

struct MobaRef { const bf16_t* Q; const bf16_t* K; const bf16_t* V; bf16_t* O; const unsigned* sel; int qb; };
struct MobaSeam { bf16x8 qr[8]; bf16x8 st_v0, st_v1, st_k0, st_k1; unsigned sel; };
#define AROW(p, k0, rr) ((p) + (size_t)((k0) + (rr)) * KVPITCH + sc)
#define VMW() asm volatile("s_waitcnt vmcnt(0)" ::: "memory")
#define VMWN(n) asm volatile("s_waitcnt vmcnt(%0)" :: "i"(n) : "memory")
#define SLOAD_H(Kp, Vp, k0) do { S.st_v0 = load8(AROW(Vp, k0, sr)); S.st_v1 = load8(AROW(Vp, k0, 32 + sr));              \
                         S.st_k0 = load8(AROW(Kp, k0, sr)); S.st_k1 = load8(AROW(Kp, k0, 32 + sr)); } while (0)
#define SWRITE_HK(bf) do { *(LAS bf16x8*)(K_lds + (bf) * SHM_K + kws) = S.st_k0; *(LAS bf16x8*)(K_lds + (bf) * SHM_K + kws + 32 * 256) = S.st_k1; } while (0)
#define SWRITE_HV(bf) do { *(LAS bf16x8*)(V_lds + (bf) * SHM_V + vst0) = S.st_v0; *(LAS bf16x8*)(V_lds + (bf) * SHM_V + vst1) = S.st_v1; } while (0)
#define SWRITE_H(bf) do { SWRITE_HV(bf); SWRITE_HK(bf); } while (0)

__device__ __forceinline__ void moba_prime(const MobaRef& cur, lptr lds, MobaSeam& S) {
    int tid = threadIdx.x; asm volatile("" : "+v"(tid)); const int wid = __builtin_amdgcn_readfirstlane(tid >> 6), lane = tid & 63, r32 = lane & 31, hi = lane >> 5;
    const int sr = tid >> 4, sc = (tid & 15) * 8, kws = KSWZ(sr, sc * 2); lptr K_lds = lds + 2 * SHM_V;
#pragma unroll
    for (int d0 = 0; d0 < 8; ++d0) S.qr[d0] = load8(cur.Q + (size_t)(wid * QBLK + r32) * APITCH + d0 * 16 + hi * 8);
    S.sel = cur.sel[wid * QBLK + r32];
    SLOAD_H(cur.K, cur.V, 0); VMW(); SWRITE_HK(0);
    __syncthreads();
}
__device__ __forceinline__ void moba_block(const MobaRef& cur, const MobaRef& nxt, lptr lds, MobaSeam& S) {
    int tid = threadIdx.x; asm volatile("" : "+v"(tid)); const int wid = __builtin_amdgcn_readfirstlane(tid >> 6), lane = tid & 63, r32 = lane & 31, hi = lane >> 5;
    const int qb = cur.qb, NT = 4 * (qb + 1);
    const int qlo = qb * QB + wid * QBLK, qm = qlo + r32 - 4 * hi;
    const unsigned sel = S.sel;
    lptr V_lds = lds; lptr K_lds = lds + 2 * SHM_V;
    LAS float* ws = (LAS float*)(lds + 2 * SHM_V + 2 * SHM_K) + wid * 64; LAS float* li_l = ws; LAS float* al_l = ws + 32;
    float m_reg = -1e30f, l_reg = 0; f32x16 o[4] = {};
    const int sr = tid >> 4, sc = (tid & 15) * 8, vst0 = v_st(sr, sc), vst1 = v_st(32 + sr, sc), kws = KSWZ(sr, sc * 2);
    const int vb0 = (int)(uintptr_t)V_lds + v_rd_base(lane);
    const bf16_t* Kh = cur.K; const bf16_t* Vh = cur.V;
    const float NEG = -__builtin_inff();
#define RESC(a) do { if (__any((a) < 1.f)) { if (hi == 0) al_l[r32] = (a); asm volatile("s_waitcnt lgkmcnt(0)" ::: "memory");              \
                     _Pragma("unroll") for (int d_ = 0; d_ < 4; ++d_) _Pragma("unroll") for (int r = 0; r < 16; ++r) o[d_][r] *= al_l[crow(r, hi)]; } } while (0)
#define KBASE(t) ((t) * KVBLK)
#define MASKT(P0_, P1_, t) do { const int kb_ = KBASE(t); const int jb_ = (t) >> 2;                                              \
        if (jb_ == qb) { if (kb_ + KVBLK - 1 > qlo) { const int dq_ = qm - kb_;                                                    \
            _Pragma("unroll") for (int r = 0; r < 16; ++r) { const int c_ = (r & 3) + 8 * (r >> 2);                                \
                if (dq_ - c_ < 0) P0_[r] = NEG; if (dq_ - c_ - 32 < 0) P1_[r] = NEG; } } }                                         \
        else { const bool keep_ = (sel >> jb_) & 1u; if (!__all(keep_)) {                                                          \
            _Pragma("unroll") for (int r = 0; r < 16; ++r) { P0_[r] = keep_ ? P0_[r] : NEG; P1_[r] = keep_ ? P1_[r] : NEG; } } } } while (0)
    constexpr int NQL = 9;
#define SEAM_K0() do { VMWN(NQL); SWRITE_HK(0); SBAR(); } while (0)
    f32x16 pA0, pA1, pB0, pB1; float mnA, mnB, alA, alB; bf16x8 pa0, pa1, pa2, pa3;
    SWRITE_HV(0); SBAR();
    SLOAD_H(Kh, Vh, KBASE(1));
    SBAR(); qkt<0>(pA0, pA1, K_lds, r32, hi, S.qr);
    MASKT(pA0, pA1, 0); partialSM(pA0, pA1, m_reg, mnA, alA);
    VMW(); SWRITE_H(1);
    __syncthreads();
#define HALF_STEP(PX0, PX1, mnX, alX, PY0, PY1, alY, t, KB, VB, SB) do {                                                      \
        SBAR(); qkt<KB>(PX0, PX1, K_lds, r32, hi, S.qr);                                                                       \
        finishSM(PY0, PY1, alY, l_reg, pa0, pa1, pa2, pa3); SBAR();                                                           \
        if ((t) + 1 < NT) { SLOAD_H(Kh, Vh, KBASE((t) + 1)); SBAR(); }                                                        \
        pv_tile<VB * SHM_V>(o, vb0, pa0, pa1, pa2, pa3); MASKT(PX0, PX1, (t)); partialSM(PX0, PX1, m_reg, mnX, alX);          \
        __syncthreads();                                                                                                      \
        if ((t) + 1 < NT) { VMW(); SWRITE_H(SB); }                                                                            \
        RESC(alX); __syncthreads(); } while (0)
    for (int t = 1; t + 1 < NT; t += 2) {
        HALF_STEP(pB0, pB1, mnB, alB, pA0, pA1, alA, t, 1, 0, 0);
        HALF_STEP(pA0, pA1, mnA, alA, pB0, pB1, alB, t + 1, 0, 1, 1);
    }
    SBAR(); qkt<1>(pB0, pB1, K_lds, r32, hi, S.qr); SBAR();
    SLOAD_H(nxt.K, nxt.V, 0); SBAR();
#pragma unroll
    for (int d0 = 0; d0 < 8; ++d0) S.qr[d0] = load8(nxt.Q + (size_t)(wid * QBLK + r32) * APITCH + d0 * 16 + hi * 8);
    S.sel = nxt.sel[wid * QBLK + r32];
    SBAR();
    finishSM(pA0, pA1, alA, l_reg, pa0, pa1, pa2, pa3); SBAR();
    pv_tile<0>(o, vb0, pa0, pa1, pa2, pa3);
    MASKT(pB0, pB1, NT - 1); partialSM(pB0, pB1, m_reg, mnB, alB); __syncthreads(); RESC(alB);
    finishSM(pB0, pB1, alB, l_reg, pa0, pa1, pa2, pa3); SBAR(); pv_tile<SHM_V>(o, vb0, pa0, pa1, pa2, pa3);
    SBAR(); SEAM_K0();
    if (hi == 0) li_l[r32] = l_reg; asm volatile("s_waitcnt lgkmcnt(0)" ::: "memory");
    float rli[16];
#pragma unroll
    for (int r = 0; r < 16; ++r) rli[r] = __builtin_amdgcn_rcpf(li_l[crow(r, hi)]);
    bf16_t* Ow = cur.O + (size_t)(wid * QBLK) * OPITCH;
#pragma unroll
    for (int r = 0; r < 16; ++r) { const int orow = crow(r, hi);
#pragma unroll
        for (int d0 = 0; d0 < 4; ++d0) { const float v = o[d0][r] * rli[r];
            const float vn = __shfl_xor(v, 1);
            if ((r32 & 1) == 0) *(unsigned*)(Ow + (size_t)orow * OPITCH + d0 * 32 + r32) = cvt_pk_bf16(v, vn); } }
    __syncthreads();
#undef RESC
#undef KBASE
#undef MASKT
#undef SEAM_K0
#undef HALF_STEP
}

__device__ __forceinline__ MobaRef moba_ref(const Params& p, int bh, int qb) {
    const int b = bh / MH, h = bh % MH;
    const bf16_t* proj = (const bf16_t*)(p.ws + WS_PROJ); bf16_t* mixed = (bf16_t*)(p.ws + WS_MIXED); const unsigned* selp = (const unsigned*)(p.ws + WS_SEL);
    MobaRef r; const size_t tok0 = (size_t)b * SEQ;
    r.Q = proj + (tok0 + (size_t)qb * QB) * APITCH + C_MQ + h * HD;
    r.K = (const bf16_t*)(p.ws + WS_KC) + (size_t)bh * SEQ * HD; r.V = (const bf16_t*)(p.ws + WS_VC) + (size_t)bh * SEQ * HD;
    r.O = mixed + (tok0 + (size_t)qb * QB) * OPITCH + h * HD; r.sel = selp + (size_t)bh * SEQ + qb * QB; r.qb = qb; return r;
}
__device__ __forceinline__ void phase_moba(const Params& p, lptr lds) {
    const int G = gridDim.x; const int bx = blockIdx.x; const int vcu = (G % 8 == 0) ? (bx % 8) * (G / 8) + bx / 8 : bx;
    constexpr int NITEM = NBATCH * MH * 8;
    int L = vcu; if (L >= NITEM) return;
    int pass = 0;
    MobaRef cur = moba_ref(p, L >> 3, L & 7);
    MobaSeam S;
    moba_prime(cur, lds, S);
    for (;;) {
        const bool more_pass = pass == 0, more_item = L + G < NITEM, last = !more_pass && !more_item;
        int Ln = L, passn = 1;
        if (!more_pass) { passn = 0; Ln = more_item ? L + G : L; }
        const MobaRef nxt = last ? cur : moba_ref(p, Ln >> 3, passn ? 15 - (Ln & 7) : (Ln & 7));
        moba_block(cur, nxt, lds, S);
        if (last) break;
        cur = nxt; pass = passn; L = Ln;
    }
}
#undef SLOAD_H
#undef SWRITE_HK
#undef SWRITE_HV
#undef SWRITE_H
#undef VMWN
}
namespace att {
__device__ __forceinline__ void stage_vstyle(lptr dst, const bf16_t* src, size_t pitch, int tid) {
    const int sr = tid >> 4, sc = (tid & 15) * 8;
    const bf16x8 a = load8(src + (size_t)sr * pitch + sc), b = load8(src + (size_t)(32 + sr) * pitch + sc);
    *(LAS bf16x8*)(dst + v_st(sr, sc)) = a; *(LAS bf16x8*)(dst + v_st(32 + sr, sc)) = b;
}
__device__ __forceinline__ void stage_kstyle(lptr dst, const bf16_t* src, size_t pitch, int tid) {
    const int sr = tid >> 4, sc = (tid & 15) * 8;
    const bf16x8 a = load8(src + (size_t)sr * pitch + sc), b = load8(src + (size_t)(32 + sr) * pitch + sc);
    *(LAS bf16x8*)(dst + KSWZ(sr, sc * 2)) = a; *(LAS bf16x8*)(dst + KSWZ(sr, sc * 2) + 32 * 256) = b;
}

__device__ __forceinline__ void phase_moba_select(const Params& p, lptr lds, int tid_) { int tid = tid_; asm volatile("" : "+v"(tid));
    const bf16_t* proj = (const bf16_t*)(p.ws + WS_PROJ); const float* kmean = (const float*)(p.ws + WS_KMEAN); unsigned* selp = (unsigned*)(p.ws + WS_SEL);
    constexpr int QP = 272;
    lptr ql = lds; LAS float* kml = (LAS float*)(lds + 256 * QP); LAS float* gl = (LAS float*)(lds + 256 * QP + 8192);
    for (int u = blockIdx.x; u < NBATCH * MH * NBLK; u += gridDim.x) {
        const int bh = u / NBLK, qb = u % NBLK, b = bh / MH, h = bh % MH;
        if (qb == 0) { if (tid < 256) selp[(size_t)bh * SEQ + tid] = 0u; continue; }
        const bf16_t* qsrc = proj + ((size_t)b * SEQ + qb * 256) * NPROJ + C_MQ + h * HD;
        for (int i = tid; i < 256 * 16; i += NTHREADS) { const int r = i >> 4, ch = i & 15; *(LAS bf16x8*)(ql + r * QP + ch * 16) = load8(qsrc + (size_t)r * NPROJ + ch * 8); }
        for (int i = tid; i < 16 * 128 / 4; i += NTHREADS) *(LAS f32x4*)(kml + i * 4) = *(const f32x4*)(kmean + (size_t)bh * NBLK * HD + i * 4);
        __syncthreads();
        const int q = tid & 255, ng = tid >> 8;
        float g[8];
#pragma unroll
        for (int n = 0; n < 8; ++n) g[n] = 0.f;
        for (int ch = 0; ch < 16; ++ch) {
            const u32x4 qw = *(const LAS u32x4*)(ql + q * QP + ch * 16);
            const float qv[8] = {bflo(qw.x), bfhi(qw.x), bflo(qw.y), bfhi(qw.y), bflo(qw.z), bfhi(qw.z), bflo(qw.w), bfhi(qw.w)};
#pragma unroll
            for (int n = 0; n < 8; ++n) { if (ng * 8 + n < qb) {
                const f32x4 k0 = *(const LAS f32x4*)(kml + (ng * 8 + n) * 128 + ch * 8), k1 = *(const LAS f32x4*)(kml + (ng * 8 + n) * 128 + ch * 8 + 4);
                g[n] += qv[0] * k0[0] + qv[1] * k0[1] + qv[2] * k0[2] + qv[3] * k0[3] + qv[4] * k1[0] + qv[5] * k1[1] + qv[6] * k1[2] + qv[7] * k1[3]; } }
        }
#pragma unroll
        for (int n = 0; n < 8; ++n) gl[q * 16 + ng * 8 + n] = g[n];
        __syncthreads();
        if (tid < 256) {
            float gv[16];
#pragma unroll
            for (int n = 0; n < 16; ++n) gv[n] = (n < qb) ? gl[tid * 16 + n] : -__builtin_inff();
            unsigned m = 0u;
#pragma unroll
            for (int k = 0; k < 3; ++k) { float best = -__builtin_inff(); int bi = -1;
#pragma unroll
                for (int n = 0; n < 16; ++n) { const bool tk = gv[n] > best; best = tk ? gv[n] : best; bi = tk ? n : bi; }
                if (bi >= 0) m |= 1u << bi;
#pragma unroll
                for (int n = 0; n < 16; ++n) gv[n] = (n == bi) ? -__builtin_inff() : gv[n]; }
            selp[(size_t)bh * SEQ + qb * 256 + tid] = m;
        }
        __syncthreads();
    }
}

__device__ __forceinline__ void phase_gla_state(const Params& p, lptr lds, int tid_) { int tid = tid_; asm volatile("" : "+v"(tid));
    const bf16_t* proj = (const bf16_t*)(p.ws + WS_PROJ); const float* dend = (const float*)(p.ws + WS_DEND); float* U = (float*)(p.ws + WS_U);
    const int wid = __builtin_amdgcn_readfirstlane(tid >> 6), lane = tid & 63, r32 = lane & 31, hi = lane >> 5;
    const int dkb = wid & 3, half = wid >> 2;
    const int vb0 = (int)(uintptr_t)lds + v_rd_base(lane);
    for (int u = blockIdx.x; u < NBATCH * GH * NBLK; u += gridDim.x) {
        const int bh = u / NBLK, j = u % NBLK, b = bh / GH, h = bh % GH;
        const size_t tok0 = (size_t)b * SEQ + j * 256;
        f32x16 o[4] = {};
        for (int t = 0; t < 4; ++t) {
            __syncthreads();
            const bf16_t* rowp = proj + (tok0 + t * 64) * NPROJ;
            stage_vstyle(lds, rowp + C_GK + h * GDK, NPROJ, tid);
            stage_vstyle(lds + SHM_V, rowp + C_GV + h * GDV, NPROJ, tid);
            stage_vstyle(lds + 2 * SHM_V, rowp + C_GV + h * GDV + 128, NPROJ, tid);
            __syncthreads();
            bf16x8 a0, a1, a2, a3;
            if (dkb == 0) tr_frags<0, 0>(vb0, a0, a1, a2, a3); else if (dkb == 1) tr_frags<0, 1>(vb0, a0, a1, a2, a3); else if (dkb == 2) tr_frags<0, 2>(vb0, a0, a1, a2, a3); else tr_frags<0, 3>(vb0, a0, a1, a2, a3);
            if (half == 0) pv_tile<SHM_V>(o, vb0, a0, a1, a2, a3); else pv_tile<2 * SHM_V>(o, vb0, a0, a1, a2, a3);
        }
        float dv[16];
#pragma unroll
        for (int r = 0; r < 16; ++r) dv[r] = dend[(size_t)u * GDK + dkb * 32 + crow(r, hi)];
        float* Uo = U + (size_t)u * (GDK * GDV);
#pragma unroll
        for (int r = 0; r < 16; ++r) { const int k = dkb * 32 + crow(r, hi);
#pragma unroll
            for (int d0 = 0; d0 < 4; ++d0) Uo[(size_t)k * GDV + half * 128 + d0 * 32 + r32] = o[d0][r] * dv[r]; }
    }
    __syncthreads();
}

__device__ __forceinline__ void phase_gla_scan(const Params& p, int tid_) { int tid = tid_; asm volatile("" : "+v"(tid));
    const float* U = (const float*)(p.ws + WS_U); const float* dend = (const float*)(p.ws + WS_DEND); bf16_t* Sj = (bf16_t*)(p.ws + WS_SJ);
    constexpr int NEL = NBATCH * GH * GDK * GDV / 4;
    for (int i = blockIdx.x * NTHREADS + tid; i < NEL; i += gridDim.x * NTHREADS) {
        const int bh = i / (GDK * GDV / 4), e4 = i % (GDK * GDV / 4), k = e4 / (GDV / 4);
        f32x4 S = {0.f, 0.f, 0.f, 0.f};
        f32x4 uv[NBLK]; float dd[NBLK];
#pragma unroll
        for (int j = 0; j < NBLK; ++j) { uv[j] = *(const f32x4*)(U + ((size_t)(bh * NBLK + j) * (GDK * GDV)) + (size_t)e4 * 4); dd[j] = dend[(size_t)(bh * NBLK + j) * GDK + k]; }
#pragma unroll
        for (int j = 0; j < NBLK; ++j) {
            u32x2 w; w.x = cvt_pk_bf16(S[0], S[1]); w.y = cvt_pk_bf16(S[2], S[3]);
            *(u32x2*)(Sj + ((size_t)(bh * NBLK + j) * (GDK * GDV)) + (size_t)e4 * 4) = w;
            S = S * dd[j] + uv[j]; }
    }
}

__device__ __forceinline__ void phase_gla_out(const Params& p, lptr lds, int tid_) { int tid = tid_; asm volatile("" : "+v"(tid));
    const bf16_t* proj = (const bf16_t*)(p.ws + WS_PROJ); const bf16_t* Sj = (const bf16_t*)(p.ws + WS_SJ); bf16_t* mixed = (bf16_t*)(p.ws + WS_MIXED);
    const int wid = __builtin_amdgcn_readfirstlane(tid >> 6), lane = tid & 63, r32 = lane & 31, hi = lane >> 5;
    constexpr int BUF = 3 * SHM_V;
    const int vb0 = (int)(uintptr_t)lds + v_rd_base(lane), vb1 = vb0 + BUF;
    const int sr = tid >> 4, sc = (tid & 15) * 8;
    const int kws = KSWZ(sr, sc * 2), vst0 = v_st(sr, sc), vst1 = v_st(32 + sr, sc);
    for (int u = blockIdx.x; u < NBATCH * GH * NBLK; u += gridDim.x) {
        const int bh = u / NBLK, j = u % NBLK, b = bh / GH, h = bh % GH;
        const size_t tok0 = (size_t)b * SEQ + j * 256;
        bf16x8 qr[8];
#pragma unroll
        for (int d0 = 0; d0 < 8; ++d0) qr[d0] = load8(proj + (tok0 + wid * 32 + r32) * NPROJ + C_GQ + h * GDK + d0 * 16 + hi * 8);
        f32x16 o[8] = {};
        bf16x8 sk0, sk1, sa0, sa1, sb0, sb1;
        const bf16_t* sp = Sj + (size_t)u * (GDK * GDV);
#define GO_LOAD(s_) do { if ((s_) < 4) { const bf16_t* rp = proj + (tok0 + (s_) * 64) * NPROJ; \
            sk0 = load8(rp + (size_t)sr * NPROJ + C_GK + h * GDK + sc); sk1 = load8(rp + (size_t)(32 + sr) * NPROJ + C_GK + h * GDK + sc); \
            sa0 = load8(rp + (size_t)sr * NPROJ + C_GV + h * GDV + sc); sa1 = load8(rp + (size_t)(32 + sr) * NPROJ + C_GV + h * GDV + sc); \
            sb0 = load8(rp + (size_t)sr * NPROJ + C_GV + h * GDV + 128 + sc); sb1 = load8(rp + (size_t)(32 + sr) * NPROJ + C_GV + h * GDV + 128 + sc); } \
          else { const bf16_t* rp = sp + (size_t)((s_) - 4) * 64 * GDV; \
            sa0 = load8(rp + (size_t)sr * GDV + sc); sa1 = load8(rp + (size_t)(32 + sr) * GDV + sc); \
            sb0 = load8(rp + (size_t)sr * GDV + 128 + sc); sb1 = load8(rp + (size_t)(32 + sr) * GDV + 128 + sc); } } while (0)
#define GO_WRITE(s_, bufo) do { if ((s_) < 4) { *(LAS bf16x8*)(lds + (bufo) + kws) = sk0; *(LAS bf16x8*)(lds + (bufo) + kws + 32 * 256) = sk1; } \
            *(LAS bf16x8*)(lds + (bufo) + SHM_V + vst0) = sa0; *(LAS bf16x8*)(lds + (bufo) + SHM_V + vst1) = sa1; \
            *(LAS bf16x8*)(lds + (bufo) + 2 * SHM_V + vst0) = sb0; *(LAS bf16x8*)(lds + (bufo) + 2 * SHM_V + vst1) = sb1; } while (0)
#define GO_STEP(s_, B_) do { GO_LOAD(s_); __syncthreads(); GO_WRITE(s_, (B_) * BUF); __syncthreads(); \
            if ((s_) < 4) { if ((s_) * 64 <= wid * 32 + 31) { f32x16 p0, p1; qkt<0>(p0, p1, lds + (B_) * BUF, r32, hi, qr); \
                    const int dq = wid * 32 + r32 - 4 * hi - (s_) * 64; \
                    _Pragma("unroll") for (int r = 0; r < 16; ++r) { const int c_ = (r & 3) + 8 * (r >> 2); if (dq - c_ < 0) p0[r] = 0.f; if (dq - c_ - 32 < 0) p1[r] = 0.f; } \
                    bf16x8 pa0, pa1, pa2, pa3; pack_p(p0, p1, pa0, pa1, pa2, pa3); \
                    pv_tile<SHM_V>(o, (B_) ? vb1 : vb0, pa0, pa1, pa2, pa3); pv_tile<2 * SHM_V>(o + 4, (B_) ? vb1 : vb0, pa0, pa1, pa2, pa3); } } \
            else { pv_tile<SHM_V>(o, (B_) ? vb1 : vb0, qr[4 * ((s_) - 4)], qr[4 * ((s_) - 4) + 1], qr[4 * ((s_) - 4) + 2], qr[4 * ((s_) - 4) + 3]); \
                   pv_tile<2 * SHM_V>(o + 4, (B_) ? vb1 : vb0, qr[4 * ((s_) - 4)], qr[4 * ((s_) - 4) + 1], qr[4 * ((s_) - 4) + 2], qr[4 * ((s_) - 4) + 3]); } } while (0)
        GO_STEP(0, 0); GO_STEP(1, 0); GO_STEP(2, 0); GO_STEP(3, 0); GO_STEP(4, 0); GO_STEP(5, 0);
#undef GO_LOAD
#undef GO_WRITE
#undef GO_STEP
        int hi_e = hi, r32_e = r32; asm volatile("" : "+v"(hi_e), "+v"(r32_e));
        float wv[8];
#pragma unroll
        for (int d0 = 0; d0 < 8; ++d0) wv[d0] = p.gla_norm_w[d0 * 32 + r32_e];
        const bf16_t* ggp = proj + (tok0 + wid * 32) * NPROJ + C_GG + h * GDV + r32_e;
        bf16_t* op = mixed + (tok0 + wid * 32) * DM + 1024 + h * GDV + r32_e;
#pragma unroll
        for (int r = 0; r < 16; ++r) { const int orow = crow(r, hi_e);
            float g[8];
#pragma unroll
            for (int d0 = 0; d0 < 8; ++d0) g[d0] = bf2f(ggp[(size_t)orow * NPROJ + d0 * 32]);
            float ss = 0.f;
#pragma unroll
            for (int d0 = 0; d0 < 8; ++d0) ss += o[d0][r] * o[d0][r];
            ss += __shfl_xor(ss, 1); ss += __shfl_xor(ss, 2); ss += __shfl_xor(ss, 4); ss += __shfl_xor(ss, 8); ss += __shfl_xor(ss, 16);
            const float rsr = 1.0f / sqrtf(ss * (1.0f / GDV) + EPS);
#pragma unroll
            for (int d0 = 0; d0 < 8; ++d0) { const float sg = g[d0] * __builtin_amdgcn_rcpf(1.0f + __expf(-g[d0]));
                const float v = o[d0][r] * rsr * wv[d0] * sg; const float vn = __shfl_xor(v, 1);
                if ((r32_e & 1) == 0) *(unsigned*)(op + (size_t)orow * DM + d0 * 32) = cvt_pk_bf16(v, vn); }
            asm volatile("" ::: "memory"); }
    }
    __syncthreads();
}
}

__device__ __forceinline__ void phase_route(const Params& p, const Ctx& c0) { const Ctx c = fresh_ctx(c0);
    const int* hist = (const int*)(p.ws + WS_HIST); const int* topi = (const int*)(p.ws + WS_TOPI); const float* rstd2 = (const float*)(p.ws + WS_RSTD2);
    int* dest = (int*)(p.ws + WS_DEST); int* row_tok = (int*)(p.ws + WS_ROWTOK); float* row_rstd = (float*)(p.ws + WS_ROWRSTD); int* blk = (int*)(p.ws + WS_BLKE);
    LAS int* cnt = (LAS int*)c.lds; LAS int* before = cnt + 32; LAS int* pstart = cnt + 64; LAS int* ea = cnt + 128;
    for (int g = blockIdx.x; g < T / 64; g += gridDim.x) {
        if (c.tid < 64) cnt[c.tid] = 0;
        __syncthreads();
        { const int e = c.tid & 31, part = c.tid >> 5; int tot = 0, bef = 0;
#pragma unroll
            for (int i = 0; i < 16; ++i) { const int gg = part * 16 + i; const int v = hist[gg * 32 + e]; tot += v; bef += (gg < g) ? v : 0; }
            atomicAdd((int*)&cnt[e], tot); atomicAdd((int*)&before[e], bef); }
        __syncthreads();
        if (c.tid == 0) { int acc = 0; for (int e = 0; e < NE; ++e) { pstart[e] = acc; acc += ((cnt[e] + 255) >> 8) << 8; } pstart[NE] = acc; }
        if (c.tid < 256) ea[c.tid] = topi[(size_t)g * 256 + c.tid];
        __syncthreads();
        if (c.tid < 256) {
            const int e = ea[c.tid]; int rank = 0;
            for (int a = 0; a < c.tid; ++a) rank += (ea[a] == e) ? 1 : 0;
            const int d = pstart[e] + before[e] + rank; const int tok = g * 64 + (c.tid >> 2);
            dest[(size_t)g * 256 + c.tid] = d; row_tok[d] = tok; row_rstd[d] = rstd2[tok];
        }
        if (g == 0 && c.tid < 64) {
            const int nb = pstart[NE] >> 8; if (c.tid == 0) blk[0] = nb;
            for (int bq = c.tid; bq < nb; bq += 64) { int e = 0; for (int q = 0; q < NE; ++q) e += (pstart[q + 1] <= bq * 256) ? 1 : 0; blk[64 + bq] = e < NE ? e : NE - 1; }
        }
        __syncthreads();
    }
}

__device__ __forceinline__ void phase_combine(const Params& p, const Ctx& c0, unsigned poison) { const Ctx c = fresh_ctx(c0);
    const float* X1 = (const float*)(p.ws + WS_X1); const unsigned char* Y = (const unsigned char*)(p.ws + WS_Y); const int* dest = (const int*)(p.ws + WS_DEST); const float* topg = (const float*)(p.ws + WS_TOPG);
    for (int t = blockIdx.x * NWAVES + c.wave; t < T; t += gridDim.x * NWAVES) {
        const int4 d4 = *(const int4*)(dest + (size_t)t * 4); const float4 g4 = *(const float4*)(topg + (size_t)t * 4);
        const int dd[4] = {d4.x, d4.y, d4.z, d4.w}; const float gg[4] = {g4.x * (1.0f / Y_SCALE), g4.y * (1.0f / Y_SCALE), g4.z * (1.0f / Y_SCALE), g4.w * (1.0f / Y_SCALE)};
        f32x4 v[8]; u32x2 yw[4][4]; float ss = 0.f;
#pragma unroll
        for (int j = 0; j < 4; ++j) { v[2 * j] = *(const f32x4*)(X1 + (size_t)t * DM + j * 512 + c.lane * 8); v[2 * j + 1] = *(const f32x4*)(X1 + (size_t)t * DM + j * 512 + c.lane * 8 + 4); }
#pragma unroll
        for (int k = 0; k < 4; ++k)
#pragma unroll
            for (int j = 0; j < 4; ++j) yw[k][j] = *(const u32x2*)(Y + (size_t)dd[k] * DM + j * 512 + c.lane * 8);
#pragma unroll
        for (int k = 0; k < 4; ++k)
#pragma unroll
            for (int j = 0; j < 4; ++j) { const f32x2 a = __builtin_amdgcn_cvt_pk_f32_fp8(yw[k][j].x, false), b = __builtin_amdgcn_cvt_pk_f32_fp8(yw[k][j].x, true);
                const f32x2 cc = __builtin_amdgcn_cvt_pk_f32_fp8(yw[k][j].y, false), d = __builtin_amdgcn_cvt_pk_f32_fp8(yw[k][j].y, true);
                v[2 * j][0] += gg[k] * a[0]; v[2 * j][1] += gg[k] * a[1]; v[2 * j][2] += gg[k] * b[0]; v[2 * j][3] += gg[k] * b[1];
                v[2 * j + 1][0] += gg[k] * cc[0]; v[2 * j + 1][1] += gg[k] * cc[1]; v[2 * j + 1][2] += gg[k] * d[0]; v[2 * j + 1][3] += gg[k] * d[1]; }
#pragma unroll
        for (int j = 0; j < 8; ++j) ss += (v[j][0] * v[j][0] + v[j][1] * v[j][1]) + (v[j][2] * v[j][2] + v[j][3] * v[j][3]);
        const float rs = 1.0f / sqrtf(wave_sum(ss) * (1.0f / DM) + EPS);
#pragma unroll
        for (int j = 0; j < 8; ++j) { const int col = (j >> 1) * 512 + c.lane * 8 + (j & 1) * 4; const f32x4 w = *(const f32x4*)(p.final_norm_w + col);
            f32x4 ov = v[j] * rs * w; if (poison) ov = (f32x4){__builtin_nanf(""), __builtin_nanf(""), __builtin_nanf(""), __builtin_nanf("")};
            *(f32x4*)(p.out + (size_t)t * DM + col) = ov; }
    }
}
__device__ __forceinline__ Ctx make_ctx(unsigned char* lds_generic) {
    Ctx c; c.lds = (LAS unsigned char*)lds_generic; c.tid = threadIdx.x; c.lane = c.tid & 63; c.wave = __builtin_amdgcn_readfirstlane(c.tid >> 6); return c;
}
__device__ __forceinline__ void phase_gemm_inproj16(const Params& p, const Ctx& c, int i0, int i1, int G, int cidx) {
    if (i0 >= i1) return;
    g8::DenseProb P{(const bf16_t*)(p.ws + WS_H), (const bf16_t*)(p.ws + WS_WIN) + (size_t)NPROJ8 * DM, T / 256, (NPROJ - NPROJ8) / 256, DM, G, cidx, i0, i1};
    g8::EpiProj E{(bf16_t*)(p.ws + WS_PROJ), (const float*)(p.ws + WS_RSTD1), 1.0f, NPROJ8};
    g8::gemm_phase(c.lds, P, E);
}
__device__ __forceinline__ void phase_gemm_outproj(const Params& p, const Ctx& c, int i0, int i1) {
    if (i0 >= i1) return;
    g8::DenseProb P{(const bf16_t*)(p.ws + WS_MIXED), (const bf16_t*)(p.ws + WS_WOUT), T / 256, DM / 256, DM, (int)gridDim.x, (int)blockIdx.x, i0, i1};
    g8::EpiX1 E{p.x, (float*)(p.ws + WS_X1)};
    g8::gemm_phase(c.lds, P, E);
}
__device__ __forceinline__ void phase_gemm_moe1(const Params& p, const Ctx& c, int i0, int i1) {
    g8::MoeProb1 P{(const bf16_t*)(p.ws + WS_H), (const bf16_t*)(p.ws + WS_WGU), (const int*)(p.ws + WS_ROWTOK), (const int*)(p.ws + WS_BLKE), DM / 2, __builtin_amdgcn_readfirstlane(*(const int*)(p.ws + WS_BLKE)), i0, i1};
    g8::EpiSwiglu E{(unsigned char*)(p.ws + WS_ACT), (const float*)(p.ws + WS_ROWRSTD), p.b_gu};
    g8::gemm_phase(c.lds, P, E);
}
__device__ __forceinline__ void phase_gemm_moe2(const Params& p, const Ctx& c) {
    g8::MoeProb2 P{(const bf16_t*)(p.ws + WS_ACT), (const bf16_t*)(p.ws + WS_WD), (const int*)(p.ws + WS_BLKE), FF / 2, __builtin_amdgcn_readfirstlane(*(const int*)(p.ws + WS_BLKE))};
    g8::EpiDown E{(unsigned char*)(p.ws + WS_Y), p.b_d};
    g8::gemm_phase(c.lds, P, E);
}


#ifndef MX_SELFTEST
#define MX_SELFTEST 0
#endif
__device__ __forceinline__ void mx_selftest(unsigned* flag) {
    const int l = threadIdx.x & 63, fr = l & 15, fq = l >> 4;
    unsigned aw[8], bw[8];
#pragma unroll
    for (int d = 0; d < 8; ++d) { float av[4], bv[4];
#pragma unroll
        for (int q = 0; q < 4; ++q) { const int e = 4 * d + q; const int k = e < 16 ? 16 * fq + e : 64 + 16 * fq + (e - 16);
            av[q] = (float)(((fr * 7 + k * 3) % 5) - 2); bv[q] = (float)(((fr * 5 + k) % 7) - 3); }
        aw[d] = cvt4_fp8(av[0], av[1], av[2], av[3]); bw[d] = cvt4_fp8(bv[0], bv[1], bv[2], bv[3]); }
    const i32x8 A = {(int)aw[0], (int)aw[1], (int)aw[2], (int)aw[3], (int)aw[4], (int)aw[5], (int)aw[6], (int)aw[7]};
    const i32x8 B = {(int)bw[0], (int)bw[1], (int)bw[2], (int)bw[3], (int)bw[4], (int)bw[5], (int)bw[6], (int)bw[7]};
    f32x4 acc = {0.f, 0.f, 0.f, 0.f};
    acc = __builtin_amdgcn_mfma_scale_f32_16x16x128_f8f6f4(B, A, acc, 0, 0, 0, 0x7f7f7f7f, 0, 0x7f7f7f7f);
    bool bad = false;
#pragma unroll
    for (int r = 0; r < 4; ++r) { const int m = fr, n = 4 * fq + r; int sum = 0;
        for (int k = 0; k < 128; ++k) sum += (((m * 7 + k * 3) % 5) - 2) * (((n * 5 + k) % 7) - 3);
        bad |= (acc[r] != (float)sum); }
    if (bad) atomicOr(flag, 1u);
}
constexpr int CW_BAR = 4096;
__global__ void __launch_bounds__(NTHREADS, 2) fwd(Params p) {
    extern __shared__ __attribute__((aligned(16))) unsigned char lds_raw[];
    const Ctx c = make_ctx(lds_raw);
    if (c.tid < 64) ((LAS unsigned*)(c.lds + LDS_MISC))[c.tid] = 0u;
    __syncthreads();
    const XcdBarrier bar = xcd_barrier_post((unsigned*)(p.ws + WS_CTL) + CW_BAR, (volatile LAS unsigned*)(c.lds + LDS_MISC + 32));
    const att::lptr al = (att::lptr)c.lds;
    if (MX_SELFTEST && blockIdx.x == 0 && c.wave == 0) mx_selftest((unsigned*)(p.ws + WS_CTL) + 8);
#ifndef PROBE_DUP
#define PROBE_DUP 0
#endif
    phase_convert(p, c); phase_norm1(p, c); if (PROBE_DUP & 64) { __syncthreads(); phase_norm1(p, c); }
    xcd_barrier(bar);
    for (int rep = 0; rep < ((PROBE_DUP & 1) ? 2 : 1); ++rep) {
        const int bx = blockIdx.x, G = gridDim.x;
        const int cut = (G == 256) ? (bx >> 3) % 7 : 0;
        if (cut > 0) phase_gemm_inproj16(p, c, 0, cut, G, bx);
        phase_convert_share(p, c, 0, CT_GU, G, bx);
        phase_gemm_inproj16(p, c, cut, 1 << 20, G, bx);
    }
    xcd_barrier(bar);
    phase_rope_kmean(p, c); phase_gla_prep(p, c);
    xcd_barrier(bar);
    att::phase_gla_state(p, al, c.tid); att::phase_moba_select(p, al, c.tid); if (PROBE_DUP & 128) { __syncthreads(); att::phase_gla_state(p, al, c.tid); att::phase_moba_select(p, al, c.tid); }
    xcd_barrier(bar);
    att::phase_gla_scan(p, c.tid); if (PROBE_DUP & 128) { __syncthreads(); att::phase_gla_scan(p, c.tid); }
    xcd_barrier(bar);
    att::phase_gla_out(p, al, c.tid); att::phase_moba(p, al); if (PROBE_DUP & 4) { __syncthreads(); att::phase_gla_out(p, al, c.tid); att::phase_moba(p, al); }
    xcd_barrier(bar);
    phase_gemm_outproj(p, c, 0, 1 << 20); if (PROBE_DUP & 8) { __syncthreads(); phase_gemm_outproj(p, c, 0, 1 << 20); }
    xcd_barrier(bar);
    phase_norm2_router(p, c); if (PROBE_DUP & 64) { __syncthreads(); phase_norm2_router(p, c); }
    xcd_barrier(bar);
    phase_route(p, c); if (PROBE_DUP & 128) { __syncthreads(); phase_route(p, c); }
    xcd_barrier(bar);
    for (int rep = 0; rep < ((PROBE_DUP & 16) ? 2 : 1); ++rep) {
        const int cut = 2 * ((blockIdx.x >> 3) & 7);
        if (cut > 0) phase_gemm_moe1(p, c, 0, cut);
        phase_convert_share(p, c, CT_GU, CT_TOTAL, (int)gridDim.x, (int)blockIdx.x);
        phase_gemm_moe1(p, c, cut, 1 << 20);
    }
    xcd_barrier(bar);
    phase_gemm_moe2(p, c); if (PROBE_DUP & 32) { __syncthreads(); phase_gemm_moe2(p, c); }
    xcd_barrier(bar);
    if (PROBE_DUP & 64) { phase_combine(p, c, 0u); __syncthreads(); }
    phase_combine(p, c, MX_SELFTEST ? *((volatile unsigned*)(p.ws + WS_CTL) + 8) : 0u);
}

extern "C" void kernel_launch(void* const* d_in, const int* in_sizes, int n_in, void* d_out, int out_size, void* d_ws, size_t ws_size, hipStream_t stream) {
    static int grid = 0;
    if (grid == 0) {
        if (n_in != 15 || ws_size < WS_END) { fprintf(stderr, "kernel_launch: unexpected inputs (n_in %d, ws %zu)\n", n_in, ws_size); grid = -1; return; }
        int dev = 0, cus = 0, per_cu = 0;
        if (hipGetDevice(&dev) != hipSuccess || hipDeviceGetAttribute(&cus, hipDeviceAttributeMultiprocessorCount, dev) != hipSuccess) { grid = -1; return; }
        if (hipFuncSetAttribute((const void*)fwd, hipFuncAttributeMaxDynamicSharedMemorySize, LDS_BYTES) != hipSuccess) { fprintf(stderr, "kernel_launch: hipFuncSetAttribute failed\n"); grid = -1; return; }
        if (hipOccupancyMaxActiveBlocksPerMultiprocessor(&per_cu, (const void*)fwd, NTHREADS, LDS_BYTES) != hipSuccess || per_cu < 1) { fprintf(stderr, "kernel_launch: occupancy query says %d blocks per CU\n", per_cu); }
        (void)hipGetLastError();
        grid = cus > 0 ? cus : 256;
    }
    if (grid < 0) return;
    Params p{};
    p.x = (const float*)d_in[0]; p.attn_norm_w = (const float*)d_in[1]; p.w_in = (const float*)d_in[2]; p.gate_w2 = (const float*)d_in[3]; p.gate_b = (const float*)d_in[4];
    p.gla_norm_w = (const float*)d_in[5]; p.w_out = (const float*)d_in[6]; p.ffn_norm_w = (const float*)d_in[7]; p.router_w = (const float*)d_in[8]; p.router_b = (const float*)d_in[9];
    p.w_gu = (const float*)d_in[10]; p.b_gu = (const float*)d_in[11]; p.w_d = (const float*)d_in[12]; p.b_d = (const float*)d_in[13]; p.final_norm_w = (const float*)d_in[14];
    p.out = (float*)d_out; p.ws = (unsigned char*)d_ws;
    if (hipMemsetAsync((char*)d_ws + WS_CTL, 0, CTL_BYTES, stream) != hipSuccess) return;
    hipLaunchKernelGGL(fwd, dim3(grid), dim3(NTHREADS), LDS_BYTES, stream, p);
}
```

```cpp
#include <hip/hip_runtime.h>
#include <stdint.h>
#include <stdio.h>

#define LAS __attribute__((address_space(3)))
typedef unsigned short bf16_t;
typedef short bf16x8 __attribute__((ext_vector_type(8)));
typedef short s16x4 __attribute__((ext_vector_type(4)));
typedef float f32x2 __attribute__((ext_vector_type(2)));
typedef float f32x4 __attribute__((ext_vector_type(4)));
typedef float f32x16 __attribute__((ext_vector_type(16)));
typedef unsigned u32x2 __attribute__((ext_vector_type(2)));
typedef unsigned u32x4 __attribute__((ext_vector_type(4)));
typedef int i32x8 __attribute__((ext_vector_type(8)));

constexpr int NBATCH = 4, SEQ = 4096, T = NBATCH * SEQ, DM = 2048;
constexpr int HD = 128, MH = 8, MBLK = 256, NBLK = SEQ / MBLK;
constexpr int GH = 4, GDK = 128, GDV = 256;
constexpr int LDW_IN = 6160, NPROJ = 6144;
constexpr int C_MQ = 0, C_MK = 1024, C_MV = 2048, C_GQ = 3072, C_GK = 3584, C_GV = 4096, C_GG = 5120, C_GZ = 6144;
constexpr int NE = 32, TOPK = 4, FF = 2048, NASSIGN = T * TOPK;
constexpr int MAXBLK = (NASSIGN + NE * 255) / 256, PROWS = MAXBLK * 256;
constexpr float EPS = 1e-5f;
constexpr float ACT_SCALE = 4.0f, W_SCALE = 64.0f, F8_UNSCALE = 1.0f / (ACT_SCALE * W_SCALE);
constexpr float Y_SCALE = 16.0f;

constexpr size_t MiB = (size_t)1 << 20;
constexpr size_t WS_CTL = 0, CTL_BYTES = 64 * 1024;
constexpr size_t WS_WIN = 16 * MiB;
constexpr size_t WS_WOUT = 40 * MiB;
constexpr size_t WS_ROPE = 48 * MiB;
constexpr size_t WS_RSTD1 = 50 * MiB;
constexpr size_t WS_GZ = 51 * MiB;
constexpr size_t WS_KMEAN = 52 * MiB;
constexpr size_t WS_DEND = 52 * MiB + 512 * 1024;
constexpr size_t WS_RSTD2 = 53 * MiB;
constexpr size_t WS_SEL = 54 * MiB;
constexpr size_t WS_TOPI = 55 * MiB;
constexpr size_t WS_TOPG = 55 * MiB + 512 * 1024;
constexpr size_t WS_HIST = 56 * MiB;
constexpr size_t WS_DEST = 56 * MiB + 512 * 1024;
constexpr size_t WS_ROWTOK = 57 * MiB;
constexpr size_t WS_ROWRSTD = 57 * MiB + 512 * 1024;
constexpr size_t WS_BLKE = 58 * MiB;
constexpr size_t WS_H = 64 * MiB;
constexpr size_t WS_PROJ = 128 * MiB;
constexpr size_t WS_MIXED = 320 * MiB;
constexpr size_t WS_X1 = 384 * MiB;
constexpr size_t WS_U = 512 * MiB;
constexpr size_t WS_SJ = 544 * MiB;
constexpr size_t WS_GLAO = 560 * MiB;
constexpr size_t WS_WGU = 640 * MiB;
constexpr size_t WS_WD = 1152 * MiB;
constexpr size_t WS_ACT = 1408 * MiB;
constexpr size_t WS_Y = 1696 * MiB;
constexpr size_t WS_H8 = WS_ACT;
constexpr size_t WS_WIN8 = 8 * MiB;
constexpr int NPROJ8 = 0;
constexpr size_t WS_END = 1984 * MiB;

constexpr int NTHREADS = 512, NWAVES = 8;
constexpr int LDS_BYTES = 149504;
constexpr int LDS_MISC = LDS_BYTES - 256;

struct Params {
    const float* x; const float* attn_norm_w; const float* w_in; const float* gate_w2; const float* gate_b; const float* gla_norm_w;
    const float* w_out; const float* ffn_norm_w; const float* router_w; const float* router_b; const float* w_gu; const float* b_gu;
    const float* w_d; const float* b_d; const float* final_norm_w;
    float* out; unsigned char* ws;
};

__device__ __forceinline__ unsigned cvt_pk_bf16(float lo, float hi) { unsigned r; asm volatile("v_cvt_pk_bf16_f32 %0, %1, %2" : "=v"(r) : "v"(lo), "v"(hi)); return r; }
__device__ __forceinline__ unsigned cvt4_fp8(float a, float b, float c, float d) { unsigned w = 0u; w = __builtin_amdgcn_cvt_pk_fp8_f32(a, b, w, false); w = __builtin_amdgcn_cvt_pk_fp8_f32(c, d, w, true); return w; }
__device__ __forceinline__ float bf2f(unsigned short b) { return __uint_as_float(((unsigned)b) << 16); }
__device__ __forceinline__ float bflo(unsigned w) { return __uint_as_float(w << 16); }
__device__ __forceinline__ float bfhi(unsigned w) { return __uint_as_float(w & 0xffff0000u); }
__device__ __forceinline__ bf16x8 pack8(f32x4 a, f32x4 b) {
    u32x4 w = {cvt_pk_bf16(a[0], a[1]), cvt_pk_bf16(a[2], a[3]), cvt_pk_bf16(b[0], b[1]), cvt_pk_bf16(b[2], b[3])};
    return __builtin_bit_cast(bf16x8, w);
}
__device__ __forceinline__ float wave_sum(float v) {
#pragma unroll
    for (int o = 1; o < 64; o <<= 1) v += __shfl_xor(v, o);
    return v;
}
#define LDS_WAIT() asm volatile("s_waitcnt lgkmcnt(0)" ::: "memory")
#define VM_WAIT() asm volatile("s_waitcnt vmcnt(0)" ::: "memory")
#define SBAR() __builtin_amdgcn_sched_barrier(0)
#define XB_TMO      128
#define XB_XCNT(j)  (256  + 64 * (j))
#define XB_XSUB(j)  (1280 + 64 * (j))
#define XB_XGEN(j)  (2304 + 64 * (j))
#define XB_TOP      3328
#define XB_TOPGEN   3392
#define XCD_BAR_WORDS 3456
#define XB_SPIN_CAP (1u << 18)

__device__ __forceinline__ unsigned xb_ld(unsigned* p)              { return __hip_atomic_load(p, __ATOMIC_RELAXED, __HIP_MEMORY_SCOPE_AGENT); }
__device__ __forceinline__ unsigned xb_add(unsigned* p, unsigned v) { return __hip_atomic_fetch_add(p, v, __ATOMIC_RELAXED, __HIP_MEMORY_SCOPE_AGENT); }
__device__ __forceinline__ unsigned xb_xcc_id() { return (unsigned)__builtin_amdgcn_s_getreg((3 << 11) | 20) & 0xFu; }
#define XB_SPIN(cond, bar) do { unsigned _sp = 0; while (cond) { __builtin_amdgcn_s_sleep(1); \
    if ((++_sp & 255u) == 0u) { if (xb_ld(&(bar)[XB_TMO])) break; if (_sp > XB_SPIN_CAP) { atomicAdd(&(bar)[XB_TMO], 1u); break; } } } } while (0)

struct XcdBarrier {
    unsigned* bar; unsigned x;
    volatile LAS unsigned* st;
};

__device__ __forceinline__ XcdBarrier xcd_barrier_post(unsigned* bar, volatile LAS unsigned* st) {
    XcdBarrier b; b.bar = bar; b.x = xb_xcc_id(); b.st = st;
    if (threadIdx.x == 0) (void)xb_add(&bar[XB_XCNT(b.x)], 1u);
    return b;
}
__device__ __forceinline__ void xcd_barrier_complete(unsigned* bar, unsigned x, unsigned& nloc, unsigned& nx) {
    const unsigned G = gridDim.x * gridDim.y * gridDim.z;
    unsigned sum, cnt, mine, sp = 0u;
    for (;;) {
        sum = 0u; cnt = 0u; mine = 0u;
#pragma unroll
        for (unsigned j = 0; j < 16; ++j) { const unsigned c = xb_ld(&bar[XB_XCNT(j)]); sum += c; cnt += (c > 0u) ? 1u : 0u; mine = (j == x) ? c : mine; }
        if (sum == G) break;
        __builtin_amdgcn_s_sleep(1);
        if ((++sp & 255u) == 0u) { if (xb_ld(&bar[XB_TMO])) break; if (sp > XB_SPIN_CAP) { atomicAdd(&bar[XB_TMO], 1u); break; } }
    }
    nloc = mine > 0u ? mine : 1u; nx = cnt > 0u ? cnt : 1u;
}

__device__ __forceinline__ void xcd_barrier(const XcdBarrier& b) {
    asm volatile("s_waitcnt vmcnt(0)" ::: "memory");
    __syncthreads();
    if (threadIdx.x == 0) {
        unsigned* bar = b.bar;
        __builtin_amdgcn_s_waitcnt(0);
        unsigned nloc = b.st[0], nx = b.st[1];
        if (nloc == 0u) { xcd_barrier_complete(bar, b.x, nloc, nx); b.st[0] = nloc; b.st[1] = nx; }
        const unsigned old = xb_add(&bar[XB_XSUB(b.x)], 1u);
        const unsigned gen = old / nloc;
        if (old + 1u == (gen + 1u) * nloc) {
            __builtin_amdgcn_fence(__ATOMIC_RELEASE, "agent");
            asm volatile("s_waitcnt vmcnt(0)" ::: "memory");
            const unsigned og = xb_add(&bar[XB_TOP], 1u);
            const unsigned tg = og / nx;
            if (og + 1u == (tg + 1u) * nx) xb_add(&bar[XB_TOPGEN], 1u);
            else XB_SPIN(xb_ld(&bar[XB_TOPGEN]) == tg, bar);
            __builtin_amdgcn_fence(__ATOMIC_ACQUIRE, "agent");
            xb_add(&bar[XB_XGEN(b.x)], 1u);
            asm volatile("s_waitcnt vmcnt(0)" ::: "memory");
        } else {
            XB_SPIN(xb_ld(&bar[XB_XGEN(b.x)]) == gen, bar);
            __builtin_amdgcn_fence(__ATOMIC_ACQUIRE, "agent");
            asm volatile("s_waitcnt vmcnt(0)" ::: "memory");
        }
    }
    __syncthreads();
}

namespace g8 {
constexpr int BM = 256, BK = 64, HALF = 128, HTB = HALF * BK * 2, STAGE_BYTES = 8 * HTB, NXCD = 8, WGM = 8;
__host__ __device__ __forceinline__ int lds_byte(int r, int c) { const int st = (r >> 4) * 2 + (c >> 5), rr = r & 15, cc = c & 31, ob = rr * 64 + cc * 2; return st * 1024 + (ob ^ (((ob >> 9) & 1) << 5)); }
__host__ __device__ __forceinline__ void stage_rc(int b, int& R, int& C) { const int st = b / 1024, sb = b % 1024, swz = sb ^ (((sb >> 9) & 1) << 5); R = (st >> 1) * 16 + swz / 64; C = (st & 1) * 32 + (swz % 64) / 2; }
__host__ __device__ __forceinline__ int perm32(int rho) { const int n = rho >> 4, i = rho & 15; return 8 * (i >> 2) + 4 * n + (i & 3); }

struct Unit { int pm, pn, e; };

__device__ __forceinline__ bool static_next(int i, int nM, int nN, int G, int c, Unit& u) {
    const int nwg = nM * nN; const long L = (long)i * G + c; if (L >= nwg) return false;
    int wgid = (int)L; { const int q = nwg / NXCD, r = nwg % NXCD, xcd = wgid % NXCD, off = wgid / NXCD; wgid = (xcd < r ? xcd * (q + 1) : r * (q + 1) + (xcd - r) * q) + off; }
    const int nig = WGM * nN, gid = wgid / nig, fm = gid * WGM, gsz = (nM - fm) < WGM ? (nM - fm) : WGM;
    u.pm = fm + ((wgid % nig) % gsz); u.pn = (wgid % nig) / gsz; u.e = 0; return true;
}

template <class Prob, class Epi>
__device__ __forceinline__ void gemm_phase(LAS unsigned char* lds, const Prob& P, const Epi& E) {
    int tid = threadIdx.x; asm volatile("" : "+v"(tid));
    const int wid = __builtin_amdgcn_readfirstlane(tid >> 6), lane = tid & 63, wr = wid >> 2, wc = wid & 3, fr = lane & 15, fq = lane >> 4;
    const int K = P.K, nt = K / BK;
    int RA[2], CA[2]; unsigned voffB[2];
#pragma unroll
    for (int i = 0; i < 2; ++i) { int R, C; stage_rc(tid * 16 + i * 8192, R, C); const int Rb = Epi::PERM ? ((R & ~31) + perm32(R & 31)) : R;
        RA[i] = R; CA[i] = C; voffB[i] = (unsigned)(Rb * K + C) * 2u; }
    const size_t kstep = (size_t)(BK * 2);
    const size_t hstep = (size_t)HALF * K * 2;
    const unsigned ldsw = (unsigned)wid * 1024u;
    const int aoff = lds_byte(wr * 64 + fr, fq * 8), boff = lds_byte(wc * 32 + fr, fq * 8);
#define G8_SA(b, h) (((b) * 2 + (h)) * HTB)
#define G8_SB(b, h) ((4 + (b) * 2 + (h)) * HTB)
#define G8_STAGE_B(bufoff, gbase) do { _Pragma("unroll") for (int _i = 0; _i < 2; ++_i) \
        __builtin_amdgcn_global_load_lds((const unsigned*)((const char*)(gbase) + voffB[_i]), (LAS unsigned*)(lds + (bufoff) + ldsw + _i * 8192), 16, 0, 0); } while (0)
#define G8_STAGE_A(bufoff, o0, o1) do { \
        __builtin_amdgcn_global_load_lds((const unsigned*)(Ab + (o0)), (LAS unsigned*)(lds + (bufoff) + ldsw), 16, 0, 0); \
        __builtin_amdgcn_global_load_lds((const unsigned*)(Ab + (o1)), (LAS unsigned*)(lds + (bufoff) + ldsw + 8192), 16, 0, 0); } while (0)
#define G8_CAT(lo, hi) __builtin_bit_cast(i32x8, __builtin_shufflevector(lo, hi, 0, 1, 2, 3, 4, 5, 6, 7))
#define G8_LO(v) __builtin_bit_cast(bf16x8, __builtin_shufflevector(v, v, 0, 1, 2, 3))
#define G8_HI(v) __builtin_bit_cast(bf16x8, __builtin_shufflevector(v, v, 4, 5, 6, 7))
#define G8_LDA(dst, b, h) do { _Pragma("unroll") for (int m = 0; m < 4; ++m) { const u32x4 _l = *(const LAS u32x4*)(lds + G8_SA(b, h) + aoff + m * 2048), _h = *(const LAS u32x4*)(lds + G8_SA(b, h) + aoff + m * 2048 + 1024); dst[m] = G8_CAT(_l, _h); } } while (0)
#define G8_LDB(dst, b, h) do { _Pragma("unroll") for (int n = 0; n < 2; ++n) { const u32x4 _l = *(const LAS u32x4*)(lds + G8_SB(b, h) + boff + n * 2048), _h = *(const LAS u32x4*)(lds + G8_SB(b, h) + boff + n * 2048 + 1024); dst[n] = G8_CAT(_l, _h); } } while (0)
#define G8_MMA(ai, bj, At, Bt) do { __builtin_amdgcn_s_setprio(1); \
        if constexpr (Prob::FP8) { _Pragma("unroll") for (int m = 0; m < 4; ++m) _Pragma("unroll") for (int n = 0; n < 2; ++n) \
            asm volatile("v_mfma_scale_f32_16x16x128_f8f6f4 %0, %1, %2, %0, %3, %3 op_sel_hi:[0,0,0]" : "+v"(acc[ai][bj][m][n]) : "v"(Bt[n]), "v"(At[m]), "v"(f8scale)); } \
        else { _Pragma("unroll") for (int m = 0; m < 4; ++m) _Pragma("unroll") for (int n = 0; n < 2; ++n) { \
            acc[ai][bj][m][n] = __builtin_amdgcn_mfma_f32_16x16x32_bf16(G8_LO(Bt[n]), G8_LO(At[m]), acc[ai][bj][m][n], 0, 0, 0); \
            acc[ai][bj][m][n] = __builtin_amdgcn_mfma_f32_16x16x32_bf16(G8_HI(Bt[n]), G8_HI(At[m]), acc[ai][bj][m][n], 0, 0, 0); } } \
        __builtin_amdgcn_s_setprio(0); } while (0)
#define G8_WAIT_V(n) asm volatile("s_waitcnt vmcnt(" #n ")" ::: "memory")
#define G8_WAIT_L(n) asm volatile("s_waitcnt lgkmcnt(" #n ")" ::: "memory")
#define G8_BAR __builtin_amdgcn_s_barrier()
#define G8_SCHED __builtin_amdgcn_sched_barrier(0)
    Unit cur, nxt, nn; int ui = 0;
    if (!P.next(0, cur)) return;
    const int f8scale = 0x7f7f7f7f;
    f32x4 acc[2][2][4][2];
#pragma unroll
    for (int a = 0; a < 2; ++a)
#pragma unroll
        for (int b = 0; b < 2; ++b)
#pragma unroll
            for (int m = 0; m < 4; ++m)
#pragma unroll
                for (int n = 0; n < 2; ++n) acc[a][b][m][n] = (f32x4){0.f, 0.f, 0.f, 0.f};
    i32x8 At[4], B0[2], B1[2];
    const char* Ab = (const char*)P.a_base();
    unsigned aoc[2][2], aon[2][2]; int raw[2][2];
    P.a_fetch(cur, RA, raw); P.a_finish(raw, CA, aoc);
    bool has_next = P.next(1, nxt);
    if (has_next) { P.a_fetch(nxt, RA, raw); P.a_finish(raw, CA, aon); }
    else { aon[0][0] = aoc[0][0]; aon[0][1] = aoc[0][1]; aon[1][0] = aoc[1][0]; aon[1][1] = aoc[1][1]; }
    const char* cB = (const char*)P.b_ptr(cur);
    const char* nB = has_next ? (const char*)P.b_ptr(nxt) : cB;
    typename Epi::Pre pre = E.fetch(cur, wr, wc, fr, fq);
    G8_STAGE_B(G8_SB(0, 0), cB); G8_STAGE_B(G8_SB(0, 1), cB + hstep); G8_STAGE_A(G8_SA(0, 0), aoc[0][0], aoc[0][1]); G8_STAGE_A(G8_SA(0, 1), aoc[1][0], aoc[1][1]);
    if (wr == 1) G8_BAR;
    G8_WAIT_V(2); G8_BAR;
    G8_STAGE_B(G8_SB(1, 0), cB + kstep); G8_STAGE_A(G8_SA(1, 0), aoc[0][0] + 128u, aoc[0][1] + 128u); G8_STAGE_B(G8_SB(1, 1), cB + hstep + kstep);
    G8_WAIT_V(6); G8_BAR;
    for (;;) {
        for (int t = 0; t < nt; t += 2) {
            const bool last = (t == nt - 2);
            const unsigned k1 = (unsigned)(t + 1) * 128u;
            const unsigned k2 = last ? 0u : (unsigned)(t + 2) * 128u;
            const unsigned a2_00 = (last ? aon[0][0] : aoc[0][0]) + k2, a2_01 = (last ? aon[0][1] : aoc[0][1]) + k2;
            const unsigned a2_10 = (last ? aon[1][0] : aoc[1][0]) + k2, a2_11 = (last ? aon[1][1] : aoc[1][1]) + k2;
            const char* b2 = last ? nB : cB + (size_t)(t + 2) * kstep;
            const char* b3 = b2 + kstep;
            G8_LDB(B0, 0, 0); G8_LDB(B1, 0, 1); G8_SCHED; G8_LDA(At, 0, 0); G8_STAGE_A(G8_SA(1, 1), aoc[1][0] + k1, aoc[1][1] + k1);
            G8_WAIT_V(8); G8_WAIT_L(0); G8_BAR; G8_MMA(0, 0, At, B0); G8_MMA(0, 1, At, B1); G8_BAR; G8_SCHED;
            G8_LDA(At, 0, 1); G8_STAGE_B(G8_SB(0, 0), b2); G8_STAGE_B(G8_SB(0, 1), b2 + hstep); G8_STAGE_A(G8_SA(0, 0), a2_00, a2_01);
            G8_WAIT_V(8); G8_WAIT_L(0); G8_BAR; G8_MMA(1, 0, At, B0); G8_MMA(1, 1, At, B1); G8_BAR; G8_SCHED;
            G8_LDB(B0, 1, 0); G8_LDB(B1, 1, 1); G8_SCHED; G8_LDA(At, 1, 0); G8_STAGE_A(G8_SA(0, 1), a2_10, a2_11);
            G8_WAIT_V(8); G8_WAIT_L(0); G8_BAR; G8_MMA(0, 0, At, B0); G8_MMA(0, 1, At, B1); G8_BAR; G8_SCHED;
            G8_LDA(At, 1, 1); G8_STAGE_B(G8_SB(1, 0), b3); G8_STAGE_B(G8_SB(1, 1), b3 + hstep); G8_STAGE_A(G8_SA(1, 0), a2_00 + 128u, a2_01 + 128u);
            G8_WAIT_V(8); G8_WAIT_L(0); G8_BAR; G8_MMA(1, 0, At, B0); G8_MMA(1, 1, At, B1); G8_BAR; G8_SCHED;
        }
        if (wr == 0) G8_BAR;
        if constexpr (Prob::FP8) asm volatile("s_nop 15\n\ts_nop 15" ::: "memory");
        const bool has_nn = has_next && P.next(ui + 2, nn);
        if (has_nn) P.a_fetch(nn, RA, raw);
        typename Epi::Pre pren = pre; if (has_next) pren = E.fetch(nxt, wr, wc, fr, fq);
        E(acc, cur, pre, wr, wc, fr, fq); pre = pren;
        if (!has_next) break;
#pragma unroll
        for (int a = 0; a < 2; ++a)
#pragma unroll
            for (int b = 0; b < 2; ++b)
#pragma unroll
                for (int m = 0; m < 4; ++m)
#pragma unroll
                    for (int n = 0; n < 2; ++n) acc[a][b][m][n] = (f32x4){0.f, 0.f, 0.f, 0.f};
        cur = nxt; cB = nB; ++ui;
        aoc[0][0] = aon[0][0]; aoc[0][1] = aon[0][1]; aoc[1][0] = aon[1][0]; aoc[1][1] = aon[1][1];
        nxt = nn; has_next = has_nn;
        if (has_next) { P.a_finish(raw, CA, aon); nB = (const char*)P.b_ptr(nxt); }
        else { nB = cB; }
        if (wr == 1) G8_BAR;
    }
    G8_WAIT_V(0);
    G8_BAR;
#undef G8_SA
#undef G8_SB
#undef G8_STAGE_A
#undef G8_STAGE_B
#undef G8_LDA
#undef G8_LDB
#undef G8_MMA
#undef G8_CAT
#undef G8_LO
#undef G8_HI
#undef G8_WAIT_V
#undef G8_WAIT_L
#undef G8_BAR
#undef G8_SCHED
}
}
namespace g8 {
template <bool F8> struct DenseProbT {
    static constexpr bool FP8 = F8;
    const bf16_t* A; const bf16_t* Bt; int nM, nN, K, G, c, i0, i1;
    __device__ __forceinline__ bool next(int i, Unit& u) const { return (i0 + i < i1) && static_next(i0 + i, nM, nN, G, c, u); }
    __device__ __forceinline__ const void* a_base() const { return A; }
    __device__ __forceinline__ void a_fetch(const Unit& u, const int (&RA)[2], int (&raw)[2][2]) const {
#pragma unroll
        for (int h = 0; h < 2; ++h)
#pragma unroll
            for (int i = 0; i < 2; ++i) raw[h][i] = u.pm * BM + h * HALF + RA[i];
    }
    __device__ __forceinline__ void a_finish(const int (&raw)[2][2], const int (&CA)[2], unsigned (&ao)[2][2]) const {
#pragma unroll
        for (int h = 0; h < 2; ++h)
#pragma unroll
            for (int i = 0; i < 2; ++i) ao[h][i] = (unsigned)((raw[h][i] * K + CA[i]) * 2);
    }
    __device__ __forceinline__ const void* b_ptr(const Unit& u) const { return Bt + (size_t)u.pn * BM * K; }
};
typedef DenseProbT<false> DenseProb;
struct MoeProb1 {
    static constexpr bool FP8 = true;
    const bf16_t* A; const bf16_t* Bt; const int* row_tok; const int* blk; int K; int nM; int i0, i1;
    __device__ __forceinline__ bool next(int i, Unit& u) const {
        if (i0 + i >= i1 || !static_next(i0 + i, nM, 2 * FF / BM, gridDim.x, blockIdx.x, u)) return false;
        u.e = blk[64 + u.pm]; return true; }
    __device__ __forceinline__ const void* a_base() const { return A; }
    __device__ __forceinline__ void a_fetch(const Unit& u, const int (&RA)[2], int (&raw)[2][2]) const {
#pragma unroll
        for (int h = 0; h < 2; ++h)
#pragma unroll
            for (int i = 0; i < 2; ++i) raw[h][i] = row_tok[u.pm * BM + h * HALF + RA[i]];
    }
    __device__ __forceinline__ void a_finish(const int (&raw)[2][2], const int (&CA)[2], unsigned (&ao)[2][2]) const {
#pragma unroll
        for (int h = 0; h < 2; ++h)
#pragma unroll
            for (int i = 0; i < 2; ++i) ao[h][i] = (unsigned)((raw[h][i] * K + CA[i]) * 2);
    }
    __device__ __forceinline__ const void* b_ptr(const Unit& u) const { return Bt + ((size_t)__builtin_amdgcn_readfirstlane(u.e) * (2 * FF) + (size_t)u.pn * BM) * K; }
};
struct MoeProb2 {
    static constexpr bool FP8 = true;
    const bf16_t* A; const bf16_t* Bt; const int* blk; int K; int nM;
    __device__ __forceinline__ bool next(int i, Unit& u) const {
        if (!static_next(i, nM, DM / BM, gridDim.x, blockIdx.x, u)) return false;
        u.e = blk[64 + u.pm]; return true; }
    __device__ __forceinline__ const void* a_base() const { return A; }
    __device__ __forceinline__ void a_fetch(const Unit& u, const int (&RA)[2], int (&raw)[2][2]) const {
#pragma unroll
        for (int h = 0; h < 2; ++h)
#pragma unroll
            for (int i = 0; i < 2; ++i) raw[h][i] = u.pm * BM + h * HALF + RA[i];
    }
    __device__ __forceinline__ void a_finish(const int (&raw)[2][2], const int (&CA)[2], unsigned (&ao)[2][2]) const {
#pragma unroll
        for (int h = 0; h < 2; ++h)
#pragma unroll
            for (int i = 0; i < 2; ++i) ao[h][i] = (unsigned)((raw[h][i] * K + CA[i]) * 2);
    }
    __device__ __forceinline__ const void* b_ptr(const Unit& u) const { return Bt + ((size_t)__builtin_amdgcn_readfirstlane(u.e) * DM + (size_t)u.pn * BM) * K; }
};

struct EpiProj {
    static constexpr bool PERM = true;
    bf16_t* __restrict__ O; const float* __restrict__ rstd; float scale; int colbase;
    struct Pre { float rs[2][4]; };
    __device__ __forceinline__ Pre fetch(const Unit& u, int wr, int wc, int fr, int fq) const {
        Pre q; const int row0 = u.pm * BM + wr * 64 + fr;
#pragma unroll
        for (int ai = 0; ai < 2; ++ai)
#pragma unroll
            for (int m = 0; m < 4; ++m) q.rs[ai][m] = rstd[row0 + ai * HALF + m * 16];
        return q; }
    __device__ __forceinline__ void operator()(const f32x4 (&acc)[2][2][4][2], const Unit& u, const Pre& q, int wr, int wc, int fr, int fq) const {
        const int row0 = u.pm * BM + wr * 64 + fr, col0 = colbase + u.pn * BM + wc * 32 + 8 * fq;
#pragma unroll
        for (int ai = 0; ai < 2; ++ai)
#pragma unroll
            for (int m = 0; m < 4; ++m) { const int row = row0 + ai * HALF + m * 16; bf16_t* rowp = O + (size_t)row * NPROJ + col0; const float rsc = q.rs[ai][m] * scale;
#pragma unroll
                for (int bj = 0; bj < 2; ++bj) { const f32x4 v0 = acc[ai][bj][m][0] * rsc, v1 = acc[ai][bj][m][1] * rsc;
                    u32x4 w; w.x = cvt_pk_bf16(v0[0], v0[1]); w.y = cvt_pk_bf16(v0[2], v0[3]); w.z = cvt_pk_bf16(v1[0], v1[1]); w.w = cvt_pk_bf16(v1[2], v1[3]);
                    *(u32x4*)(rowp + bj * HALF) = w; } }
    }
};
struct EpiX1 {
    static constexpr bool PERM = false;
    const float* __restrict__ X; float* __restrict__ O;
    struct Pre {};
    __device__ __forceinline__ Pre fetch(const Unit&, int, int, int, int) const { return Pre{}; }
    __device__ __forceinline__ void operator()(const f32x4 (&acc)[2][2][4][2], const Unit& u, const Pre&, int wr, int wc, int fr, int fq) const {
        const int row0 = u.pm * BM + wr * 64 + fr, col0 = u.pn * BM + wc * 32 + 4 * fq;
#pragma unroll
        for (int ai = 0; ai < 2; ++ai) {
            f32x4 xv[4][2][2];
#pragma unroll
            for (int m = 0; m < 4; ++m) { const size_t off = (size_t)(row0 + ai * HALF + m * 16) * DM + col0;
#pragma unroll
                for (int bj = 0; bj < 2; ++bj)
#pragma unroll
                    for (int n = 0; n < 2; ++n) xv[m][bj][n] = __builtin_nontemporal_load((const f32x4*)(X + off + bj * HALF + n * 16)); }
#pragma unroll
            for (int m = 0; m < 4; ++m) { const size_t off = (size_t)(row0 + ai * HALF + m * 16) * DM + col0;
#pragma unroll
                for (int bj = 0; bj < 2; ++bj)
#pragma unroll
                    for (int n = 0; n < 2; ++n) *(f32x4*)(O + off + bj * HALF + n * 16) = xv[m][bj][n] + acc[ai][bj][m][n]; }
        }
    }
};
struct EpiSwiglu {
    static constexpr bool PERM = true;
    unsigned char* __restrict__ O; const float* __restrict__ row_rstd; const float* __restrict__ bgu;
    struct Pre { float rsv[2][4]; };
    __device__ __forceinline__ Pre fetch(const Unit& u, int wr, int wc, int fr, int fq) const {
        Pre q; const int row0 = u.pm * BM + wr * 64 + fr;
#pragma unroll
        for (int ai = 0; ai < 2; ++ai)
#pragma unroll
            for (int m = 0; m < 4; ++m) q.rsv[ai][m] = row_rstd[row0 + ai * HALF + m * 16];
        return q; }
    __device__ __forceinline__ void operator()(const f32x4 (&acc)[2][2][4][2], const Unit& u, const Pre& q, int wr, int wc, int fr, int fq) const {
        const int row0 = u.pm * BM + wr * 64 + fr, colg = u.pn * HALF + wc * 32 + 8 * fq;
        const float* bg = bgu + (size_t)__builtin_amdgcn_readfirstlane(u.e) * (2 * FF) + colg; const float* bu = bg + FF;
        const f32x4 bg0 = *(const f32x4*)bg, bg1 = *(const f32x4*)(bg + 4), bu0 = *(const f32x4*)bu, bu1 = *(const f32x4*)(bu + 4);
#pragma unroll
        for (int ai = 0; ai < 2; ++ai)
#pragma unroll
            for (int m = 0; m < 4; ++m) { const int row = row0 + ai * HALF + m * 16; const float rs = q.rsv[ai][m] * F8_UNSCALE;
                f32x4 g0 = acc[ai][0][m][0] * rs + bg0, g1 = acc[ai][0][m][1] * rs + bg1, u0 = acc[ai][1][m][0] * rs + bu0, u1 = acc[ai][1][m][1] * rs + bu1;
                float o[8];
#pragma unroll
                for (int j = 0; j < 8; ++j) { float g = j < 4 ? g0[j] : g1[j - 4], uu = j < 4 ? u0[j] : u1[j - 4];
                    g = fminf(g, 7.0f); uu = __builtin_amdgcn_fmed3f(uu, -7.0f, 7.0f);
                    const float sg = __builtin_amdgcn_rcpf(1.0f + __builtin_amdgcn_exp2f(g * (-1.702f * 1.4426950408889634f)));
                    o[j] = (uu * ACT_SCALE + ACT_SCALE) * (g * sg); }
                u32x2 w; w.x = cvt4_fp8(o[0], o[1], o[2], o[3]); w.y = cvt4_fp8(o[4], o[5], o[6], o[7]);
                *(u32x2*)(O + (size_t)row * FF + colg) = w; }
    }
};
struct EpiDown {
    static constexpr bool PERM = true;
    unsigned char* __restrict__ O; const float* __restrict__ bd;
    struct Pre { f32x4 bv[2][2]; };
    __device__ __forceinline__ Pre fetch(const Unit& u, int wr, int wc, int fr, int fq) const {
        Pre q; const int col0 = u.pn * BM + wc * 32 + 8 * fq;
        const float* bp = bd + (size_t)__builtin_amdgcn_readfirstlane(u.e) * DM + col0;
#pragma unroll
        for (int bj = 0; bj < 2; ++bj)
#pragma unroll
            for (int n = 0; n < 2; ++n) q.bv[bj][n] = *(const f32x4*)(bp + bj * HALF + 4 * n) * Y_SCALE;
        return q; }
    __device__ __forceinline__ void operator()(const f32x4 (&acc)[2][2][4][2], const Unit& u, const Pre& q, int wr, int wc, int fr, int fq) const {
        const int row0 = u.pm * BM + wr * 64 + fr, col0 = u.pn * BM + wc * 32 + 8 * fq;
#pragma unroll
        for (int ai = 0; ai < 2; ++ai)
#pragma unroll
            for (int m = 0; m < 4; ++m) { unsigned char* rowp = O + (size_t)(row0 + ai * HALF + m * 16) * DM + col0;
#pragma unroll
                for (int bj = 0; bj < 2; ++bj) { const f32x4 v0 = acc[ai][bj][m][0] * (F8_UNSCALE * Y_SCALE) + q.bv[bj][0], v1 = acc[ai][bj][m][1] * (F8_UNSCALE * Y_SCALE) + q.bv[bj][1];
                    u32x2 w; w.x = cvt4_fp8(v0[0], v0[1], v0[2], v0[3]); w.y = cvt4_fp8(v1[0], v1[1], v1[2], v1[3]);
                    *(u32x2*)(rowp + bj * HALF) = w; } }
    }
};
}
struct Ctx { LAS unsigned char* lds; int tid, lane, wave; };
__device__ __forceinline__ Ctx fresh_ctx(const Ctx& c0) { Ctx c; c.lds = c0.lds; int t = threadIdx.x; asm volatile("" : "+v"(t)); c.tid = t; c.lane = t & 63; c.wave = __builtin_amdgcn_readfirstlane(t >> 6); return c; }

__device__ __forceinline__ void transpose_item(const float* W, int ld, int K, int k0, int n0, bf16_t* WT_row0  , LAS float* scr, int lane) {
    float tv[32];
#pragma unroll
    for (int i = 0; i < 32; ++i) { const int kk = 2 * i + (lane >> 5); tv[i] = __builtin_nontemporal_load(W + (size_t)(k0 + kk) * ld + n0 + (lane & 31)); }
#pragma unroll
    for (int i = 0; i < 32; ++i) { const int kk = 2 * i + (lane >> 5); scr[kk * 33 + (lane & 31)] = tv[i]; }
    LDS_WAIT(); asm volatile("" ::: "memory");
    const int c = lane & 7;
#pragma unroll
    for (int j = 0; j < 4; ++j) { const int n = (lane >> 3) + 8 * j; const LAS float* s = scr + (8 * c) * 33 + n;
        u32x4 o; o.x = cvt_pk_bf16(s[0 * 33], s[1 * 33]); o.y = cvt_pk_bf16(s[2 * 33], s[3 * 33]); o.z = cvt_pk_bf16(s[4 * 33], s[5 * 33]); o.w = cvt_pk_bf16(s[6 * 33], s[7 * 33]);
        *(u32x4*)(WT_row0 + (size_t)n * K + k0 + 8 * c) = o; }
    LDS_WAIT(); asm volatile("" ::: "memory");
}
struct ConvItem { const float* src; unsigned char* dst; int ld; };
constexpr int CV_KB8 = DM / 128, CV_GU1 = CV_KB8 * (2 * FF / 32), CV_D1 = CV_KB8 * (DM / 32), CV_GU = NE * CV_GU1, CV_D = NE * CV_D1, CV_TOTAL = CV_GU + CV_D;
constexpr int CV_IN8 = CV_KB8 * (NPROJ8 / 32);
constexpr int CV_EARLY = CV_TOTAL / 4;
__device__ __forceinline__ ConvItem conv_decode(const Params& p, int r) {
    ConvItem it;
    if (r < CV_GU) { const int e = r / CV_GU1, q = r % CV_GU1, nb = q % (2 * FF / 32), kb = q / (2 * FF / 32); const int n0 = 32 * nb;
        const int nn = n0 < FF ? n0 : n0 - FF; const int orow = 256 * (nn / 128) + (nn % 128) + (n0 < FF ? 0 : 128);
        it.src = p.w_gu + (size_t)e * DM * (2 * FF) + (size_t)(128 * kb) * (2 * FF) + n0; it.ld = 2 * FF;
        it.dst = (unsigned char*)(p.ws + WS_WGU) + ((size_t)e * (2 * FF) + orow) * DM + 128 * kb; }
    else if (r >= CV_TOTAL) { r -= CV_TOTAL; const int nb = r % (NPROJ8 / 32), kb = r / (NPROJ8 / 32);
        it.src = p.w_in + (size_t)(128 * kb) * LDW_IN + 32 * nb; it.ld = LDW_IN;
        it.dst = (unsigned char*)(p.ws + WS_WIN8) + (size_t)(32 * nb) * DM + 128 * kb; }
    else { r -= CV_GU; const int e = r / CV_D1, q = r % CV_D1, nb = q % (DM / 32), kb = q / (DM / 32);
        it.src = p.w_d + (size_t)e * FF * DM + (size_t)(128 * kb) * DM + 32 * nb; it.ld = DM;
        it.dst = (unsigned char*)(p.ws + WS_WD) + ((size_t)e * DM + 32 * nb) * FF + 128 * kb; }
    return it;
}
__device__ __forceinline__ void conv_load(const ConvItem& it, f32x4 (&tv)[16], int lane) {
    const float* s = it.src + (size_t)((lane >> 3) * 8) * it.ld + (lane & 7) * 4;
#pragma unroll
    for (int a = 0; a < 2; ++a)
#pragma unroll
        for (int b = 0; b < 8; ++b) tv[8 * a + b] = __builtin_nontemporal_load((const f32x4*)(s + (size_t)(64 * a + b) * it.ld));
}
__device__ __forceinline__ void conv_store(const ConvItem& it, const f32x4 (&tv)[16], LAS float*, int lane) {
    unsigned char* d = it.dst + (size_t)((lane & 7) * 4) * DM + (lane >> 3) * 8;
#pragma unroll
    for (int a = 0; a < 2; ++a)
#pragma unroll
        for (int i = 0; i < 4; ++i) { u32x2 o;
            o.x = cvt4_fp8(tv[8 * a + 0][i] * W_SCALE, tv[8 * a + 1][i] * W_SCALE, tv[8 * a + 2][i] * W_SCALE, tv[8 * a + 3][i] * W_SCALE);
            o.y = cvt4_fp8(tv[8 * a + 4][i] * W_SCALE, tv[8 * a + 5][i] * W_SCALE, tv[8 * a + 6][i] * W_SCALE, tv[8 * a + 7][i] * W_SCALE);
            *(u32x2*)(d + (size_t)i * DM + 64 * a) = o; }
}
__device__ __forceinline__ void conv_range(const Params& p, int lo, int hi, int w, int nw, LAS float* scr, int lane) {
    for (int it = lo + w; it < hi; it += 2 * nw) {
        const int i1 = it + nw < hi ? it + nw : it;
        f32x4 ta[16], tb[16];
        const ConvItem A = conv_decode(p, it), B = conv_decode(p, i1);
        conv_load(A, ta, lane); conv_load(B, tb, lane);
        __builtin_amdgcn_sched_barrier(0);
        conv_store(A, ta, scr, lane); conv_store(B, tb, scr, lane);
        __builtin_amdgcn_sched_barrier(0);
    }
}
__device__ __forceinline__ void phase_convert(const Params& p, const Ctx& c0) { const Ctx c = fresh_ctx(c0);
    LAS float* scr = (LAS float*)(c.lds + c.wave * 18432);
    const int gw = blockIdx.x * NWAVES + c.wave, NGW = gridDim.x * NWAVES;
    bf16_t* WinT = (bf16_t*)(p.ws + WS_WIN); bf16_t* WoutT = (bf16_t*)(p.ws + WS_WOUT);
    constexpr int KB = DM / 64;
    constexpr int I_IN = KB * ((NPROJ - NPROJ8) / 32), I_OUT = KB * (DM / 32), NITEMS = I_IN + I_OUT;
    for (int it = gw; it < NITEMS; it += NGW) {
        int r = it;
        if (r < I_IN) { const int nb = r % ((NPROJ - NPROJ8) / 32), kb = r / ((NPROJ - NPROJ8) / 32); transpose_item(p.w_in, LDW_IN, DM, 64 * kb, NPROJ8 + 32 * nb, WinT + (size_t)(NPROJ8 + 32 * nb) * DM, scr, c.lane); continue; } r -= I_IN;
        { const int nb = r % (DM / 32), kb = r / (DM / 32); transpose_item(p.w_out, DM, DM, 64 * kb, 32 * nb, WoutT + (size_t)(32 * nb) * DM, scr, c.lane); }
    }
    conv_range(p, CV_TOTAL, CV_TOTAL + CV_IN8, gw, NGW, scr, c.lane);
    float* rc = (float*)(p.ws + WS_ROPE); float* rs = rc + SEQ * 64;
    for (int i = blockIdx.x * NTHREADS + c.tid; i < SEQ * 64; i += gridDim.x * NTHREADS) {
        const int pos = i >> 6, j = i & 63;
        const float inv = 1.0f / powf(10000.0f, (float)(2 * j) / 128.0f);
        const float ang = (float)pos * inv; float sn, cs; sincosf(ang, &sn, &cs); rc[i] = cs; rs[i] = sn; }
}
constexpr int CT_GU1 = (DM / 128) * (2 * FF / 256), CT_D1 = (FF / 128) * (DM / 256), CT_GU = NE * CT_GU1, CT_D = NE * CT_D1, CT_TOTAL = CT_GU + CT_D;
struct ConvTile { const float* src; unsigned char* dst; int ld; int gu; };
__device__ __forceinline__ ConvTile ctile_decode(const Params& p, int r) {
    ConvTile t;
    if (r < CT_GU) { const int e = r / CT_GU1, q = r % CT_GU1, nt = q % (2 * FF / 256), kt = q / (2 * FF / 256);
        t.src = p.w_gu + (size_t)e * DM * (2 * FF) + (size_t)(128 * kt) * (2 * FF) + 256 * nt; t.ld = 2 * FF; t.gu = 256 * nt;
        t.dst = (unsigned char*)(p.ws + WS_WGU) + (size_t)e * (2 * FF) * DM + 128 * kt; }
    else { r -= CT_GU; const int e = r / CT_D1, q = r % CT_D1, nt = q % (DM / 256), kt = q / (DM / 256);
        t.src = p.w_d + (size_t)e * FF * DM + (size_t)(128 * kt) * DM + 256 * nt; t.ld = DM; t.gu = -1;
        t.dst = (unsigned char*)(p.ws + WS_WD) + ((size_t)e * DM + 256 * nt) * FF + 128 * kt; }
    return t;
}
__device__ __forceinline__ void ctile_load(const ConvTile& t, f32x4 (&tv)[16], int wave, int lane) {
    const float* s = t.src + (size_t)(16 * wave) * t.ld + 4 * lane;
#pragma unroll
    for (int i = 0; i < 16; ++i) tv[i] = __builtin_nontemporal_load((const f32x4*)(s + (size_t)i * t.ld));
}
__device__ __forceinline__ void ctile_store(const ConvTile& t, const f32x4 (&tv)[16], LAS unsigned char* lds, int tid, int wave, int lane) {
#pragma unroll
    for (int c = 0; c < 4; ++c) { u32x4 o;
#pragma unroll
        for (int q = 0; q < 4; ++q) o[q] = cvt4_fp8(tv[4 * q][c] * W_SCALE, tv[4 * q + 1][c] * W_SCALE, tv[4 * q + 2][c] * W_SCALE, tv[4 * q + 3][c] * W_SCALE);
        const int n = 4 * lane + c; *(LAS u32x4*)(lds + n * 128 + ((wave ^ (lane & 7)) << 4)) = o; }
    __syncthreads();
#pragma unroll
    for (int j = 0; j < 4; ++j) { const int n = 64 * j + (tid >> 3), ch = tid & 7;
        const u32x4 o = *(const LAS u32x4*)(lds + n * 128 + ((ch ^ ((n >> 2) & 7)) << 4));
        int orow = n;
        if (t.gu >= 0) { const int ng = t.gu + n; const int nn = ng < FF ? ng : ng - FF; orow = 256 * (nn / 128) + (nn % 128) + (ng < FF ? 0 : 128); }
        *(u32x4*)(t.dst + (size_t)orow * DM + 16 * ch) = o; }
    __syncthreads();
}
__device__ __forceinline__ void phase_convert_share(const Params& p, const Ctx& c0, int lo, int hi, int G, int w) { const Ctx c = fresh_ctx(c0);
    for (int it = lo + w; it < hi; it += 2 * G) {
        const int i1 = it + G < hi ? it + G : it;
        f32x4 ta[16], tb[16];
        const ConvTile A = ctile_decode(p, it), B = ctile_decode(p, i1);
        ctile_load(A, ta, c.wave, c.lane); ctile_load(B, tb, c.wave, c.lane);
        __builtin_amdgcn_sched_barrier(0);
        ctile_store(A, ta, c.lds, c.tid, c.wave, c.lane); ctile_store(B, tb, c.lds, c.tid, c.wave, c.lane);
        __builtin_amdgcn_sched_barrier(0);
    }
}

template <int NTL, int OUT8  >
__device__ __forceinline__ void norm_skinny_half(const float* xrows, const float* wn, const float* Wsk, int ldw, void* hrows_, void* hrows8_, int hk, int lane, f32x4 (&acc)[NTL], float& ss) {
    const int row = lane & 15, kq = lane >> 4;
    ss = 0.f;
#pragma unroll
    for (int t = 0; t < NTL; ++t) acc[t] = (f32x4){0.f, 0.f, 0.f, 0.f};
#pragma unroll 4
    for (int ks = 0; ks < 32; ++ks) {
        const int d0 = 1024 * hk + 32 * ks + 8 * kq;
        f32x4 xa = *(const f32x4*)(xrows + (size_t)row * DM + d0), xb = *(const f32x4*)(xrows + (size_t)row * DM + d0 + 4);
        const f32x4 wa = *(const f32x4*)(wn + d0), wb = *(const f32x4*)(wn + d0 + 4);
        ss += (xa[0] * xa[0] + xa[1] * xa[1]) + (xa[2] * xa[2] + xa[3] * xa[3]) + (xb[0] * xb[0] + xb[1] * xb[1]) + (xb[2] * xb[2] + xb[3] * xb[3]);
        xa = xa * wa; xb = xb * wb;
        u32x4 hw; hw.x = cvt_pk_bf16(xa[0], xa[1]); hw.y = cvt_pk_bf16(xa[2], xa[3]); hw.z = cvt_pk_bf16(xb[0], xb[1]); hw.w = cvt_pk_bf16(xb[2], xb[3]);
        if constexpr (OUT8 >= 1) { u32x2 q; q.x = cvt4_fp8(xa[0] * ACT_SCALE, xa[1] * ACT_SCALE, xa[2] * ACT_SCALE, xa[3] * ACT_SCALE); q.y = cvt4_fp8(xb[0] * ACT_SCALE, xb[1] * ACT_SCALE, xb[2] * ACT_SCALE, xb[3] * ACT_SCALE);
            *(u32x2*)((unsigned char*)hrows8_ + (size_t)row * DM + d0) = q; }
        if constexpr (OUT8 != 1) *(u32x4*)((bf16_t*)hrows_ + (size_t)row * DM + d0) = hw;
        const f32x4 ra = {xa[0] - bflo(hw.x), xa[1] - bfhi(hw.x), xa[2] - bflo(hw.y), xa[3] - bfhi(hw.y)}, rb = {xb[0] - bflo(hw.z), xb[1] - bfhi(hw.z), xb[2] - bflo(hw.w), xb[3] - bfhi(hw.w)};
        const bf16x8 ah = __builtin_bit_cast(bf16x8, hw), al = pack8(ra, rb);
#pragma unroll
        for (int t = 0; t < NTL; ++t) {
            float wv[8];
#pragma unroll
            for (int i = 0; i < 8; ++i) wv[i] = Wsk[(size_t)(d0 + i) * ldw + t * 16 + row];
            u32x4 bw; bw.x = cvt_pk_bf16(wv[0], wv[1]); bw.y = cvt_pk_bf16(wv[2], wv[3]); bw.z = cvt_pk_bf16(wv[4], wv[5]); bw.w = cvt_pk_bf16(wv[6], wv[7]);
            const f32x4 r0 = {wv[0] - bflo(bw.x), wv[1] - bfhi(bw.x), wv[2] - bflo(bw.y), wv[3] - bfhi(bw.y)}, r1 = {wv[4] - bflo(bw.z), wv[5] - bfhi(bw.z), wv[6] - bflo(bw.w), wv[7] - bfhi(bw.w)};
            const bf16x8 bh = __builtin_bit_cast(bf16x8, bw), bl = pack8(r0, r1);
            acc[t] = __builtin_amdgcn_mfma_f32_16x16x32_bf16(ah, bh, acc[t], 0, 0, 0);
            acc[t] = __builtin_amdgcn_mfma_f32_16x16x32_bf16(al, bh, acc[t], 0, 0, 0);
            acc[t] = __builtin_amdgcn_mfma_f32_16x16x32_bf16(ah, bl, acc[t], 0, 0, 0);
        }
    }
    ss += __shfl_xor(ss, 16); ss += __shfl_xor(ss, 32);
}

__device__ __forceinline__ void phase_norm1(const Params& p, const Ctx& c0) { const Ctx c = fresh_ctx(c0);
    bf16_t* H = (bf16_t*)(p.ws + WS_H); float* rstd = (float*)(p.ws + WS_RSTD1); float* gz = (float*)(p.ws + WS_GZ);
    const int pair = c.wave >> 1, hk = c.wave & 1;
    LAS float* scr = (LAS float*)(c.lds + pair * 4096);
    for (int u = blockIdx.x * 4 + pair; u < T / 16; u += gridDim.x * 4) {
        f32x4 acc[1]; float ss;
        norm_skinny_half<1, (NPROJ8 > 0 ? 2 : 0)>(p.x + (size_t)u * 16 * DM, p.attn_norm_w, p.w_in + C_GZ, LDW_IN, H + (size_t)u * 16 * DM, (unsigned char*)(p.ws + WS_H8) + (size_t)u * 16 * DM, hk, c.lane, acc, ss);
        if (hk == 1) { *(LAS f32x4*)(scr + c.lane * 4) = acc[0]; if (c.lane < 16) scr[256 + c.lane] = ss; }
        __syncthreads();
        if (hk == 0) {
            const f32x4 o = *(LAS f32x4*)(scr + c.lane * 4); const float tot = ss + scr[256 + (c.lane & 15)];
            const float rs = 1.0f / sqrtf(tot * (1.0f / DM) + EPS);
            if (c.lane < 16) { rstd[u * 16 + c.lane] = rs; scr[512 + c.lane] = rs; }
            LDS_WAIT();
#pragma unroll
            for (int r = 0; r < 4; ++r) { const int row = (c.lane >> 4) * 4 + r; gz[(size_t)(u * 16 + row) * 16 + (c.lane & 15)] = (acc[0][r] + o[r]) * scr[512 + row]; }
        }
        __syncthreads();
    }
}

__device__ __forceinline__ void phase_norm2_router(const Params& p, const Ctx& c0) { const Ctx c = fresh_ctx(c0);
    bf16_t* H = (bf16_t*)(p.ws + WS_H); float* rstd = (float*)(p.ws + WS_RSTD2); const float* X1 = (const float*)(p.ws + WS_X1);
    int* topi = (int*)(p.ws + WS_TOPI); float* topg = (float*)(p.ws + WS_TOPG); int* hist = (int*)(p.ws + WS_HIST); int* row_tok = (int*)(p.ws + WS_ROWTOK);
    const int pair = c.wave >> 1, hk = c.wave & 1;
    LAS float* scr = (LAS float*)(c.lds + pair * 8192);
    LAS int* hcnt = (LAS int*)(c.lds + 65536);
    { float* row_rstd = (float*)(p.ws + WS_ROWRSTD);
      for (int i = blockIdx.x * NTHREADS + c.tid; i < PROWS; i += gridDim.x * NTHREADS) { row_tok[i] = 0; row_rstd[i] = 0.f; } }
    for (int g = blockIdx.x; g < T / 64; g += gridDim.x) {
        if (c.tid < 32) hcnt[c.tid] = 0;
        __syncthreads();
        const int u = g * 4 + pair;
        f32x4 acc[2]; float ss;
        norm_skinny_half<2, 1>(X1 + (size_t)u * 16 * DM, p.ffn_norm_w, p.router_w, NE, nullptr, (unsigned char*)H + (size_t)u * 16 * DM, hk, c.lane, acc, ss);
        if (hk == 1) { *(LAS f32x4*)(scr + c.lane * 4) = acc[0]; *(LAS f32x4*)(scr + 256 + c.lane * 4) = acc[1]; if (c.lane < 16) scr[512 + c.lane] = ss; }
        __syncthreads();
        if (hk == 0) {
            const f32x4 o0 = *(LAS f32x4*)(scr + c.lane * 4), o1 = *(LAS f32x4*)(scr + 256 + c.lane * 4); const float tot = ss + scr[512 + (c.lane & 15)];
            const float rs = 1.0f / sqrtf(tot * (1.0f / DM) + EPS);
            if (c.lane < 16) { rstd[u * 16 + c.lane] = rs; scr[528 + c.lane] = rs; }
            LDS_WAIT();
            const float b0 = p.router_b[c.lane & 15], b1 = p.router_b[16 + (c.lane & 15)];
#pragma unroll
            for (int r = 0; r < 4; ++r) { const int row = (c.lane >> 4) * 4 + r; const float rr = scr[528 + row];
                scr[1024 + row * 32 + (c.lane & 15)] = (acc[0][r] + o0[r]) * rr + b0; scr[1024 + row * 32 + 16 + (c.lane & 15)] = (acc[1][r] + o1[r]) * rr + b1; }
            LDS_WAIT();
            if (c.lane < 16) {
                float lv[32];
#pragma unroll
                for (int j = 0; j < 32; ++j) lv[j] = scr[1024 + c.lane * 32 + j];
                int bi[4]; float bv[4];
#pragma unroll
                for (int k = 0; k < 4; ++k) { float best = -__builtin_inff(); int bidx = 0;
#pragma unroll
                    for (int j = 0; j < 32; ++j) { const bool tk = lv[j] > best; best = tk ? lv[j] : best; bidx = tk ? j : bidx; }
                    bi[k] = bidx; bv[k] = best;
#pragma unroll
                    for (int j = 0; j < 32; ++j) lv[j] = (j == bidx) ? -__builtin_inff() : lv[j]; }
                const float e1 = __expf(bv[1] - bv[0]), e2 = __expf(bv[2] - bv[0]), e3 = __expf(bv[3] - bv[0]); const float inv = 1.0f / (1.0f + e1 + e2 + e3);
                const int tok = u * 16 + c.lane;
                *(int4*)(topi + (size_t)tok * 4) = make_int4(bi[0], bi[1], bi[2], bi[3]);
                *(float4*)(topg + (size_t)tok * 4) = make_float4(inv, e1 * inv, e2 * inv, e3 * inv);
#pragma unroll
                for (int k = 0; k < 4; ++k) atomicAdd((int*)&hcnt[bi[k]], 1);
            }
        }
        __syncthreads();
        if (c.tid < 32) hist[g * 32 + c.tid] = hcnt[c.tid];
        __syncthreads();
    }
}

__device__ __forceinline__ void phase_rope_kmean(const Params& p, const Ctx& c0) { const Ctx c = fresh_ctx(c0);
    bf16_t* proj = (bf16_t*)(p.ws + WS_PROJ); const float* rc = (const float*)(p.ws + WS_ROPE); const float* rsn = rc + SEQ * 64; float* kmean = (float*)(p.ws + WS_KMEAN);
    LAS float* red = (LAS float*)c.lds;
    const int cg = c.tid & 7, tk = c.tid >> 3;
    for (int u = blockIdx.x; u < NBATCH * MH * NBLK; u += gridDim.x) {
        const int b = u / (MH * NBLK), h = (u / NBLK) % MH, blk = u % NBLK;
        float s1[8], s2[8];
#pragma unroll
        for (int j = 0; j < 8; ++j) { s1[j] = 0.f; s2[j] = 0.f; }
#pragma unroll
        for (int ps = 0; ps < 4; ++ps) {
            const int pos = blk * MBLK + ps * 64 + tk; const size_t row = (size_t)(b * SEQ + pos) * NPROJ;
            const f32x4 ca = *(const f32x4*)(rc + pos * 64 + 8 * cg), cb = *(const f32x4*)(rc + pos * 64 + 8 * cg + 4), sa = *(const f32x4*)(rsn + pos * 64 + 8 * cg), sb = *(const f32x4*)(rsn + pos * 64 + 8 * cg + 4);
            const float cs[8] = {ca[0], ca[1], ca[2], ca[3], cb[0], cb[1], cb[2], cb[3]}, sn[8] = {sa[0], sa[1], sa[2], sa[3], sb[0], sb[1], sb[2], sb[3]};
#pragma unroll
            for (int qk = 0; qk < 2; ++qk) {
                bf16_t* base = proj + row + (qk ? C_MK : C_MQ) + h * HD + 8 * cg;
                const u32x4 t1 = *(const u32x4*)base, t2 = *(const u32x4*)(base + 64);
                float a[8], bb[8];
#pragma unroll
                for (int j = 0; j < 4; ++j) { a[2 * j] = bflo(t1[j]); a[2 * j + 1] = bfhi(t1[j]); bb[2 * j] = bflo(t2[j]); bb[2 * j + 1] = bfhi(t2[j]); }
                float o1[8], o2[8];
#pragma unroll
                for (int j = 0; j < 8; ++j) { o1[j] = a[j] * cs[j] - bb[j] * sn[j]; o2[j] = bb[j] * cs[j] + a[j] * sn[j]; }
                u32x4 w1, w2;
#pragma unroll
                for (int j = 0; j < 4; ++j) { w1[j] = cvt_pk_bf16(o1[2 * j], o1[2 * j + 1]); w2[j] = cvt_pk_bf16(o2[2 * j], o2[2 * j + 1]); }
                *(u32x4*)base = w1; *(u32x4*)(base + 64) = w2;
                if (qk) {
#pragma unroll
                    for (int j = 0; j < 8; ++j) { s1[j] += o1[j]; s2[j] += o2[j]; } }
            }
        }
#pragma unroll
        for (int j = 0; j < 8; ++j) {
#pragma unroll
            for (int o = 8; o < 64; o <<= 1) { s1[j] += __shfl_xor(s1[j], o); s2[j] += __shfl_xor(s2[j], o); } }
        if (c.lane < 8) {
#pragma unroll
            for (int j = 0; j < 8; ++j) { red[c.wave * 128 + 8 * cg + j] = s1[j]; red[c.wave * 128 + 64 + 8 * cg + j] = s2[j]; } }
        __syncthreads();
        if (c.tid < 128) { float s = 0.f;
#pragma unroll
            for (int w = 0; w < 8; ++w) s += red[w * 128 + c.tid];
            kmean[(size_t)u * HD + c.tid] = s * (1.0f / MBLK); }
        __syncthreads();
    }
}

__device__ __forceinline__ void phase_gla_prep(const Params& p, const Ctx& c0) { const Ctx c = fresh_ctx(c0);
    bf16_t* proj = (bf16_t*)(p.ws + WS_PROJ); const float* gz = (const float*)(p.ws + WS_GZ); float* dend = (float*)(p.ws + WS_DEND);
    LAS float* gzl = (LAS float*)c.lds;
    LAS float* seg = (LAS float*)(c.lds + 16384);
    const int ch = c.tid & 127, tq = __builtin_amdgcn_readfirstlane(c.tid >> 7);
    for (int u = blockIdx.x; u < NBATCH * GH * NBLK; u += gridDim.x) {
        const int b = u / (GH * NBLK), h = (u / NBLK) % GH, j = u % NBLK;
        const int tok0 = b * SEQ + j * MBLK;
        for (int i = c.tid; i < 256 * 4; i += NTHREADS) *(LAS f32x4*)(gzl + i * 4) = *(const f32x4*)(gz + (size_t)tok0 * 16 + i * 4);
        float w2[16];
#pragma unroll
        for (int r = 0; r < 16; ++r) w2[r] = p.gate_w2[r * 512 + h * GDK + ch];
        const float bias = p.gate_b[h * GDK + ch];
        __syncthreads();
        float run = 0.f; float Bv[64];
#pragma unroll
        for (int i = 0; i < 64; ++i) {
            const LAS float* g = gzl + (tq * 64 + i) * 16;
            const f32x4 g0 = *(const LAS f32x4*)g, g1 = *(const LAS f32x4*)(g + 4), g2 = *(const LAS f32x4*)(g + 8), g3 = *(const LAS f32x4*)(g + 12);
            float lg = bias;
            lg += g0[0] * w2[0] + g0[1] * w2[1] + g0[2] * w2[2] + g0[3] * w2[3]; lg += g1[0] * w2[4] + g1[1] * w2[5] + g1[2] * w2[6] + g1[3] * w2[7];
            lg += g2[0] * w2[8] + g2[1] * w2[9] + g2[2] * w2[10] + g2[3] * w2[11]; lg += g3[0] * w2[12] + g3[1] * w2[13] + g3[2] * w2[14] + g3[3] * w2[15];
            const float ls = fminf(lg, 0.f) - __logf(1.0f + __expf(-fabsf(lg)));
            run += ls * (1.0f / 16.0f); Bv[i] = run; }
        seg[tq * 128 + ch] = run;
        __syncthreads();
        float off = 0.f, tot = 0.f;
#pragma unroll
        for (int s = 0; s < 4; ++s) { const float v = seg[s * 128 + ch]; tot += v; off += (s < tq) ? v : 0.f; }
        if (tq == 0) dend[(size_t)u * GDK + ch] = __expf(tot);
        bf16_t* qp = proj + (size_t)(tok0 + tq * 64) * NPROJ + C_GQ + h * GDK + ch; bf16_t* kp = proj + (size_t)(tok0 + tq * 64) * NPROJ + C_GK + h * GDK + ch;
#pragma unroll
        for (int i = 0; i < 64; ++i) { const float Bt = off + Bv[i];
            const float q = bf2f(qp[(size_t)i * NPROJ]), k = bf2f(kp[(size_t)i * NPROJ]);
            const float qt = q * __expf(Bt) * 0.08838834764831845f, kt = k * __expf(-Bt);
            qp[(size_t)i * NPROJ] = (bf16_t)(cvt_pk_bf16(qt, 0.f) & 0xffffu); kp[(size_t)i * NPROJ] = (bf16_t)(cvt_pk_bf16(kt, 0.f) & 0xffffu); }
        __syncthreads();
    }
}
namespace att {
constexpr int NW = 8, QBLK = 32, KVBLK = 64, QB = 256, D = 128;
constexpr int SHM_V = KVBLK * D * 2, SHM_K = KVBLK * D * 2;
constexpr int ATT_LDS = 2 * SHM_V + 2 * SHM_K + NW * 64 * 4;
constexpr float SCALE = 0.08838834764831845f;
constexpr float THR = 8.f;
constexpr int APITCH = NPROJ, OPITCH = DM;
typedef LAS char* lptr;
typedef const LAS char* lcptr;

#define KSWZ(row, colB) ((row) * 256 + ((colB) ^ (((row) & 7) << 4)))
__device__ __forceinline__ int v_st(int k, int c) { const int kk = (k & ~0xC) | ((k & 4) << 1) | ((k & 8) >> 1); return ((kk >> 3) * 4 + (c >> 5)) * 512 + ((kk & 7) * 32 + (c & 31)) * 2; }
__device__ __forceinline__ int v_rd_base(int lane) { return ((lane & 3) << 3) | (((lane >> 2) & 3) << 6) | (((lane >> 4) & 1) << 5) | (((lane >> 5) & 1) << 8); }
constexpr int v_rd_off(int d0, int ks, int half) { return d0 * 512 + ks * 4096 + half * 2048; }
__device__ __forceinline__ int crow(int r, int hi) { return (r & 3) + 8 * (r >> 2) + 4 * hi; }
__device__ __forceinline__ bf16x8 load8(const bf16_t* p) { return *reinterpret_cast<const bf16x8*>(p); }

__device__ __forceinline__ void pack_p(const f32x16& p0, const f32x16& p1, bf16x8& pa0, bf16x8& pa1, bf16x8& pa2, bf16x8& pa3) {
#define PK4(P, B_, OUT) do { unsigned a0 = cvt_pk_bf16(P[B_+0], P[B_+1]), a1 = cvt_pk_bf16(P[B_+2], P[B_+3]);                          \
        unsigned b0 = cvt_pk_bf16(P[B_+4], P[B_+5]), b1 = cvt_pk_bf16(P[B_+6], P[B_+7]);                                             \
        auto r0 = __builtin_amdgcn_permlane32_swap(a0, b0, false, false); auto r1 = __builtin_amdgcn_permlane32_swap(a1, b1, false, false); \
        u32x4 w = {r0[0], r1[0], r0[1], r1[1]}; OUT = __builtin_bit_cast(bf16x8, w); } while (0)
    PK4(p0, 0, pa0); PK4(p0, 8, pa1); PK4(p1, 0, pa2); PK4(p1, 8, pa3);
#undef PK4
}
__device__ __forceinline__ void partialSM(f32x16& p0, f32x16& p1, float& m_reg, float& mn, float& alpha) {
    float pmax = p0[0];
#pragma unroll
    for (int r = 1; r < 16; ++r) pmax = fmaxf(pmax, p0[r]);
#pragma unroll
    for (int r = 0; r < 16; ++r) pmax = fmaxf(pmax, p1[r]);
    { auto rr = __builtin_amdgcn_permlane32_swap(__float_as_uint(pmax), __float_as_uint(pmax), false, false);
      pmax = fmaxf(__uint_as_float(rr[0]), __uint_as_float(rr[1])); }
    constexpr float C2 = 1.4426950408889634f * SCALE;
    if (__builtin_expect(__all((pmax - m_reg) * SCALE <= THR), 1)) { mn = m_reg; alpha = 1.f; }
    else { mn = fmaxf(m_reg, pmax); alpha = __builtin_amdgcn_exp2f((m_reg - mn) * C2); m_reg = mn; }
    const float mnL = -mn * C2;
#pragma unroll
    for (int r = 0; r < 16; ++r) p0[r] = fmaf(p0[r], C2, mnL);
#pragma unroll
    for (int r = 0; r < 16; ++r) p1[r] = fmaf(p1[r], C2, mnL);
#pragma unroll
    for (int r = 0; r < 16; ++r) p0[r] = __builtin_amdgcn_exp2f(p0[r]);
}
__device__ __forceinline__ void finishSM(f32x16& p0, f32x16& p1, float alpha, float& l_reg, bf16x8& pa0, bf16x8& pa1, bf16x8& pa2, bf16x8& pa3) {
#pragma unroll
    for (int r = 0; r < 16; ++r) p1[r] = __builtin_amdgcn_exp2f(p1[r]);
    float ps = 0;
#pragma unroll
    for (int r = 0; r < 16; ++r) ps += p0[r];
#pragma unroll
    for (int r = 0; r < 16; ++r) ps += p1[r];
    { auto rr = __builtin_amdgcn_permlane32_swap(__float_as_uint(ps), __float_as_uint(ps), false, false);
      ps = __uint_as_float(rr[0]) + __uint_as_float(rr[1]); }
    l_reg = l_reg * alpha + ps;
    pack_p(p0, p1, pa0, pa1, pa2, pa3);
}
template <int KB>
__device__ __forceinline__ void qkt(f32x16& p0, f32x16& p1, lcptr K_lds, int r32, int hi, const bf16x8* qr, float init = 0.f) {
#pragma unroll
    for (int r = 0; r < 16; ++r) { p0[r] = init; p1[r] = init; }
    lcptr kb[4];
#pragma unroll
    for (int dd = 0; dd < 4; ++dd) kb[dd] = K_lds + KB * SHM_K + KSWZ(r32, (dd * 16 + hi * 8) * 2);
#pragma unroll
    for (int d0 = 0; d0 < 8; ++d0) { lcptr a = kb[d0 & 3] + (d0 >> 2) * 128;
        bf16x8 b0 = *reinterpret_cast<const LAS bf16x8*>(a);
        bf16x8 b1 = *reinterpret_cast<const LAS bf16x8*>(a + 32 * 256);
        p0 = __builtin_amdgcn_mfma_f32_32x32x16_bf16(b0, qr[d0], p0, 0, 0, 0);
        p1 = __builtin_amdgcn_mfma_f32_32x32x16_bf16(b1, qr[d0], p1, 0, 0, 0); }
}
#define TRRD(dst, vb, off) asm volatile("ds_read_b64_tr_b16 %0, %1 offset:%2" : "=&v"(dst) : "v"(vb), "i"(off) : "memory")
template <int VOFF>
__device__ __forceinline__ void pv_tile(f32x16* o, int vb0, bf16x8 pa0, bf16x8 pa1, bf16x8 pa2, bf16x8 pa3) {
#define PV_D0(d0) do { s16x4 l0, l1, l2, l3, h0, h1, h2, h3; constexpr int b_ = VOFF + v_rd_off(d0, 0, 0); \
        TRRD(l0, vb0, b_); TRRD(h0, vb0, b_ + 2048); TRRD(l1, vb0, b_ + 4096); TRRD(h1, vb0, b_ + 6144); TRRD(l2, vb0, b_ + 8192); TRRD(h2, vb0, b_ + 10240); TRRD(l3, vb0, b_ + 12288); TRRD(h3, vb0, b_ + 14336); \
        asm volatile("s_waitcnt lgkmcnt(0)" ::: "memory"); SBAR(); \
        o[d0] = __builtin_amdgcn_mfma_f32_32x32x16_bf16(pa0, (bf16x8){l0[0], l0[1], l0[2], l0[3], h0[0], h0[1], h0[2], h0[3]}, o[d0], 0, 0, 0);   \
        o[d0] = __builtin_amdgcn_mfma_f32_32x32x16_bf16(pa1, (bf16x8){l1[0], l1[1], l1[2], l1[3], h1[0], h1[1], h1[2], h1[3]}, o[d0], 0, 0, 0);   \
        o[d0] = __builtin_amdgcn_mfma_f32_32x32x16_bf16(pa2, (bf16x8){l2[0], l2[1], l2[2], l2[3], h2[0], h2[1], h2[2], h2[3]}, o[d0], 0, 0, 0);   \
        o[d0] = __builtin_amdgcn_mfma_f32_32x32x16_bf16(pa3, (bf16x8){l3[0], l3[1], l3[2], l3[3], h3[0], h3[1], h3[2], h3[3]}, o[d0], 0, 0, 0); } while (0)
    PV_D0(0); PV_D0(1); PV_D0(2); PV_D0(3);
#undef PV_D0
}
template <int VOFF, int D0>
__device__ __forceinline__ void tr_frags(int vb0, bf16x8& f0, bf16x8& f1, bf16x8& f2, bf16x8& f3) {
    s16x4 l0, l1, l2, l3, h0, h1, h2, h3; constexpr int b_ = VOFF + v_rd_off(D0, 0, 0);
    TRRD(l0, vb0, b_); TRRD(h0, vb0, b_ + 2048); TRRD(l1, vb0, b_ + 4096); TRRD(h1, vb0, b_ + 6144); TRRD(l2, vb0, b_ + 8192); TRRD(h2, vb0, b_ + 10240); TRRD(l3, vb0, b_ + 12288); TRRD(h3, vb0, b_ + 14336);
    asm volatile("s_waitcnt lgkmcnt(0)" ::: "memory"); SBAR();
    f0 = (bf16x8){l0[0], l0[1], l0[2], l0[3], h0[0], h0[1], h0[2], h0[3]}; f1 = (bf16x8){l1[0], l1[1], l1[2], l1[3], h1[0], h1[1], h1[2], h1[3]};
    f2 = (bf16x8){l2[0], l2[1], l2[2], l2[3], h2[0], h2[1], h2[2], h2[3]}; f3 = (bf16x8){l3[0], l3[1], l3[2], l3[3], h3[0], h3[1], h3[2], h3[3]};
}

struct MobaRef { const bf16_t* Q; const bf16_t* K; const bf16_t* V; bf16_t* O; const unsigned* sel; int qb; };
struct MobaSeam { bf16x8 qr[8]; bf16x8 st_v0, st_v1, st_k0, st_k1; unsigned sel; };
#define AROW(p, k0, rr) ((p) + (size_t)((k0) + (rr)) * APITCH + sc)
#define VMW() asm volatile("s_waitcnt vmcnt(0)" ::: "memory")
#define VMWN(n) asm volatile("s_waitcnt vmcnt(%0)" :: "i"(n) : "memory")
#define SLOAD_H(Kp, Vp, k0) do { S.st_v0 = load8(AROW(Vp, k0, sr)); S.st_v1 = load8(AROW(Vp, k0, 32 + sr));              \
                         S.st_k0 = load8(AROW(Kp, k0, sr)); S.st_k1 = load8(AROW(Kp, k0, 32 + sr)); } while (0)
#define SWRITE_HK(bf) do { *(LAS bf16x8*)(K_lds + (bf) * SHM_K + kws) = S.st_k0; *(LAS bf16x8*)(K_lds + (bf) * SHM_K + kws + 32 * 256) = S.st_k1; } while (0)
#define SWRITE_HV(bf) do { *(LAS bf16x8*)(V_lds + (bf) * SHM_V + vst0) = S.st_v0; *(LAS bf16x8*)(V_lds + (bf) * SHM_V + vst1) = S.st_v1; } while (0)
#define SWRITE_H(bf) do { SWRITE_HV(bf); SWRITE_HK(bf); } while (0)

__device__ __forceinline__ void moba_prime(const MobaRef& cur, lptr lds, MobaSeam& S) {
    int tid = threadIdx.x; asm volatile("" : "+v"(tid)); const int wid = __builtin_amdgcn_readfirstlane(tid >> 6), lane = tid & 63, r32 = lane & 31, hi = lane >> 5;
    const int sr = tid >> 4, sc = (tid & 15) * 8, kws = KSWZ(sr, sc * 2); lptr K_lds = lds + 2 * SHM_V;
#pragma unroll
    for (int d0 = 0; d0 < 8; ++d0) S.qr[d0] = load8(cur.Q + (size_t)(wid * QBLK + r32) * APITCH + d0 * 16 + hi * 8);
    S.sel = cur.sel[wid * QBLK + r32];
    SLOAD_H(cur.K, cur.V, 0); VMW(); SWRITE_HK(0);
    __syncthreads();
}
__device__ __forceinline__ void moba_block(const MobaRef& cur, const MobaRef& nxt, lptr lds, MobaSeam& S) {
    int tid = threadIdx.x; asm volatile("" : "+v"(tid)); const int wid = __builtin_amdgcn_readfirstlane(tid >> 6), lane = tid & 63, r32 = lane & 31, hi = lane >> 5;
    const int qb = cur.qb, NT = 4 * (qb + 1);
    const int qlo = qb * QB + wid * QBLK, qm = qlo + r32 - 4 * hi;
    const unsigned sel = S.sel;
    lptr V_lds = lds; lptr K_lds = lds + 2 * SHM_V;
    LAS float* ws = (LAS float*)(lds + 2 * SHM_V + 2 * SHM_K) + wid * 64; LAS float* li_l = ws; LAS float* al_l = ws + 32;
    float m_reg = -1e30f, l_reg = 0; f32x16 o[4] = {};
    const int sr = tid >> 4, sc = (tid & 15) * 8, vst0 = v_st(sr, sc), vst1 = v_st(32 + sr, sc), kws = KSWZ(sr, sc * 2);
    const int vb0 = (int)(uintptr_t)V_lds + v_rd_base(lane);
    const bf16_t* Kh = cur.K; const bf16_t* Vh = cur.V;
    const float NEG = -__builtin_inff();
#define RESC(a) do { if (__any((a) < 1.f)) { if (hi == 0) al_l[r32] = (a); asm volatile("s_waitcnt lgkmcnt(0)" ::: "memory");              \
                     _Pragma("unroll") for (int d_ = 0; d_ < 4; ++d_) _Pragma("unroll") for (int r = 0; r < 16; ++r) o[d_][r] *= al_l[crow(r, hi)]; } } while (0)
#define KBASE(t) ((t) * KVBLK)
#define MASKT(P0_, P1_, t) do { const int kb_ = KBASE(t); const int jb_ = (t) >> 2;                                              \
        if (jb_ == qb) { if (kb_ + KVBLK - 1 > qlo) { const int dq_ = qm - kb_;                                                    \
            _Pragma("unroll") for (int r = 0; r < 16; ++r) { const int c_ = (r & 3) + 8 * (r >> 2);                                \
                if (dq_ - c_ < 0) P0_[r] = NEG; if (dq_ - c_ - 32 < 0) P1_[r] = NEG; } } }                                         \
        } while (0)
#define SELINIT(t) ((((t) >> 2) == qb || ((sel >> ((t) >> 2)) & 1u)) ? 0.f : NEG)
    constexpr int NQL = 9;
#define SEAM_K0() do { VMWN(NQL); SWRITE_HK(0); SBAR(); } while (0)
    f32x16 pA0, pA1, pB0, pB1; float mnA, mnB, alA, alB; bf16x8 pa0, pa1, pa2, pa3;
    SWRITE_HV(0); SBAR();
    SLOAD_H(Kh, Vh, KBASE(1));
    SBAR(); qkt<0>(pA0, pA1, K_lds, r32, hi, S.qr, SELINIT(0));
    MASKT(pA0, pA1, 0); partialSM(pA0, pA1, m_reg, mnA, alA);
    VMW(); SWRITE_H(1);
    __syncthreads();
#define HALF_STEP(PX0, PX1, mnX, alX, PY0, PY1, alY, t, KB, VB, SB) do {                                                      \
        SBAR(); qkt<KB>(PX0, PX1, K_lds, r32, hi, S.qr, SELINIT(t));                                                           \
        finishSM(PY0, PY1, alY, l_reg, pa0, pa1, pa2, pa3); SBAR();                                                           \
        if ((t) + 1 < NT) { SLOAD_H(Kh, Vh, KBASE((t) + 1)); SBAR(); }                                                        \
        pv_tile<VB * SHM_V>(o, vb0, pa0, pa1, pa2, pa3); MASKT(PX0, PX1, (t)); partialSM(PX0, PX1, m_reg, mnX, alX);          \
        __syncthreads();                                                                                                      \
        if ((t) + 1 < NT) { VMW(); SWRITE_H(SB); }                                                                            \
        RESC(alX); __syncthreads(); } while (0)
    for (int t = 1; t + 1 < NT; t += 2) {
        HALF_STEP(pB0, pB1, mnB, alB, pA0, pA1, alA, t, 1, 0, 0);
        HALF_STEP(pA0, pA1, mnA, alA, pB0, pB1, alB, t + 1, 0, 1, 1);
    }
    SBAR(); qkt<1>(pB0, pB1, K_lds, r32, hi, S.qr, SELINIT(NT - 1)); SBAR();
    SLOAD_H(nxt.K, nxt.V, 0); SBAR();
#pragma unroll
    for (int d0 = 0; d0 < 8; ++d0) S.qr[d0] = load8(nxt.Q + (size_t)(wid * QBLK + r32) * APITCH + d0 * 16 + hi * 8);
    S.sel = nxt.sel[wid * QBLK + r32];
    SBAR();
    finishSM(pA0, pA1, alA, l_reg, pa0, pa1, pa2, pa3); SBAR();
    pv_tile<0>(o, vb0, pa0, pa1, pa2, pa3);
    MASKT(pB0, pB1, NT - 1); partialSM(pB0, pB1, m_reg, mnB, alB); __syncthreads(); RESC(alB);
    finishSM(pB0, pB1, alB, l_reg, pa0, pa1, pa2, pa3); SBAR(); pv_tile<SHM_V>(o, vb0, pa0, pa1, pa2, pa3);
    SBAR(); SEAM_K0();
    if (hi == 0) li_l[r32] = l_reg; asm volatile("s_waitcnt lgkmcnt(0)" ::: "memory");
    float rli[16];
#pragma unroll
    for (int r = 0; r < 16; ++r) rli[r] = __builtin_amdgcn_rcpf(li_l[crow(r, hi)]);
    bf16_t* Ow = cur.O + (size_t)(wid * QBLK) * OPITCH;
#pragma unroll
    for (int r = 0; r < 16; ++r) { const int orow = crow(r, hi);
#pragma unroll
        for (int d0 = 0; d0 < 4; ++d0) { const float v = o[d0][r] * rli[r];
            const float vn = __shfl_xor(v, 1);
            if ((r32 & 1) == 0) *(unsigned*)(Ow + (size_t)orow * OPITCH + d0 * 32 + r32) = cvt_pk_bf16(v, vn); } }
    __syncthreads();
#undef RESC
#undef KBASE
#undef MASKT
#undef SELINIT
#undef SEAM_K0
#undef HALF_STEP
}

__device__ __forceinline__ MobaRef moba_ref(const Params& p, int bh, int qb) {
    const int b = bh / MH, h = bh % MH;
    const bf16_t* proj = (const bf16_t*)(p.ws + WS_PROJ); bf16_t* mixed = (bf16_t*)(p.ws + WS_MIXED); const unsigned* selp = (const unsigned*)(p.ws + WS_SEL);
    MobaRef r; const size_t tok0 = (size_t)b * SEQ;
    r.Q = proj + (tok0 + (size_t)qb * QB) * APITCH + C_MQ + h * HD; r.K = proj + tok0 * APITCH + C_MK + h * HD; r.V = proj + tok0 * APITCH + C_MV + h * HD;
    r.O = mixed + (tok0 + (size_t)qb * QB) * OPITCH + h * HD; r.sel = selp + (size_t)bh * SEQ + qb * QB; r.qb = qb; return r;
}
__device__ __forceinline__ void phase_moba(const Params& p, lptr lds) {
    const int G = gridDim.x; const int bx = blockIdx.x; const int vcu = (G % 8 == 0) ? (bx % 8) * (G / 8) + bx / 8 : bx;
    constexpr int NITEM = NBATCH * MH * 8;
    int L = vcu; if (L >= NITEM) return;
    int pass = 0;
    MobaRef cur = moba_ref(p, L >> 3, L & 7);
    MobaSeam S;
    moba_prime(cur, lds, S);
    for (;;) {
        const bool more_pass = pass == 0, more_item = L + G < NITEM, last = !more_pass && !more_item;
        int Ln = L, passn = 1;
        if (!more_pass) { passn = 0; Ln = more_item ? L + G : L; }
        const MobaRef nxt = last ? cur : moba_ref(p, Ln >> 3, passn ? 15 - (Ln & 7) : (Ln & 7));
        moba_block(cur, nxt, lds, S);
        if (last) break;
        cur = nxt; pass = passn; L = Ln;
    }
}
#undef SLOAD_H
#undef SWRITE_HK
#undef SWRITE_HV
#undef SWRITE_H
#undef VMWN
}
namespace att {
__device__ __forceinline__ void stage_vstyle(lptr dst, const bf16_t* src, size_t pitch, int tid) {
    const int sr = tid >> 4, sc = (tid & 15) * 8;
    const bf16x8 a = load8(src + (size_t)sr * pitch + sc), b = load8(src + (size_t)(32 + sr) * pitch + sc);
    *(LAS bf16x8*)(dst + v_st(sr, sc)) = a; *(LAS bf16x8*)(dst + v_st(32 + sr, sc)) = b;
}
__device__ __forceinline__ void stage_kstyle(lptr dst, const bf16_t* src, size_t pitch, int tid) {
    const int sr = tid >> 4, sc = (tid & 15) * 8;
    const bf16x8 a = load8(src + (size_t)sr * pitch + sc), b = load8(src + (size_t)(32 + sr) * pitch + sc);
    *(LAS bf16x8*)(dst + KSWZ(sr, sc * 2)) = a; *(LAS bf16x8*)(dst + KSWZ(sr, sc * 2) + 32 * 256) = b;
}

__device__ __forceinline__ void phase_moba_select(const Params& p, lptr lds, int tid_) { int tid = tid_; asm volatile("" : "+v"(tid));
    const bf16_t* proj = (const bf16_t*)(p.ws + WS_PROJ); const float* kmean = (const float*)(p.ws + WS_KMEAN); unsigned* selp = (unsigned*)(p.ws + WS_SEL);
    constexpr int QP = 272;
    lptr ql = lds; LAS float* kml = (LAS float*)(lds + 256 * QP); LAS float* gl = (LAS float*)(lds + 256 * QP + 8192);
    for (int u = blockIdx.x; u < NBATCH * MH * NBLK; u += gridDim.x) {
        const int bh = u / NBLK, qb = u % NBLK, b = bh / MH, h = bh % MH;
        if (qb == 0) { if (tid < 256) selp[(size_t)bh * SEQ + tid] = 0u; continue; }
        const bf16_t* qsrc = proj + ((size_t)b * SEQ + qb * 256) * NPROJ + C_MQ + h * HD;
        for (int i = tid; i < 256 * 16; i += NTHREADS) { const int r = i >> 4, ch = i & 15; *(LAS bf16x8*)(ql + r * QP + ch * 16) = load8(qsrc + (size_t)r * NPROJ + ch * 8); }
        for (int i = tid; i < 16 * 128 / 4; i += NTHREADS) *(LAS f32x4*)(kml + i * 4) = *(const f32x4*)(kmean + (size_t)bh * NBLK * HD + i * 4);
        __syncthreads();
        const int q = tid & 255, ng = tid >> 8;
        float g[8];
#pragma unroll
        for (int n = 0; n < 8; ++n) g[n] = 0.f;
        for (int ch = 0; ch < 16; ++ch) {
            const u32x4 qw = *(const LAS u32x4*)(ql + q * QP + ch * 16);
            const float qv[8] = {bflo(qw.x), bfhi(qw.x), bflo(qw.y), bfhi(qw.y), bflo(qw.z), bfhi(qw.z), bflo(qw.w), bfhi(qw.w)};
#pragma unroll
            for (int n = 0; n < 8; ++n) { if (ng * 8 + n < qb) {
                const f32x4 k0 = *(const LAS f32x4*)(kml + (ng * 8 + n) * 128 + ch * 8), k1 = *(const LAS f32x4*)(kml + (ng * 8 + n) * 128 + ch * 8 + 4);
                g[n] += qv[0] * k0[0] + qv[1] * k0[1] + qv[2] * k0[2] + qv[3] * k0[3] + qv[4] * k1[0] + qv[5] * k1[1] + qv[6] * k1[2] + qv[7] * k1[3]; } }
        }
#pragma unroll
        for (int n = 0; n < 8; ++n) gl[q * 16 + ng * 8 + n] = g[n];
        __syncthreads();
        if (tid < 256) {
            float gv[16];
#pragma unroll
            for (int n = 0; n < 16; ++n) gv[n] = (n < qb) ? gl[tid * 16 + n] : -__builtin_inff();
            unsigned m = 0u;
#pragma unroll
            for (int k = 0; k < 3; ++k) { float best = -__builtin_inff(); int bi = -1;
#pragma unroll
                for (int n = 0; n < 16; ++n) { const bool tk = gv[n] > best; best = tk ? gv[n] : best; bi = tk ? n : bi; }
                if (bi >= 0) m |= 1u << bi;
#pragma unroll
                for (int n = 0; n < 16; ++n) gv[n] = (n == bi) ? -__builtin_inff() : gv[n]; }
            selp[(size_t)bh * SEQ + qb * 256 + tid] = m;
        }
        __syncthreads();
    }
}

__device__ __forceinline__ void phase_gla_state(const Params& p, lptr lds, int tid_) { int tid = tid_; asm volatile("" : "+v"(tid));
    const bf16_t* proj = (const bf16_t*)(p.ws + WS_PROJ); const float* dend = (const float*)(p.ws + WS_DEND); float* U = (float*)(p.ws + WS_U);
    const int wid = __builtin_amdgcn_readfirstlane(tid >> 6), lane = tid & 63, r32 = lane & 31, hi = lane >> 5;
    const int dkb = wid & 3, half = wid >> 2;
    const int vb0 = (int)(uintptr_t)lds + v_rd_base(lane);
    for (int u = blockIdx.x; u < NBATCH * GH * NBLK; u += gridDim.x) {
        const int bh = u / NBLK, j = u % NBLK, b = bh / GH, h = bh % GH;
        const size_t tok0 = (size_t)b * SEQ + j * 256;
        f32x16 o[4] = {};
        for (int t = 0; t < 4; ++t) {
            __syncthreads();
            const bf16_t* rowp = proj + (tok0 + t * 64) * NPROJ;
            stage_vstyle(lds, rowp + C_GK + h * GDK, NPROJ, tid);
            stage_vstyle(lds + SHM_V, rowp + C_GV + h * GDV, NPROJ, tid);
            stage_vstyle(lds + 2 * SHM_V, rowp + C_GV + h * GDV + 128, NPROJ, tid);
            __syncthreads();
            bf16x8 a0, a1, a2, a3;
            if (dkb == 0) tr_frags<0, 0>(vb0, a0, a1, a2, a3); else if (dkb == 1) tr_frags<0, 1>(vb0, a0, a1, a2, a3); else if (dkb == 2) tr_frags<0, 2>(vb0, a0, a1, a2, a3); else tr_frags<0, 3>(vb0, a0, a1, a2, a3);
            if (half == 0) pv_tile<SHM_V>(o, vb0, a0, a1, a2, a3); else pv_tile<2 * SHM_V>(o, vb0, a0, a1, a2, a3);
        }
        float dv[16];
#pragma unroll
        for (int r = 0; r < 16; ++r) dv[r] = dend[(size_t)u * GDK + dkb * 32 + crow(r, hi)];
        float* Uo = U + (size_t)u * (GDK * GDV);
#pragma unroll
        for (int r = 0; r < 16; ++r) { const int k = dkb * 32 + crow(r, hi);
#pragma unroll
            for (int d0 = 0; d0 < 4; ++d0) Uo[(size_t)k * GDV + half * 128 + d0 * 32 + r32] = o[d0][r] * dv[r]; }
    }
    __syncthreads();
}

__device__ __forceinline__ void phase_gla_scan(const Params& p, int tid_) { int tid = tid_; asm volatile("" : "+v"(tid));
    const float* U = (const float*)(p.ws + WS_U); const float* dend = (const float*)(p.ws + WS_DEND); bf16_t* Sj = (bf16_t*)(p.ws + WS_SJ);
    constexpr int NEL = NBATCH * GH * GDK * GDV / 4;
    for (int i = blockIdx.x * NTHREADS + tid; i < NEL; i += gridDim.x * NTHREADS) {
        const int bh = i / (GDK * GDV / 4), e4 = i % (GDK * GDV / 4), k = e4 / (GDV / 4);
        f32x4 S = {0.f, 0.f, 0.f, 0.f};
        f32x4 uv[NBLK]; float dd[NBLK];
#pragma unroll
        for (int j = 0; j < NBLK; ++j) { uv[j] = *(const f32x4*)(U + ((size_t)(bh * NBLK + j) * (GDK * GDV)) + (size_t)e4 * 4); dd[j] = dend[(size_t)(bh * NBLK + j) * GDK + k]; }
#pragma unroll
        for (int j = 0; j < NBLK; ++j) {
            u32x2 w; w.x = cvt_pk_bf16(S[0], S[1]); w.y = cvt_pk_bf16(S[2], S[3]);
            *(u32x2*)(Sj + ((size_t)(bh * NBLK + j) * (GDK * GDV)) + (size_t)e4 * 4) = w;
            S = S * dd[j] + uv[j]; }
    }
}

__device__ __forceinline__ void phase_gla_out(const Params& p, lptr lds, int tid_) { int tid = tid_; asm volatile("" : "+v"(tid));
    const bf16_t* proj = (const bf16_t*)(p.ws + WS_PROJ); const bf16_t* Sj = (const bf16_t*)(p.ws + WS_SJ); bf16_t* mixed = (bf16_t*)(p.ws + WS_MIXED);
    const int wid = __builtin_amdgcn_readfirstlane(tid >> 6), lane = tid & 63, r32 = lane & 31, hi = lane >> 5;
    constexpr int BUF = 3 * SHM_V;
    const int vb0 = (int)(uintptr_t)lds + v_rd_base(lane), vb1 = vb0 + BUF;
    const int sr = tid >> 4, sc = (tid & 15) * 8;
    const int kws = KSWZ(sr, sc * 2), vst0 = v_st(sr, sc), vst1 = v_st(32 + sr, sc);
    for (int u = blockIdx.x; u < NBATCH * GH * NBLK; u += gridDim.x) {
        const int bh = u / NBLK, j = u % NBLK, b = bh / GH, h = bh % GH;
        const size_t tok0 = (size_t)b * SEQ + j * 256;
        bf16x8 qr[8];
#pragma unroll
        for (int d0 = 0; d0 < 8; ++d0) qr[d0] = load8(proj + (tok0 + wid * 32 + r32) * NPROJ + C_GQ + h * GDK + d0 * 16 + hi * 8);
        f32x16 o[8] = {};
        bf16x8 sk0, sk1, sa0, sa1, sb0, sb1;
        const bf16_t* sp = Sj + (size_t)u * (GDK * GDV);
#define GO_LOAD(s_) do { if ((s_) < 4) { const bf16_t* rp = proj + (tok0 + (s_) * 64) * NPROJ; \
            sk0 = load8(rp + (size_t)sr * NPROJ + C_GK + h * GDK + sc); sk1 = load8(rp + (size_t)(32 + sr) * NPROJ + C_GK + h * GDK + sc); \
            sa0 = load8(rp + (size_t)sr * NPROJ + C_GV + h * GDV + sc); sa1 = load8(rp + (size_t)(32 + sr) * NPROJ + C_GV + h * GDV + sc); \
            sb0 = load8(rp + (size_t)sr * NPROJ + C_GV + h * GDV + 128 + sc); sb1 = load8(rp + (size_t)(32 + sr) * NPROJ + C_GV + h * GDV + 128 + sc); } \
          else { const bf16_t* rp = sp + (size_t)((s_) - 4) * 64 * GDV; \
            sa0 = load8(rp + (size_t)sr * GDV + sc); sa1 = load8(rp + (size_t)(32 + sr) * GDV + sc); \
            sb0 = load8(rp + (size_t)sr * GDV + 128 + sc); sb1 = load8(rp + (size_t)(32 + sr) * GDV + 128 + sc); } } while (0)
#define GO_WRITE(s_, bufo) do { if ((s_) < 4) { *(LAS bf16x8*)(lds + (bufo) + kws) = sk0; *(LAS bf16x8*)(lds + (bufo) + kws + 32 * 256) = sk1; } \
            *(LAS bf16x8*)(lds + (bufo) + SHM_V + vst0) = sa0; *(LAS bf16x8*)(lds + (bufo) + SHM_V + vst1) = sa1; \
            *(LAS bf16x8*)(lds + (bufo) + 2 * SHM_V + vst0) = sb0; *(LAS bf16x8*)(lds + (bufo) + 2 * SHM_V + vst1) = sb1; } while (0)
#define GO_STEP(s_, B_) do { GO_LOAD(s_); __syncthreads(); GO_WRITE(s_, (B_) * BUF); __syncthreads(); \
            if ((s_) < 4) { if ((s_) * 64 <= wid * 32 + 31) { f32x16 p0, p1; qkt<0>(p0, p1, lds + (B_) * BUF, r32, hi, qr); \
                    const int dq = wid * 32 + r32 - 4 * hi - (s_) * 64; \
                    _Pragma("unroll") for (int r = 0; r < 16; ++r) { const int c_ = (r & 3) + 8 * (r >> 2); if (dq - c_ < 0) p0[r] = 0.f; if (dq - c_ - 32 < 0) p1[r] = 0.f; } \
                    bf16x8 pa0, pa1, pa2, pa3; pack_p(p0, p1, pa0, pa1, pa2, pa3); \
                    pv_tile<SHM_V>(o, (B_) ? vb1 : vb0, pa0, pa1, pa2, pa3); pv_tile<2 * SHM_V>(o + 4, (B_) ? vb1 : vb0, pa0, pa1, pa2, pa3); } } \
            else { pv_tile<SHM_V>(o, (B_) ? vb1 : vb0, qr[4 * ((s_) - 4)], qr[4 * ((s_) - 4) + 1], qr[4 * ((s_) - 4) + 2], qr[4 * ((s_) - 4) + 3]); \
                   pv_tile<2 * SHM_V>(o + 4, (B_) ? vb1 : vb0, qr[4 * ((s_) - 4)], qr[4 * ((s_) - 4) + 1], qr[4 * ((s_) - 4) + 2], qr[4 * ((s_) - 4) + 3]); } } while (0)
        GO_STEP(0, 0); GO_STEP(1, 0); GO_STEP(2, 0); GO_STEP(3, 0); GO_STEP(4, 0); GO_STEP(5, 0);
#undef GO_LOAD
#undef GO_WRITE
#undef GO_STEP
        int hi_e = hi, r32_e = r32; asm volatile("" : "+v"(hi_e), "+v"(r32_e));
        float wv[8];
#pragma unroll
        for (int d0 = 0; d0 < 8; ++d0) wv[d0] = p.gla_norm_w[d0 * 32 + r32_e];
        const bf16_t* ggp = proj + (tok0 + wid * 32) * NPROJ + C_GG + h * GDV + r32_e;
        bf16_t* op = mixed + (tok0 + wid * 32) * DM + 1024 + h * GDV + r32_e;
#pragma unroll
        for (int r = 0; r < 16; ++r) { const int orow = crow(r, hi_e);
            float g[8];
#pragma unroll
            for (int d0 = 0; d0 < 8; ++d0) g[d0] = bf2f(ggp[(size_t)orow * NPROJ + d0 * 32]);
            float ss = 0.f;
#pragma unroll
            for (int d0 = 0; d0 < 8; ++d0) ss += o[d0][r] * o[d0][r];
            ss += __shfl_xor(ss, 1); ss += __shfl_xor(ss, 2); ss += __shfl_xor(ss, 4); ss += __shfl_xor(ss, 8); ss += __shfl_xor(ss, 16);
            const float rsr = 1.0f / sqrtf(ss * (1.0f / GDV) + EPS);
#pragma unroll
            for (int d0 = 0; d0 < 8; ++d0) { const float sg = g[d0] * __builtin_amdgcn_rcpf(1.0f + __expf(-g[d0]));
                const float v = o[d0][r] * rsr * wv[d0] * sg; const float vn = __shfl_xor(v, 1);
                if ((r32_e & 1) == 0) *(unsigned*)(op + (size_t)orow * DM + d0 * 32) = cvt_pk_bf16(v, vn); }
            asm volatile("" ::: "memory"); }
    }
    __syncthreads();
}
}

__device__ __forceinline__ void phase_route(const Params& p, const Ctx& c0) { const Ctx c = fresh_ctx(c0);
    const int* hist = (const int*)(p.ws + WS_HIST); const int* topi = (const int*)(p.ws + WS_TOPI); const float* rstd2 = (const float*)(p.ws + WS_RSTD2);
    int* dest = (int*)(p.ws + WS_DEST); int* row_tok = (int*)(p.ws + WS_ROWTOK); float* row_rstd = (float*)(p.ws + WS_ROWRSTD); int* blk = (int*)(p.ws + WS_BLKE);
    LAS int* cnt = (LAS int*)c.lds; LAS int* before = cnt + 32; LAS int* pstart = cnt + 64; LAS int* ea = cnt + 128;
    for (int g = blockIdx.x; g < T / 64; g += gridDim.x) {
        if (c.tid < 64) cnt[c.tid] = 0;
        __syncthreads();
        { const int e = c.tid & 31, part = c.tid >> 5; int tot = 0, bef = 0;
#pragma unroll
            for (int i = 0; i < 16; ++i) { const int gg = part * 16 + i; const int v = hist[gg * 32 + e]; tot += v; bef += (gg < g) ? v : 0; }
            atomicAdd((int*)&cnt[e], tot); atomicAdd((int*)&before[e], bef); }
        __syncthreads();
        if (c.tid == 0) { int acc = 0; for (int e = 0; e < NE; ++e) { pstart[e] = acc; acc += ((cnt[e] + 255) >> 8) << 8; } pstart[NE] = acc; }
        if (c.tid < 256) ea[c.tid] = topi[(size_t)g * 256 + c.tid];
        __syncthreads();
        if (c.tid < 256) {
            const int e = ea[c.tid]; int rank = 0;
            for (int a = 0; a < c.tid; ++a) rank += (ea[a] == e) ? 1 : 0;
            const int d = pstart[e] + before[e] + rank; const int tok = g * 64 + (c.tid >> 2);
            dest[(size_t)g * 256 + c.tid] = d; row_tok[d] = tok; row_rstd[d] = rstd2[tok];
        }
        if (g == 0 && c.tid < 64) {
            const int nb = pstart[NE] >> 8; if (c.tid == 0) blk[0] = nb;
            for (int bq = c.tid; bq < nb; bq += 64) { int e = 0; for (int q = 0; q < NE; ++q) e += (pstart[q + 1] <= bq * 256) ? 1 : 0; blk[64 + bq] = e < NE ? e : NE - 1; }
        }
        __syncthreads();
    }
}

__device__ __forceinline__ void phase_combine(const Params& p, const Ctx& c0, unsigned poison) { const Ctx c = fresh_ctx(c0);
    const float* X1 = (const float*)(p.ws + WS_X1); const unsigned char* Y = (const unsigned char*)(p.ws + WS_Y); const int* dest = (const int*)(p.ws + WS_DEST); const float* topg = (const float*)(p.ws + WS_TOPG);
    for (int t = blockIdx.x * NWAVES + c.wave; t < T; t += gridDim.x * NWAVES) {
        const int4 d4 = *(const int4*)(dest + (size_t)t * 4); const float4 g4 = *(const float4*)(topg + (size_t)t * 4);
        const int dd[4] = {d4.x, d4.y, d4.z, d4.w}; const float gg[4] = {g4.x * (1.0f / Y_SCALE), g4.y * (1.0f / Y_SCALE), g4.z * (1.0f / Y_SCALE), g4.w * (1.0f / Y_SCALE)};
        f32x4 v[8]; u32x2 yw[4][4]; float ss = 0.f;
#pragma unroll
        for (int j = 0; j < 4; ++j) { v[2 * j] = *(const f32x4*)(X1 + (size_t)t * DM + j * 512 + c.lane * 8); v[2 * j + 1] = *(const f32x4*)(X1 + (size_t)t * DM + j * 512 + c.lane * 8 + 4); }
#pragma unroll
        for (int k = 0; k < 4; ++k)
#pragma unroll
            for (int j = 0; j < 4; ++j) yw[k][j] = *(const u32x2*)(Y + (size_t)dd[k] * DM + j * 512 + c.lane * 8);
#pragma unroll
        for (int k = 0; k < 4; ++k)
#pragma unroll
            for (int j = 0; j < 4; ++j) { const f32x2 a = __builtin_amdgcn_cvt_pk_f32_fp8(yw[k][j].x, false), b = __builtin_amdgcn_cvt_pk_f32_fp8(yw[k][j].x, true);
                const f32x2 cc = __builtin_amdgcn_cvt_pk_f32_fp8(yw[k][j].y, false), d = __builtin_amdgcn_cvt_pk_f32_fp8(yw[k][j].y, true);
                v[2 * j][0] += gg[k] * a[0]; v[2 * j][1] += gg[k] * a[1]; v[2 * j][2] += gg[k] * b[0]; v[2 * j][3] += gg[k] * b[1];
                v[2 * j + 1][0] += gg[k] * cc[0]; v[2 * j + 1][1] += gg[k] * cc[1]; v[2 * j + 1][2] += gg[k] * d[0]; v[2 * j + 1][3] += gg[k] * d[1]; }
#pragma unroll
        for (int j = 0; j < 8; ++j) ss += (v[j][0] * v[j][0] + v[j][1] * v[j][1]) + (v[j][2] * v[j][2] + v[j][3] * v[j][3]);
        const float rs = 1.0f / sqrtf(wave_sum(ss) * (1.0f / DM) + EPS);
#pragma unroll
        for (int j = 0; j < 8; ++j) { const int col = (j >> 1) * 512 + c.lane * 8 + (j & 1) * 4; const f32x4 w = *(const f32x4*)(p.final_norm_w + col);
            f32x4 ov = v[j] * rs * w; if (poison) ov = (f32x4){__builtin_nanf(""), __builtin_nanf(""), __builtin_nanf(""), __builtin_nanf("")};
            *(f32x4*)(p.out + (size_t)t * DM + col) = ov; }
    }
}
__device__ __forceinline__ Ctx make_ctx(unsigned char* lds_generic) {
    Ctx c; c.lds = (LAS unsigned char*)lds_generic; c.tid = threadIdx.x; c.lane = c.tid & 63; c.wave = __builtin_amdgcn_readfirstlane(c.tid >> 6); return c;
}
__device__ __forceinline__ void phase_gemm_inproj16(const Params& p, const Ctx& c, int i0, int i1, int G, int cidx) {
    if (i0 >= i1) return;
    g8::DenseProb P{(const bf16_t*)(p.ws + WS_H), (const bf16_t*)(p.ws + WS_WIN) + (size_t)NPROJ8 * DM, T / 256, (NPROJ - NPROJ8) / 256, DM, G, cidx, i0, i1};
    g8::EpiProj E{(bf16_t*)(p.ws + WS_PROJ), (const float*)(p.ws + WS_RSTD1), 1.0f, NPROJ8};
    g8::gemm_phase(c.lds, P, E);
}
__device__ __forceinline__ void phase_gemm_outproj(const Params& p, const Ctx& c, int i0, int i1) {
    if (i0 >= i1) return;
    g8::DenseProb P{(const bf16_t*)(p.ws + WS_MIXED), (const bf16_t*)(p.ws + WS_WOUT), T / 256, DM / 256, DM, (int)gridDim.x, (int)blockIdx.x, i0, i1};
    g8::EpiX1 E{p.x, (float*)(p.ws + WS_X1)};
    g8::gemm_phase(c.lds, P, E);
}
__device__ __forceinline__ void phase_gemm_moe1(const Params& p, const Ctx& c, int i0, int i1) {
    g8::MoeProb1 P{(const bf16_t*)(p.ws + WS_H), (const bf16_t*)(p.ws + WS_WGU), (const int*)(p.ws + WS_ROWTOK), (const int*)(p.ws + WS_BLKE), DM / 2, __builtin_amdgcn_readfirstlane(*(const int*)(p.ws + WS_BLKE)), i0, i1};
    g8::EpiSwiglu E{(unsigned char*)(p.ws + WS_ACT), (const float*)(p.ws + WS_ROWRSTD), p.b_gu};
    g8::gemm_phase(c.lds, P, E);
}
__device__ __forceinline__ void phase_gemm_moe2(const Params& p, const Ctx& c) {
    g8::MoeProb2 P{(const bf16_t*)(p.ws + WS_ACT), (const bf16_t*)(p.ws + WS_WD), (const int*)(p.ws + WS_BLKE), FF / 2, __builtin_amdgcn_readfirstlane(*(const int*)(p.ws + WS_BLKE))};
    g8::EpiDown E{(unsigned char*)(p.ws + WS_Y), p.b_d};
    g8::gemm_phase(c.lds, P, E);
}


#ifndef MX_SELFTEST
#define MX_SELFTEST 0
#endif
__device__ __forceinline__ void mx_selftest(unsigned* flag) {
    const int l = threadIdx.x & 63, fr = l & 15, fq = l >> 4;
    unsigned aw[8], bw[8];
#pragma unroll
    for (int d = 0; d < 8; ++d) { float av[4], bv[4];
#pragma unroll
        for (int q = 0; q < 4; ++q) { const int e = 4 * d + q; const int k = e < 16 ? 16 * fq + e : 64 + 16 * fq + (e - 16);
            av[q] = (float)(((fr * 7 + k * 3) % 5) - 2); bv[q] = (float)(((fr * 5 + k) % 7) - 3); }
        aw[d] = cvt4_fp8(av[0], av[1], av[2], av[3]); bw[d] = cvt4_fp8(bv[0], bv[1], bv[2], bv[3]); }
    const i32x8 A = {(int)aw[0], (int)aw[1], (int)aw[2], (int)aw[3], (int)aw[4], (int)aw[5], (int)aw[6], (int)aw[7]};
    const i32x8 B = {(int)bw[0], (int)bw[1], (int)bw[2], (int)bw[3], (int)bw[4], (int)bw[5], (int)bw[6], (int)bw[7]};
    f32x4 acc = {0.f, 0.f, 0.f, 0.f};
    acc = __builtin_amdgcn_mfma_scale_f32_16x16x128_f8f6f4(B, A, acc, 0, 0, 0, 0x7f7f7f7f, 0, 0x7f7f7f7f);
    bool bad = false;
#pragma unroll
    for (int r = 0; r < 4; ++r) { const int m = fr, n = 4 * fq + r; int sum = 0;
        for (int k = 0; k < 128; ++k) sum += (((m * 7 + k * 3) % 5) - 2) * (((n * 5 + k) % 7) - 3);
        bad |= (acc[r] != (float)sum); }
    if (bad) atomicOr(flag, 1u);
}
constexpr int CW_BAR = 4096;
__global__ void __launch_bounds__(NTHREADS, 2) fwd(Params p) {
    extern __shared__ __attribute__((aligned(16))) unsigned char lds_raw[];
    const Ctx c = make_ctx(lds_raw);
    if (c.tid < 64) ((LAS unsigned*)(c.lds + LDS_MISC))[c.tid] = 0u;
    __syncthreads();
    const XcdBarrier bar = xcd_barrier_post((unsigned*)(p.ws + WS_CTL) + CW_BAR, (volatile LAS unsigned*)(c.lds + LDS_MISC + 32));
    const att::lptr al = (att::lptr)c.lds;
    if (MX_SELFTEST && blockIdx.x == 0 && c.wave == 0) mx_selftest((unsigned*)(p.ws + WS_CTL) + 8);
#ifndef PROBE_DUP
#define PROBE_DUP 0
#endif
    phase_convert(p, c); phase_norm1(p, c); if (PROBE_DUP & 64) { __syncthreads(); phase_norm1(p, c); }
    xcd_barrier(bar);
    for (int rep = 0; rep < ((PROBE_DUP & 1) ? 2 : 1); ++rep) {
        const int bx = blockIdx.x, G = gridDim.x;
        const int cut = (G == 256) ? (bx >> 3) % 7 : 0;
        if (cut > 0) phase_gemm_inproj16(p, c, 0, cut, G, bx);
        phase_convert_share(p, c, 0, CT_GU, G, bx);
        phase_gemm_inproj16(p, c, cut, 1 << 20, G, bx);
    }
    xcd_barrier(bar);
    phase_rope_kmean(p, c); phase_gla_prep(p, c);
    xcd_barrier(bar);
    att::phase_gla_state(p, al, c.tid); att::phase_moba_select(p, al, c.tid); if (PROBE_DUP & 128) { __syncthreads(); att::phase_gla_state(p, al, c.tid); att::phase_moba_select(p, al, c.tid); }
    xcd_barrier(bar);
    att::phase_gla_scan(p, c.tid); if (PROBE_DUP & 128) { __syncthreads(); att::phase_gla_scan(p, c.tid); }
    xcd_barrier(bar);
    att::phase_gla_out(p, al, c.tid); att::phase_moba(p, al); if (PROBE_DUP & 4) { __syncthreads(); att::phase_gla_out(p, al, c.tid); att::phase_moba(p, al); }
    xcd_barrier(bar);
    phase_gemm_outproj(p, c, 0, 1 << 20); if (PROBE_DUP & 8) { __syncthreads(); phase_gemm_outproj(p, c, 0, 1 << 20); }
    xcd_barrier(bar);
    phase_norm2_router(p, c); if (PROBE_DUP & 64) { __syncthreads(); phase_norm2_router(p, c); }
    xcd_barrier(bar);
    phase_route(p, c); if (PROBE_DUP & 128) { __syncthreads(); phase_route(p, c); }
    xcd_barrier(bar);
    for (int rep = 0; rep < ((PROBE_DUP & 16) ? 2 : 1); ++rep) {
        const int cut = 2 * ((blockIdx.x >> 3) & 7);
        if (cut > 0) phase_gemm_moe1(p, c, 0, cut);
        phase_convert_share(p, c, CT_GU, CT_TOTAL, (int)gridDim.x, (int)blockIdx.x);
        phase_gemm_moe1(p, c, cut, 1 << 20);
    }
    xcd_barrier(bar);
    phase_gemm_moe2(p, c); if (PROBE_DUP & 32) { __syncthreads(); phase_gemm_moe2(p, c); }
    xcd_barrier(bar);
    if (PROBE_DUP & 64) { phase_combine(p, c, 0u); __syncthreads(); }
    phase_combine(p, c, MX_SELFTEST ? *((volatile unsigned*)(p.ws + WS_CTL) + 8) : 0u);
}

extern "C" void kernel_launch(void* const* d_in, const int* in_sizes, int n_in, void* d_out, int out_size, void* d_ws, size_t ws_size, hipStream_t stream) {
    static int grid = 0;
    if (grid == 0) {
        if (n_in != 15 || ws_size < WS_END) { fprintf(stderr, "kernel_launch: unexpected inputs (n_in %d, ws %zu)\n", n_in, ws_size); grid = -1; return; }
        int dev = 0, cus = 0, per_cu = 0;
        if (hipGetDevice(&dev) != hipSuccess || hipDeviceGetAttribute(&cus, hipDeviceAttributeMultiprocessorCount, dev) != hipSuccess) { grid = -1; return; }
        if (hipFuncSetAttribute((const void*)fwd, hipFuncAttributeMaxDynamicSharedMemorySize, LDS_BYTES) != hipSuccess) { fprintf(stderr, "kernel_launch: hipFuncSetAttribute failed\n"); grid = -1; return; }
        if (hipOccupancyMaxActiveBlocksPerMultiprocessor(&per_cu, (const void*)fwd, NTHREADS, LDS_BYTES) != hipSuccess || per_cu < 1) { fprintf(stderr, "kernel_launch: occupancy query says %d blocks per CU\n", per_cu); }
        (void)hipGetLastError();
        grid = cus > 0 ? cus : 256;
    }
    if (grid < 0) return;
    Params p{};
    p.x = (const float*)d_in[0]; p.attn_norm_w = (const float*)d_in[1]; p.w_in = (const float*)d_in[2]; p.gate_w2 = (const float*)d_in[3]; p.gate_b = (const float*)d_in[4];
    p.gla_norm_w = (const float*)d_in[5]; p.w_out = (const float*)d_in[6]; p.ffn_norm_w = (const float*)d_in[7]; p.router_w = (const float*)d_in[8]; p.router_b = (const float*)d_in[9];
    p.w_gu = (const float*)d_in[10]; p.b_gu = (const float*)d_in[11]; p.w_d = (const float*)d_in[12]; p.b_d = (const float*)d_in[13]; p.final_norm_w = (const float*)d_in[14];
    p.out = (float*)d_out; p.ws = (unsigned char*)d_ws;
    if (hipMemsetAsync((char*)d_ws + WS_CTL, 0, CTL_BYTES, stream) != hipSuccess) return;
    hipLaunchKernelGGL(fwd, dim3(grid), dim3(NTHREADS), LDS_BYTES, stream, p);
}
```

```cpp
#include <hip/hip_runtime.h>
#include <stdint.h>
#include <stdio.h>

#define LAS __attribute__((address_space(3)))
typedef unsigned short bf16_t;
typedef short bf16x8 __attribute__((ext_vector_type(8)));
typedef short s16x4 __attribute__((ext_vector_type(4)));
typedef float f32x2 __attribute__((ext_vector_type(2)));
typedef float f32x4 __attribute__((ext_vector_type(4)));
typedef float f32x16 __attribute__((ext_vector_type(16)));
typedef unsigned u32x2 __attribute__((ext_vector_type(2)));
typedef unsigned u32x4 __attribute__((ext_vector_type(4)));
typedef int i32x8 __attribute__((ext_vector_type(8)));

constexpr int NBATCH = 4, SEQ = 4096, T = NBATCH * SEQ, DM = 2048;
constexpr int HD = 128, MH = 8, MBLK = 256, NBLK = SEQ / MBLK;
constexpr int GH = 4, GDK = 128, GDV = 256;
constexpr int LDW_IN = 6160, NPROJ = 6144;
constexpr int C_MQ = 0, C_MK = 1024, C_MV = 2048, C_GQ = 3072, C_GK = 3584, C_GV = 4096, C_GG = 5120, C_GZ = 6144;
constexpr int NE = 32, TOPK = 4, FF = 2048, NASSIGN = T * TOPK;
constexpr int MAXBLK = (NASSIGN + NE * 255) / 256, PROWS = MAXBLK * 256;
constexpr float EPS = 1e-5f;
constexpr float ACT_SCALE = 4.0f, W_SCALE = 64.0f, F8_UNSCALE = 1.0f / (ACT_SCALE * W_SCALE);
constexpr float Y_SCALE = 16.0f;

constexpr size_t MiB = (size_t)1 << 20;
constexpr size_t WS_CTL = 0, CTL_BYTES = 64 * 1024;
constexpr size_t WS_WIN = 16 * MiB;
constexpr size_t WS_WOUT = 40 * MiB;
constexpr size_t WS_ROPE = 48 * MiB;
constexpr size_t WS_RSTD1 = 50 * MiB;
constexpr size_t WS_GZ = 51 * MiB;
constexpr size_t WS_KMEAN = 52 * MiB;
constexpr size_t WS_DEND = 52 * MiB + 512 * 1024;
constexpr size_t WS_RSTD2 = 53 * MiB;
constexpr size_t WS_SEL = 54 * MiB;
constexpr size_t WS_TOPI = 55 * MiB;
constexpr size_t WS_TOPG = 55 * MiB + 512 * 1024;
constexpr size_t WS_HIST = 56 * MiB;
constexpr size_t WS_DEST = 56 * MiB + 512 * 1024;
constexpr size_t WS_ROWTOK = 57 * MiB;
constexpr size_t WS_ROWRSTD = 57 * MiB + 512 * 1024;
constexpr size_t WS_BLKE = 58 * MiB;
constexpr size_t WS_H = 64 * MiB;
constexpr size_t WS_PROJ = 128 * MiB;
constexpr size_t WS_MIXED = 320 * MiB;
constexpr size_t WS_X1 = 384 * MiB;
constexpr size_t WS_U = 512 * MiB;
constexpr size_t WS_SJ = 544 * MiB;
constexpr size_t WS_GLAO = 560 * MiB;
constexpr size_t WS_WGU = 640 * MiB;
constexpr size_t WS_WD = 1152 * MiB;
constexpr size_t WS_ACT = 1408 * MiB;
constexpr size_t WS_Y = 1696 * MiB;
constexpr size_t WS_H8 = WS_ACT;
constexpr size_t WS_WIN8 = 8 * MiB;
constexpr int NPROJ8 = 0;
constexpr size_t WS_END = 1984 * MiB;

constexpr int NTHREADS = 512, NWAVES = 8;
constexpr int LDS_BYTES = 149504;
constexpr int LDS_MISC = LDS_BYTES - 256;

struct Params {
    const float* x; const float* attn_norm_w; const float* w_in; const float* gate_w2; const float* gate_b; const float* gla_norm_w;
    const float* w_out; const float* ffn_norm_w; const float* router_w; const float* router_b; const float* w_gu; const float* b_gu;
    const float* w_d; const float* b_d; const float* final_norm_w;
    float* out; unsigned char* ws;
};

__device__ __forceinline__ unsigned cvt_pk_bf16(float lo, float hi) { unsigned r; asm volatile("v_cvt_pk_bf16_f32 %0, %1, %2" : "=v"(r) : "v"(lo), "v"(hi)); return r; }
__device__ __forceinline__ unsigned cvt4_fp8(float a, float b, float c, float d) { unsigned w = 0u; w = __builtin_amdgcn_cvt_pk_fp8_f32(a, b, w, false); w = __builtin_amdgcn_cvt_pk_fp8_f32(c, d, w, true); return w; }
__device__ __forceinline__ float bf2f(unsigned short b) { return __uint_as_float(((unsigned)b) << 16); }
__device__ __forceinline__ float bflo(unsigned w) { return __uint_as_float(w << 16); }
__device__ __forceinline__ float bfhi(unsigned w) { return __uint_as_float(w & 0xffff0000u); }
__device__ __forceinline__ bf16x8 pack8(f32x4 a, f32x4 b) {
    u32x4 w = {cvt_pk_bf16(a[0], a[1]), cvt_pk_bf16(a[2], a[3]), cvt_pk_bf16(b[0], b[1]), cvt_pk_bf16(b[2], b[3])};
    return __builtin_bit_cast(bf16x8, w);
}
__device__ __forceinline__ float wave_sum(float v) {
#pragma unroll
    for (int o = 1; o < 64; o <<= 1) v += __shfl_xor(v, o);
    return v;
}
#define LDS_WAIT() asm volatile("s_waitcnt lgkmcnt(0)" ::: "memory")
#define VM_WAIT() asm volatile("s_waitcnt vmcnt(0)" ::: "memory")
#define SBAR() __builtin_amdgcn_sched_barrier(0)
#define XB_TMO      128
#define XB_XCNT(j)  (256  + 64 * (j))
#define XB_XSUB(j)  (1280 + 64 * (j))
#define XB_XGEN(j)  (2304 + 64 * (j))
#define XB_TOP      3328
#define XB_TOPGEN   3392
#define XCD_BAR_WORDS 3456
#define XB_SPIN_CAP (1u << 18)

__device__ __forceinline__ unsigned xb_ld(unsigned* p)              { return __hip_atomic_load(p, __ATOMIC_RELAXED, __HIP_MEMORY_SCOPE_AGENT); }
__device__ __forceinline__ unsigned xb_add(unsigned* p, unsigned v) { return __hip_atomic_fetch_add(p, v, __ATOMIC_RELAXED, __HIP_MEMORY_SCOPE_AGENT); }
__device__ __forceinline__ unsigned xb_xcc_id() { return (unsigned)__builtin_amdgcn_s_getreg((3 << 11) | 20) & 0xFu; }
#define XB_SPIN(cond, bar) do { unsigned _sp = 0; while (cond) { __builtin_amdgcn_s_sleep(1); \
    if ((++_sp & 255u) == 0u) { if (xb_ld(&(bar)[XB_TMO])) break; if (_sp > XB_SPIN_CAP) { atomicAdd(&(bar)[XB_TMO], 1u); break; } } } } while (0)

struct XcdBarrier {
    unsigned* bar; unsigned x;
    volatile LAS unsigned* st;
};

__device__ __forceinline__ XcdBarrier xcd_barrier_post(unsigned* bar, volatile LAS unsigned* st) {
    XcdBarrier b; b.bar = bar; b.x = xb_xcc_id(); b.st = st;
    if (threadIdx.x == 0) (void)xb_add(&bar[XB_XCNT(b.x)], 1u);
    return b;
}
__device__ __forceinline__ void xcd_barrier_complete(unsigned* bar, unsigned x, unsigned& nloc, unsigned& nx) {
    const unsigned G = gridDim.x * gridDim.y * gridDim.z;
    unsigned sum, cnt, mine, sp = 0u;
    for (;;) {
        sum = 0u; cnt = 0u; mine = 0u;
#pragma unroll
        for (unsigned j = 0; j < 16; ++j) { const unsigned c = xb_ld(&bar[XB_XCNT(j)]); sum += c; cnt += (c > 0u) ? 1u : 0u; mine = (j == x) ? c : mine; }
        if (sum == G) break;
        __builtin_amdgcn_s_sleep(1);
        if ((++sp & 255u) == 0u) { if (xb_ld(&bar[XB_TMO])) break; if (sp > XB_SPIN_CAP) { atomicAdd(&bar[XB_TMO], 1u); break; } }
    }
    nloc = mine > 0u ? mine : 1u; nx = cnt > 0u ? cnt : 1u;
}

__device__ __forceinline__ void xcd_barrier(const XcdBarrier& b) {
    asm volatile("s_waitcnt vmcnt(0)" ::: "memory");
    __syncthreads();
    if (threadIdx.x == 0) {
        unsigned* bar = b.bar;
        __builtin_amdgcn_s_waitcnt(0);
        unsigned nloc = b.st[0], nx = b.st[1];
        if (nloc == 0u) { xcd_barrier_complete(bar, b.x, nloc, nx); b.st[0] = nloc; b.st[1] = nx; }
        const unsigned old = xb_add(&bar[XB_XSUB(b.x)], 1u);
        const unsigned gen = old / nloc;
        if (old + 1u == (gen + 1u) * nloc) {
            __builtin_amdgcn_fence(__ATOMIC_RELEASE, "agent");
            asm volatile("s_waitcnt vmcnt(0)" ::: "memory");
            const unsigned og = xb_add(&bar[XB_TOP], 1u);
            const unsigned tg = og / nx;
            if (og + 1u == (tg + 1u) * nx) xb_add(&bar[XB_TOPGEN], 1u);
            else XB_SPIN(xb_ld(&bar[XB_TOPGEN]) == tg, bar);
            __builtin_amdgcn_fence(__ATOMIC_ACQUIRE, "agent");
            xb_add(&bar[XB_XGEN(b.x)], 1u);
            asm volatile("s_waitcnt vmcnt(0)" ::: "memory");
        } else {
            XB_SPIN(xb_ld(&bar[XB_XGEN(b.x)]) == gen, bar);
            __builtin_amdgcn_fence(__ATOMIC_ACQUIRE, "agent");
            asm volatile("s_waitcnt vmcnt(0)" ::: "memory");
        }
    }
    __syncthreads();
}

namespace g8 {
constexpr int BM = 256, BK = 64, HALF = 128, HTB = HALF * BK * 2, STAGE_BYTES = 8 * HTB, NXCD = 8, WGM = 8;
__host__ __device__ __forceinline__ int lds_byte(int r, int c) { const int st = (r >> 4) * 2 + (c >> 5), rr = r & 15, cc = c & 31, ob = rr * 64 + cc * 2; return st * 1024 + (ob ^ (((ob >> 9) & 1) << 5)); }
__host__ __device__ __forceinline__ void stage_rc(int b, int& R, int& C) { const int st = b / 1024, sb = b % 1024, swz = sb ^ (((sb >> 9) & 1) << 5); R = (st >> 1) * 16 + swz / 64; C = (st & 1) * 32 + (swz % 64) / 2; }
__host__ __device__ __forceinline__ int perm32(int rho) { const int n = rho >> 4, i = rho & 15; return 8 * (i >> 2) + 4 * n + (i & 3); }

struct Unit { int pm, pn, e; };

template <int WGM_>
__device__ __forceinline__ bool static_next(int i, int nM, int nN, int G, int c, Unit& u) {
    const int nwg = nM * nN; const long L = (long)i * G + c; if (L >= nwg) return false;
    int wgid = (int)L; { const int q = nwg / NXCD, r = nwg % NXCD, xcd = wgid % NXCD, off = wgid / NXCD; wgid = (xcd < r ? xcd * (q + 1) : r * (q + 1) + (xcd - r) * q) + off; }
    const int nig = WGM_ * nN, gid = wgid / nig, fm = gid * WGM_, gsz = (nM - fm) < WGM_ ? (nM - fm) : WGM_;
    u.pm = fm + ((wgid % nig) % gsz); u.pn = (wgid % nig) / gsz; u.e = 0; return true;
}

template <class Prob, class Epi>
__device__ __forceinline__ void gemm_phase(LAS unsigned char* lds, const Prob& P, const Epi& E) {
    int tid = threadIdx.x; asm volatile("" : "+v"(tid));
    const int wid = __builtin_amdgcn_readfirstlane(tid >> 6), lane = tid & 63, wr = wid >> 2, wc = wid & 3, fr = lane & 15, fq = lane >> 4;
    const int K = P.K, nt = K / BK;
    int RA[2], CA[2]; unsigned voffB[2];
#pragma unroll
    for (int i = 0; i < 2; ++i) { int R, C; stage_rc(tid * 16 + i * 8192, R, C); const int Rb = Epi::PERM ? ((R & ~31) + perm32(R & 31)) : R;
        RA[i] = R; CA[i] = C; voffB[i] = (unsigned)(Rb * K + C) * 2u; }
    const size_t kstep = (size_t)(BK * 2);
    const size_t hstep = (size_t)HALF * K * 2;
    const unsigned ldsw = (unsigned)wid * 1024u;
    const int aoff = lds_byte(wr * 64 + fr, fq * 8), boff = lds_byte(wc * 32 + fr, fq * 8);
#define G8_SA(b, h) (((b) * 2 + (h)) * HTB)
#define G8_SB(b, h) ((4 + (b) * 2 + (h)) * HTB)
#define G8_STAGE_B(bufoff, gbase) do { _Pragma("unroll") for (int _i = 0; _i < 2; ++_i) \
        __builtin_amdgcn_global_load_lds((const unsigned*)((const char*)(gbase) + voffB[_i]), (LAS unsigned*)(lds + (bufoff) + ldsw + _i * 8192), 16, 0, 0); } while (0)
#define G8_STAGE_A(bufoff, o0, o1) do { \
        __builtin_amdgcn_global_load_lds((const unsigned*)(Ab + (o0)), (LAS unsigned*)(lds + (bufoff) + ldsw), 16, 0, 0); \
        __builtin_amdgcn_global_load_lds((const unsigned*)(Ab + (o1)), (LAS unsigned*)(lds + (bufoff) + ldsw + 8192), 16, 0, 0); } while (0)
#define G8_CAT(lo, hi) __builtin_bit_cast(i32x8, __builtin_shufflevector(lo, hi, 0, 1, 2, 3, 4, 5, 6, 7))
#define G8_LO(v) __builtin_bit_cast(bf16x8, __builtin_shufflevector(v, v, 0, 1, 2, 3))
#define G8_HI(v) __builtin_bit_cast(bf16x8, __builtin_shufflevector(v, v, 4, 5, 6, 7))
#define G8_LDA(dst, b, h) do { _Pragma("unroll") for (int m = 0; m < 4; ++m) { const u32x4 _l = *(const LAS u32x4*)(lds + G8_SA(b, h) + aoff + m * 2048), _h = *(const LAS u32x4*)(lds + G8_SA(b, h) + aoff + m * 2048 + 1024); dst[m] = G8_CAT(_l, _h); } } while (0)
#define G8_LDB(dst, b, h) do { _Pragma("unroll") for (int n = 0; n < 2; ++n) { const u32x4 _l = *(const LAS u32x4*)(lds + G8_SB(b, h) + boff + n * 2048), _h = *(const LAS u32x4*)(lds + G8_SB(b, h) + boff + n * 2048 + 1024); dst[n] = G8_CAT(_l, _h); } } while (0)
#define G8_MMA(ai, bj, At, Bt) do { __builtin_amdgcn_s_setprio(1); \
        if constexpr (Prob::FP8) { _Pragma("unroll") for (int m = 0; m < 4; ++m) _Pragma("unroll") for (int n = 0; n < 2; ++n) \
            asm volatile("v_mfma_scale_f32_16x16x128_f8f6f4 %0, %1, %2, %0, %3, %3 op_sel_hi:[0,0,0]" : "+v"(acc[ai][bj][m][n]) : "v"(Bt[n]), "v"(At[m]), "v"(f8scale)); } \
        else { _Pragma("unroll") for (int m = 0; m < 4; ++m) _Pragma("unroll") for (int n = 0; n < 2; ++n) { \
            acc[ai][bj][m][n] = __builtin_amdgcn_mfma_f32_16x16x32_bf16(G8_LO(Bt[n]), G8_LO(At[m]), acc[ai][bj][m][n], 0, 0, 0); \
            acc[ai][bj][m][n] = __builtin_amdgcn_mfma_f32_16x16x32_bf16(G8_HI(Bt[n]), G8_HI(At[m]), acc[ai][bj][m][n], 0, 0, 0); } } \
        __builtin_amdgcn_s_setprio(0); } while (0)
#define G8_WAIT_V(n) asm volatile("s_waitcnt vmcnt(" #n ")" ::: "memory")
#define G8_WAIT_L(n) asm volatile("s_waitcnt lgkmcnt(" #n ")" ::: "memory")
#define G8_BAR __builtin_amdgcn_s_barrier()
#define G8_SCHED __builtin_amdgcn_sched_barrier(0)
    Unit cur, nxt, nn; int ui = 0;
    if (!P.next(0, cur)) return;
    const int f8scale = 0x7f7f7f7f;
    f32x4 acc[2][2][4][2];
#pragma unroll
    for (int a = 0; a < 2; ++a)
#pragma unroll
        for (int b = 0; b < 2; ++b)
#pragma unroll
            for (int m = 0; m < 4; ++m)
#pragma unroll
                for (int n = 0; n < 2; ++n) acc[a][b][m][n] = (f32x4){0.f, 0.f, 0.f, 0.f};
    i32x8 At[4], B0[2], B1[2];
    const char* Ab = (const char*)P.a_base();
    unsigned aoc[2][2], aon[2][2]; int raw[2][2];
    P.a_fetch(cur, RA, raw); P.a_finish(raw, CA, aoc);
    bool has_next = P.next(1, nxt);
    if (has_next) { P.a_fetch(nxt, RA, raw); P.a_finish(raw, CA, aon); }
    else { aon[0][0] = aoc[0][0]; aon[0][1] = aoc[0][1]; aon[1][0] = aoc[1][0]; aon[1][1] = aoc[1][1]; }
    const char* cB = (const char*)P.b_ptr(cur);
    const char* nB = has_next ? (const char*)P.b_ptr(nxt) : cB;
    typename Epi::Pre pre = E.fetch(cur, wr, wc, fr, fq);
    G8_STAGE_B(G8_SB(0, 0), cB); G8_STAGE_B(G8_SB(0, 1), cB + hstep); G8_STAGE_A(G8_SA(0, 0), aoc[0][0], aoc[0][1]); G8_STAGE_A(G8_SA(0, 1), aoc[1][0], aoc[1][1]);
    if (wr == 1) G8_BAR;
    G8_WAIT_V(2); G8_BAR;
    G8_STAGE_B(G8_SB(1, 0), cB + kstep); G8_STAGE_A(G8_SA(1, 0), aoc[0][0] + 128u, aoc[0][1] + 128u); G8_STAGE_B(G8_SB(1, 1), cB + hstep + kstep);
    G8_WAIT_V(6); G8_BAR;
    for (;;) {
        for (int t = 0; t < nt; t += 2) {
            const bool last = (t == nt - 2);
            const unsigned k1 = (unsigned)(t + 1) * 128u;
            const unsigned k2 = last ? 0u : (unsigned)(t + 2) * 128u;
            const unsigned a2_00 = (last ? aon[0][0] : aoc[0][0]) + k2, a2_01 = (last ? aon[0][1] : aoc[0][1]) + k2;
            const unsigned a2_10 = (last ? aon[1][0] : aoc[1][0]) + k2, a2_11 = (last ? aon[1][1] : aoc[1][1]) + k2;
            const char* b2 = last ? nB : cB + (size_t)(t + 2) * kstep;
            const char* b3 = b2 + kstep;
            G8_LDB(B0, 0, 0); G8_LDB(B1, 0, 1); G8_SCHED; G8_LDA(At, 0, 0); G8_STAGE_A(G8_SA(1, 1), aoc[1][0] + k1, aoc[1][1] + k1);
            G8_WAIT_V(8); G8_WAIT_L(0); G8_BAR; G8_MMA(0, 0, At, B0); G8_MMA(0, 1, At, B1); G8_BAR; G8_SCHED;
            G8_LDA(At, 0, 1); G8_STAGE_B(G8_SB(0, 0), b2); G8_STAGE_B(G8_SB(0, 1), b2 + hstep); G8_STAGE_A(G8_SA(0, 0), a2_00, a2_01);
            G8_WAIT_V(8); G8_WAIT_L(0); G8_BAR; G8_MMA(1, 0, At, B0); G8_MMA(1, 1, At, B1); G8_BAR; G8_SCHED;
            G8_LDB(B0, 1, 0); G8_LDB(B1, 1, 1); G8_SCHED; G8_LDA(At, 1, 0); G8_STAGE_A(G8_SA(0, 1), a2_10, a2_11);
            G8_WAIT_V(8); G8_WAIT_L(0); G8_BAR; G8_MMA(0, 0, At, B0); G8_MMA(0, 1, At, B1); G8_BAR; G8_SCHED;
            G8_LDA(At, 1, 1); G8_STAGE_B(G8_SB(1, 0), b3); G8_STAGE_B(G8_SB(1, 1), b3 + hstep); G8_STAGE_A(G8_SA(1, 0), a2_00 + 128u, a2_01 + 128u);
            G8_WAIT_V(8); G8_WAIT_L(0); G8_BAR; G8_MMA(1, 0, At, B0); G8_MMA(1, 1, At, B1); G8_BAR; G8_SCHED;
        }
        if (wr == 0) G8_BAR;
        if constexpr (Prob::FP8) asm volatile("s_nop 15\n\ts_nop 15" ::: "memory");
        const bool has_nn = has_next && P.next(ui + 2, nn);
        if (has_nn) P.a_fetch(nn, RA, raw);
        typename Epi::Pre pren = pre; if (has_next) pren = E.fetch(nxt, wr, wc, fr, fq);
        E(acc, cur, pre, wr, wc, fr, fq); pre = pren;
        if (!has_next) break;
#pragma unroll
        for (int a = 0; a < 2; ++a)
#pragma unroll
            for (int b = 0; b < 2; ++b)
#pragma unroll
                for (int m = 0; m < 4; ++m)
#pragma unroll
                    for (int n = 0; n < 2; ++n) acc[a][b][m][n] = (f32x4){0.f, 0.f, 0.f, 0.f};
        cur = nxt; cB = nB; ++ui;
        aoc[0][0] = aon[0][0]; aoc[0][1] = aon[0][1]; aoc[1][0] = aon[1][0]; aoc[1][1] = aon[1][1];
        nxt = nn; has_next = has_nn;
        if (has_next) { P.a_finish(raw, CA, aon); nB = (const char*)P.b_ptr(nxt); }
        else { nB = cB; }
        if (wr == 1) G8_BAR;
    }
    G8_WAIT_V(0);
    G8_BAR;
#undef G8_SA
#undef G8_SB
#undef G8_STAGE_A
#undef G8_STAGE_B
#undef G8_LDA
#undef G8_LDB
#undef G8_MMA
#undef G8_CAT
#undef G8_LO
#undef G8_HI
#undef G8_WAIT_V
#undef G8_WAIT_L
#undef G8_BAR
#undef G8_SCHED
}
}
namespace g8 {
#ifndef WGM_IN
#define WGM_IN 8
#endif
#ifndef WGM_OUT
#define WGM_OUT 8
#endif
#ifndef WGM_M1
#define WGM_M1 4
#endif
#ifndef WGM_M2
#define WGM_M2 4
#endif
template <bool F8, int WG_ = 8> struct DenseProbT {
    static constexpr bool FP8 = F8;
    const bf16_t* A; const bf16_t* Bt; int nM, nN, K, G, c, i0, i1;
    __device__ __forceinline__ bool next(int i, Unit& u) const { return (i0 + i < i1) && static_next<WG_>(i0 + i, nM, nN, G, c, u); }
    __device__ __forceinline__ const void* a_base() const { return A; }
    __device__ __forceinline__ void a_fetch(const Unit& u, const int (&RA)[2], int (&raw)[2][2]) const {
#pragma unroll
        for (int h = 0; h < 2; ++h)
#pragma unroll
            for (int i = 0; i < 2; ++i) raw[h][i] = u.pm * BM + h * HALF + RA[i];
    }
    __device__ __forceinline__ void a_finish(const int (&raw)[2][2], const int (&CA)[2], unsigned (&ao)[2][2]) const {
#pragma unroll
        for (int h = 0; h < 2; ++h)
#pragma unroll
            for (int i = 0; i < 2; ++i) ao[h][i] = (unsigned)((raw[h][i] * K + CA[i]) * 2);
    }
    __device__ __forceinline__ const void* b_ptr(const Unit& u) const { return Bt + (size_t)u.pn * BM * K; }
};
typedef DenseProbT<false, WGM_IN> DenseProbIn; typedef DenseProbT<false, WGM_OUT> DenseProbOut;
struct MoeProb1 {
    static constexpr bool FP8 = true;
    const bf16_t* A; const bf16_t* Bt; const int* row_tok; const int* blk; int K; int nM; int i0, i1;
    __device__ __forceinline__ bool next(int i, Unit& u) const {
        if (i0 + i >= i1 || !static_next<WGM_M1>(i0 + i, nM, 2 * FF / BM, gridDim.x, blockIdx.x, u)) return false;
        u.e = blk[64 + u.pm]; return true; }
    __device__ __forceinline__ const void* a_base() const { return A; }
    __device__ __forceinline__ void a_fetch(const Unit& u, const int (&RA)[2], int (&raw)[2][2]) const {
#pragma unroll
        for (int h = 0; h < 2; ++h)
#pragma unroll
            for (int i = 0; i < 2; ++i) raw[h][i] = row_tok[u.pm * BM + h * HALF + RA[i]];
    }
    __device__ __forceinline__ void a_finish(const int (&raw)[2][2], const int (&CA)[2], unsigned (&ao)[2][2]) const {
#pragma unroll
        for (int h = 0; h < 2; ++h)
#pragma unroll
            for (int i = 0; i < 2; ++i) ao[h][i] = (unsigned)((raw[h][i] * K + CA[i]) * 2);
    }
    __device__ __forceinline__ const void* b_ptr(const Unit& u) const { return Bt + ((size_t)__builtin_amdgcn_readfirstlane(u.e) * (2 * FF) + (size_t)u.pn * BM) * K; }
};
struct MoeProb2 {
    static constexpr bool FP8 = true;
    const bf16_t* A; const bf16_t* Bt; const int* blk; int K; int nM;
    __device__ __forceinline__ bool next(int i, Unit& u) const {
        if (!static_next<WGM_M2>(i, nM, DM / BM, gridDim.x, blockIdx.x, u)) return false;
        u.e = blk[64 + u.pm]; return true; }
    __device__ __forceinline__ const void* a_base() const { return A; }
    __device__ __forceinline__ void a_fetch(const Unit& u, const int (&RA)[2], int (&raw)[2][2]) const {
#pragma unroll
        for (int h = 0; h < 2; ++h)
#pragma unroll
            for (int i = 0; i < 2; ++i) raw[h][i] = u.pm * BM + h * HALF + RA[i];
    }
    __device__ __forceinline__ void a_finish(const int (&raw)[2][2], const int (&CA)[2], unsigned (&ao)[2][2]) const {
#pragma unroll
        for (int h = 0; h < 2; ++h)
#pragma unroll
            for (int i = 0; i < 2; ++i) ao[h][i] = (unsigned)((raw[h][i] * K + CA[i]) * 2);
    }
    __device__ __forceinline__ const void* b_ptr(const Unit& u) const { return Bt + ((size_t)__builtin_amdgcn_readfirstlane(u.e) * DM + (size_t)u.pn * BM) * K; }
};

struct EpiProj {
    static constexpr bool PERM = true;
    bf16_t* __restrict__ O; const float* __restrict__ rstd; float scale; int colbase;
    struct Pre { float rs[2][4]; };
    __device__ __forceinline__ Pre fetch(const Unit& u, int wr, int wc, int fr, int fq) const {
        Pre q; const int row0 = u.pm * BM + wr * 64 + fr;
#pragma unroll
        for (int ai = 0; ai < 2; ++ai)
#pragma unroll
            for (int m = 0; m < 4; ++m) q.rs[ai][m] = rstd[row0 + ai * HALF + m * 16];
        return q; }
    __device__ __forceinline__ void operator()(const f32x4 (&acc)[2][2][4][2], const Unit& u, const Pre& q, int wr, int wc, int fr, int fq) const {
        const int row0 = u.pm * BM + wr * 64 + fr, col0 = colbase + u.pn * BM + wc * 32 + 8 * fq;
#pragma unroll
        for (int ai = 0; ai < 2; ++ai)
#pragma unroll
            for (int m = 0; m < 4; ++m) { const int row = row0 + ai * HALF + m * 16; bf16_t* rowp = O + (size_t)row * NPROJ + col0; const float rsc = q.rs[ai][m] * scale;
#pragma unroll
                for (int bj = 0; bj < 2; ++bj) { const f32x4 v0 = acc[ai][bj][m][0] * rsc, v1 = acc[ai][bj][m][1] * rsc;
                    u32x4 w; w.x = cvt_pk_bf16(v0[0], v0[1]); w.y = cvt_pk_bf16(v0[2], v0[3]); w.z = cvt_pk_bf16(v1[0], v1[1]); w.w = cvt_pk_bf16(v1[2], v1[3]);
                    *(u32x4*)(rowp + bj * HALF) = w; } }
    }
};
struct EpiX1 {
    static constexpr bool PERM = false;
    const float* __restrict__ X; float* __restrict__ O;
    struct Pre {};
    __device__ __forceinline__ Pre fetch(const Unit&, int, int, int, int) const { return Pre{}; }
    __device__ __forceinline__ void operator()(const f32x4 (&acc)[2][2][4][2], const Unit& u, const Pre&, int wr, int wc, int fr, int fq) const {
        const int row0 = u.pm * BM + wr * 64 + fr, col0 = u.pn * BM + wc * 32 + 4 * fq;
#pragma unroll
        for (int ai = 0; ai < 2; ++ai) {
            f32x4 xv[4][2][2];
#pragma unroll
            for (int m = 0; m < 4; ++m) { const size_t off = (size_t)(row0 + ai * HALF + m * 16) * DM + col0;
#pragma unroll
                for (int bj = 0; bj < 2; ++bj)
#pragma unroll
                    for (int n = 0; n < 2; ++n) xv[m][bj][n] = __builtin_nontemporal_load((const f32x4*)(X + off + bj * HALF + n * 16)); }
#pragma unroll
            for (int m = 0; m < 4; ++m) { const size_t off = (size_t)(row0 + ai * HALF + m * 16) * DM + col0;
#pragma unroll
                for (int bj = 0; bj < 2; ++bj)
#pragma unroll
                    for (int n = 0; n < 2; ++n) *(f32x4*)(O + off + bj * HALF + n * 16) = xv[m][bj][n] + acc[ai][bj][m][n]; }
        }
    }
};
struct EpiSwiglu {
    static constexpr bool PERM = true;
    unsigned char* __restrict__ O; const float* __restrict__ row_rstd; const float* __restrict__ bgu;
    struct Pre { float rsv[2][4]; };
    __device__ __forceinline__ Pre fetch(const Unit& u, int wr, int wc, int fr, int fq) const {
        Pre q; const int row0 = u.pm * BM + wr * 64 + fr;
#pragma unroll
        for (int ai = 0; ai < 2; ++ai)
#pragma unroll
            for (int m = 0; m < 4; ++m) q.rsv[ai][m] = row_rstd[row0 + ai * HALF + m * 16];
        return q; }
    __device__ __forceinline__ void operator()(const f32x4 (&acc)[2][2][4][2], const Unit& u, const Pre& q, int wr, int wc, int fr, int fq) const {
        const int row0 = u.pm * BM + wr * 64 + fr, colg = u.pn * HALF + wc * 32 + 8 * fq;
        const float* bg = bgu + (size_t)__builtin_amdgcn_readfirstlane(u.e) * (2 * FF) + colg; const float* bu = bg + FF;
        const f32x4 bg0 = *(const f32x4*)bg, bg1 = *(const f32x4*)(bg + 4), bu0 = *(const f32x4*)bu, bu1 = *(const f32x4*)(bu + 4);
#pragma unroll
        for (int ai = 0; ai < 2; ++ai)
#pragma unroll
            for (int m = 0; m < 4; ++m) { const int row = row0 + ai * HALF + m * 16; const float rs = q.rsv[ai][m] * F8_UNSCALE;
                f32x4 g0 = acc[ai][0][m][0] * rs + bg0, g1 = acc[ai][0][m][1] * rs + bg1, u0 = acc[ai][1][m][0] * rs + bu0, u1 = acc[ai][1][m][1] * rs + bu1;
                float o[8];
#pragma unroll
                for (int j = 0; j < 8; ++j) { float g = j < 4 ? g0[j] : g1[j - 4], uu = j < 4 ? u0[j] : u1[j - 4];
                    g = fminf(g, 7.0f); uu = __builtin_amdgcn_fmed3f(uu, -7.0f, 7.0f);
                    const float sg = __builtin_amdgcn_rcpf(1.0f + __builtin_amdgcn_exp2f(g * (-1.702f * 1.4426950408889634f)));
                    o[j] = (uu * ACT_SCALE + ACT_SCALE) * (g * sg); }
                u32x2 w; w.x = cvt4_fp8(o[0], o[1], o[2], o[3]); w.y = cvt4_fp8(o[4], o[5], o[6], o[7]);
                *(u32x2*)(O + (size_t)row * FF + colg) = w; }
    }
};
struct EpiDown {
    static constexpr bool PERM = true;
    unsigned char* __restrict__ O; const float* __restrict__ bd;
    struct Pre { f32x4 bv[2][2]; };
    __device__ __forceinline__ Pre fetch(const Unit& u, int wr, int wc, int fr, int fq) const {
        Pre q; const int col0 = u.pn * BM + wc * 32 + 8 * fq;
        const float* bp = bd + (size_t)__builtin_amdgcn_readfirstlane(u.e) * DM + col0;
#pragma unroll
        for (int bj = 0; bj < 2; ++bj)
#pragma unroll
            for (int n = 0; n < 2; ++n) q.bv[bj][n] = *(const f32x4*)(bp + bj * HALF + 4 * n) * Y_SCALE;
        return q; }
    __device__ __forceinline__ void operator()(const f32x4 (&acc)[2][2][4][2], const Unit& u, const Pre& q, int wr, int wc, int fr, int fq) const {
        const int row0 = u.pm * BM + wr * 64 + fr, col0 = u.pn * BM + wc * 32 + 8 * fq;
#pragma unroll
        for (int ai = 0; ai < 2; ++ai)
#pragma unroll
            for (int m = 0; m < 4; ++m) { unsigned char* rowp = O + (size_t)(row0 + ai * HALF + m * 16) * DM + col0;
#pragma unroll
                for (int bj = 0; bj < 2; ++bj) { const f32x4 v0 = acc[ai][bj][m][0] * (F8_UNSCALE * Y_SCALE) + q.bv[bj][0], v1 = acc[ai][bj][m][1] * (F8_UNSCALE * Y_SCALE) + q.bv[bj][1];
                    u32x2 w; w.x = cvt4_fp8(v0[0], v0[1], v0[2], v0[3]); w.y = cvt4_fp8(v1[0], v1[1], v1[2], v1[3]);
                    *(u32x2*)(rowp + bj * HALF) = w; } }
    }
};
}
struct Ctx { LAS unsigned char* lds; int tid, lane, wave; };
__device__ __forceinline__ Ctx fresh_ctx(const Ctx& c0) { Ctx c; c.lds = c0.lds; int t = threadIdx.x; asm volatile("" : "+v"(t)); c.tid = t; c.lane = t & 63; c.wave = __builtin_amdgcn_readfirstlane(t >> 6); return c; }

__device__ __forceinline__ void transpose_item(const float* W, int ld, int K, int k0, int n0, bf16_t* WT_row0  , LAS float* scr, int lane) {
    float tv[32];
#pragma unroll
    for (int i = 0; i < 32; ++i) { const int kk = 2 * i + (lane >> 5); tv[i] = __builtin_nontemporal_load(W + (size_t)(k0 + kk) * ld + n0 + (lane & 31)); }
#pragma unroll
    for (int i = 0; i < 32; ++i) { const int kk = 2 * i + (lane >> 5); scr[kk * 33 + (lane & 31)] = tv[i]; }
    LDS_WAIT(); asm volatile("" ::: "memory");
    const int c = lane & 7;
#pragma unroll
    for (int j = 0; j < 4; ++j) { const int n = (lane >> 3) + 8 * j; const LAS float* s = scr + (8 * c) * 33 + n;
        u32x4 o; o.x = cvt_pk_bf16(s[0 * 33], s[1 * 33]); o.y = cvt_pk_bf16(s[2 * 33], s[3 * 33]); o.z = cvt_pk_bf16(s[4 * 33], s[5 * 33]); o.w = cvt_pk_bf16(s[6 * 33], s[7 * 33]);
        *(u32x4*)(WT_row0 + (size_t)n * K + k0 + 8 * c) = o; }
    LDS_WAIT(); asm volatile("" ::: "memory");
}
struct ConvItem { const float* src; unsigned char* dst; int ld; };
constexpr int CV_KB8 = DM / 128, CV_GU1 = CV_KB8 * (2 * FF / 32), CV_D1 = CV_KB8 * (DM / 32), CV_GU = NE * CV_GU1, CV_D = NE * CV_D1, CV_TOTAL = CV_GU + CV_D;
constexpr int CV_IN8 = CV_KB8 * (NPROJ8 / 32);
constexpr int CV_EARLY = CV_TOTAL / 4;
__device__ __forceinline__ ConvItem conv_decode(const Params& p, int r) {
    ConvItem it;
    if (r < CV_GU) { const int e = r / CV_GU1, q = r % CV_GU1, nb = q % (2 * FF / 32), kb = q / (2 * FF / 32); const int n0 = 32 * nb;
        const int nn = n0 < FF ? n0 : n0 - FF; const int orow = 256 * (nn / 128) + (nn % 128) + (n0 < FF ? 0 : 128);
        it.src = p.w_gu + (size_t)e * DM * (2 * FF) + (size_t)(128 * kb) * (2 * FF) + n0; it.ld = 2 * FF;
        it.dst = (unsigned char*)(p.ws + WS_WGU) + ((size_t)e * (2 * FF) + orow) * DM + 128 * kb; }
    else if (r >= CV_TOTAL) { r -= CV_TOTAL; const int nb = r % (NPROJ8 / 32), kb = r / (NPROJ8 / 32);
        it.src = p.w_in + (size_t)(128 * kb) * LDW_IN + 32 * nb; it.ld = LDW_IN;
        it.dst = (unsigned char*)(p.ws + WS_WIN8) + (size_t)(32 * nb) * DM + 128 * kb; }
    else { r -= CV_GU; const int e = r / CV_D1, q = r % CV_D1, nb = q % (DM / 32), kb = q / (DM / 32);
        it.src = p.w_d + (size_t)e * FF * DM + (size_t)(128 * kb) * DM + 32 * nb; it.ld = DM;
        it.dst = (unsigned char*)(p.ws + WS_WD) + ((size_t)e * DM + 32 * nb) * FF + 128 * kb; }
    return it;
}
__device__ __forceinline__ void conv_load(const ConvItem& it, f32x4 (&tv)[16], int lane) {
    const float* s = it.src + (size_t)((lane >> 3) * 8) * it.ld + (lane & 7) * 4;
#pragma unroll
    for (int a = 0; a < 2; ++a)
#pragma unroll
        for (int b = 0; b < 8; ++b) tv[8 * a + b] = __builtin_nontemporal_load((const f32x4*)(s + (size_t)(64 * a + b) * it.ld));
}
__device__ __forceinline__ void conv_store(const ConvItem& it, const f32x4 (&tv)[16], LAS float*, int lane) {
    unsigned char* d = it.dst + (size_t)((lane & 7) * 4) * DM + (lane >> 3) * 8;
#pragma unroll
    for (int a = 0; a < 2; ++a)
#pragma unroll
        for (int i = 0; i < 4; ++i) { u32x2 o;
            o.x = cvt4_fp8(tv[8 * a + 0][i] * W_SCALE, tv[8 * a + 1][i] * W_SCALE, tv[8 * a + 2][i] * W_SCALE, tv[8 * a + 3][i] * W_SCALE);
            o.y = cvt4_fp8(tv[8 * a + 4][i] * W_SCALE, tv[8 * a + 5][i] * W_SCALE, tv[8 * a + 6][i] * W_SCALE, tv[8 * a + 7][i] * W_SCALE);
            *(u32x2*)(d + (size_t)i * DM + 64 * a) = o; }
}
__device__ __forceinline__ void conv_range(const Params& p, int lo, int hi, int w, int nw, LAS float* scr, int lane) {
    for (int it = lo + w; it < hi; it += 2 * nw) {
        const int i1 = it + nw < hi ? it + nw : it;
        f32x4 ta[16], tb[16];
        const ConvItem A = conv_decode(p, it), B = conv_decode(p, i1);
        conv_load(A, ta, lane); conv_load(B, tb, lane);
        __builtin_amdgcn_sched_barrier(0);
        conv_store(A, ta, scr, lane); conv_store(B, tb, scr, lane);
        __builtin_amdgcn_sched_barrier(0);
    }
}
__device__ __forceinline__ void phase_convert(const Params& p, const Ctx& c0) { const Ctx c = fresh_ctx(c0);
    LAS float* scr = (LAS float*)(c.lds + c.wave * 18432);
    const int gw = blockIdx.x * NWAVES + c.wave, NGW = gridDim.x * NWAVES;
    bf16_t* WinT = (bf16_t*)(p.ws + WS_WIN); bf16_t* WoutT = (bf16_t*)(p.ws + WS_WOUT);
    constexpr int KB = DM / 64;
    constexpr int I_IN = KB * ((NPROJ - NPROJ8) / 32), I_OUT = KB * (DM / 32), NITEMS = I_IN + I_OUT;
    for (int it = gw; it < NITEMS; it += NGW) {
        int r = it;
        if (r < I_IN) { const int nb = r % ((NPROJ - NPROJ8) / 32), kb = r / ((NPROJ - NPROJ8) / 32); transpose_item(p.w_in, LDW_IN, DM, 64 * kb, NPROJ8 + 32 * nb, WinT + (size_t)(NPROJ8 + 32 * nb) * DM, scr, c.lane); continue; } r -= I_IN;
        { const int nb = r % (DM / 32), kb = r / (DM / 32); transpose_item(p.w_out, DM, DM, 64 * kb, 32 * nb, WoutT + (size_t)(32 * nb) * DM, scr, c.lane); }
    }
    conv_range(p, CV_TOTAL, CV_TOTAL + CV_IN8, gw, NGW, scr, c.lane);
    float* rc = (float*)(p.ws + WS_ROPE); float* rs = rc + SEQ * 64;
    for (int i = blockIdx.x * NTHREADS + c.tid; i < SEQ * 64; i += gridDim.x * NTHREADS) {
        const int pos = i >> 6, j = i & 63;
        const float inv = 1.0f / powf(10000.0f, (float)(2 * j) / 128.0f);
        const float ang = (float)pos * inv; float sn, cs; sincosf(ang, &sn, &cs); rc[i] = cs; rs[i] = sn; }
}
constexpr int CT_GU1 = (DM / 128) * (2 * FF / 256), CT_D1 = (FF / 128) * (DM / 256), CT_GU = NE * CT_GU1, CT_D = NE * CT_D1, CT_TOTAL = CT_GU + CT_D;
struct ConvTile { const float* src; unsigned char* dst; int ld; int gu; };
__device__ __forceinline__ ConvTile ctile_decode(const Params& p, int r) {
    ConvTile t;
    if (r < CT_GU) { const int e = r / CT_GU1, q = r % CT_GU1, nt = q % (2 * FF / 256), kt = q / (2 * FF / 256);
        t.src = p.w_gu + (size_t)e * DM * (2 * FF) + (size_t)(128 * kt) * (2 * FF) + 256 * nt; t.ld = 2 * FF; t.gu = 256 * nt;
        t.dst = (unsigned char*)(p.ws + WS_WGU) + (size_t)e * (2 * FF) * DM + 128 * kt; }
    else { r -= CT_GU; const int e = r / CT_D1, q = r % CT_D1, nt = q % (DM / 256), kt = q / (DM / 256);
        t.src = p.w_d + (size_t)e * FF * DM + (size_t)(128 * kt) * DM + 256 * nt; t.ld = DM; t.gu = -1;
        t.dst = (unsigned char*)(p.ws + WS_WD) + ((size_t)e * DM + 256 * nt) * FF + 128 * kt; }
    return t;
}
__device__ __forceinline__ void ctile_load(const ConvTile& t, f32x4 (&tv)[16], int wave, int lane) {
    const float* s = t.src + (size_t)(16 * wave) * t.ld + 4 * lane;
#pragma unroll
    for (int i = 0; i < 16; ++i) tv[i] = __builtin_nontemporal_load((const f32x4*)(s + (size_t)i * t.ld));
}
__device__ __forceinline__ void ctile_store(const ConvTile& t, const f32x4 (&tv)[16], LAS unsigned char* lds, int tid, int wave, int lane) {
#pragma unroll
    for (int c = 0; c < 4; ++c) { u32x4 o;
#pragma unroll
        for (int q = 0; q < 4; ++q) o[q] = cvt4_fp8(tv[4 * q][c] * W_SCALE, tv[4 * q + 1][c] * W_SCALE, tv[4 * q + 2][c] * W_SCALE, tv[4 * q + 3][c] * W_SCALE);
        const int n = 4 * lane + c; *(LAS u32x4*)(lds + n * 128 + ((wave ^ (lane & 7)) << 4)) = o; }
    __syncthreads();
#pragma unroll
    for (int j = 0; j < 4; ++j) { const int n = 64 * j + (tid >> 3), ch = tid & 7;
        const u32x4 o = *(const LAS u32x4*)(lds + n * 128 + ((ch ^ ((n >> 2) & 7)) << 4));
        int orow = n;
        if (t.gu >= 0) { const int ng = t.gu + n; const int nn = ng < FF ? ng : ng - FF; orow = 256 * (nn / 128) + (nn % 128) + (ng < FF ? 0 : 128); }
        *(u32x4*)(t.dst + (size_t)orow * DM + 16 * ch) = o; }
    __syncthreads();
}
__device__ __forceinline__ void phase_convert_share(const Params& p, const Ctx& c0, int lo, int hi, int G, int w) { const Ctx c = fresh_ctx(c0);
    for (int it = lo + w; it < hi; it += 2 * G) {
        const int i1 = it + G < hi ? it + G : it;
        f32x4 ta[16], tb[16];
        const ConvTile A = ctile_decode(p, it), B = ctile_decode(p, i1);
        ctile_load(A, ta, c.wave, c.lane); ctile_load(B, tb, c.wave, c.lane);
        __builtin_amdgcn_sched_barrier(0);
        ctile_store(A, ta, c.lds, c.tid, c.wave, c.lane); ctile_store(B, tb, c.lds, c.tid, c.wave, c.lane);
        __builtin_amdgcn_sched_barrier(0);
    }
}

template <int NTL, int OUT8  >
__device__ __forceinline__ void norm_skinny_half(const float* xrows, const float* wn, const float* Wsk, int ldw, void* hrows_, void* hrows8_, int hk, int lane, f32x4 (&acc)[NTL], float& ss) {
    const int row = lane & 15, kq = lane >> 4;
    ss = 0.f;
#pragma unroll
    for (int t = 0; t < NTL; ++t) acc[t] = (f32x4){0.f, 0.f, 0.f, 0.f};
#pragma unroll 4
    for (int ks = 0; ks < 32; ++ks) {
        const int d0 = 1024 * hk + 32 * ks + 8 * kq;
        f32x4 xa = *(const f32x4*)(xrows + (size_t)row * DM + d0), xb = *(const f32x4*)(xrows + (size_t)row * DM + d0 + 4);
        const f32x4 wa = *(const f32x4*)(wn + d0), wb = *(const f32x4*)(wn + d0 + 4);
        ss += (xa[0] * xa[0] + xa[1] * xa[1]) + (xa[2] * xa[2] + xa[3] * xa[3]) + (xb[0] * xb[0] + xb[1] * xb[1]) + (xb[2] * xb[2] + xb[3] * xb[3]);
        xa = xa * wa; xb = xb * wb;
        u32x4 hw; hw.x = cvt_pk_bf16(xa[0], xa[1]); hw.y = cvt_pk_bf16(xa[2], xa[3]); hw.z = cvt_pk_bf16(xb[0], xb[1]); hw.w = cvt_pk_bf16(xb[2], xb[3]);
        if constexpr (OUT8 >= 1) { u32x2 q; q.x = cvt4_fp8(xa[0] * ACT_SCALE, xa[1] * ACT_SCALE, xa[2] * ACT_SCALE, xa[3] * ACT_SCALE); q.y = cvt4_fp8(xb[0] * ACT_SCALE, xb[1] * ACT_SCALE, xb[2] * ACT_SCALE, xb[3] * ACT_SCALE);
            *(u32x2*)((unsigned char*)hrows8_ + (size_t)row * DM + d0) = q; }
        if constexpr (OUT8 != 1) *(u32x4*)((bf16_t*)hrows_ + (size_t)row * DM + d0) = hw;
        const f32x4 ra = {xa[0] - bflo(hw.x), xa[1] - bfhi(hw.x), xa[2] - bflo(hw.y), xa[3] - bfhi(hw.y)}, rb = {xb[0] - bflo(hw.z), xb[1] - bfhi(hw.z), xb[2] - bflo(hw.w), xb[3] - bfhi(hw.w)};
        const bf16x8 ah = __builtin_bit_cast(bf16x8, hw), al = pack8(ra, rb);
#pragma unroll
        for (int t = 0; t < NTL; ++t) {
            float wv[8];
#pragma unroll
            for (int i = 0; i < 8; ++i) wv[i] = Wsk[(size_t)(d0 + i) * ldw + t * 16 + row];
            u32x4 bw; bw.x = cvt_pk_bf16(wv[0], wv[1]); bw.y = cvt_pk_bf16(wv[2], wv[3]); bw.z = cvt_pk_bf16(wv[4], wv[5]); bw.w = cvt_pk_bf16(wv[6], wv[7]);
            const f32x4 r0 = {wv[0] - bflo(bw.x), wv[1] - bfhi(bw.x), wv[2] - bflo(bw.y), wv[3] - bfhi(bw.y)}, r1 = {wv[4] - bflo(bw.z), wv[5] - bfhi(bw.z), wv[6] - bflo(bw.w), wv[7] - bfhi(bw.w)};
            const bf16x8 bh = __builtin_bit_cast(bf16x8, bw), bl = pack8(r0, r1);
            acc[t] = __builtin_amdgcn_mfma_f32_16x16x32_bf16(ah, bh, acc[t], 0, 0, 0);
            acc[t] = __builtin_amdgcn_mfma_f32_16x16x32_bf16(al, bh, acc[t], 0, 0, 0);
            acc[t] = __builtin_amdgcn_mfma_f32_16x16x32_bf16(ah, bl, acc[t], 0, 0, 0);
        }
    }
    ss += __shfl_xor(ss, 16); ss += __shfl_xor(ss, 32);
}

__device__ __forceinline__ void phase_norm1(const Params& p, const Ctx& c0) { const Ctx c = fresh_ctx(c0);
    bf16_t* H = (bf16_t*)(p.ws + WS_H); float* rstd = (float*)(p.ws + WS_RSTD1); float* gz = (float*)(p.ws + WS_GZ);
    const int pair = c.wave >> 1, hk = c.wave & 1;
    LAS float* scr = (LAS float*)(c.lds + pair * 4096);
    for (int u = blockIdx.x * 4 + pair; u < T / 16; u += gridDim.x * 4) {
        f32x4 acc[1]; float ss;
        norm_skinny_half<1, (NPROJ8 > 0 ? 2 : 0)>(p.x + (size_t)u * 16 * DM, p.attn_norm_w, p.w_in + C_GZ, LDW_IN, H + (size_t)u * 16 * DM, (unsigned char*)(p.ws + WS_H8) + (size_t)u * 16 * DM, hk, c.lane, acc, ss);
        if (hk == 1) { *(LAS f32x4*)(scr + c.lane * 4) = acc[0]; if (c.lane < 16) scr[256 + c.lane] = ss; }
        __syncthreads();
        if (hk == 0) {
            const f32x4 o = *(LAS f32x4*)(scr + c.lane * 4); const float tot = ss + scr[256 + (c.lane & 15)];
            const float rs = 1.0f / sqrtf(tot * (1.0f / DM) + EPS);
            if (c.lane < 16) { rstd[u * 16 + c.lane] = rs; scr[512 + c.lane] = rs; }
            LDS_WAIT();
#pragma unroll
            for (int r = 0; r < 4; ++r) { const int row = (c.lane >> 4) * 4 + r; gz[(size_t)(u * 16 + row) * 16 + (c.lane & 15)] = (acc[0][r] + o[r]) * scr[512 + row]; }
        }
        __syncthreads();
    }
}

__device__ __forceinline__ void phase_norm2_router(const Params& p, const Ctx& c0) { const Ctx c = fresh_ctx(c0);
    bf16_t* H = (bf16_t*)(p.ws + WS_H); float* rstd = (float*)(p.ws + WS_RSTD2); const float* X1 = (const float*)(p.ws + WS_X1);
    int* topi = (int*)(p.ws + WS_TOPI); float* topg = (float*)(p.ws + WS_TOPG); int* hist = (int*)(p.ws + WS_HIST); int* row_tok = (int*)(p.ws + WS_ROWTOK);
    const int pair = c.wave >> 1, hk = c.wave & 1;
    LAS float* scr = (LAS float*)(c.lds + pair * 8192);
    LAS int* hcnt = (LAS int*)(c.lds + 65536);
    { float* row_rstd = (float*)(p.ws + WS_ROWRSTD);
      for (int i = blockIdx.x * NTHREADS + c.tid; i < PROWS; i += gridDim.x * NTHREADS) { row_tok[i] = 0; row_rstd[i] = 0.f; } }
    for (int g = blockIdx.x; g < T / 64; g += gridDim.x) {
        if (c.tid < 32) hcnt[c.tid] = 0;
        __syncthreads();
        const int u = g * 4 + pair;
        f32x4 acc[2]; float ss;
        norm_skinny_half<2, 1>(X1 + (size_t)u * 16 * DM, p.ffn_norm_w, p.router_w, NE, nullptr, (unsigned char*)H + (size_t)u * 16 * DM, hk, c.lane, acc, ss);
        if (hk == 1) { *(LAS f32x4*)(scr + c.lane * 4) = acc[0]; *(LAS f32x4*)(scr + 256 + c.lane * 4) = acc[1]; if (c.lane < 16) scr[512 + c.lane] = ss; }
        __syncthreads();
        if (hk == 0) {
            const f32x4 o0 = *(LAS f32x4*)(scr + c.lane * 4), o1 = *(LAS f32x4*)(scr + 256 + c.lane * 4); const float tot = ss + scr[512 + (c.lane & 15)];
            const float rs = 1.0f / sqrtf(tot * (1.0f / DM) + EPS);
            if (c.lane < 16) { rstd[u * 16 + c.lane] = rs; scr[528 + c.lane] = rs; }
            LDS_WAIT();
            const float b0 = p.router_b[c.lane & 15], b1 = p.router_b[16 + (c.lane & 15)];
#pragma unroll
            for (int r = 0; r < 4; ++r) { const int row = (c.lane >> 4) * 4 + r; const float rr = scr[528 + row];
                scr[1024 + row * 32 + (c.lane & 15)] = (acc[0][r] + o0[r]) * rr + b0; scr[1024 + row * 32 + 16 + (c.lane & 15)] = (acc[1][r] + o1[r]) * rr + b1; }
            LDS_WAIT();
            if (c.lane < 16) {
                float lv[32];
#pragma unroll
                for (int j = 0; j < 32; ++j) lv[j] = scr[1024 + c.lane * 32 + j];
                int bi[4]; float bv[4];
#pragma unroll
                for (int k = 0; k < 4; ++k) { float best = -__builtin_inff(); int bidx = 0;
#pragma unroll
                    for (int j = 0; j < 32; ++j) { const bool tk = lv[j] > best; best = tk ? lv[j] : best; bidx = tk ? j : bidx; }
                    bi[k] = bidx; bv[k] = best;
#pragma unroll
                    for (int j = 0; j < 32; ++j) lv[j] = (j == bidx) ? -__builtin_inff() : lv[j]; }
                const float e1 = __expf(bv[1] - bv[0]), e2 = __expf(bv[2] - bv[0]), e3 = __expf(bv[3] - bv[0]); const float inv = 1.0f / (1.0f + e1 + e2 + e3);
                const int tok = u * 16 + c.lane;
                *(int4*)(topi + (size_t)tok * 4) = make_int4(bi[0], bi[1], bi[2], bi[3]);
                *(float4*)(topg + (size_t)tok * 4) = make_float4(inv, e1 * inv, e2 * inv, e3 * inv);
#pragma unroll
                for (int k = 0; k < 4; ++k) atomicAdd((int*)&hcnt[bi[k]], 1);
            }
        }
        __syncthreads();
        if (c.tid < 32) hist[g * 32 + c.tid] = hcnt[c.tid];
        __syncthreads();
    }
}

__device__ __forceinline__ void phase_rope_kmean(const Params& p, const Ctx& c0) { const Ctx c = fresh_ctx(c0);
    bf16_t* proj = (bf16_t*)(p.ws + WS_PROJ); const float* rc = (const float*)(p.ws + WS_ROPE); const float* rsn = rc + SEQ * 64; float* kmean = (float*)(p.ws + WS_KMEAN);
    LAS float* red = (LAS float*)c.lds;
    const int cg = c.tid & 7, tk = c.tid >> 3;
    for (int u = blockIdx.x; u < NBATCH * MH * NBLK; u += gridDim.x) {
        const int b = u / (MH * NBLK), h = (u / NBLK) % MH, blk = u % NBLK;
        float s1[8], s2[8];
#pragma unroll
        for (int j = 0; j < 8; ++j) { s1[j] = 0.f; s2[j] = 0.f; }
#pragma unroll
        for (int ps = 0; ps < 4; ++ps) {
            const int pos = blk * MBLK + ps * 64 + tk; const size_t row = (size_t)(b * SEQ + pos) * NPROJ;
            const f32x4 ca = *(const f32x4*)(rc + pos * 64 + 8 * cg), cb = *(const f32x4*)(rc + pos * 64 + 8 * cg + 4), sa = *(const f32x4*)(rsn + pos * 64 + 8 * cg), sb = *(const f32x4*)(rsn + pos * 64 + 8 * cg + 4);
            const float cs[8] = {ca[0], ca[1], ca[2], ca[3], cb[0], cb[1], cb[2], cb[3]}, sn[8] = {sa[0], sa[1], sa[2], sa[3], sb[0], sb[1], sb[2], sb[3]};
#pragma unroll
            for (int qk = 0; qk < 2; ++qk) {
                bf16_t* base = proj + row + (qk ? C_MK : C_MQ) + h * HD + 8 * cg;
                const u32x4 t1 = *(const u32x4*)base, t2 = *(const u32x4*)(base + 64);
                float a[8], bb[8];
#pragma unroll
                for (int j = 0; j < 4; ++j) { a[2 * j] = bflo(t1[j]); a[2 * j + 1] = bfhi(t1[j]); bb[2 * j] = bflo(t2[j]); bb[2 * j + 1] = bfhi(t2[j]); }
                float o1[8], o2[8];
#pragma unroll
                for (int j = 0; j < 8; ++j) { o1[j] = a[j] * cs[j] - bb[j] * sn[j]; o2[j] = bb[j] * cs[j] + a[j] * sn[j]; }
                u32x4 w1, w2;
#pragma unroll
                for (int j = 0; j < 4; ++j) { w1[j] = cvt_pk_bf16(o1[2 * j], o1[2 * j + 1]); w2[j] = cvt_pk_bf16(o2[2 * j], o2[2 * j + 1]); }
                *(u32x4*)base = w1; *(u32x4*)(base + 64) = w2;
                if (qk) {
#pragma unroll
                    for (int j = 0; j < 8; ++j) { s1[j] += o1[j]; s2[j] += o2[j]; } }
            }
        }
#pragma unroll
        for (int j = 0; j < 8; ++j) {
#pragma unroll
            for (int o = 8; o < 64; o <<= 1) { s1[j] += __shfl_xor(s1[j], o); s2[j] += __shfl_xor(s2[j], o); } }
        if (c.lane < 8) {
#pragma unroll
            for (int j = 0; j < 8; ++j) { red[c.wave * 128 + 8 * cg + j] = s1[j]; red[c.wave * 128 + 64 + 8 * cg + j] = s2[j]; } }
        __syncthreads();
        if (c.tid < 128) { float s = 0.f;
#pragma unroll
            for (int w = 0; w < 8; ++w) s += red[w * 128 + c.tid];
            kmean[(size_t)u * HD + c.tid] = s * (1.0f / MBLK); }
        __syncthreads();
    }
}

__device__ __forceinline__ void phase_gla_prep(const Params& p, const Ctx& c0) { const Ctx c = fresh_ctx(c0);
    bf16_t* proj = (bf16_t*)(p.ws + WS_PROJ); const float* gz = (const float*)(p.ws + WS_GZ); float* dend = (float*)(p.ws + WS_DEND);
    LAS float* gzl = (LAS float*)c.lds;
    LAS float* seg = (LAS float*)(c.lds + 16384);
    const int ch = c.tid & 127, tq = __builtin_amdgcn_readfirstlane(c.tid >> 7);
    for (int u = blockIdx.x; u < NBATCH * GH * NBLK; u += gridDim.x) {
        const int b = u / (GH * NBLK), h = (u / NBLK) % GH, j = u % NBLK;
        const int tok0 = b * SEQ + j * MBLK;
        for (int i = c.tid; i < 256 * 4; i += NTHREADS) *(LAS f32x4*)(gzl + i * 4) = *(const f32x4*)(gz + (size_t)tok0 * 16 + i * 4);
        float w2[16];
#pragma unroll
        for (int r = 0; r < 16; ++r) w2[r] = p.gate_w2[r * 512 + h * GDK + ch];
        const float bias = p.gate_b[h * GDK + ch];
        __syncthreads();
        float run = 0.f; float Bv[64];
#pragma unroll
        for (int i = 0; i < 64; ++i) {
            const LAS float* g = gzl + (tq * 64 + i) * 16;
            const f32x4 g0 = *(const LAS f32x4*)g, g1 = *(const LAS f32x4*)(g + 4), g2 = *(const LAS f32x4*)(g + 8), g3 = *(const LAS f32x4*)(g + 12);
            float lg = bias;
            lg += g0[0] * w2[0] + g0[1] * w2[1] + g0[2] * w2[2] + g0[3] * w2[3]; lg += g1[0] * w2[4] + g1[1] * w2[5] + g1[2] * w2[6] + g1[3] * w2[7];
            lg += g2[0] * w2[8] + g2[1] * w2[9] + g2[2] * w2[10] + g2[3] * w2[11]; lg += g3[0] * w2[12] + g3[1] * w2[13] + g3[2] * w2[14] + g3[3] * w2[15];
            const float ls = fminf(lg, 0.f) - __logf(1.0f + __expf(-fabsf(lg)));
            run += ls * (1.0f / 16.0f); Bv[i] = run; }
        seg[tq * 128 + ch] = run;
        __syncthreads();
        float off = 0.f, tot = 0.f;
#pragma unroll
        for (int s = 0; s < 4; ++s) { const float v = seg[s * 128 + ch]; tot += v; off += (s < tq) ? v : 0.f; }
        if (tq == 0) dend[(size_t)u * GDK + ch] = __expf(tot);
        bf16_t* qp = proj + (size_t)(tok0 + tq * 64) * NPROJ + C_GQ + h * GDK + ch; bf16_t* kp = proj + (size_t)(tok0 + tq * 64) * NPROJ + C_GK + h * GDK + ch;
#pragma unroll
        for (int i = 0; i < 64; ++i) { const float Bt = off + Bv[i];
            const float q = bf2f(qp[(size_t)i * NPROJ]), k = bf2f(kp[(size_t)i * NPROJ]);
            const float qt = q * __expf(Bt) * 0.08838834764831845f, kt = k * __expf(-Bt);
            qp[(size_t)i * NPROJ] = (bf16_t)(cvt_pk_bf16(qt, 0.f) & 0xffffu); kp[(size_t)i * NPROJ] = (bf16_t)(cvt_pk_bf16(kt, 0.f) & 0xffffu); }
        __syncthreads();
    }
}
namespace att {
constexpr int NW = 8, QBLK = 32, KVBLK = 64, QB = 256, D = 128;
constexpr int SHM_V = KVBLK * D * 2, SHM_K = KVBLK * D * 2;
constexpr int ATT_LDS = 2 * SHM_V + 2 * SHM_K + NW * 64 * 4;
constexpr float SCALE = 0.08838834764831845f;
constexpr float THR = 8.f;
constexpr int APITCH = NPROJ, OPITCH = DM;
typedef LAS char* lptr;
typedef const LAS char* lcptr;

#define KSWZ(row, colB) ((row) * 256 + ((colB) ^ (((row) & 7) << 4)))
__device__ __forceinline__ int v_st(int k, int c) { const int kk = (k & ~0xC) | ((k & 4) << 1) | ((k & 8) >> 1); return ((kk >> 3) * 4 + (c >> 5)) * 512 + ((kk & 7) * 32 + (c & 31)) * 2; }
__device__ __forceinline__ int v_rd_base(int lane) { return ((lane & 3) << 3) | (((lane >> 2) & 3) << 6) | (((lane >> 4) & 1) << 5) | (((lane >> 5) & 1) << 8); }
constexpr int v_rd_off(int d0, int ks, int half) { return d0 * 512 + ks * 4096 + half * 2048; }
__device__ __forceinline__ int crow(int r, int hi) { return (r & 3) + 8 * (r >> 2) + 4 * hi; }
__device__ __forceinline__ bf16x8 load8(const bf16_t* p) { return *reinterpret_cast<const bf16x8*>(p); }

__device__ __forceinline__ void pack_p(const f32x16& p0, const f32x16& p1, bf16x8& pa0, bf16x8& pa1, bf16x8& pa2, bf16x8& pa3) {
#define PK4(P, B_, OUT) do { unsigned a0 = cvt_pk_bf16(P[B_+0], P[B_+1]), a1 = cvt_pk_bf16(P[B_+2], P[B_+3]);                          \
        unsigned b0 = cvt_pk_bf16(P[B_+4], P[B_+5]), b1 = cvt_pk_bf16(P[B_+6], P[B_+7]);                                             \
        auto r0 = __builtin_amdgcn_permlane32_swap(a0, b0, false, false); auto r1 = __builtin_amdgcn_permlane32_swap(a1, b1, false, false); \
        u32x4 w = {r0[0], r1[0], r0[1], r1[1]}; OUT = __builtin_bit_cast(bf16x8, w); } while (0)
    PK4(p0, 0, pa0); PK4(p0, 8, pa1); PK4(p1, 0, pa2); PK4(p1, 8, pa3);
#undef PK4
}
__device__ __forceinline__ void partialSM(f32x16& p0, f32x16& p1, float& m_reg, float& mn, float& alpha) {
    float pmax = p0[0];
#pragma unroll
    for (int r = 1; r < 16; ++r) pmax = fmaxf(pmax, p0[r]);
#pragma unroll
    for (int r = 0; r < 16; ++r) pmax = fmaxf(pmax, p1[r]);
    { auto rr = __builtin_amdgcn_permlane32_swap(__float_as_uint(pmax), __float_as_uint(pmax), false, false);
      pmax = fmaxf(__uint_as_float(rr[0]), __uint_as_float(rr[1])); }
    constexpr float C2 = 1.4426950408889634f * SCALE;
    if (__builtin_expect(__all((pmax - m_reg) * SCALE <= THR), 1)) { mn = m_reg; alpha = 1.f; }
    else { mn = fmaxf(m_reg, pmax); alpha = __builtin_amdgcn_exp2f((m_reg - mn) * C2); m_reg = mn; }
    const float mnL = -mn * C2;
#pragma unroll
    for (int r = 0; r < 16; ++r) p0[r] = fmaf(p0[r], C2, mnL);
#pragma unroll
    for (int r = 0; r < 16; ++r) p1[r] = fmaf(p1[r], C2, mnL);
#pragma unroll
    for (int r = 0; r < 16; ++r) p0[r] = __builtin_amdgcn_exp2f(p0[r]);
}
__device__ __forceinline__ void finishSM(f32x16& p0, f32x16& p1, float alpha, float& l_reg, bf16x8& pa0, bf16x8& pa1, bf16x8& pa2, bf16x8& pa3) {
#pragma unroll
    for (int r = 0; r < 16; ++r) p1[r] = __builtin_amdgcn_exp2f(p1[r]);
    float ps = 0;
#pragma unroll
    for (int r = 0; r < 16; ++r) ps += p0[r];
#pragma unroll
    for (int r = 0; r < 16; ++r) ps += p1[r];
    { auto rr = __builtin_amdgcn_permlane32_swap(__float_as_uint(ps), __float_as_uint(ps), false, false);
      ps = __uint_as_float(rr[0]) + __uint_as_float(rr[1]); }
    l_reg = l_reg * alpha + ps;
    pack_p(p0, p1, pa0, pa1, pa2, pa3);
}
template <int KB>
__device__ __forceinline__ void qkt(f32x16& p0, f32x16& p1, lcptr K_lds, int r32, int hi, const bf16x8* qr, float init = 0.f) {
#pragma unroll
    for (int r = 0; r < 16; ++r) { p0[r] = init; p1[r] = init; }
    lcptr kb[4];
#pragma unroll
    for (int dd = 0; dd < 4; ++dd) kb[dd] = K_lds + KB * SHM_K + KSWZ(r32, (dd * 16 + hi * 8) * 2);
#pragma unroll
    for (int d0 = 0; d0 < 8; ++d0) { lcptr a = kb[d0 & 3] + (d0 >> 2) * 128;
        bf16x8 b0 = *reinterpret_cast<const LAS bf16x8*>(a);
        bf16x8 b1 = *reinterpret_cast<const LAS bf16x8*>(a + 32 * 256);
        p0 = __builtin_amdgcn_mfma_f32_32x32x16_bf16(b0, qr[d0], p0, 0, 0, 0);
        p1 = __builtin_amdgcn_mfma_f32_32x32x16_bf16(b1, qr[d0], p1, 0, 0, 0); }
}
#define TRRD(dst, vb, off) asm volatile("ds_read_b64_tr_b16 %0, %1 offset:%2" : "=&v"(dst) : "v"(vb), "i"(off) : "memory")
template <int VOFF>
__device__ __forceinline__ void pv_tile(f32x16* o, int vb0, bf16x8 pa0, bf16x8 pa1, bf16x8 pa2, bf16x8 pa3) {
#define PV_D0(d0) do { s16x4 l0, l1, l2, l3, h0, h1, h2, h3; constexpr int b_ = VOFF + v_rd_off(d0, 0, 0); \
        TRRD(l0, vb0, b_); TRRD(h0, vb0, b_ + 2048); TRRD(l1, vb0, b_ + 4096); TRRD(h1, vb0, b_ + 6144); TRRD(l2, vb0, b_ + 8192); TRRD(h2, vb0, b_ + 10240); TRRD(l3, vb0, b_ + 12288); TRRD(h3, vb0, b_ + 14336); \
        asm volatile("s_waitcnt lgkmcnt(0)" ::: "memory"); SBAR(); \
        o[d0] = __builtin_amdgcn_mfma_f32_32x32x16_bf16(pa0, (bf16x8){l0[0], l0[1], l0[2], l0[3], h0[0], h0[1], h0[2], h0[3]}, o[d0], 0, 0, 0);   \
        o[d0] = __builtin_amdgcn_mfma_f32_32x32x16_bf16(pa1, (bf16x8){l1[0], l1[1], l1[2], l1[3], h1[0], h1[1], h1[2], h1[3]}, o[d0], 0, 0, 0);   \
        o[d0] = __builtin_amdgcn_mfma_f32_32x32x16_bf16(pa2, (bf16x8){l2[0], l2[1], l2[2], l2[3], h2[0], h2[1], h2[2], h2[3]}, o[d0], 0, 0, 0);   \
        o[d0] = __builtin_amdgcn_mfma_f32_32x32x16_bf16(pa3, (bf16x8){l3[0], l3[1], l3[2], l3[3], h3[0], h3[1], h3[2], h3[3]}, o[d0], 0, 0, 0); } while (0)
    PV_D0(0); PV_D0(1); PV_D0(2); PV_D0(3);
#undef PV_D0
}
template <int VOFF, int D0>
__device__ __forceinline__ void tr_frags(int vb0, bf16x8& f0, bf16x8& f1, bf16x8& f2, bf16x8& f3) {
    s16x4 l0, l1, l2, l3, h0, h1, h2, h3; constexpr int b_ = VOFF + v_rd_off(D0, 0, 0);
    TRRD(l0, vb0, b_); TRRD(h0, vb0, b_ + 2048); TRRD(l1, vb0, b_ + 4096); TRRD(h1, vb0, b_ + 6144); TRRD(l2, vb0, b_ + 8192); TRRD(h2, vb0, b_ + 10240); TRRD(l3, vb0, b_ + 12288); TRRD(h3, vb0, b_ + 14336);
    asm volatile("s_waitcnt lgkmcnt(0)" ::: "memory"); SBAR();
    f0 = (bf16x8){l0[0], l0[1], l0[2], l0[3], h0[0], h0[1], h0[2], h0[3]}; f1 = (bf16x8){l1[0], l1[1], l1[2], l1[3], h1[0], h1[1], h1[2], h1[3]};
    f2 = (bf16x8){l2[0], l2[1], l2[2], l2[3], h2[0], h2[1], h2[2], h2[3]}; f3 = (bf16x8){l3[0], l3[1], l3[2], l3[3], h3[0], h3[1], h3[2], h3[3]};
}

struct MobaRef { const bf16_t* Q; const bf16_t* K; const bf16_t* V; bf16_t* O; const unsigned* sel; int qb; };
struct MobaSeam { bf16x8 qr[8]; bf16x8 st_v0, st_v1, st_k0, st_k1; unsigned sel; };
#define AROW(p, k0, rr) ((p) + (size_t)((k0) + (rr)) * APITCH + sc)
#define VMW() asm volatile("s_waitcnt vmcnt(0)" ::: "memory")
#define VMWN(n) asm volatile("s_waitcnt vmcnt(%0)" :: "i"(n) : "memory")
#define SLOAD_H(Kp, Vp, k0) do { S.st_v0 = load8(AROW(Vp, k0, sr)); S.st_v1 = load8(AROW(Vp, k0, 32 + sr));              \
                         S.st_k0 = load8(AROW(Kp, k0, sr)); S.st_k1 = load8(AROW(Kp, k0, 32 + sr)); } while (0)
#define SWRITE_HK(bf) do { *(LAS bf16x8*)(K_lds + (bf) * SHM_K + kws) = S.st_k0; *(LAS bf16x8*)(K_lds + (bf) * SHM_K + kws + 32 * 256) = S.st_k1; } while (0)
#define SWRITE_HV(bf) do { *(LAS bf16x8*)(V_lds + (bf) * SHM_V + vst0) = S.st_v0; *(LAS bf16x8*)(V_lds + (bf) * SHM_V + vst1) = S.st_v1; } while (0)
#define SWRITE_H(bf) do { SWRITE_HV(bf); SWRITE_HK(bf); } while (0)

__device__ __forceinline__ void moba_prime(const MobaRef& cur, lptr lds, MobaSeam& S) {
    int tid = threadIdx.x; asm volatile("" : "+v"(tid)); const int wid = __builtin_amdgcn_readfirstlane(tid >> 6), lane = tid & 63, r32 = lane & 31, hi = lane >> 5;
    const int sr = tid >> 4, sc = (tid & 15) * 8, kws = KSWZ(sr, sc * 2); lptr K_lds = lds + 2 * SHM_V;
#pragma unroll
    for (int d0 = 0; d0 < 8; ++d0) S.qr[d0] = load8(cur.Q + (size_t)(wid * QBLK + r32) * APITCH + d0 * 16 + hi * 8);
    S.sel = cur.sel[wid * QBLK + r32];
    SLOAD_H(cur.K, cur.V, 0); VMW(); SWRITE_HK(0);
    __syncthreads();
}
__device__ __forceinline__ void moba_block(const MobaRef& cur, const MobaRef& nxt, lptr lds, MobaSeam& S) {
    int tid = threadIdx.x; asm volatile("" : "+v"(tid)); const int wid = __builtin_amdgcn_readfirstlane(tid >> 6), lane = tid & 63, r32 = lane & 31, hi = lane >> 5;
    const int qb = cur.qb, NT = 4 * (qb + 1);
    const int qlo = qb * QB + wid * QBLK, qm = qlo + r32 - 4 * hi;
    const unsigned sel = S.sel;
    lptr V_lds = lds; lptr K_lds = lds + 2 * SHM_V;
    LAS float* ws = (LAS float*)(lds + 2 * SHM_V + 2 * SHM_K) + wid * 64; LAS float* li_l = ws; LAS float* al_l = ws + 32;
    float m_reg = -1e30f, l_reg = 0; f32x16 o[4] = {};
    const int sr = tid >> 4, sc = (tid & 15) * 8, vst0 = v_st(sr, sc), vst1 = v_st(32 + sr, sc), kws = KSWZ(sr, sc * 2);
    const int vb0 = (int)(uintptr_t)V_lds + v_rd_base(lane);
    const bf16_t* Kh = cur.K; const bf16_t* Vh = cur.V;
    const float NEG = -__builtin_inff();
#define RESC(a) do { if (__any((a) < 1.f)) { if (hi == 0) al_l[r32] = (a); asm volatile("s_waitcnt lgkmcnt(0)" ::: "memory");              \
                     _Pragma("unroll") for (int d_ = 0; d_ < 4; ++d_) _Pragma("unroll") for (int r = 0; r < 16; ++r) o[d_][r] *= al_l[crow(r, hi)]; } } while (0)
#define KBASE(t) ((t) * KVBLK)
#define MASKT(P0_, P1_, t) do { const int kb_ = KBASE(t); const int jb_ = (t) >> 2;                                              \
        if (jb_ == qb) { if (kb_ + KVBLK - 1 > qlo) { const int dq_ = qm - kb_;                                                    \
            _Pragma("unroll") for (int r = 0; r < 16; ++r) { const int c_ = (r & 3) + 8 * (r >> 2);                                \
                if (dq_ - c_ < 0) P0_[r] = NEG; if (dq_ - c_ - 32 < 0) P1_[r] = NEG; } } }                                         \
        } while (0)
#define SELINIT(t) ((((t) >> 2) == qb || ((sel >> ((t) >> 2)) & 1u)) ? 0.f : NEG)
    constexpr int NQL = 9;
#define SEAM_K0() do { VMWN(NQL); SWRITE_HK(0); SBAR(); } while (0)
    f32x16 pA0, pA1, pB0, pB1; float mnA, mnB, alA, alB; bf16x8 pa0, pa1, pa2, pa3;
    SWRITE_HV(0); SBAR();
    SLOAD_H(Kh, Vh, KBASE(1));
    SBAR(); qkt<0>(pA0, pA1, K_lds, r32, hi, S.qr, SELINIT(0));
    MASKT(pA0, pA1, 0); partialSM(pA0, pA1, m_reg, mnA, alA);
    VMW(); SWRITE_H(1);
    __syncthreads();
#define HALF_STEP(PX0, PX1, mnX, alX, PY0, PY1, alY, t, KB, VB, SB) do {                                                      \
        SBAR(); qkt<KB>(PX0, PX1, K_lds, r32, hi, S.qr, SELINIT(t));                                                           \
        finishSM(PY0, PY1, alY, l_reg, pa0, pa1, pa2, pa3); SBAR();                                                           \
        if ((t) + 1 < NT) { SLOAD_H(Kh, Vh, KBASE((t) + 1)); SBAR(); }                                                        \
        pv_tile<VB * SHM_V>(o, vb0, pa0, pa1, pa2, pa3); MASKT(PX0, PX1, (t)); partialSM(PX0, PX1, m_reg, mnX, alX);          \
        __syncthreads();                                                                                                      \
        if ((t) + 1 < NT) { VMW(); SWRITE_H(SB); }                                                                            \
        RESC(alX); __syncthreads(); } while (0)
    for (int t = 1; t + 1 < NT; t += 2) {
        HALF_STEP(pB0, pB1, mnB, alB, pA0, pA1, alA, t, 1, 0, 0);
        HALF_STEP(pA0, pA1, mnA, alA, pB0, pB1, alB, t + 1, 0, 1, 1);
    }
    SBAR(); qkt<1>(pB0, pB1, K_lds, r32, hi, S.qr, SELINIT(NT - 1)); SBAR();
    SLOAD_H(nxt.K, nxt.V, 0); SBAR();
#pragma unroll
    for (int d0 = 0; d0 < 8; ++d0) S.qr[d0] = load8(nxt.Q + (size_t)(wid * QBLK + r32) * APITCH + d0 * 16 + hi * 8);
    S.sel = nxt.sel[wid * QBLK + r32];
    SBAR();
    finishSM(pA0, pA1, alA, l_reg, pa0, pa1, pa2, pa3); SBAR();
    pv_tile<0>(o, vb0, pa0, pa1, pa2, pa3);
    MASKT(pB0, pB1, NT - 1); partialSM(pB0, pB1, m_reg, mnB, alB); __syncthreads(); RESC(alB);
    finishSM(pB0, pB1, alB, l_reg, pa0, pa1, pa2, pa3); SBAR(); pv_tile<SHM_V>(o, vb0, pa0, pa1, pa2, pa3);
    SBAR(); SEAM_K0();
    if (hi == 0) li_l[r32] = l_reg; asm volatile("s_waitcnt lgkmcnt(0)" ::: "memory");
    float rli[16];
#pragma unroll
    for (int r = 0; r < 16; ++r) rli[r] = __builtin_amdgcn_rcpf(li_l[crow(r, hi)]);
    bf16_t* Ow = cur.O + (size_t)(wid * QBLK) * OPITCH;
#pragma unroll
    for (int r = 0; r < 16; ++r) { const int orow = crow(r, hi);
#pragma unroll
        for (int d0 = 0; d0 < 4; ++d0) { const float v = o[d0][r] * rli[r];
            const float vn = __shfl_xor(v, 1);
            if ((r32 & 1) == 0) *(unsigned*)(Ow + (size_t)orow * OPITCH + d0 * 32 + r32) = cvt_pk_bf16(v, vn); } }
    __syncthreads();
#undef RESC
#undef KBASE
#undef MASKT
#undef SELINIT
#undef SEAM_K0
#undef HALF_STEP
}

__device__ __forceinline__ MobaRef moba_ref(const Params& p, int bh, int qb) {
    const int b = bh / MH, h = bh % MH;
    const bf16_t* proj = (const bf16_t*)(p.ws + WS_PROJ); bf16_t* mixed = (bf16_t*)(p.ws + WS_MIXED); const unsigned* selp = (const unsigned*)(p.ws + WS_SEL);
    MobaRef r; const size_t tok0 = (size_t)b * SEQ;
    r.Q = proj + (tok0 + (size_t)qb * QB) * APITCH + C_MQ + h * HD; r.K = proj + tok0 * APITCH + C_MK + h * HD; r.V = proj + tok0 * APITCH + C_MV + h * HD;
    r.O = mixed + (tok0 + (size_t)qb * QB) * OPITCH + h * HD; r.sel = selp + (size_t)bh * SEQ + qb * QB; r.qb = qb; return r;
}
__device__ __forceinline__ void phase_moba(const Params& p, lptr lds) {
    const int G = gridDim.x; const int bx = blockIdx.x; const int vcu = (G % 8 == 0) ? (bx % 8) * (G / 8) + bx / 8 : bx;
    constexpr int NITEM = NBATCH * MH * 8;
    int L = vcu; if (L >= NITEM) return;
    int pass = 0;
    MobaRef cur = moba_ref(p, L >> 3, L & 7);
    MobaSeam S;
    moba_prime(cur, lds, S);
    for (;;) {
        const bool more_pass = pass == 0, more_item = L + G < NITEM, last = !more_pass && !more_item;
        int Ln = L, passn = 1;
        if (!more_pass) { passn = 0; Ln = more_item ? L + G : L; }
        const MobaRef nxt = last ? cur : moba_ref(p, Ln >> 3, passn ? 15 - (Ln & 7) : (Ln & 7));
        moba_block(cur, nxt, lds, S);
        if (last) break;
        cur = nxt; pass = passn; L = Ln;
    }
}
#undef SLOAD_H
#undef SWRITE_HK
#undef SWRITE_HV
#undef SWRITE_H
#undef VMWN
}
namespace att {
__device__ __forceinline__ void stage_vstyle(lptr dst, const bf16_t* src, size_t pitch, int tid) {
    const int sr = tid >> 4, sc = (tid & 15) * 8;
    const bf16x8 a = load8(src + (size_t)sr * pitch + sc), b = load8(src + (size_t)(32 + sr) * pitch + sc);
    *(LAS bf16x8*)(dst + v_st(sr, sc)) = a; *(LAS bf16x8*)(dst + v_st(32 + sr, sc)) = b;
}
__device__ __forceinline__ void stage_kstyle(lptr dst, const bf16_t* src, size_t pitch, int tid) {
    const int sr = tid >> 4, sc = (tid & 15) * 8;
    const bf16x8 a = load8(src + (size_t)sr * pitch + sc), b = load8(src + (size_t)(32 + sr) * pitch + sc);
    *(LAS bf16x8*)(dst + KSWZ(sr, sc * 2)) = a; *(LAS bf16x8*)(dst + KSWZ(sr, sc * 2) + 32 * 256) = b;
}

__device__ __forceinline__ void phase_moba_select(const Params& p, lptr lds, int tid_) { int tid = tid_; asm volatile("" : "+v"(tid));
    const bf16_t* proj = (const bf16_t*)(p.ws + WS_PROJ); const float* kmean = (const float*)(p.ws + WS_KMEAN); unsigned* selp = (unsigned*)(p.ws + WS_SEL);
    constexpr int QP = 272;
    lptr ql = lds; LAS float* kml = (LAS float*)(lds + 256 * QP); LAS float* gl = (LAS float*)(lds + 256 * QP + 8192);
    for (int u = blockIdx.x; u < NBATCH * MH * NBLK; u += gridDim.x) {
        const int bh = u / NBLK, qb = u % NBLK, b = bh / MH, h = bh % MH;
        if (qb == 0) { if (tid < 256) selp[(size_t)bh * SEQ + tid] = 0u; continue; }
        const bf16_t* qsrc = proj + ((size_t)b * SEQ + qb * 256) * NPROJ + C_MQ + h * HD;
        for (int i = tid; i < 256 * 16; i += NTHREADS) { const int r = i >> 4, ch = i & 15; *(LAS bf16x8*)(ql + r * QP + ch * 16) = load8(qsrc + (size_t)r * NPROJ + ch * 8); }
        for (int i = tid; i < 16 * 128 / 4; i += NTHREADS) *(LAS f32x4*)(kml + i * 4) = *(const f32x4*)(kmean + (size_t)bh * NBLK * HD + i * 4);
        __syncthreads();
        const int q = tid & 255, ng = tid >> 8;
        float g[8];
#pragma unroll
        for (int n = 0; n < 8; ++n) g[n] = 0.f;
        for (int ch = 0; ch < 16; ++ch) {
            const u32x4 qw = *(const LAS u32x4*)(ql + q * QP + ch * 16);
            const float qv[8] = {bflo(qw.x), bfhi(qw.x), bflo(qw.y), bfhi(qw.y), bflo(qw.z), bfhi(qw.z), bflo(qw.w), bfhi(qw.w)};
#pragma unroll
            for (int n = 0; n < 8; ++n) { if (ng * 8 + n < qb) {
                const f32x4 k0 = *(const LAS f32x4*)(kml + (ng * 8 + n) * 128 + ch * 8), k1 = *(const LAS f32x4*)(kml + (ng * 8 + n) * 128 + ch * 8 + 4);
                g[n] += qv[0] * k0[0] + qv[1] * k0[1] + qv[2] * k0[2] + qv[3] * k0[3] + qv[4] * k1[0] + qv[5] * k1[1] + qv[6] * k1[2] + qv[7] * k1[3]; } }
        }
#pragma unroll
        for (int n = 0; n < 8; ++n) gl[q * 16 + ng * 8 + n] = g[n];
        __syncthreads();
        if (tid < 256) {
            float gv[16];
#pragma unroll
            for (int n = 0; n < 16; ++n) gv[n] = (n < qb) ? gl[tid * 16 + n] : -__builtin_inff();
            unsigned m = 0u;
#pragma unroll
            for (int k = 0; k < 3; ++k) { float best = -__builtin_inff(); int bi = -1;
#pragma unroll
                for (int n = 0; n < 16; ++n) { const bool tk = gv[n] > best; best = tk ? gv[n] : best; bi = tk ? n : bi; }
                if (bi >= 0) m |= 1u << bi;
#pragma unroll
                for (int n = 0; n < 16; ++n) gv[n] = (n == bi) ? -__builtin_inff() : gv[n]; }
            selp[(size_t)bh * SEQ + qb * 256 + tid] = m;
        }
        __syncthreads();
    }
}

__device__ __forceinline__ void phase_gla_state(const Params& p, lptr lds, int tid_) { int tid = tid_; asm volatile("" : "+v"(tid));
    const bf16_t* proj = (const bf16_t*)(p.ws + WS_PROJ); const float* dend = (const float*)(p.ws + WS_DEND); float* U = (float*)(p.ws + WS_U);
    const int wid = __builtin_amdgcn_readfirstlane(tid >> 6), lane = tid & 63, r32 = lane & 31, hi = lane >> 5;
    const int dkb = wid & 3, half = wid >> 2;
    const int vb0 = (int)(uintptr_t)lds + v_rd_base(lane);
    for (int u = blockIdx.x; u < NBATCH * GH * NBLK; u += gridDim.x) {
        const int bh = u / NBLK, j = u % NBLK, b = bh / GH, h = bh % GH;
        const size_t tok0 = (size_t)b * SEQ + j * 256;
        f32x16 o[4] = {};
        for (int t = 0; t < 4; ++t) {
            __syncthreads();
            const bf16_t* rowp = proj + (tok0 + t * 64) * NPROJ;
            stage_vstyle(lds, rowp + C_GK + h * GDK, NPROJ, tid);
            stage_vstyle(lds + SHM_V, rowp + C_GV + h * GDV, NPROJ, tid);
            stage_vstyle(lds + 2 * SHM_V, rowp + C_GV + h * GDV + 128, NPROJ, tid);
            __syncthreads();
            bf16x8 a0, a1, a2, a3;
            if (dkb == 0) tr_frags<0, 0>(vb0, a0, a1, a2, a3); else if (dkb == 1) tr_frags<0, 1>(vb0, a0, a1, a2, a3); else if (dkb == 2) tr_frags<0, 2>(vb0, a0, a1, a2, a3); else tr_frags<0, 3>(vb0, a0, a1, a2, a3);
            if (half == 0) pv_tile<SHM_V>(o, vb0, a0, a1, a2, a3); else pv_tile<2 * SHM_V>(o, vb0, a0, a1, a2, a3);
        }
        float dv[16];
#pragma unroll
        for (int r = 0; r < 16; ++r) dv[r] = dend[(size_t)u * GDK + dkb * 32 + crow(r, hi)];
        float* Uo = U + (size_t)u * (GDK * GDV);
#pragma unroll
        for (int r = 0; r < 16; ++r) { const int k = dkb * 32 + crow(r, hi);
#pragma unroll
            for (int d0 = 0; d0 < 4; ++d0) Uo[(size_t)k * GDV + half * 128 + d0 * 32 + r32] = o[d0][r] * dv[r]; }
    }
    __syncthreads();
}

__device__ __forceinline__ void phase_gla_scan(const Params& p, int tid_) { int tid = tid_; asm volatile("" : "+v"(tid));
    const float* U = (const float*)(p.ws + WS_U); const float* dend = (const float*)(p.ws + WS_DEND); bf16_t* Sj = (bf16_t*)(p.ws + WS_SJ);
    constexpr int NEL = NBATCH * GH * GDK * GDV / 4;
    for (int i = blockIdx.x * NTHREADS + tid; i < NEL; i += gridDim.x * NTHREADS) {
        const int bh = i / (GDK * GDV / 4), e4 = i % (GDK * GDV / 4), k = e4 / (GDV / 4);
        f32x4 S = {0.f, 0.f, 0.f, 0.f};
        f32x4 uv[NBLK]; float dd[NBLK];
#pragma unroll
        for (int j = 0; j < NBLK; ++j) { uv[j] = *(const f32x4*)(U + ((size_t)(bh * NBLK + j) * (GDK * GDV)) + (size_t)e4 * 4); dd[j] = dend[(size_t)(bh * NBLK + j) * GDK + k]; }
#pragma unroll
        for (int j = 0; j < NBLK; ++j) {
            u32x2 w; w.x = cvt_pk_bf16(S[0], S[1]); w.y = cvt_pk_bf16(S[2], S[3]);
            *(u32x2*)(Sj + ((size_t)(bh * NBLK + j) * (GDK * GDV)) + (size_t)e4 * 4) = w;
            S = S * dd[j] + uv[j]; }
    }
}

__device__ __forceinline__ void phase_gla_out(const Params& p, lptr lds, int tid_) { int tid = tid_; asm volatile("" : "+v"(tid));
    const bf16_t* proj = (const bf16_t*)(p.ws + WS_PROJ); const bf16_t* Sj = (const bf16_t*)(p.ws + WS_SJ); bf16_t* mixed = (bf16_t*)(p.ws + WS_MIXED);
    const int wid = __builtin_amdgcn_readfirstlane(tid >> 6), lane = tid & 63, r32 = lane & 31, hi = lane >> 5;
    constexpr int BUF = 3 * SHM_V;
    const int vb0 = (int)(uintptr_t)lds + v_rd_base(lane), vb1 = vb0 + BUF;
    const int sr = tid >> 4, sc = (tid & 15) * 8;
    const int kws = KSWZ(sr, sc * 2), vst0 = v_st(sr, sc), vst1 = v_st(32 + sr, sc);
    for (int u = blockIdx.x; u < NBATCH * GH * NBLK; u += gridDim.x) {
        const int bh = u / NBLK, j = u % NBLK, b = bh / GH, h = bh % GH;
        const size_t tok0 = (size_t)b * SEQ + j * 256;
        bf16x8 qr[8];
#pragma unroll
        for (int d0 = 0; d0 < 8; ++d0) qr[d0] = load8(proj + (tok0 + wid * 32 + r32) * NPROJ + C_GQ + h * GDK + d0 * 16 + hi * 8);
        f32x16 o[8] = {};
        bf16x8 sk0, sk1, sa0, sa1, sb0, sb1;
        const bf16_t* sp = Sj + (size_t)u * (GDK * GDV);
#define GO_LOAD(s_) do { if ((s_) < 4) { const bf16_t* rp = proj + (tok0 + (s_) * 64) * NPROJ; \
            sk0 = load8(rp + (size_t)sr * NPROJ + C_GK + h * GDK + sc); sk1 = load8(rp + (size_t)(32 + sr) * NPROJ + C_GK + h * GDK + sc); \
            sa0 = load8(rp + (size_t)sr * NPROJ + C_GV + h * GDV + sc); sa1 = load8(rp + (size_t)(32 + sr) * NPROJ + C_GV + h * GDV + sc); \
            sb0 = load8(rp + (size_t)sr * NPROJ + C_GV + h * GDV + 128 + sc); sb1 = load8(rp + (size_t)(32 + sr) * NPROJ + C_GV + h * GDV + 128 + sc); } \
          else { const bf16_t* rp = sp + (size_t)((s_) - 4) * 64 * GDV; \
            sa0 = load8(rp + (size_t)sr * GDV + sc); sa1 = load8(rp + (size_t)(32 + sr) * GDV + sc); \
            sb0 = load8(rp + (size_t)sr * GDV + 128 + sc); sb1 = load8(rp + (size_t)(32 + sr) * GDV + 128 + sc); } } while (0)
#define GO_WRITE(s_, bufo) do { if ((s_) < 4) { *(LAS bf16x8*)(lds + (bufo) + kws) = sk0; *(LAS bf16x8*)(lds + (bufo) + kws + 32 * 256) = sk1; } \
            *(LAS bf16x8*)(lds + (bufo) + SHM_V + vst0) = sa0; *(LAS bf16x8*)(lds + (bufo) + SHM_V + vst1) = sa1; \
            *(LAS bf16x8*)(lds + (bufo) + 2 * SHM_V + vst0) = sb0; *(LAS bf16x8*)(lds + (bufo) + 2 * SHM_V + vst1) = sb1; } while (0)
#define GO_STEP(s_, B_) do { GO_LOAD(s_); __syncthreads(); GO_WRITE(s_, (B_) * BUF); __syncthreads(); \
            if ((s_) < 4) { if ((s_) * 64 <= wid * 32 + 31) { f32x16 p0, p1; qkt<0>(p0, p1, lds + (B_) * BUF, r32, hi, qr); \
                    const int dq = wid * 32 + r32 - 4 * hi - (s_) * 64; \
                    _Pragma("unroll") for (int r = 0; r < 16; ++r) { const int c_ = (r & 3) + 8 * (r >> 2); if (dq - c_ < 0) p0[r] = 0.f; if (dq - c_ - 32 < 0) p1[r] = 0.f; } \
                    bf16x8 pa0, pa1, pa2, pa3; pack_p(p0, p1, pa0, pa1, pa2, pa3); \
                    pv_tile<SHM_V>(o, (B_) ? vb1 : vb0, pa0, pa1, pa2, pa3); pv_tile<2 * SHM_V>(o + 4, (B_) ? vb1 : vb0, pa0, pa1, pa2, pa3); } } \
            else { pv_tile<SHM_V>(o, (B_) ? vb1 : vb0, qr[4 * ((s_) - 4)], qr[4 * ((s_) - 4) + 1], qr[4 * ((s_) - 4) + 2], qr[4 * ((s_) - 4) + 3]); \
                   pv_tile<2 * SHM_V>(o + 4, (B_) ? vb1 : vb0, qr[4 * ((s_) - 4)], qr[4 * ((s_) - 4) + 1], qr[4 * ((s_) - 4) + 2], qr[4 * ((s_) - 4) + 3]); } } while (0)
        GO_STEP(0, 0); GO_STEP(1, 0); GO_STEP(2, 0); GO_STEP(3, 0); GO_STEP(4, 0); GO_STEP(5, 0);
#undef GO_LOAD
#undef GO_WRITE
#undef GO_STEP
        int hi_e = hi, r32_e = r32; asm volatile("" : "+v"(hi_e), "+v"(r32_e));
        float wv[8];
#pragma unroll
        for (int d0 = 0; d0 < 8; ++d0) wv[d0] = p.gla_norm_w[d0 * 32 + r32_e];
        const bf16_t* ggp = proj + (tok0 + wid * 32) * NPROJ + C_GG + h * GDV + r32_e;
        bf16_t* op = mixed + (tok0 + wid * 32) * DM + 1024 + h * GDV + r32_e;
#pragma unroll
        for (int r = 0; r < 16; ++r) { const int orow = crow(r, hi_e);
            float g[8];
#pragma unroll
            for (int d0 = 0; d0 < 8; ++d0) g[d0] = bf2f(ggp[(size_t)orow * NPROJ + d0 * 32]);
            float ss = 0.f;
#pragma unroll
            for (int d0 = 0; d0 < 8; ++d0) ss += o[d0][r] * o[d0][r];
            ss += __shfl_xor(ss, 1); ss += __shfl_xor(ss, 2); ss += __shfl_xor(ss, 4); ss += __shfl_xor(ss, 8); ss += __shfl_xor(ss, 16);
            const float rsr = 1.0f / sqrtf(ss * (1.0f / GDV) + EPS);
#pragma unroll
            for (int d0 = 0; d0 < 8; ++d0) { const float sg = g[d0] * __builtin_amdgcn_rcpf(1.0f + __expf(-g[d0]));
                const float v = o[d0][r] * rsr * wv[d0] * sg; const float vn = __shfl_xor(v, 1);
                if ((r32_e & 1) == 0) *(unsigned*)(op + (size_t)orow * DM + d0 * 32) = cvt_pk_bf16(v, vn); }
            asm volatile("" ::: "memory"); }
    }
    __syncthreads();
}
}

__device__ __forceinline__ void phase_route(const Params& p, const Ctx& c0) { const Ctx c = fresh_ctx(c0);
    const int* hist = (const int*)(p.ws + WS_HIST); const int* topi = (const int*)(p.ws + WS_TOPI); const float* rstd2 = (const float*)(p.ws + WS_RSTD2);
    int* dest = (int*)(p.ws + WS_DEST); int* row_tok = (int*)(p.ws + WS_ROWTOK); float* row_rstd = (float*)(p.ws + WS_ROWRSTD); int* blk = (int*)(p.ws + WS_BLKE);
    LAS int* cnt = (LAS int*)c.lds; LAS int* before = cnt + 32; LAS int* pstart = cnt + 64; LAS int* ea = cnt + 128;
    for (int g = blockIdx.x; g < T / 64; g += gridDim.x) {
        if (c.tid < 64) cnt[c.tid] = 0;
        __syncthreads();
        { const int e = c.tid & 31, part = c.tid >> 5; int tot = 0, bef = 0;
#pragma unroll
            for (int i = 0; i < 16; ++i) { const int gg = part * 16 + i; const int v = hist[gg * 32 + e]; tot += v; bef += (gg < g) ? v : 0; }
            atomicAdd((int*)&cnt[e], tot); atomicAdd((int*)&before[e], bef); }
        __syncthreads();
        if (c.tid == 0) { int acc = 0; for (int e = 0; e < NE; ++e) { pstart[e] = acc; acc += ((cnt[e] + 255) >> 8) << 8; } pstart[NE] = acc; }
        if (c.tid < 256) ea[c.tid] = topi[(size_t)g * 256 + c.tid];
        __syncthreads();
        if (c.tid < 256) {
            const int e = ea[c.tid]; int rank = 0;
            for (int a = 0; a < c.tid; ++a) rank += (ea[a] == e) ? 1 : 0;
            const int d = pstart[e] + before[e] + rank; const int tok = g * 64 + (c.tid >> 2);
            dest[(size_t)g * 256 + c.tid] = d; row_tok[d] = tok; row_rstd[d] = rstd2[tok];
        }
        if (g == 0 && c.tid < 64) {
            const int nb = pstart[NE] >> 8; if (c.tid == 0) blk[0] = nb;
            for (int bq = c.tid; bq < nb; bq += 64) { int e = 0; for (int q = 0; q < NE; ++q) e += (pstart[q + 1] <= bq * 256) ? 1 : 0; blk[64 + bq] = e < NE ? e : NE - 1; }
        }
        __syncthreads();
    }
}

__device__ __forceinline__ void phase_combine(const Params& p, const Ctx& c0, unsigned poison) { const Ctx c = fresh_ctx(c0);
    const float* X1 = (const float*)(p.ws + WS_X1); const unsigned char* Y = (const unsigned char*)(p.ws + WS_Y); const int* dest = (const int*)(p.ws + WS_DEST); const float* topg = (const float*)(p.ws + WS_TOPG);
    for (int t = blockIdx.x * NWAVES + c.wave; t < T; t += gridDim.x * NWAVES) {
        const int4 d4 = *(const int4*)(dest + (size_t)t * 4); const float4 g4 = *(const float4*)(topg + (size_t)t * 4);
        const int dd[4] = {d4.x, d4.y, d4.z, d4.w}; const float gg[4] = {g4.x * (1.0f / Y_SCALE), g4.y * (1.0f / Y_SCALE), g4.z * (1.0f / Y_SCALE), g4.w * (1.0f / Y_SCALE)};
        f32x4 v[8]; u32x2 yw[4][4]; float ss = 0.f;
#pragma unroll
        for (int j = 0; j < 4; ++j) { v[2 * j] = *(const f32x4*)(X1 + (size_t)t * DM + j * 512 + c.lane * 8); v[2 * j + 1] = *(const f32x4*)(X1 + (size_t)t * DM + j * 512 + c.lane * 8 + 4); }
#pragma unroll
        for (int k = 0; k < 4; ++k)
#pragma unroll
            for (int j = 0; j < 4; ++j) yw[k][j] = *(const u32x2*)(Y + (size_t)dd[k] * DM + j * 512 + c.lane * 8);
#pragma unroll
        for (int k = 0; k < 4; ++k)
#pragma unroll
            for (int j = 0; j < 4; ++j) { const f32x2 a = __builtin_amdgcn_cvt_pk_f32_fp8(yw[k][j].x, false), b = __builtin_amdgcn_cvt_pk_f32_fp8(yw[k][j].x, true);
                const f32x2 cc = __builtin_amdgcn_cvt_pk_f32_fp8(yw[k][j].y, false), d = __builtin_amdgcn_cvt_pk_f32_fp8(yw[k][j].y, true);
                v[2 * j][0] += gg[k] * a[0]; v[2 * j][1] += gg[k] * a[1]; v[2 * j][2] += gg[k] * b[0]; v[2 * j][3] += gg[k] * b[1];
                v[2 * j + 1][0] += gg[k] * cc[0]; v[2 * j + 1][1] += gg[k] * cc[1]; v[2 * j + 1][2] += gg[k] * d[0]; v[2 * j + 1][3] += gg[k] * d[1]; }
#pragma unroll
        for (int j = 0; j < 8; ++j) ss += (v[j][0] * v[j][0] + v[j][1] * v[j][1]) + (v[j][2] * v[j][2] + v[j][3] * v[j][3]);
        const float rs = 1.0f / sqrtf(wave_sum(ss) * (1.0f / DM) + EPS);
#pragma unroll
        for (int j = 0; j < 8; ++j) { const int col = (j >> 1) * 512 + c.lane * 8 + (j & 1) * 4; const f32x4 w = *(const f32x4*)(p.final_norm_w + col);
            f32x4 ov = v[j] * rs * w; if (poison) ov = (f32x4){__builtin_nanf(""), __builtin_nanf(""), __builtin_nanf(""), __builtin_nanf("")};
            *(f32x4*)(p.out + (size_t)t * DM + col) = ov; }
    }
}
__device__ __forceinline__ Ctx make_ctx(unsigned char* lds_generic) {
    Ctx c; c.lds = (LAS unsigned char*)lds_generic; c.tid = threadIdx.x; c.lane = c.tid & 63; c.wave = __builtin_amdgcn_readfirstlane(c.tid >> 6); return c;
}
__device__ __forceinline__ void phase_gemm_inproj16(const Params& p, const Ctx& c, int i0, int i1, int G, int cidx) {
    if (i0 >= i1) return;
    g8::DenseProbIn P{(const bf16_t*)(p.ws + WS_H), (const bf16_t*)(p.ws + WS_WIN) + (size_t)NPROJ8 * DM, T / 256, (NPROJ - NPROJ8) / 256, DM, G, cidx, i0, i1};
    g8::EpiProj E{(bf16_t*)(p.ws + WS_PROJ), (const float*)(p.ws + WS_RSTD1), 1.0f, NPROJ8};
    g8::gemm_phase(c.lds, P, E);
}
__device__ __forceinline__ void phase_gemm_outproj(const Params& p, const Ctx& c, int i0, int i1) {
    if (i0 >= i1) return;
    g8::DenseProbOut P{(const bf16_t*)(p.ws + WS_MIXED), (const bf16_t*)(p.ws + WS_WOUT), T / 256, DM / 256, DM, (int)gridDim.x, (int)blockIdx.x, i0, i1};
    g8::EpiX1 E{p.x, (float*)(p.ws + WS_X1)};
    g8::gemm_phase(c.lds, P, E);
}
__device__ __forceinline__ void phase_gemm_moe1(const Params& p, const Ctx& c, int i0, int i1) {
    g8::MoeProb1 P{(const bf16_t*)(p.ws + WS_H), (const bf16_t*)(p.ws + WS_WGU), (const int*)(p.ws + WS_ROWTOK), (const int*)(p.ws + WS_BLKE), DM / 2, __builtin_amdgcn_readfirstlane(*(const int*)(p.ws + WS_BLKE)), i0, i1};
    g8::EpiSwiglu E{(unsigned char*)(p.ws + WS_ACT), (const float*)(p.ws + WS_ROWRSTD), p.b_gu};
    g8::gemm_phase(c.lds, P, E);
}
__device__ __forceinline__ void phase_gemm_moe2(const Params& p, const Ctx& c) {
    g8::MoeProb2 P{(const bf16_t*)(p.ws + WS_ACT), (const bf16_t*)(p.ws + WS_WD), (const int*)(p.ws + WS_BLKE), FF / 2, __builtin_amdgcn_readfirstlane(*(const int*)(p.ws + WS_BLKE))};
    g8::EpiDown E{(unsigned char*)(p.ws + WS_Y), p.b_d};
    g8::gemm_phase(c.lds, P, E);
}


#ifndef MX_SELFTEST
#define MX_SELFTEST 0
#endif
__device__ __forceinline__ void mx_selftest(unsigned* flag) {
    const int l = threadIdx.x & 63, fr = l & 15, fq = l >> 4;
    unsigned aw[8], bw[8];
#pragma unroll
    for (int d = 0; d < 8; ++d) { float av[4], bv[4];
#pragma unroll
        for (int q = 0; q < 4; ++q) { const int e = 4 * d + q; const int k = e < 16 ? 16 * fq + e : 64 + 16 * fq + (e - 16);
            av[q] = (float)(((fr * 7 + k * 3) % 5) - 2); bv[q] = (float)(((fr * 5 + k) % 7) - 3); }
        aw[d] = cvt4_fp8(av[0], av[1], av[2], av[3]); bw[d] = cvt4_fp8(bv[0], bv[1], bv[2], bv[3]); }
    const i32x8 A = {(int)aw[0], (int)aw[1], (int)aw[2], (int)aw[3], (int)aw[4], (int)aw[5], (int)aw[6], (int)aw[7]};
    const i32x8 B = {(int)bw[0], (int)bw[1], (int)bw[2], (int)bw[3], (int)bw[4], (int)bw[5], (int)bw[6], (int)bw[7]};
    f32x4 acc = {0.f, 0.f, 0.f, 0.f};
    acc = __builtin_amdgcn_mfma_scale_f32_16x16x128_f8f6f4(B, A, acc, 0, 0, 0, 0x7f7f7f7f, 0, 0x7f7f7f7f);
    bool bad = false;
#pragma unroll
    for (int r = 0; r < 4; ++r) { const int m = fr, n = 4 * fq + r; int sum = 0;
        for (int k = 0; k < 128; ++k) sum += (((m * 7 + k * 3) % 5) - 2) * (((n * 5 + k) % 7) - 3);
        bad |= (acc[r] != (float)sum); }
    if (bad) atomicOr(flag, 1u);
}
constexpr int CW_BAR = 4096;
__global__ void __launch_bounds__(NTHREADS, 2) fwd(Params p) {
    extern __shared__ __attribute__((aligned(16))) unsigned char lds_raw[];
    const Ctx c = make_ctx(lds_raw);
    if (c.tid < 64) ((LAS unsigned*)(c.lds + LDS_MISC))[c.tid] = 0u;
    __syncthreads();
    const XcdBarrier bar = xcd_barrier_post((unsigned*)(p.ws + WS_CTL) + CW_BAR, (volatile LAS unsigned*)(c.lds + LDS_MISC + 32));
    const att::lptr al = (att::lptr)c.lds;
    if (MX_SELFTEST && blockIdx.x == 0 && c.wave == 0) mx_selftest((unsigned*)(p.ws + WS_CTL) + 8);
#ifndef PROBE_DUP
#define PROBE_DUP 0
#endif
    phase_convert(p, c); phase_norm1(p, c); if (PROBE_DUP & 64) { __syncthreads(); phase_norm1(p, c); }
    xcd_barrier(bar);
    for (int rep = 0; rep < ((PROBE_DUP & 1) ? 2 : 1); ++rep) {
        const int bx = blockIdx.x, G = gridDim.x;
        const int cut = (G == 256) ? (bx >> 3) % 7 : 0;
        if (cut > 0) phase_gemm_inproj16(p, c, 0, cut, G, bx);
        phase_convert_share(p, c, 0, CT_GU, G, bx);
        phase_gemm_inproj16(p, c, cut, 1 << 20, G, bx);
    }
    xcd_barrier(bar);
    phase_rope_kmean(p, c); phase_gla_prep(p, c);
    xcd_barrier(bar);
    att::phase_gla_state(p, al, c.tid); att::phase_moba_select(p, al, c.tid); if (PROBE_DUP & 128) { __syncthreads(); att::phase_gla_state(p, al, c.tid); att::phase_moba_select(p, al, c.tid); }
    xcd_barrier(bar);
    att::phase_gla_scan(p, c.tid); if (PROBE_DUP & 128) { __syncthreads(); att::phase_gla_scan(p, c.tid); }
    xcd_barrier(bar);
    att::phase_gla_out(p, al, c.tid); att::phase_moba(p, al); if (PROBE_DUP & 4) { __syncthreads(); att::phase_gla_out(p, al, c.tid); att::phase_moba(p, al); }
    xcd_barrier(bar);
    phase_gemm_outproj(p, c, 0, 1 << 20); if (PROBE_DUP & 8) { __syncthreads(); phase_gemm_outproj(p, c, 0, 1 << 20); }
    xcd_barrier(bar);
    phase_norm2_router(p, c); if (PROBE_DUP & 64) { __syncthreads(); phase_norm2_router(p, c); }
    xcd_barrier(bar);
    phase_route(p, c); if (PROBE_DUP & 128) { __syncthreads(); phase_route(p, c); }
    xcd_barrier(bar);
    for (int rep = 0; rep < ((PROBE_DUP & 16) ? 2 : 1); ++rep) {
        const int cut = 2 * ((blockIdx.x >> 3) & 7);
        if (cut > 0) phase_gemm_moe1(p, c, 0, cut);
        phase_convert_share(p, c, CT_GU, CT_TOTAL, (int)gridDim.x, (int)blockIdx.x);
        phase_gemm_moe1(p, c, cut, 1 << 20);
    }
    xcd_barrier(bar);
    phase_gemm_moe2(p, c); if (PROBE_DUP & 32) { __syncthreads(); phase_gemm_moe2(p, c); }
    xcd_barrier(bar);
    if (PROBE_DUP & 64) { phase_combine(p, c, 0u); __syncthreads(); }
    phase_combine(p, c, MX_SELFTEST ? *((volatile unsigned*)(p.ws + WS_CTL) + 8) : 0u);
}

extern "C" void kernel_launch(void* const* d_in, const int* in_sizes, int n_in, void* d_out, int out_size, void* d_ws, size_t ws_size, hipStream_t stream) {
    static int grid = 0;
    if (grid == 0) {
        if (n_in != 15 || ws_size < WS_END) { fprintf(stderr, "kernel_launch: unexpected inputs (n_in %d, ws %zu)\n", n_in, ws_size); grid = -1; return; }
        int dev = 0, cus = 0, per_cu = 0;
        if (hipGetDevice(&dev) != hipSuccess || hipDeviceGetAttribute(&cus, hipDeviceAttributeMultiprocessorCount, dev) != hipSuccess) { grid = -1; return; }
        if (hipFuncSetAttribute((const void*)fwd, hipFuncAttributeMaxDynamicSharedMemorySize, LDS_BYTES) != hipSuccess) { fprintf(stderr, "kernel_launch: hipFuncSetAttribute failed\n"); grid = -1; return; }
        if (hipOccupancyMaxActiveBlocksPerMultiprocessor(&per_cu, (const void*)fwd, NTHREADS, LDS_BYTES) != hipSuccess || per_cu < 1) { fprintf(stderr, "kernel_launch: occupancy query says %d blocks per CU\n", per_cu); }
        (void)hipGetLastError();
        grid = cus > 0 ? cus : 256;
    }
    if (grid < 0) return;
    Params p{};
    p.x = (const float*)d_in[0]; p.attn_norm_w = (const float*)d_in[1]; p.w_in = (const float*)d_in[2]; p.gate_w2 = (const float*)d_in[3]; p.gate_b = (const float*)d_in[4];
    p.gla_norm_w = (const float*)d_in[5]; p.w_out = (const float*)d_in[6]; p.ffn_norm_w = (const float*)d_in[7]; p.router_w = (const float*)d_in[8]; p.router_b = (const float*)d_in[9];
    p.w_gu = (const float*)d_in[10]; p.b_gu = (const float*)d_in[11]; p.w_d = (const float*)d_in[12]; p.b_d = (const float*)d_in[13]; p.final_norm_w = (const float*)d_in[14];
    p.out = (float*)d_out; p.ws = (unsigned char*)d_ws;
    if (hipMemsetAsync((char*)d_ws + WS_CTL, 0, CTL_BYTES, stream) != hipSuccess) return;
    hipLaunchKernelGGL(fwd, dim3(grid), dim3(NTHREADS), LDS_BYTES, stream, p);
}
```

```cpp
#include <hip/hip_runtime.h>
#include <stdint.h>
#include <stdio.h>

#define LAS __attribute__((address_space(3)))
typedef unsigned short bf16_t;
typedef short bf16x8 __attribute__((ext_vector_type(8)));
typedef short s16x4 __attribute__((ext_vector_type(4)));
typedef float f32x2 __attribute__((ext_vector_type(2)));
typedef float f32x4 __attribute__((ext_vector_type(4)));
typedef float f32x16 __attribute__((ext_vector_type(16)));
typedef unsigned u32x2 __attribute__((ext_vector_type(2)));
typedef unsigned u32x4 __attribute__((ext_vector_type(4)));
typedef int i32x8 __attribute__((ext_vector_type(8)));

constexpr int NBATCH = 4, SEQ = 4096, T = NBATCH * SEQ, DM = 2048;
constexpr int HD = 128, MH = 8, MBLK = 256, NBLK = SEQ / MBLK;
constexpr int GH = 4, GDK = 128, GDV = 256;
constexpr int LDW_IN = 6160, NPROJ = 6144;
constexpr int C_MQ = 0, C_MK = 1024, C_MV = 2048, C_GQ = 3072, C_GK = 3584, C_GV = 4096, C_GG = 5120, C_GZ = 6144;
constexpr int NE = 32, TOPK = 4, FF = 2048, NASSIGN = T * TOPK;
constexpr int MAXBLK = (NASSIGN + NE * 255) / 256, PROWS = MAXBLK * 256;
constexpr float EPS = 1e-5f;
constexpr float ACT_SCALE = 4.0f, W_SCALE = 64.0f, F8_UNSCALE = 1.0f / (ACT_SCALE * W_SCALE);
constexpr float Y_SCALE = 16.0f;

constexpr size_t MiB = (size_t)1 << 20;
constexpr size_t WS_CTL = 0, CTL_BYTES = 64 * 1024;
constexpr size_t WS_WIN = 16 * MiB;
constexpr size_t WS_WOUT = 40 * MiB;
constexpr size_t WS_ROPE = 48 * MiB;
constexpr size_t WS_RSTD1 = 50 * MiB;
constexpr size_t WS_GZ = 51 * MiB;
constexpr size_t WS_KMEAN = 52 * MiB;
constexpr size_t WS_DEND = 52 * MiB + 512 * 1024;
constexpr size_t WS_RSTD2 = 53 * MiB;
constexpr size_t WS_SEL = 54 * MiB;
constexpr size_t WS_TOPI = 55 * MiB;
constexpr size_t WS_TOPG = 55 * MiB + 512 * 1024;
constexpr size_t WS_HIST = 56 * MiB;
constexpr size_t WS_DEST = 56 * MiB + 512 * 1024;
constexpr size_t WS_ROWTOK = 57 * MiB;
constexpr size_t WS_ROWRSTD = 57 * MiB + 512 * 1024;
constexpr size_t WS_BLKE = 58 * MiB;
constexpr size_t WS_H = 64 * MiB;
constexpr size_t WS_PROJ = 128 * MiB;
constexpr size_t WS_MIXED = 320 * MiB;
constexpr size_t WS_X1 = 384 * MiB;
constexpr size_t WS_U = 512 * MiB;
constexpr size_t WS_SJ = 544 * MiB;
constexpr size_t WS_WGU = 640 * MiB;
constexpr size_t WS_WD = 1152 * MiB;
constexpr size_t WS_ACT = 1408 * MiB;
constexpr size_t WS_Y = 1696 * MiB;
constexpr size_t WS_END = 1984 * MiB;

constexpr int NTHREADS = 512, NWAVES = 8;
constexpr int LDS_BYTES = 149504;
constexpr int LDS_MISC = LDS_BYTES - 256;

struct Params {
    const float* x; const float* attn_norm_w; const float* w_in; const float* gate_w2; const float* gate_b; const float* gla_norm_w;
    const float* w_out; const float* ffn_norm_w; const float* router_w; const float* router_b; const float* w_gu; const float* b_gu;
    const float* w_d; const float* b_d; const float* final_norm_w;
    float* out; unsigned char* ws;
};

__device__ __forceinline__ unsigned cvt_pk_bf16(float lo, float hi) { unsigned r; asm volatile("v_cvt_pk_bf16_f32 %0, %1, %2" : "=v"(r) : "v"(lo), "v"(hi)); return r; }
__device__ __forceinline__ unsigned cvt4_fp8(float a, float b, float c, float d) { unsigned w = 0u; w = __builtin_amdgcn_cvt_pk_fp8_f32(a, b, w, false); w = __builtin_amdgcn_cvt_pk_fp8_f32(c, d, w, true); return w; }
__device__ __forceinline__ float bf2f(unsigned short b) { return __uint_as_float(((unsigned)b) << 16); }
__device__ __forceinline__ float bflo(unsigned w) { return __uint_as_float(w << 16); }
__device__ __forceinline__ float bfhi(unsigned w) { return __uint_as_float(w & 0xffff0000u); }
__device__ __forceinline__ bf16x8 pack8(f32x4 a, f32x4 b) {
    u32x4 w = {cvt_pk_bf16(a[0], a[1]), cvt_pk_bf16(a[2], a[3]), cvt_pk_bf16(b[0], b[1]), cvt_pk_bf16(b[2], b[3])};
    return __builtin_bit_cast(bf16x8, w);
}
__device__ __forceinline__ float wave_sum(float v) {
#pragma unroll
    for (int o = 1; o < 64; o <<= 1) v += __shfl_xor(v, o);
    return v;
}
#define LDS_WAIT() asm volatile("s_waitcnt lgkmcnt(0)" ::: "memory")
#define VM_WAIT() asm volatile("s_waitcnt vmcnt(0)" ::: "memory")
#define SBAR() __builtin_amdgcn_sched_barrier(0)
#define XB_TMO      128
#define XB_XCNT(j)  (256  + 64 * (j))
#define XB_XSUB(j)  (1280 + 64 * (j))
#define XB_XGEN(j)  (2304 + 64 * (j))
#define XB_TOP      3328
#define XB_TOPGEN   3392
#define XCD_BAR_WORDS 3456
#define XB_SPIN_CAP (1u << 18)

__device__ __forceinline__ unsigned xb_ld(unsigned* p)              { return __hip_atomic_load(p, __ATOMIC_RELAXED, __HIP_MEMORY_SCOPE_AGENT); }
__device__ __forceinline__ unsigned xb_add(unsigned* p, unsigned v) { return __hip_atomic_fetch_add(p, v, __ATOMIC_RELAXED, __HIP_MEMORY_SCOPE_AGENT); }
__device__ __forceinline__ unsigned xb_xcc_id() { return (unsigned)__builtin_amdgcn_s_getreg((3 << 11) | 20) & 0xFu; }
#define XB_SPIN(cond, bar) do { unsigned _sp = 0; while (cond) { __builtin_amdgcn_s_sleep(1); \
    if ((++_sp & 255u) == 0u) { if (xb_ld(&(bar)[XB_TMO])) break; if (_sp > XB_SPIN_CAP) { atomicAdd(&(bar)[XB_TMO], 1u); break; } } } } while (0)

struct XcdBarrier {
    unsigned* bar; unsigned x;
    volatile LAS unsigned* st;
};

__device__ __forceinline__ XcdBarrier xcd_barrier_post(unsigned* bar, volatile LAS unsigned* st) {
    XcdBarrier b; b.bar = bar; b.x = xb_xcc_id(); b.st = st;
    if (threadIdx.x == 0) (void)xb_add(&bar[XB_XCNT(b.x)], 1u);
    return b;
}
__device__ __forceinline__ void xcd_barrier_complete(unsigned* bar, unsigned x, unsigned& nloc, unsigned& nx) {
    const unsigned G = gridDim.x * gridDim.y * gridDim.z;
    unsigned sum, cnt, mine, sp = 0u;
    for (;;) {
        sum = 0u; cnt = 0u; mine = 0u;
#pragma unroll
        for (unsigned j = 0; j < 16; ++j) { const unsigned c = xb_ld(&bar[XB_XCNT(j)]); sum += c; cnt += (c > 0u) ? 1u : 0u; mine = (j == x) ? c : mine; }
        if (sum == G) break;
        __builtin_amdgcn_s_sleep(1);
        if ((++sp & 255u) == 0u) { if (xb_ld(&bar[XB_TMO])) break; if (sp > XB_SPIN_CAP) { atomicAdd(&bar[XB_TMO], 1u); break; } }
    }
    nloc = mine > 0u ? mine : 1u; nx = cnt > 0u ? cnt : 1u;
}

__device__ __forceinline__ void xcd_barrier(const XcdBarrier& b) {
    asm volatile("s_waitcnt vmcnt(0)" ::: "memory");
    __syncthreads();
    if (threadIdx.x == 0) {
        unsigned* bar = b.bar;
        __builtin_amdgcn_s_waitcnt(0);
        unsigned nloc = b.st[0], nx = b.st[1];
        if (nloc == 0u) { xcd_barrier_complete(bar, b.x, nloc, nx); b.st[0] = nloc; b.st[1] = nx; }
        const unsigned old = xb_add(&bar[XB_XSUB(b.x)], 1u);
        const unsigned gen = old / nloc;
        if (old + 1u == (gen + 1u) * nloc) {
            __builtin_amdgcn_fence(__ATOMIC_RELEASE, "agent");
            asm volatile("s_waitcnt vmcnt(0)" ::: "memory");
            const unsigned og = xb_add(&bar[XB_TOP], 1u);
            const unsigned tg = og / nx;
            if (og + 1u == (tg + 1u) * nx) xb_add(&bar[XB_TOPGEN], 1u);
            else XB_SPIN(xb_ld(&bar[XB_TOPGEN]) == tg, bar);
            __builtin_amdgcn_fence(__ATOMIC_ACQUIRE, "agent");
            xb_add(&bar[XB_XGEN(b.x)], 1u);
            asm volatile("s_waitcnt vmcnt(0)" ::: "memory");
        } else {
            XB_SPIN(xb_ld(&bar[XB_XGEN(b.x)]) == gen, bar);
            __builtin_amdgcn_fence(__ATOMIC_ACQUIRE, "agent");
            asm volatile("s_waitcnt vmcnt(0)" ::: "memory");
        }
    }
    __syncthreads();
}

namespace g8 {
constexpr int BM = 256, BK = 64, HALF = 128, HTB = HALF * BK * 2, STAGE_BYTES = 8 * HTB, NXCD = 8, WGM = 8;
__host__ __device__ __forceinline__ int lds_byte(int r, int c) { const int st = (r >> 4) * 2 + (c >> 5), rr = r & 15, cc = c & 31, ob = rr * 64 + cc * 2; return st * 1024 + (ob ^ (((ob >> 9) & 1) << 5)); }
__host__ __device__ __forceinline__ void stage_rc(int b, int& R, int& C) { const int st = b / 1024, sb = b % 1024, swz = sb ^ (((sb >> 9) & 1) << 5); R = (st >> 1) * 16 + swz / 64; C = (st & 1) * 32 + (swz % 64) / 2; }
__host__ __device__ __forceinline__ int perm32(int rho) { const int n = rho >> 4, i = rho & 15; return 8 * (i >> 2) + 4 * n + (i & 3); }

struct Unit { int pm, pn, e; };

template <int WGM_>
__device__ __forceinline__ bool static_next(int i, int nM, int nN, int G, int c, Unit& u) {
    const int nwg = nM * nN; const long L = (long)i * G + c; if (L >= nwg) return false;
    int wgid = (int)L; { const int q = nwg / NXCD, r = nwg % NXCD, xcd = wgid % NXCD, off = wgid / NXCD; wgid = (xcd < r ? xcd * (q + 1) : r * (q + 1) + (xcd - r) * q) + off; }
    const int nig = WGM_ * nN, gid = wgid / nig, fm = gid * WGM_, gsz = (nM - fm) < WGM_ ? (nM - fm) : WGM_;
    u.pm = fm + ((wgid % nig) % gsz); u.pn = (wgid % nig) / gsz; u.e = 0; return true;
}

template <class Prob, class Epi>
__device__ __forceinline__ void gemm_phase(LAS unsigned char* lds, const Prob& P, const Epi& E) {
    int tid = threadIdx.x; asm volatile("" : "+v"(tid));
    const int wid = __builtin_amdgcn_readfirstlane(tid >> 6), lane = tid & 63, wr = wid >> 2, wc = wid & 3, fr = lane & 15, fq = lane >> 4;
    const int K = P.K, nt = K / BK;
    int RA[2], CA[2]; unsigned voffB[2];
#pragma unroll
    for (int i = 0; i < 2; ++i) { int R, C; stage_rc(tid * 16 + i * 8192, R, C); const int Rb = Epi::PERM ? ((R & ~31) + perm32(R & 31)) : R;
        RA[i] = R; CA[i] = C; voffB[i] = (unsigned)(Rb * K + C) * 2u; }
    const size_t kstep = (size_t)(BK * 2);
    const size_t hstep = (size_t)HALF * K * 2;
    const unsigned ldsw = (unsigned)wid * 1024u;
    const int aoff = lds_byte(wr * 64 + fr, fq * 8), boff = lds_byte(wc * 32 + fr, fq * 8);
#define G8_SA(b, h) (((b) * 2 + (h)) * HTB)
#define G8_SB(b, h) ((4 + (b) * 2 + (h)) * HTB)
#define G8_STAGE_B(bufoff, gbase) do { _Pragma("unroll") for (int _i = 0; _i < 2; ++_i) \
        __builtin_amdgcn_global_load_lds((const unsigned*)((const char*)(gbase) + voffB[_i]), (LAS unsigned*)(lds + (bufoff) + ldsw + _i * 8192), 16, 0, 0); } while (0)
#define G8_STAGE_A(bufoff, o0, o1) do { \
        __builtin_amdgcn_global_load_lds((const unsigned*)(Ab + (o0)), (LAS unsigned*)(lds + (bufoff) + ldsw), 16, 0, 0); \
        __builtin_amdgcn_global_load_lds((const unsigned*)(Ab + (o1)), (LAS unsigned*)(lds + (bufoff) + ldsw + 8192), 16, 0, 0); } while (0)
#define G8_CAT(lo, hi) __builtin_bit_cast(i32x8, __builtin_shufflevector(lo, hi, 0, 1, 2, 3, 4, 5, 6, 7))
#define G8_LO(v) __builtin_bit_cast(bf16x8, __builtin_shufflevector(v, v, 0, 1, 2, 3))
#define G8_HI(v) __builtin_bit_cast(bf16x8, __builtin_shufflevector(v, v, 4, 5, 6, 7))
#define G8_LDA(dst, b, h) do { _Pragma("unroll") for (int m = 0; m < 4; ++m) { const u32x4 _l = *(const LAS u32x4*)(lds + G8_SA(b, h) + aoff + m * 2048), _h = *(const LAS u32x4*)(lds + G8_SA(b, h) + aoff + m * 2048 + 1024); dst[m] = G8_CAT(_l, _h); } } while (0)
#define G8_LDB(dst, b, h) do { _Pragma("unroll") for (int n = 0; n < 2; ++n) { const u32x4 _l = *(const LAS u32x4*)(lds + G8_SB(b, h) + boff + n * 2048), _h = *(const LAS u32x4*)(lds + G8_SB(b, h) + boff + n * 2048 + 1024); dst[n] = G8_CAT(_l, _h); } } while (0)
#define G8_MMA(ai, bj, At, Bt) do { __builtin_amdgcn_s_setprio(1); \
        if constexpr (Prob::FP8) { _Pragma("unroll") for (int m = 0; m < 4; ++m) _Pragma("unroll") for (int n = 0; n < 2; ++n) \
            asm volatile("v_mfma_scale_f32_16x16x128_f8f6f4 %0, %1, %2, %0, %3, %3 op_sel_hi:[0,0,0]" : "+v"(acc[ai][bj][m][n]) : "v"(Bt[n]), "v"(At[m]), "v"(f8scale)); } \
        else { _Pragma("unroll") for (int m = 0; m < 4; ++m) _Pragma("unroll") for (int n = 0; n < 2; ++n) { \
            acc[ai][bj][m][n] = __builtin_amdgcn_mfma_f32_16x16x32_bf16(G8_LO(Bt[n]), G8_LO(At[m]), acc[ai][bj][m][n], 0, 0, 0); \
            acc[ai][bj][m][n] = __builtin_amdgcn_mfma_f32_16x16x32_bf16(G8_HI(Bt[n]), G8_HI(At[m]), acc[ai][bj][m][n], 0, 0, 0); } } \
        __builtin_amdgcn_s_setprio(0); } while (0)
#define G8_WAIT_V(n) asm volatile("s_waitcnt vmcnt(" #n ")" ::: "memory")
#define G8_WAIT_L(n) asm volatile("s_waitcnt lgkmcnt(" #n ")" ::: "memory")
#define G8_BAR __builtin_amdgcn_s_barrier()
#define G8_SCHED __builtin_amdgcn_sched_barrier(0)
    Unit cur, nxt, nn; int ui = 0;
    if (!P.next(0, cur)) return;
    const int f8scale = 0x7f7f7f7f;
    f32x4 acc[2][2][4][2];
#pragma unroll
    for (int a = 0; a < 2; ++a)
#pragma unroll
        for (int b = 0; b < 2; ++b)
#pragma unroll
            for (int m = 0; m < 4; ++m)
#pragma unroll
                for (int n = 0; n < 2; ++n) acc[a][b][m][n] = (f32x4){0.f, 0.f, 0.f, 0.f};
    i32x8 At[4], B0[2], B1[2];
    const char* Ab = (const char*)P.a_base();
    unsigned aoc[2][2], aon[2][2]; int raw[2][2];
    P.a_fetch(cur, RA, raw); P.a_finish(raw, CA, aoc);
    bool has_next = P.next(1, nxt);
    if (has_next) { P.a_fetch(nxt, RA, raw); P.a_finish(raw, CA, aon); }
    else { aon[0][0] = aoc[0][0]; aon[0][1] = aoc[0][1]; aon[1][0] = aoc[1][0]; aon[1][1] = aoc[1][1]; }
    const char* cB = (const char*)P.b_ptr(cur);
    const char* nB = has_next ? (const char*)P.b_ptr(nxt) : cB;
    typename Epi::Pre pre = E.fetch(cur, wr, wc, fr, fq);
    G8_STAGE_B(G8_SB(0, 0), cB); G8_STAGE_B(G8_SB(0, 1), cB + hstep); G8_STAGE_A(G8_SA(0, 0), aoc[0][0], aoc[0][1]); G8_STAGE_A(G8_SA(0, 1), aoc[1][0], aoc[1][1]);
    if (wr == 1) G8_BAR;
    G8_WAIT_V(2); G8_BAR;
    G8_STAGE_B(G8_SB(1, 0), cB + kstep); G8_STAGE_A(G8_SA(1, 0), aoc[0][0] + 128u, aoc[0][1] + 128u); G8_STAGE_B(G8_SB(1, 1), cB + hstep + kstep);
    G8_WAIT_V(6); G8_BAR;
    for (;;) {
        for (int t = 0; t < nt; t += 2) {
            const bool last = (t == nt - 2);
            const unsigned k1 = (unsigned)(t + 1) * 128u;
            const unsigned k2 = last ? 0u : (unsigned)(t + 2) * 128u;
            const unsigned a2_00 = (last ? aon[0][0] : aoc[0][0]) + k2, a2_01 = (last ? aon[0][1] : aoc[0][1]) + k2;
            const unsigned a2_10 = (last ? aon[1][0] : aoc[1][0]) + k2, a2_11 = (last ? aon[1][1] : aoc[1][1]) + k2;
            const char* b2 = last ? nB : cB + (size_t)(t + 2) * kstep;
            const char* b3 = b2 + kstep;
            G8_LDB(B0, 0, 0); G8_LDB(B1, 0, 1); G8_SCHED; G8_LDA(At, 0, 0); G8_STAGE_A(G8_SA(1, 1), aoc[1][0] + k1, aoc[1][1] + k1);
            G8_WAIT_V(8); G8_WAIT_L(0); G8_BAR; G8_MMA(0, 0, At, B0); G8_MMA(0, 1, At, B1); G8_BAR; G8_SCHED;
            G8_LDA(At, 0, 1); G8_STAGE_B(G8_SB(0, 0), b2); G8_STAGE_B(G8_SB(0, 1), b2 + hstep); G8_STAGE_A(G8_SA(0, 0), a2_00, a2_01);
            G8_WAIT_V(8); G8_WAIT_L(0); G8_BAR; G8_MMA(1, 0, At, B0); G8_MMA(1, 1, At, B1); G8_BAR; G8_SCHED;
            G8_LDB(B0, 1, 0); G8_LDB(B1, 1, 1); G8_SCHED; G8_LDA(At, 1, 0); G8_STAGE_A(G8_SA(0, 1), a2_10, a2_11);
            G8_WAIT_V(8); G8_WAIT_L(0); G8_BAR; G8_MMA(0, 0, At, B0); G8_MMA(0, 1, At, B1); G8_BAR; G8_SCHED;
            G8_LDA(At, 1, 1); G8_STAGE_B(G8_SB(1, 0), b3); G8_STAGE_B(G8_SB(1, 1), b3 + hstep); G8_STAGE_A(G8_SA(1, 0), a2_00 + 128u, a2_01 + 128u);
            G8_WAIT_V(8); G8_WAIT_L(0); G8_BAR; G8_MMA(1, 0, At, B0); G8_MMA(1, 1, At, B1); G8_BAR; G8_SCHED;
        }
        if (wr == 0) G8_BAR;
        if constexpr (Prob::FP8) asm volatile("s_nop 15\n\ts_nop 15" ::: "memory");
        const bool has_nn = has_next && P.next(ui + 2, nn);
        if (has_nn) P.a_fetch(nn, RA, raw);
        typename Epi::Pre pren = pre; if (has_next) pren = E.fetch(nxt, wr, wc, fr, fq);
        E(acc, cur, pre, wr, wc, fr, fq); pre = pren;
        if (!has_next) break;
#pragma unroll
        for (int a = 0; a < 2; ++a)
#pragma unroll
            for (int b = 0; b < 2; ++b)
#pragma unroll
                for (int m = 0; m < 4; ++m)
#pragma unroll
                    for (int n = 0; n < 2; ++n) acc[a][b][m][n] = (f32x4){0.f, 0.f, 0.f, 0.f};
        cur = nxt; cB = nB; ++ui;
        aoc[0][0] = aon[0][0]; aoc[0][1] = aon[0][1]; aoc[1][0] = aon[1][0]; aoc[1][1] = aon[1][1];
        nxt = nn; has_next = has_nn;
        if (has_next) { P.a_finish(raw, CA, aon); nB = (const char*)P.b_ptr(nxt); }
        else { nB = cB; }
        if (wr == 1) G8_BAR;
    }
    G8_WAIT_V(0);
    G8_BAR;
#undef G8_SA
#undef G8_SB
#undef G8_STAGE_A
#undef G8_STAGE_B
#undef G8_LDA
#undef G8_LDB
#undef G8_MMA
#undef G8_CAT
#undef G8_LO
#undef G8_HI
#undef G8_WAIT_V
#undef G8_WAIT_L
#undef G8_BAR
#undef G8_SCHED
}
}
namespace g8 {
#ifndef WGM_IN
#define WGM_IN 8
#endif
#ifndef WGM_OUT
#define WGM_OUT 8
#endif
#ifndef WGM_M1
#define WGM_M1 4
#endif
#ifndef WGM_M2
#define WGM_M2 4
#endif
template <bool F8, int WG_ = 8> struct DenseProbT {
    static constexpr bool FP8 = F8;
    const bf16_t* A; const bf16_t* Bt; int nM, nN, K, G, c, i0, i1;
    __device__ __forceinline__ bool next(int i, Unit& u) const { return (i0 + i < i1) && static_next<WG_>(i0 + i, nM, nN, G, c, u); }
    __device__ __forceinline__ const void* a_base() const { return A; }
    __device__ __forceinline__ void a_fetch(const Unit& u, const int (&RA)[2], int (&raw)[2][2]) const {
#pragma unroll
        for (int h = 0; h < 2; ++h)
#pragma unroll
            for (int i = 0; i < 2; ++i) raw[h][i] = u.pm * BM + h * HALF + RA[i];
    }
    __device__ __forceinline__ void a_finish(const int (&raw)[2][2], const int (&CA)[2], unsigned (&ao)[2][2]) const {
#pragma unroll
        for (int h = 0; h < 2; ++h)
#pragma unroll
            for (int i = 0; i < 2; ++i) ao[h][i] = (unsigned)((raw[h][i] * K + CA[i]) * 2);
    }
    __device__ __forceinline__ const void* b_ptr(const Unit& u) const { return Bt + (size_t)u.pn * BM * K; }
};
typedef DenseProbT<false, WGM_IN> DenseProbIn; typedef DenseProbT<false, WGM_OUT> DenseProbOut;
struct MoeProb1 {
    static constexpr bool FP8 = true;
    const bf16_t* A; const bf16_t* Bt; const int* row_tok; const int* blk; int K; int nM; int i0, i1;
    __device__ __forceinline__ bool next(int i, Unit& u) const {
        if (i0 + i >= i1 || !static_next<WGM_M1>(i0 + i, nM, 2 * FF / BM, gridDim.x, blockIdx.x, u)) return false;
        u.e = blk[64 + u.pm]; return true; }
    __device__ __forceinline__ const void* a_base() const { return A; }
    __device__ __forceinline__ void a_fetch(const Unit& u, const int (&RA)[2], int (&raw)[2][2]) const {
#pragma unroll
        for (int h = 0; h < 2; ++h)
#pragma unroll
            for (int i = 0; i < 2; ++i) raw[h][i] = row_tok[u.pm * BM + h * HALF + RA[i]];
    }
    __device__ __forceinline__ void a_finish(const int (&raw)[2][2], const int (&CA)[2], unsigned (&ao)[2][2]) const {
#pragma unroll
        for (int h = 0; h < 2; ++h)
#pragma unroll
            for (int i = 0; i < 2; ++i) ao[h][i] = (unsigned)((raw[h][i] * K + CA[i]) * 2);
    }
    __device__ __forceinline__ const void* b_ptr(const Unit& u) const { return Bt + ((size_t)__builtin_amdgcn_readfirstlane(u.e) * (2 * FF) + (size_t)u.pn * BM) * K; }
};
struct MoeProb2 {
    static constexpr bool FP8 = true;
    const bf16_t* A; const bf16_t* Bt; const int* blk; int K; int nM;
    __device__ __forceinline__ bool next(int i, Unit& u) const {
        if (!static_next<WGM_M2>(i, nM, DM / BM, gridDim.x, blockIdx.x, u)) return false;
        u.e = blk[64 + u.pm]; return true; }
    __device__ __forceinline__ const void* a_base() const { return A; }
    __device__ __forceinline__ void a_fetch(const Unit& u, const int (&RA)[2], int (&raw)[2][2]) const {
#pragma unroll
        for (int h = 0; h < 2; ++h)
#pragma unroll
            for (int i = 0; i < 2; ++i) raw[h][i] = u.pm * BM + h * HALF + RA[i];
    }
    __device__ __forceinline__ void a_finish(const int (&raw)[2][2], const int (&CA)[2], unsigned (&ao)[2][2]) const {
#pragma unroll
        for (int h = 0; h < 2; ++h)
#pragma unroll
            for (int i = 0; i < 2; ++i) ao[h][i] = (unsigned)((raw[h][i] * K + CA[i]) * 2);
    }
    __device__ __forceinline__ const void* b_ptr(const Unit& u) const { return Bt + ((size_t)__builtin_amdgcn_readfirstlane(u.e) * DM + (size_t)u.pn * BM) * K; }
};

struct EpiProj {
    static constexpr bool PERM = true;
    bf16_t* __restrict__ O; const float* __restrict__ rstd; float scale; int colbase;
    struct Pre { float rs[2][4]; };
    __device__ __forceinline__ Pre fetch(const Unit& u, int wr, int wc, int fr, int fq) const {
        Pre q; const int row0 = u.pm * BM + wr * 64 + fr;
#pragma unroll
        for (int ai = 0; ai < 2; ++ai)
#pragma unroll
            for (int m = 0; m < 4; ++m) q.rs[ai][m] = rstd[row0 + ai * HALF + m * 16];
        return q; }
    __device__ __forceinline__ void operator()(const f32x4 (&acc)[2][2][4][2], const Unit& u, const Pre& q, int wr, int wc, int fr, int fq) const {
        const int row0 = u.pm * BM + wr * 64 + fr, col0 = colbase + u.pn * BM + wc * 32 + 8 * fq;
#pragma unroll
        for (int ai = 0; ai < 2; ++ai)
#pragma unroll
            for (int m = 0; m < 4; ++m) { const int row = row0 + ai * HALF + m * 16; bf16_t* rowp = O + (size_t)row * NPROJ + col0; const float rsc = q.rs[ai][m] * scale;
#pragma unroll
                for (int bj = 0; bj < 2; ++bj) { const f32x4 v0 = acc[ai][bj][m][0] * rsc, v1 = acc[ai][bj][m][1] * rsc;
                    u32x4 w; w.x = cvt_pk_bf16(v0[0], v0[1]); w.y = cvt_pk_bf16(v0[2], v0[3]); w.z = cvt_pk_bf16(v1[0], v1[1]); w.w = cvt_pk_bf16(v1[2], v1[3]);
                    *(u32x4*)(rowp + bj * HALF) = w; } }
    }
};
struct EpiX1 {
    static constexpr bool PERM = false;
    const float* __restrict__ X; float* __restrict__ O;
    struct Pre {};
    __device__ __forceinline__ Pre fetch(const Unit&, int, int, int, int) const { return Pre{}; }
    __device__ __forceinline__ void operator()(const f32x4 (&acc)[2][2][4][2], const Unit& u, const Pre&, int wr, int wc, int fr, int fq) const {
        const int row0 = u.pm * BM + wr * 64 + fr, col0 = u.pn * BM + wc * 32 + 4 * fq;
#pragma unroll
        for (int ai = 0; ai < 2; ++ai) {
            f32x4 xv[4][2][2];
#pragma unroll
            for (int m = 0; m < 4; ++m) { const size_t off = (size_t)(row0 + ai * HALF + m * 16) * DM + col0;
#pragma unroll
                for (int bj = 0; bj < 2; ++bj)
#pragma unroll
                    for (int n = 0; n < 2; ++n) xv[m][bj][n] = __builtin_nontemporal_load((const f32x4*)(X + off + bj * HALF + n * 16)); }
#pragma unroll
            for (int m = 0; m < 4; ++m) { const size_t off = (size_t)(row0 + ai * HALF + m * 16) * DM + col0;
#pragma unroll
                for (int bj = 0; bj < 2; ++bj)
#pragma unroll
                    for (int n = 0; n < 2; ++n) *(f32x4*)(O + off + bj * HALF + n * 16) = xv[m][bj][n] + acc[ai][bj][m][n]; }
        }
    }
};
struct EpiSwiglu {
    static constexpr bool PERM = true;
    unsigned char* __restrict__ O; const float* __restrict__ row_rstd; const float* __restrict__ bgu;
    struct Pre { float rsv[2][4]; };
    __device__ __forceinline__ Pre fetch(const Unit& u, int wr, int wc, int fr, int fq) const {
        Pre q; const int row0 = u.pm * BM + wr * 64 + fr;
#pragma unroll
        for (int ai = 0; ai < 2; ++ai)
#pragma unroll
            for (int m = 0; m < 4; ++m) q.rsv[ai][m] = row_rstd[row0 + ai * HALF + m * 16];
        return q; }
    __device__ __forceinline__ void operator()(const f32x4 (&acc)[2][2][4][2], const Unit& u, const Pre& q, int wr, int wc, int fr, int fq) const {
        const int row0 = u.pm * BM + wr * 64 + fr, colg = u.pn * HALF + wc * 32 + 8 * fq;
        const float* bg = bgu + (size_t)__builtin_amdgcn_readfirstlane(u.e) * (2 * FF) + colg; const float* bu = bg + FF;
        const f32x4 bg0 = *(const f32x4*)bg, bg1 = *(const f32x4*)(bg + 4), bu0 = *(const f32x4*)bu, bu1 = *(const f32x4*)(bu + 4);
#pragma unroll
        for (int ai = 0; ai < 2; ++ai)
#pragma unroll
            for (int m = 0; m < 4; ++m) { const int row = row0 + ai * HALF + m * 16; const float rs = q.rsv[ai][m] * F8_UNSCALE;
                f32x4 g0 = acc[ai][0][m][0] * rs + bg0, g1 = acc[ai][0][m][1] * rs + bg1, u0 = acc[ai][1][m][0] * rs + bu0, u1 = acc[ai][1][m][1] * rs + bu1;
                float o[8];
#pragma unroll
                for (int j = 0; j < 8; ++j) { float g = j < 4 ? g0[j] : g1[j - 4], uu = j < 4 ? u0[j] : u1[j - 4];
                    g = fminf(g, 7.0f); uu = __builtin_amdgcn_fmed3f(uu, -7.0f, 7.0f);
                    const float sg = __builtin_amdgcn_rcpf(1.0f + __builtin_amdgcn_exp2f(g * (-1.702f * 1.4426950408889634f)));
                    o[j] = (uu * ACT_SCALE + ACT_SCALE) * (g * sg); }
                u32x2 w; w.x = cvt4_fp8(o[0], o[1], o[2], o[3]); w.y = cvt4_fp8(o[4], o[5], o[6], o[7]);
                *(u32x2*)(O + (size_t)row * FF + colg) = w; }
    }
};
struct EpiDown {
    static constexpr bool PERM = true;
    unsigned char* __restrict__ O; const float* __restrict__ bd;
    struct Pre { f32x4 bv[2][2]; };
    __device__ __forceinline__ Pre fetch(const Unit& u, int wr, int wc, int fr, int fq) const {
        Pre q; const int col0 = u.pn * BM + wc * 32 + 8 * fq;
        const float* bp = bd + (size_t)__builtin_amdgcn_readfirstlane(u.e) * DM + col0;
#pragma unroll
        for (int bj = 0; bj < 2; ++bj)
#pragma unroll
            for (int n = 0; n < 2; ++n) q.bv[bj][n] = *(const f32x4*)(bp + bj * HALF + 4 * n) * Y_SCALE;
        return q; }
    __device__ __forceinline__ void operator()(const f32x4 (&acc)[2][2][4][2], const Unit& u, const Pre& q, int wr, int wc, int fr, int fq) const {
        const int row0 = u.pm * BM + wr * 64 + fr, col0 = u.pn * BM + wc * 32 + 8 * fq;
#pragma unroll
        for (int ai = 0; ai < 2; ++ai)
#pragma unroll
            for (int m = 0; m < 4; ++m) { unsigned char* rowp = O + (size_t)(row0 + ai * HALF + m * 16) * DM + col0;
#pragma unroll
                for (int bj = 0; bj < 2; ++bj) { const f32x4 v0 = acc[ai][bj][m][0] * (F8_UNSCALE * Y_SCALE) + q.bv[bj][0], v1 = acc[ai][bj][m][1] * (F8_UNSCALE * Y_SCALE) + q.bv[bj][1];
                    u32x2 w; w.x = cvt4_fp8(v0[0], v0[1], v0[2], v0[3]); w.y = cvt4_fp8(v1[0], v1[1], v1[2], v1[3]);
                    *(u32x2*)(rowp + bj * HALF) = w; } }
    }
};
}
struct Ctx { LAS unsigned char* lds; int tid, lane, wave; };
__device__ __forceinline__ Ctx fresh_ctx(const Ctx& c0) { Ctx c; c.lds = c0.lds; int t = threadIdx.x; asm volatile("" : "+v"(t)); c.tid = t; c.lane = t & 63; c.wave = __builtin_amdgcn_readfirstlane(t >> 6); return c; }

__device__ __forceinline__ void transpose_item(const float* W, int ld, int K, int k0, int n0, bf16_t* WT_row0  , LAS float* scr, int lane) {
    float tv[32];
#pragma unroll
    for (int i = 0; i < 32; ++i) { const int kk = 2 * i + (lane >> 5); tv[i] = __builtin_nontemporal_load(W + (size_t)(k0 + kk) * ld + n0 + (lane & 31)); }
#pragma unroll
    for (int i = 0; i < 32; ++i) { const int kk = 2 * i + (lane >> 5); scr[kk * 33 + (lane & 31)] = tv[i]; }
    LDS_WAIT(); asm volatile("" ::: "memory");
    const int c = lane & 7;
#pragma unroll
    for (int j = 0; j < 4; ++j) { const int n = (lane >> 3) + 8 * j; const LAS float* s = scr + (8 * c) * 33 + n;
        u32x4 o; o.x = cvt_pk_bf16(s[0 * 33], s[1 * 33]); o.y = cvt_pk_bf16(s[2 * 33], s[3 * 33]); o.z = cvt_pk_bf16(s[4 * 33], s[5 * 33]); o.w = cvt_pk_bf16(s[6 * 33], s[7 * 33]);
        *(u32x4*)(WT_row0 + (size_t)n * K + k0 + 8 * c) = o; }
    LDS_WAIT(); asm volatile("" ::: "memory");
}
__device__ __forceinline__ void phase_convert(const Params& p, const Ctx& c0) { const Ctx c = fresh_ctx(c0);
    LAS float* scr = (LAS float*)(c.lds + c.wave * 18432);
    const int gw = blockIdx.x * NWAVES + c.wave, NGW = gridDim.x * NWAVES;
    bf16_t* WinT = (bf16_t*)(p.ws + WS_WIN); bf16_t* WoutT = (bf16_t*)(p.ws + WS_WOUT);
    constexpr int KB = DM / 64;
    constexpr int I_IN = KB * (NPROJ / 32), I_OUT = KB * (DM / 32), NITEMS = I_IN + I_OUT;
    for (int it = gw; it < NITEMS; it += NGW) {
        int r = it;
        if (r < I_IN) { const int nb = r % (NPROJ / 32), kb = r / (NPROJ / 32); transpose_item(p.w_in, LDW_IN, DM, 64 * kb, 32 * nb, WinT + (size_t)(32 * nb) * DM, scr, c.lane); continue; } r -= I_IN;
        { const int nb = r % (DM / 32), kb = r / (DM / 32); transpose_item(p.w_out, DM, DM, 64 * kb, 32 * nb, WoutT + (size_t)(32 * nb) * DM, scr, c.lane); }
    }
    float* rc = (float*)(p.ws + WS_ROPE); float* rs = rc + SEQ * 64;
    for (int i = blockIdx.x * NTHREADS + c.tid; i < SEQ * 64; i += gridDim.x * NTHREADS) {
        const int pos = i >> 6, j = i & 63;
        const float inv = 1.0f / powf(10000.0f, (float)(2 * j) / 128.0f);
        const float ang = (float)pos * inv; float sn, cs; sincosf(ang, &sn, &cs); rc[i] = cs; rs[i] = sn; }
}
constexpr int CT_GU1 = (DM / 128) * (2 * FF / 256), CT_D1 = (FF / 128) * (DM / 256), CT_GU = NE * CT_GU1, CT_D = NE * CT_D1, CT_TOTAL = CT_GU + CT_D;
struct ConvTile { const float* src; unsigned char* dst; int ld; int gu; };
__device__ __forceinline__ ConvTile ctile_decode(const Params& p, int r) {
    ConvTile t;
    if (r < CT_GU) { const int e = r / CT_GU1, q = r % CT_GU1, nt = q % (2 * FF / 256), kt = q / (2 * FF / 256);
        t.src = p.w_gu + (size_t)e * DM * (2 * FF) + (size_t)(128 * kt) * (2 * FF) + 256 * nt; t.ld = 2 * FF; t.gu = 256 * nt;
        t.dst = (unsigned char*)(p.ws + WS_WGU) + (size_t)e * (2 * FF) * DM + 128 * kt; }
    else { r -= CT_GU; const int e = r / CT_D1, q = r % CT_D1, nt = q % (DM / 256), kt = q / (DM / 256);
        t.src = p.w_d + (size_t)e * FF * DM + (size_t)(128 * kt) * DM + 256 * nt; t.ld = DM; t.gu = -1;
        t.dst = (unsigned char*)(p.ws + WS_WD) + ((size_t)e * DM + 256 * nt) * FF + 128 * kt; }
    return t;
}
__device__ __forceinline__ void ctile_load(const ConvTile& t, f32x4 (&tv)[16], int wave, int lane) {
    const float* s = t.src + (size_t)(16 * wave) * t.ld + 4 * lane;
#pragma unroll
    for (int i = 0; i < 16; ++i) tv[i] = __builtin_nontemporal_load((const f32x4*)(s + (size_t)i * t.ld));
}
__device__ __forceinline__ void ctile_store(const ConvTile& t, const f32x4 (&tv)[16], LAS unsigned char* lds, int tid, int wave, int lane) {
#pragma unroll
    for (int c = 0; c < 4; ++c) { u32x4 o;
#pragma unroll
        for (int q = 0; q < 4; ++q) o[q] = cvt4_fp8(tv[4 * q][c] * W_SCALE, tv[4 * q + 1][c] * W_SCALE, tv[4 * q + 2][c] * W_SCALE, tv[4 * q + 3][c] * W_SCALE);
        const int n = 4 * lane + c; *(LAS u32x4*)(lds + n * 128 + ((wave ^ (lane & 7)) << 4)) = o; }
    __syncthreads();
#pragma unroll
    for (int j = 0; j < 4; ++j) { const int n = 64 * j + (tid >> 3), ch = tid & 7;
        const u32x4 o = *(const LAS u32x4*)(lds + n * 128 + ((ch ^ ((n >> 2) & 7)) << 4));
        int orow = n;
        if (t.gu >= 0) { const int ng = t.gu + n; const int nn = ng < FF ? ng : ng - FF; orow = 256 * (nn / 128) + (nn % 128) + (ng < FF ? 0 : 128); }
        *(u32x4*)(t.dst + (size_t)orow * DM + 16 * ch) = o; }
    __syncthreads();
}
__device__ __forceinline__ void phase_convert_share(const Params& p, const Ctx& c0, int lo, int hi, int G, int w) { const Ctx c = fresh_ctx(c0);
    for (int it = lo + w; it < hi; it += 2 * G) {
        const int i1 = it + G < hi ? it + G : it;
        f32x4 ta[16], tb[16];
        const ConvTile A = ctile_decode(p, it), B = ctile_decode(p, i1);
        ctile_load(A, ta, c.wave, c.lane); ctile_load(B, tb, c.wave, c.lane);
        __builtin_amdgcn_sched_barrier(0);
        ctile_store(A, ta, c.lds, c.tid, c.wave, c.lane); ctile_store(B, tb, c.lds, c.tid, c.wave, c.lane);
        __builtin_amdgcn_sched_barrier(0);
    }
}

template <int NTL, int OUT8  >
__device__ __forceinline__ void norm_skinny_half(const float* xrows, const float* wn, const float* Wsk, int ldw, void* hrows_, void* hrows8_, int hk, int lane, f32x4 (&acc)[NTL], float& ss) {
    const int row = lane & 15, kq = lane >> 4;
    ss = 0.f;
#pragma unroll
    for (int t = 0; t < NTL; ++t) acc[t] = (f32x4){0.f, 0.f, 0.f, 0.f};
#pragma unroll 4
    for (int ks = 0; ks < 32; ++ks) {
        const int d0 = 1024 * hk + 32 * ks + 8 * kq;
        f32x4 xa = *(const f32x4*)(xrows + (size_t)row * DM + d0), xb = *(const f32x4*)(xrows + (size_t)row * DM + d0 + 4);
        const f32x4 wa = *(const f32x4*)(wn + d0), wb = *(const f32x4*)(wn + d0 + 4);
        ss += (xa[0] * xa[0] + xa[1] * xa[1]) + (xa[2] * xa[2] + xa[3] * xa[3]) + (xb[0] * xb[0] + xb[1] * xb[1]) + (xb[2] * xb[2] + xb[3] * xb[3]);
        xa = xa * wa; xb = xb * wb;
        u32x4 hw; hw.x = cvt_pk_bf16(xa[0], xa[1]); hw.y = cvt_pk_bf16(xa[2], xa[3]); hw.z = cvt_pk_bf16(xb[0], xb[1]); hw.w = cvt_pk_bf16(xb[2], xb[3]);
        if constexpr (OUT8 >= 1) { u32x2 q; q.x = cvt4_fp8(xa[0] * ACT_SCALE, xa[1] * ACT_SCALE, xa[2] * ACT_SCALE, xa[3] * ACT_SCALE); q.y = cvt4_fp8(xb[0] * ACT_SCALE, xb[1] * ACT_SCALE, xb[2] * ACT_SCALE, xb[3] * ACT_SCALE);
            *(u32x2*)((unsigned char*)hrows8_ + (size_t)row * DM + d0) = q; }
        if constexpr (OUT8 != 1) *(u32x4*)((bf16_t*)hrows_ + (size_t)row * DM + d0) = hw;
        const f32x4 ra = {xa[0] - bflo(hw.x), xa[1] - bfhi(hw.x), xa[2] - bflo(hw.y), xa[3] - bfhi(hw.y)}, rb = {xb[0] - bflo(hw.z), xb[1] - bfhi(hw.z), xb[2] - bflo(hw.w), xb[3] - bfhi(hw.w)};
        const bf16x8 ah = __builtin_bit_cast(bf16x8, hw), al = pack8(ra, rb);
#pragma unroll
        for (int t = 0; t < NTL; ++t) {
            float wv[8];
#pragma unroll
            for (int i = 0; i < 8; ++i) wv[i] = Wsk[(size_t)(d0 + i) * ldw + t * 16 + row];
            u32x4 bw; bw.x = cvt_pk_bf16(wv[0], wv[1]); bw.y = cvt_pk_bf16(wv[2], wv[3]); bw.z = cvt_pk_bf16(wv[4], wv[5]); bw.w = cvt_pk_bf16(wv[6], wv[7]);
            const f32x4 r0 = {wv[0] - bflo(bw.x), wv[1] - bfhi(bw.x), wv[2] - bflo(bw.y), wv[3] - bfhi(bw.y)}, r1 = {wv[4] - bflo(bw.z), wv[5] - bfhi(bw.z), wv[6] - bflo(bw.w), wv[7] - bfhi(bw.w)};
            const bf16x8 bh = __builtin_bit_cast(bf16x8, bw), bl = pack8(r0, r1);
            acc[t] = __builtin_amdgcn_mfma_f32_16x16x32_bf16(ah, bh, acc[t], 0, 0, 0);
            acc[t] = __builtin_amdgcn_mfma_f32_16x16x32_bf16(al, bh, acc[t], 0, 0, 0);
            acc[t] = __builtin_amdgcn_mfma_f32_16x16x32_bf16(ah, bl, acc[t], 0, 0, 0);
        }
    }
    ss += __shfl_xor(ss, 16); ss += __shfl_xor(ss, 32);
}

__device__ __forceinline__ void phase_norm1(const Params& p, const Ctx& c0) { const Ctx c = fresh_ctx(c0);
    bf16_t* H = (bf16_t*)(p.ws + WS_H); float* rstd = (float*)(p.ws + WS_RSTD1); float* gz = (float*)(p.ws + WS_GZ);
    const int pair = c.wave >> 1, hk = c.wave & 1;
    LAS float* scr = (LAS float*)(c.lds + pair * 4096);
    for (int u = blockIdx.x * 4 + pair; u < T / 16; u += gridDim.x * 4) {
        f32x4 acc[1]; float ss;
        norm_skinny_half<1, 0>(p.x + (size_t)u * 16 * DM, p.attn_norm_w, p.w_in + C_GZ, LDW_IN, H + (size_t)u * 16 * DM, nullptr, hk, c.lane, acc, ss);
        if (hk == 1) { *(LAS f32x4*)(scr + c.lane * 4) = acc[0]; if (c.lane < 16) scr[256 + c.lane] = ss; }
        __syncthreads();
        if (hk == 0) {
            const f32x4 o = *(LAS f32x4*)(scr + c.lane * 4); const float tot = ss + scr[256 + (c.lane & 15)];
            const float rs = 1.0f / sqrtf(tot * (1.0f / DM) + EPS);
            if (c.lane < 16) { rstd[u * 16 + c.lane] = rs; scr[512 + c.lane] = rs; }
            LDS_WAIT();
#pragma unroll
            for (int r = 0; r < 4; ++r) { const int row = (c.lane >> 4) * 4 + r; gz[(size_t)(u * 16 + row) * 16 + (c.lane & 15)] = (acc[0][r] + o[r]) * scr[512 + row]; }
        }
        __syncthreads();
    }
}

__device__ __forceinline__ void phase_norm2_router(const Params& p, const Ctx& c0) { const Ctx c = fresh_ctx(c0);
    bf16_t* H = (bf16_t*)(p.ws + WS_H); float* rstd = (float*)(p.ws + WS_RSTD2); const float* X1 = (const float*)(p.ws + WS_X1);
    int* topi = (int*)(p.ws + WS_TOPI); float* topg = (float*)(p.ws + WS_TOPG); int* hist = (int*)(p.ws + WS_HIST); int* row_tok = (int*)(p.ws + WS_ROWTOK);
    const int pair = c.wave >> 1, hk = c.wave & 1;
    LAS float* scr = (LAS float*)(c.lds + pair * 8192);
    LAS int* hcnt = (LAS int*)(c.lds + 65536);
    { float* row_rstd = (float*)(p.ws + WS_ROWRSTD);
      for (int i = blockIdx.x * NTHREADS + c.tid; i < PROWS; i += gridDim.x * NTHREADS) { row_tok[i] = 0; row_rstd[i] = 0.f; } }
    for (int g = blockIdx.x; g < T / 64; g += gridDim.x) {
        if (c.tid < 32) hcnt[c.tid] = 0;
        __syncthreads();
        const int u = g * 4 + pair;
        f32x4 acc[2]; float ss;
        norm_skinny_half<2, 1>(X1 + (size_t)u * 16 * DM, p.ffn_norm_w, p.router_w, NE, nullptr, (unsigned char*)H + (size_t)u * 16 * DM, hk, c.lane, acc, ss);
        if (hk == 1) { *(LAS f32x4*)(scr + c.lane * 4) = acc[0]; *(LAS f32x4*)(scr + 256 + c.lane * 4) = acc[1]; if (c.lane < 16) scr[512 + c.lane] = ss; }
        __syncthreads();
        if (hk == 0) {
            const f32x4 o0 = *(LAS f32x4*)(scr + c.lane * 4), o1 = *(LAS f32x4*)(scr + 256 + c.lane * 4); const float tot = ss + scr[512 + (c.lane & 15)];
            const float rs = 1.0f / sqrtf(tot * (1.0f / DM) + EPS);
            if (c.lane < 16) { rstd[u * 16 + c.lane] = rs; scr[528 + c.lane] = rs; }
            LDS_WAIT();
            const float b0 = p.router_b[c.lane & 15], b1 = p.router_b[16 + (c.lane & 15)];
#pragma unroll
            for (int r = 0; r < 4; ++r) { const int row = (c.lane >> 4) * 4 + r; const float rr = scr[528 + row];
                scr[1024 + row * 32 + (c.lane & 15)] = (acc[0][r] + o0[r]) * rr + b0; scr[1024 + row * 32 + 16 + (c.lane & 15)] = (acc[1][r] + o1[r]) * rr + b1; }
            LDS_WAIT();
            if (c.lane < 16) {
                float lv[32];
#pragma unroll
                for (int j = 0; j < 32; ++j) lv[j] = scr[1024 + c.lane * 32 + j];
                int bi[4]; float bv[4];
#pragma unroll
                for (int k = 0; k < 4; ++k) { float best = -__builtin_inff(); int bidx = 0;
#pragma unroll
                    for (int j = 0; j < 32; ++j) { const bool tk = lv[j] > best; best = tk ? lv[j] : best; bidx = tk ? j : bidx; }
                    bi[k] = bidx; bv[k] = best;
#pragma unroll
                    for (int j = 0; j < 32; ++j) lv[j] = (j == bidx) ? -__builtin_inff() : lv[j]; }
                const float e1 = __expf(bv[1] - bv[0]), e2 = __expf(bv[2] - bv[0]), e3 = __expf(bv[3] - bv[0]); const float inv = 1.0f / (1.0f + e1 + e2 + e3);
                const int tok = u * 16 + c.lane;
                *(int4*)(topi + (size_t)tok * 4) = make_int4(bi[0], bi[1], bi[2], bi[3]);
                *(float4*)(topg + (size_t)tok * 4) = make_float4(inv, e1 * inv, e2 * inv, e3 * inv);
#pragma unroll
                for (int k = 0; k < 4; ++k) atomicAdd((int*)&hcnt[bi[k]], 1);
            }
        }
        __syncthreads();
        if (c.tid < 32) hist[g * 32 + c.tid] = hcnt[c.tid];
        __syncthreads();
    }
}

__device__ __forceinline__ void phase_rope_kmean(const Params& p, const Ctx& c0) { const Ctx c = fresh_ctx(c0);
    bf16_t* proj = (bf16_t*)(p.ws + WS_PROJ); const float* rc = (const float*)(p.ws + WS_ROPE); const float* rsn = rc + SEQ * 64; float* kmean = (float*)(p.ws + WS_KMEAN);
    LAS float* red = (LAS float*)c.lds;
    const int cg = c.tid & 7, tk = c.tid >> 3;
    for (int u = blockIdx.x; u < NBATCH * MH * NBLK; u += gridDim.x) {
        const int b = u / (MH * NBLK), h = (u / NBLK) % MH, blk = u % NBLK;
        float s1[8], s2[8];
#pragma unroll
        for (int j = 0; j < 8; ++j) { s1[j] = 0.f; s2[j] = 0.f; }
#pragma unroll
        for (int ps = 0; ps < 4; ++ps) {
            const int pos = blk * MBLK + ps * 64 + tk; const size_t row = (size_t)(b * SEQ + pos) * NPROJ;
            const f32x4 ca = *(const f32x4*)(rc + pos * 64 + 8 * cg), cb = *(const f32x4*)(rc + pos * 64 + 8 * cg + 4), sa = *(const f32x4*)(rsn + pos * 64 + 8 * cg), sb = *(const f32x4*)(rsn + pos * 64 + 8 * cg + 4);
            const float cs[8] = {ca[0], ca[1], ca[2], ca[3], cb[0], cb[1], cb[2], cb[3]}, sn[8] = {sa[0], sa[1], sa[2], sa[3], sb[0], sb[1], sb[2], sb[3]};
#pragma unroll
            for (int qk = 0; qk < 2; ++qk) {
                bf16_t* base = proj + row + (qk ? C_MK : C_MQ) + h * HD + 8 * cg;
                const u32x4 t1 = *(const u32x4*)base, t2 = *(const u32x4*)(base + 64);
                float a[8], bb[8];
#pragma unroll
                for (int j = 0; j < 4; ++j) { a[2 * j] = bflo(t1[j]); a[2 * j + 1] = bfhi(t1[j]); bb[2 * j] = bflo(t2[j]); bb[2 * j + 1] = bfhi(t2[j]); }
                float o1[8], o2[8];
#pragma unroll
                for (int j = 0; j < 8; ++j) { o1[j] = a[j] * cs[j] - bb[j] * sn[j]; o2[j] = bb[j] * cs[j] + a[j] * sn[j]; }
                u32x4 w1, w2;
#pragma unroll
                for (int j = 0; j < 4; ++j) { w1[j] = cvt_pk_bf16(o1[2 * j], o1[2 * j + 1]); w2[j] = cvt_pk_bf16(o2[2 * j], o2[2 * j + 1]); }
                *(u32x4*)base = w1; *(u32x4*)(base + 64) = w2;
                if (qk) {
#pragma unroll
                    for (int j = 0; j < 8; ++j) { s1[j] += o1[j]; s2[j] += o2[j]; } }
            }
        }
#pragma unroll
        for (int j = 0; j < 8; ++j) {
#pragma unroll
            for (int o = 8; o < 64; o <<= 1) { s1[j] += __shfl_xor(s1[j], o); s2[j] += __shfl_xor(s2[j], o); } }
        if (c.lane < 8) {
#pragma unroll
            for (int j = 0; j < 8; ++j) { red[c.wave * 128 + 8 * cg + j] = s1[j]; red[c.wave * 128 + 64 + 8 * cg + j] = s2[j]; } }
        __syncthreads();
        if (c.tid < 128) { float s = 0.f;
#pragma unroll
            for (int w = 0; w < 8; ++w) s += red[w * 128 + c.tid];
            kmean[(size_t)u * HD + c.tid] = s * (1.0f / MBLK); }
        __syncthreads();
    }
}

__device__ __forceinline__ void phase_gla_prep(const Params& p, const Ctx& c0) { const Ctx c = fresh_ctx(c0);
    bf16_t* proj = (bf16_t*)(p.ws + WS_PROJ); const float* gz = (const float*)(p.ws + WS_GZ); float* dend = (float*)(p.ws + WS_DEND);
    LAS float* gzl = (LAS float*)c.lds;
    LAS float* seg = (LAS float*)(c.lds + 16384);
    const int ch = c.tid & 127, tq = __builtin_amdgcn_readfirstlane(c.tid >> 7);
    for (int u = blockIdx.x; u < NBATCH * GH * NBLK; u += gridDim.x) {
        const int b = u / (GH * NBLK), h = (u / NBLK) % GH, j = u % NBLK;
        const int tok0 = b * SEQ + j * MBLK;
        for (int i = c.tid; i < 256 * 4; i += NTHREADS) *(LAS f32x4*)(gzl + i * 4) = *(const f32x4*)(gz + (size_t)tok0 * 16 + i * 4);
        float w2[16];
#pragma unroll
        for (int r = 0; r < 16; ++r) w2[r] = p.gate_w2[r * 512 + h * GDK + ch];
        const float bias = p.gate_b[h * GDK + ch];
        __syncthreads();
        float run = 0.f; float Bv[64];
#pragma unroll
        for (int i = 0; i < 64; ++i) {
            const LAS float* g = gzl + (tq * 64 + i) * 16;
            const f32x4 g0 = *(const LAS f32x4*)g, g1 = *(const LAS f32x4*)(g + 4), g2 = *(const LAS f32x4*)(g + 8), g3 = *(const LAS f32x4*)(g + 12);
            float lg = bias;
            lg += g0[0] * w2[0] + g0[1] * w2[1] + g0[2] * w2[2] + g0[3] * w2[3]; lg += g1[0] * w2[4] + g1[1] * w2[5] + g1[2] * w2[6] + g1[3] * w2[7];
            lg += g2[0] * w2[8] + g2[1] * w2[9] + g2[2] * w2[10] + g2[3] * w2[11]; lg += g3[0] * w2[12] + g3[1] * w2[13] + g3[2] * w2[14] + g3[3] * w2[15];
            const float ls = fminf(lg, 0.f) - __logf(1.0f + __expf(-fabsf(lg)));
            run += ls * (1.0f / 16.0f); Bv[i] = run; }
        seg[tq * 128 + ch] = run;
        __syncthreads();
        float off = 0.f, tot = 0.f;
#pragma unroll
        for (int s = 0; s < 4; ++s) { const float v = seg[s * 128 + ch]; tot += v; off += (s < tq) ? v : 0.f; }
        if (tq == 0) dend[(size_t)u * GDK + ch] = __expf(tot);
        bf16_t* qp = proj + (size_t)(tok0 + tq * 64) * NPROJ + C_GQ + h * GDK + ch; bf16_t* kp = proj + (size_t)(tok0 + tq * 64) * NPROJ + C_GK + h * GDK + ch;
#pragma unroll
        for (int i = 0; i < 64; ++i) { const float Bt = off + Bv[i];
            const float q = bf2f(qp[(size_t)i * NPROJ]), k = bf2f(kp[(size_t)i * NPROJ]);
            const float qt = q * __expf(Bt) * 0.08838834764831845f, kt = k * __expf(-Bt);
            qp[(size_t)i * NPROJ] = (bf16_t)(cvt_pk_bf16(qt, 0.f) & 0xffffu); kp[(size_t)i * NPROJ] = (bf16_t)(cvt_pk_bf16(kt, 0.f) & 0xffffu); }
        __syncthreads();
    }
}
namespace att {
constexpr int NW = 8, QBLK = 32, KVBLK = 64, QB = 256, D = 128;
constexpr int SHM_V = KVBLK * D * 2, SHM_K = KVBLK * D * 2;
constexpr int ATT_LDS = 2 * SHM_V + 2 * SHM_K + NW * 64 * 4;
constexpr float SCALE = 0.08838834764831845f;
constexpr float THR = 8.f;
constexpr int APITCH = NPROJ, OPITCH = DM;
typedef LAS char* lptr;
typedef const LAS char* lcptr;

#define KSWZ(row, colB) ((row) * 256 + ((colB) ^ (((row) & 7) << 4)))
__device__ __forceinline__ int v_st(int k, int c) { const int kk = (k & ~0xC) | ((k & 4) << 1) | ((k & 8) >> 1); return ((kk >> 3) * 4 + (c >> 5)) * 512 + ((kk & 7) * 32 + (c & 31)) * 2; }
__device__ __forceinline__ int v_rd_base(int lane) { return ((lane & 3) << 3) | (((lane >> 2) & 3) << 6) | (((lane >> 4) & 1) << 5) | (((lane >> 5) & 1) << 8); }
constexpr int v_rd_off(int d0, int ks, int half) { return d0 * 512 + ks * 4096 + half * 2048; }
__device__ __forceinline__ int crow(int r, int hi) { return (r & 3) + 8 * (r >> 2) + 4 * hi; }
__device__ __forceinline__ bf16x8 load8(const bf16_t* p) { return *reinterpret_cast<const bf16x8*>(p); }

__device__ __forceinline__ void pack_p(const f32x16& p0, const f32x16& p1, bf16x8& pa0, bf16x8& pa1, bf16x8& pa2, bf16x8& pa3) {
#define PK4(P, B_, OUT) do { unsigned a0 = cvt_pk_bf16(P[B_+0], P[B_+1]), a1 = cvt_pk_bf16(P[B_+2], P[B_+3]);                          \
        unsigned b0 = cvt_pk_bf16(P[B_+4], P[B_+5]), b1 = cvt_pk_bf16(P[B_+6], P[B_+7]);                                             \
        auto r0 = __builtin_amdgcn_permlane32_swap(a0, b0, false, false); auto r1 = __builtin_amdgcn_permlane32_swap(a1, b1, false, false); \
        u32x4 w = {r0[0], r1[0], r0[1], r1[1]}; OUT = __builtin_bit_cast(bf16x8, w); } while (0)
    PK4(p0, 0, pa0); PK4(p0, 8, pa1); PK4(p1, 0, pa2); PK4(p1, 8, pa3);
#undef PK4
}
__device__ __forceinline__ void partialSM(f32x16& p0, f32x16& p1, float& m_reg, float& mn, float& alpha) {
    float pmax = p0[0];
#pragma unroll
    for (int r = 1; r < 16; ++r) pmax = fmaxf(pmax, p0[r]);
#pragma unroll
    for (int r = 0; r < 16; ++r) pmax = fmaxf(pmax, p1[r]);
    { auto rr = __builtin_amdgcn_permlane32_swap(__float_as_uint(pmax), __float_as_uint(pmax), false, false);
      pmax = fmaxf(__uint_as_float(rr[0]), __uint_as_float(rr[1])); }
    constexpr float C2 = 1.4426950408889634f * SCALE;
    if (__builtin_expect(__all((pmax - m_reg) * SCALE <= THR), 1)) { mn = m_reg; alpha = 1.f; }
    else { mn = fmaxf(m_reg, pmax); alpha = __builtin_amdgcn_exp2f((m_reg - mn) * C2); m_reg = mn; }
    const float mnL = -mn * C2;
#pragma unroll
    for (int r = 0; r < 16; ++r) p0[r] = fmaf(p0[r], C2, mnL);
#pragma unroll
    for (int r = 0; r < 16; ++r) p1[r] = fmaf(p1[r], C2, mnL);
#pragma unroll
    for (int r = 0; r < 16; ++r) p0[r] = __builtin_amdgcn_exp2f(p0[r]);
}
__device__ __forceinline__ void finishSM(f32x16& p0, f32x16& p1, float alpha, float& l_reg, bf16x8& pa0, bf16x8& pa1, bf16x8& pa2, bf16x8& pa3) {
#pragma unroll
    for (int r = 0; r < 16; ++r) p1[r] = __builtin_amdgcn_exp2f(p1[r]);
    float ps = 0;
#pragma unroll
    for (int r = 0; r < 16; ++r) ps += p0[r];
#pragma unroll
    for (int r = 0; r < 16; ++r) ps += p1[r];
    { auto rr = __builtin_amdgcn_permlane32_swap(__float_as_uint(ps), __float_as_uint(ps), false, false);
      ps = __uint_as_float(rr[0]) + __uint_as_float(rr[1]); }
    l_reg = l_reg * alpha + ps;
    pack_p(p0, p1, pa0, pa1, pa2, pa3);
}
template <int KB>
__device__ __forceinline__ void qkt(f32x16& p0, f32x16& p1, lcptr K_lds, int r32, int hi, const bf16x8* qr, float init = 0.f) {
#pragma unroll
    for (int r = 0; r < 16; ++r) { p0[r] = init; p1[r] = init; }
    lcptr kb[4];
#pragma unroll
    for (int dd = 0; dd < 4; ++dd) kb[dd] = K_lds + KB * SHM_K + KSWZ(r32, (dd * 16 + hi * 8) * 2);
#pragma unroll
    for (int d0 = 0; d0 < 8; ++d0) { lcptr a = kb[d0 & 3] + (d0 >> 2) * 128;
        bf16x8 b0 = *reinterpret_cast<const LAS bf16x8*>(a);
        bf16x8 b1 = *reinterpret_cast<const LAS bf16x8*>(a + 32 * 256);
        p0 = __builtin_amdgcn_mfma_f32_32x32x16_bf16(b0, qr[d0], p0, 0, 0, 0);
        p1 = __builtin_amdgcn_mfma_f32_32x32x16_bf16(b1, qr[d0], p1, 0, 0, 0); }
}
#define TRRD(dst, vb, off) asm volatile("ds_read_b64_tr_b16 %0, %1 offset:%2" : "=&v"(dst) : "v"(vb), "i"(off) : "memory")
template <int VOFF>
__device__ __forceinline__ void pv_tile(f32x16* o, int vb0, bf16x8 pa0, bf16x8 pa1, bf16x8 pa2, bf16x8 pa3) {
#define PV_D0(d0) do { s16x4 l0, l1, l2, l3, h0, h1, h2, h3; constexpr int b_ = VOFF + v_rd_off(d0, 0, 0); \
        TRRD(l0, vb0, b_); TRRD(h0, vb0, b_ + 2048); TRRD(l1, vb0, b_ + 4096); TRRD(h1, vb0, b_ + 6144); TRRD(l2, vb0, b_ + 8192); TRRD(h2, vb0, b_ + 10240); TRRD(l3, vb0, b_ + 12288); TRRD(h3, vb0, b_ + 14336); \
        asm volatile("s_waitcnt lgkmcnt(0)" ::: "memory"); SBAR(); \
        o[d0] = __builtin_amdgcn_mfma_f32_32x32x16_bf16(pa0, (bf16x8){l0[0], l0[1], l0[2], l0[3], h0[0], h0[1], h0[2], h0[3]}, o[d0], 0, 0, 0);   \
        o[d0] = __builtin_amdgcn_mfma_f32_32x32x16_bf16(pa1, (bf16x8){l1[0], l1[1], l1[2], l1[3], h1[0], h1[1], h1[2], h1[3]}, o[d0], 0, 0, 0);   \
        o[d0] = __builtin_amdgcn_mfma_f32_32x32x16_bf16(pa2, (bf16x8){l2[0], l2[1], l2[2], l2[3], h2[0], h2[1], h2[2], h2[3]}, o[d0], 0, 0, 0);   \
        o[d0] = __builtin_amdgcn_mfma_f32_32x32x16_bf16(pa3, (bf16x8){l3[0], l3[1], l3[2], l3[3], h3[0], h3[1], h3[2], h3[3]}, o[d0], 0, 0, 0); } while (0)
    PV_D0(0); PV_D0(1); PV_D0(2); PV_D0(3);
#undef PV_D0
}
template <int VOFF, int D0>
__device__ __forceinline__ void tr_frags(int vb0, bf16x8& f0, bf16x8& f1, bf16x8& f2, bf16x8& f3) {
    s16x4 l0, l1, l2, l3, h0, h1, h2, h3; constexpr int b_ = VOFF + v_rd_off(D0, 0, 0);
    TRRD(l0, vb0, b_); TRRD(h0, vb0, b_ + 2048); TRRD(l1, vb0, b_ + 4096); TRRD(h1, vb0, b_ + 6144); TRRD(l2, vb0, b_ + 8192); TRRD(h2, vb0, b_ + 10240); TRRD(l3, vb0, b_ + 12288); TRRD(h3, vb0, b_ + 14336);
    asm volatile("s_waitcnt lgkmcnt(0)" ::: "memory"); SBAR();
    f0 = (bf16x8){l0[0], l0[1], l0[2], l0[3], h0[0], h0[1], h0[2], h0[3]}; f1 = (bf16x8){l1[0], l1[1], l1[2], l1[3], h1[0], h1[1], h1[2], h1[3]};
    f2 = (bf16x8){l2[0], l2[1], l2[2], l2[3], h2[0], h2[1], h2[2], h2[3]}; f3 = (bf16x8){l3[0], l3[1], l3[2], l3[3], h3[0], h3[1], h3[2], h3[3]};
}

struct MobaRef { const bf16_t* Q; const bf16_t* K; const bf16_t* V; bf16_t* O; const unsigned* sel; int qb; };
struct MobaSeam { bf16x8 qr[8]; bf16x8 st_v0, st_v1, st_k0, st_k1; unsigned sel; };
#define AROW(p, k0, rr) ((p) + (size_t)((k0) + (rr)) * APITCH + sc)
#define VMW() asm volatile("s_waitcnt vmcnt(0)" ::: "memory")
#define VMWN(n) asm volatile("s_waitcnt vmcnt(%0)" :: "i"(n) : "memory")
#define SLOAD_H(Kp, Vp, k0) do { S.st_v0 = load8(AROW(Vp, k0, sr)); S.st_v1 = load8(AROW(Vp, k0, 32 + sr));              \
                         S.st_k0 = load8(AROW(Kp, k0, sr)); S.st_k1 = load8(AROW(Kp, k0, 32 + sr)); } while (0)
#define SWRITE_HK(bf) do { *(LAS bf16x8*)(K_lds + (bf) * SHM_K + kws) = S.st_k0; *(LAS bf16x8*)(K_lds + (bf) * SHM_K + kws + 32 * 256) = S.st_k1; } while (0)
#define SWRITE_HV(bf) do { *(LAS bf16x8*)(V_lds + (bf) * SHM_V + vst0) = S.st_v0; *(LAS bf16x8*)(V_lds + (bf) * SHM_V + vst1) = S.st_v1; } while (0)
#define SWRITE_H(bf) do { SWRITE_HV(bf); SWRITE_HK(bf); } while (0)

__device__ __forceinline__ void moba_prime(const MobaRef& cur, lptr lds, MobaSeam& S) {
    int tid = threadIdx.x; asm volatile("" : "+v"(tid)); const int wid = __builtin_amdgcn_readfirstlane(tid >> 6), lane = tid & 63, r32 = lane & 31, hi = lane >> 5;
    const int sr = tid >> 4, sc = (tid & 15) * 8, kws = KSWZ(sr, sc * 2); lptr K_lds = lds + 2 * SHM_V;
#pragma unroll
    for (int d0 = 0; d0 < 8; ++d0) S.qr[d0] = load8(cur.Q + (size_t)(wid * QBLK + r32) * APITCH + d0 * 16 + hi * 8);
    S.sel = cur.sel[wid * QBLK + r32];
    SLOAD_H(cur.K, cur.V, 0); VMW(); SWRITE_HK(0);
    __syncthreads();
}
__device__ __forceinline__ void moba_block(const MobaRef& cur, const MobaRef& nxt, lptr lds, MobaSeam& S) {
    int tid = threadIdx.x; asm volatile("" : "+v"(tid)); const int wid = __builtin_amdgcn_readfirstlane(tid >> 6), lane = tid & 63, r32 = lane & 31, hi = lane >> 5;
    const int qb = cur.qb, NT = 4 * (qb + 1);
    const int qlo = qb * QB + wid * QBLK, qm = qlo + r32 - 4 * hi;
    const unsigned sel = S.sel;
    lptr V_lds = lds; lptr K_lds = lds + 2 * SHM_V;
    LAS float* ws = (LAS float*)(lds + 2 * SHM_V + 2 * SHM_K) + wid * 64; LAS float* li_l = ws; LAS float* al_l = ws + 32;
    float m_reg = -1e30f, l_reg = 0; f32x16 o[4] = {};
    const int sr = tid >> 4, sc = (tid & 15) * 8, vst0 = v_st(sr, sc), vst1 = v_st(32 + sr, sc), kws = KSWZ(sr, sc * 2);
    const int vb0 = (int)(uintptr_t)V_lds + v_rd_base(lane);
    const bf16_t* Kh = cur.K; const bf16_t* Vh = cur.V;
    const float NEG = -__builtin_inff();
#define RESC(a) do { if (__any((a) < 1.f)) { if (hi == 0) al_l[r32] = (a); asm volatile("s_waitcnt lgkmcnt(0)" ::: "memory");              \
                     _Pragma("unroll") for (int d_ = 0; d_ < 4; ++d_) _Pragma("unroll") for (int r = 0; r < 16; ++r) o[d_][r] *= al_l[crow(r, hi)]; } } while (0)
#define KBASE(t) ((t) * KVBLK)
#define MASKT(P0_, P1_, t) do { const int kb_ = KBASE(t); const int jb_ = (t) >> 2;                                              \
        if (jb_ == qb) { if (kb_ + KVBLK - 1 > qlo) { const int dq_ = qm - kb_;                                                    \
            _Pragma("unroll") for (int r = 0; r < 16; ++r) { const int c_ = (r & 3) + 8 * (r >> 2);                                \
                if (dq_ - c_ < 0) P0_[r] = NEG; if (dq_ - c_ - 32 < 0) P1_[r] = NEG; } } }                                         \
        } while (0)
#define SELINIT(t) ((((t) >> 2) == qb || ((sel >> ((t) >> 2)) & 1u)) ? 0.f : NEG)
    constexpr int NQL = 9;
#define SEAM_K0() do { VMWN(NQL); SWRITE_HK(0); SBAR(); } while (0)
    f32x16 pA0, pA1, pB0, pB1; float mnA, mnB, alA, alB; bf16x8 pa0, pa1, pa2, pa3;
    SWRITE_HV(0); SBAR();
    SLOAD_H(Kh, Vh, KBASE(1));
    SBAR(); qkt<0>(pA0, pA1, K_lds, r32, hi, S.qr, SELINIT(0));
    MASKT(pA0, pA1, 0); partialSM(pA0, pA1, m_reg, mnA, alA);
    VMW(); SWRITE_H(1);
    __syncthreads();
#define HALF_STEP(PX0, PX1, mnX, alX, PY0, PY1, alY, t, KB, VB, SB) do {                                                      \
        SBAR(); qkt<KB>(PX0, PX1, K_lds, r32, hi, S.qr, SELINIT(t));                                                           \
        finishSM(PY0, PY1, alY, l_reg, pa0, pa1, pa2, pa3); SBAR();                                                           \
        if ((t) + 1 < NT) { SLOAD_H(Kh, Vh, KBASE((t) + 1)); SBAR(); }                                                        \
        pv_tile<VB * SHM_V>(o, vb0, pa0, pa1, pa2, pa3); MASKT(PX0, PX1, (t)); partialSM(PX0, PX1, m_reg, mnX, alX);          \
        __syncthreads();                                                                                                      \
        if ((t) + 1 < NT) { VMW(); SWRITE_H(SB); }                                                                            \
        RESC(alX); __syncthreads(); } while (0)
    for (int t = 1; t + 1 < NT; t += 2) {
        HALF_STEP(pB0, pB1, mnB, alB, pA0, pA1, alA, t, 1, 0, 0);
        HALF_STEP(pA0, pA1, mnA, alA, pB0, pB1, alB, t + 1, 0, 1, 1);
    }
    SBAR(); qkt<1>(pB0, pB1, K_lds, r32, hi, S.qr, SELINIT(NT - 1)); SBAR();
    SLOAD_H(nxt.K, nxt.V, 0); SBAR();
#pragma unroll
    for (int d0 = 0; d0 < 8; ++d0) S.qr[d0] = load8(nxt.Q + (size_t)(wid * QBLK + r32) * APITCH + d0 * 16 + hi * 8);
    S.sel = nxt.sel[wid * QBLK + r32];
    SBAR();
    finishSM(pA0, pA1, alA, l_reg, pa0, pa1, pa2, pa3); SBAR();
    pv_tile<0>(o, vb0, pa0, pa1, pa2, pa3);
    MASKT(pB0, pB1, NT - 1); partialSM(pB0, pB1, m_reg, mnB, alB); __syncthreads(); RESC(alB);
    finishSM(pB0, pB1, alB, l_reg, pa0, pa1, pa2, pa3); SBAR(); pv_tile<SHM_V>(o, vb0, pa0, pa1, pa2, pa3);
    SBAR(); SEAM_K0();
    if (hi == 0) li_l[r32] = l_reg; asm volatile("s_waitcnt lgkmcnt(0)" ::: "memory");
    float rli[16];
#pragma unroll
    for (int r = 0; r < 16; ++r) rli[r] = __builtin_amdgcn_rcpf(li_l[crow(r, hi)]);
    bf16_t* Ow = cur.O + (size_t)(wid * QBLK) * OPITCH;
#pragma unroll
    for (int r = 0; r < 16; ++r) { const int orow = crow(r, hi);
#pragma unroll
        for (int d0 = 0; d0 < 4; ++d0) { const float v = o[d0][r] * rli[r];
            const float vn = __shfl_xor(v, 1);
            if ((r32 & 1) == 0) *(unsigned*)(Ow + (size_t)orow * OPITCH + d0 * 32 + r32) = cvt_pk_bf16(v, vn); } }
    __syncthreads();
#undef RESC
#undef KBASE
#undef MASKT
#undef SELINIT
#undef SEAM_K0
#undef HALF_STEP
}

__device__ __forceinline__ MobaRef moba_ref(const Params& p, int bh, int qb) {
    const int b = bh / MH, h = bh % MH;
    const bf16_t* proj = (const bf16_t*)(p.ws + WS_PROJ); bf16_t* mixed = (bf16_t*)(p.ws + WS_MIXED); const unsigned* selp = (const unsigned*)(p.ws + WS_SEL);
    MobaRef r; const size_t tok0 = (size_t)b * SEQ;
    r.Q = proj + (tok0 + (size_t)qb * QB) * APITCH + C_MQ + h * HD; r.K = proj + tok0 * APITCH + C_MK + h * HD; r.V = proj + tok0 * APITCH + C_MV + h * HD;
    r.O = mixed + (tok0 + (size_t)qb * QB) * OPITCH + h * HD; r.sel = selp + (size_t)bh * SEQ + qb * QB; r.qb = qb; return r;
}
__device__ __forceinline__ void phase_moba(const Params& p, lptr lds) {
    const int G = gridDim.x; const int bx = blockIdx.x; const int vcu = (G % 8 == 0) ? (bx % 8) * (G / 8) + bx / 8 : bx;
    constexpr int NITEM = NBATCH * MH * 8;
    int L = vcu; if (L >= NITEM) return;
    int pass = 0;
    MobaRef cur = moba_ref(p, L >> 3, L & 7);
    MobaSeam S;
    moba_prime(cur, lds, S);
    for (;;) {
        const bool more_pass = pass == 0, more_item = L + G < NITEM, last = !more_pass && !more_item;
        int Ln = L, passn = 1;
        if (!more_pass) { passn = 0; Ln = more_item ? L + G : L; }
        const MobaRef nxt = last ? cur : moba_ref(p, Ln >> 3, passn ? 15 - (Ln & 7) : (Ln & 7));
        moba_block(cur, nxt, lds, S);
        if (last) break;
        cur = nxt; pass = passn; L = Ln;
    }
}
#undef SLOAD_H
#undef SWRITE_HK
#undef SWRITE_HV
#undef SWRITE_H
#undef VMWN
}
namespace att {
__device__ __forceinline__ void stage_vstyle(lptr dst, const bf16_t* src, size_t pitch, int tid) {
    const int sr = tid >> 4, sc = (tid & 15) * 8;
    const bf16x8 a = load8(src + (size_t)sr * pitch + sc), b = load8(src + (size_t)(32 + sr) * pitch + sc);
    *(LAS bf16x8*)(dst + v_st(sr, sc)) = a; *(LAS bf16x8*)(dst + v_st(32 + sr, sc)) = b;
}
__device__ __forceinline__ void stage_kstyle(lptr dst, const bf16_t* src, size_t pitch, int tid) {
    const int sr = tid >> 4, sc = (tid & 15) * 8;
    const bf16x8 a = load8(src + (size_t)sr * pitch + sc), b = load8(src + (size_t)(32 + sr) * pitch + sc);
    *(LAS bf16x8*)(dst + KSWZ(sr, sc * 2)) = a; *(LAS bf16x8*)(dst + KSWZ(sr, sc * 2) + 32 * 256) = b;
}

__device__ __forceinline__ void phase_moba_select(const Params& p, lptr lds, int tid_) { int tid = tid_; asm volatile("" : "+v"(tid));
    const bf16_t* proj = (const bf16_t*)(p.ws + WS_PROJ); const float* kmean = (const float*)(p.ws + WS_KMEAN); unsigned* selp = (unsigned*)(p.ws + WS_SEL);
    constexpr int QP = 272;
    lptr ql = lds; LAS float* kml = (LAS float*)(lds + 256 * QP); LAS float* gl = (LAS float*)(lds + 256 * QP + 8192);
    for (int u = blockIdx.x; u < NBATCH * MH * NBLK; u += gridDim.x) {
        const int bh = u / NBLK, qb = u % NBLK, b = bh / MH, h = bh % MH;
        if (qb == 0) { if (tid < 256) selp[(size_t)bh * SEQ + tid] = 0u; continue; }
        const bf16_t* qsrc = proj + ((size_t)b * SEQ + qb * 256) * NPROJ + C_MQ + h * HD;
        for (int i = tid; i < 256 * 16; i += NTHREADS) { const int r = i >> 4, ch = i & 15; *(LAS bf16x8*)(ql + r * QP + ch * 16) = load8(qsrc + (size_t)r * NPROJ + ch * 8); }
        for (int i = tid; i < 16 * 128 / 4; i += NTHREADS) *(LAS f32x4*)(kml + i * 4) = *(const f32x4*)(kmean + (size_t)bh * NBLK * HD + i * 4);
        __syncthreads();
        const int q = tid & 255, ng = tid >> 8;
        float g[8];
#pragma unroll
        for (int n = 0; n < 8; ++n) g[n] = 0.f;
        for (int ch = 0; ch < 16; ++ch) {
            const u32x4 qw = *(const LAS u32x4*)(ql + q * QP + ch * 16);
            const float qv[8] = {bflo(qw.x), bfhi(qw.x), bflo(qw.y), bfhi(qw.y), bflo(qw.z), bfhi(qw.z), bflo(qw.w), bfhi(qw.w)};
#pragma unroll
            for (int n = 0; n < 8; ++n) { if (ng * 8 + n < qb) {
                const f32x4 k0 = *(const LAS f32x4*)(kml + (ng * 8 + n) * 128 + ch * 8), k1 = *(const LAS f32x4*)(kml + (ng * 8 + n) * 128 + ch * 8 + 4);
                g[n] += qv[0] * k0[0] + qv[1] * k0[1] + qv[2] * k0[2] + qv[3] * k0[3] + qv[4] * k1[0] + qv[5] * k1[1] + qv[6] * k1[2] + qv[7] * k1[3]; } }
        }
#pragma unroll
        for (int n = 0; n < 8; ++n) gl[q * 16 + ng * 8 + n] = g[n];
        __syncthreads();
        if (tid < 256) {
            float gv[16];
#pragma unroll
            for (int n = 0; n < 16; ++n) gv[n] = (n < qb) ? gl[tid * 16 + n] : -__builtin_inff();
            unsigned m = 0u;
#pragma unroll
            for (int k = 0; k < 3; ++k) { float best = -__builtin_inff(); int bi = -1;
#pragma unroll
                for (int n = 0; n < 16; ++n) { const bool tk = gv[n] > best; best = tk ? gv[n] : best; bi = tk ? n : bi; }
                if (bi >= 0) m |= 1u << bi;
#pragma unroll
                for (int n = 0; n < 16; ++n) gv[n] = (n == bi) ? -__builtin_inff() : gv[n]; }
            selp[(size_t)bh * SEQ + qb * 256 + tid] = m;
        }
        __syncthreads();
    }
}

__device__ __forceinline__ void phase_gla_state(const Params& p, lptr lds, int tid_) { int tid = tid_; asm volatile("" : "+v"(tid));
    const bf16_t* proj = (const bf16_t*)(p.ws + WS_PROJ); const float* dend = (const float*)(p.ws + WS_DEND); float* U = (float*)(p.ws + WS_U);
    const int wid = __builtin_amdgcn_readfirstlane(tid >> 6), lane = tid & 63, r32 = lane & 31, hi = lane >> 5;
    const int dkb = wid & 3, half = wid >> 2;
    const int vb0 = (int)(uintptr_t)lds + v_rd_base(lane);
    for (int u = blockIdx.x; u < NBATCH * GH * NBLK; u += gridDim.x) {
        const int bh = u / NBLK, j = u % NBLK, b = bh / GH, h = bh % GH;
        const size_t tok0 = (size_t)b * SEQ + j * 256;
        f32x16 o[4] = {};
        for (int t = 0; t < 4; ++t) {
            __syncthreads();
            const bf16_t* rowp = proj + (tok0 + t * 64) * NPROJ;
            stage_vstyle(lds, rowp + C_GK + h * GDK, NPROJ, tid);
            stage_vstyle(lds + SHM_V, rowp + C_GV + h * GDV, NPROJ, tid);
            stage_vstyle(lds + 2 * SHM_V, rowp + C_GV + h * GDV + 128, NPROJ, tid);
            __syncthreads();
            bf16x8 a0, a1, a2, a3;
            if (dkb == 0) tr_frags<0, 0>(vb0, a0, a1, a2, a3); else if (dkb == 1) tr_frags<0, 1>(vb0, a0, a1, a2, a3); else if (dkb == 2) tr_frags<0, 2>(vb0, a0, a1, a2, a3); else tr_frags<0, 3>(vb0, a0, a1, a2, a3);
            if (half == 0) pv_tile<SHM_V>(o, vb0, a0, a1, a2, a3); else pv_tile<2 * SHM_V>(o, vb0, a0, a1, a2, a3);
        }
        float dv[16];
#pragma unroll
        for (int r = 0; r < 16; ++r) dv[r] = dend[(size_t)u * GDK + dkb * 32 + crow(r, hi)];
        float* Uo = U + (size_t)u * (GDK * GDV);
#pragma unroll
        for (int r = 0; r < 16; ++r) { const int k = dkb * 32 + crow(r, hi);
#pragma unroll
            for (int d0 = 0; d0 < 4; ++d0) Uo[(size_t)k * GDV + half * 128 + d0 * 32 + r32] = o[d0][r] * dv[r]; }
    }
    __syncthreads();
}

__device__ __forceinline__ void phase_gla_scan(const Params& p, int tid_) { int tid = tid_; asm volatile("" : "+v"(tid));
    const float* U = (const float*)(p.ws + WS_U); const float* dend = (const float*)(p.ws + WS_DEND); bf16_t* Sj = (bf16_t*)(p.ws + WS_SJ);
    constexpr int NEL = NBATCH * GH * GDK * GDV / 4;
    for (int i = blockIdx.x * NTHREADS + tid; i < NEL; i += gridDim.x * NTHREADS) {
        const int bh = i / (GDK * GDV / 4), e4 = i % (GDK * GDV / 4), k = e4 / (GDV / 4);
        f32x4 S = {0.f, 0.f, 0.f, 0.f};
        f32x4 uv[NBLK]; float dd[NBLK];
#pragma unroll
        for (int j = 0; j < NBLK; ++j) { uv[j] = *(const f32x4*)(U + ((size_t)(bh * NBLK + j) * (GDK * GDV)) + (size_t)e4 * 4); dd[j] = dend[(size_t)(bh * NBLK + j) * GDK + k]; }
#pragma unroll
        for (int j = 0; j < NBLK; ++j) {
            u32x2 w; w.x = cvt_pk_bf16(S[0], S[1]); w.y = cvt_pk_bf16(S[2], S[3]);
            *(u32x2*)(Sj + ((size_t)(bh * NBLK + j) * (GDK * GDV)) + (size_t)e4 * 4) = w;
            S = S * dd[j] + uv[j]; }
    }
}

__device__ __forceinline__ void phase_gla_out(const Params& p, lptr lds, int tid_) { int tid = tid_; asm volatile("" : "+v"(tid));
    const bf16_t* proj = (const bf16_t*)(p.ws + WS_PROJ); const bf16_t* Sj = (const bf16_t*)(p.ws + WS_SJ); bf16_t* mixed = (bf16_t*)(p.ws + WS_MIXED);
    const int wid = __builtin_amdgcn_readfirstlane(tid >> 6), lane = tid & 63, r32 = lane & 31, hi = lane >> 5;
    constexpr int BUF = 3 * SHM_V;
    const int vb0 = (int)(uintptr_t)lds + v_rd_base(lane), vb1 = vb0 + BUF;
    const int sr = tid >> 4, sc = (tid & 15) * 8;
    const int kws = KSWZ(sr, sc * 2), vst0 = v_st(sr, sc), vst1 = v_st(32 + sr, sc);
    for (int u = blockIdx.x; u < NBATCH * GH * NBLK; u += gridDim.x) {
        const int bh = u / NBLK, j = u % NBLK, b = bh / GH, h = bh % GH;
        const size_t tok0 = (size_t)b * SEQ + j * 256;
        bf16x8 qr[8];
#pragma unroll
        for (int d0 = 0; d0 < 8; ++d0) qr[d0] = load8(proj + (tok0 + wid * 32 + r32) * NPROJ + C_GQ + h * GDK + d0 * 16 + hi * 8);
        f32x16 o[8] = {};
        bf16x8 sk0, sk1, sa0, sa1, sb0, sb1;
        const bf16_t* sp = Sj + (size_t)u * (GDK * GDV);
#define GO_LOAD(s_) do { if ((s_) < 4) { const bf16_t* rp = proj + (tok0 + (s_) * 64) * NPROJ; \
            sk0 = load8(rp + (size_t)sr * NPROJ + C_GK + h * GDK + sc); sk1 = load8(rp + (size_t)(32 + sr) * NPROJ + C_GK + h * GDK + sc); \
            sa0 = load8(rp + (size_t)sr * NPROJ + C_GV + h * GDV + sc); sa1 = load8(rp + (size_t)(32 + sr) * NPROJ + C_GV + h * GDV + sc); \
            sb0 = load8(rp + (size_t)sr * NPROJ + C_GV + h * GDV + 128 + sc); sb1 = load8(rp + (size_t)(32 + sr) * NPROJ + C_GV + h * GDV + 128 + sc); } \
          else { const bf16_t* rp = sp + (size_t)((s_) - 4) * 64 * GDV; \
            sa0 = load8(rp + (size_t)sr * GDV + sc); sa1 = load8(rp + (size_t)(32 + sr) * GDV + sc); \
            sb0 = load8(rp + (size_t)sr * GDV + 128 + sc); sb1 = load8(rp + (size_t)(32 + sr) * GDV + 128 + sc); } } while (0)
#define GO_WRITE(s_, bufo) do { if ((s_) < 4) { *(LAS bf16x8*)(lds + (bufo) + kws) = sk0; *(LAS bf16x8*)(lds + (bufo) + kws + 32 * 256) = sk1; } \
            *(LAS bf16x8*)(lds + (bufo) + SHM_V + vst0) = sa0; *(LAS bf16x8*)(lds + (bufo) + SHM_V + vst1) = sa1; \
            *(LAS bf16x8*)(lds + (bufo) + 2 * SHM_V + vst0) = sb0; *(LAS bf16x8*)(lds + (bufo) + 2 * SHM_V + vst1) = sb1; } while (0)
#define GO_STEP(s_, B_) do { GO_LOAD(s_); __syncthreads(); GO_WRITE(s_, (B_) * BUF); __syncthreads(); \
            if ((s_) < 4) { if ((s_) * 64 <= wid * 32 + 31) { f32x16 p0, p1; qkt<0>(p0, p1, lds + (B_) * BUF, r32, hi, qr); \
                    const int dq = wid * 32 + r32 - 4 * hi - (s_) * 64; \
                    _Pragma("unroll") for (int r = 0; r < 16; ++r) { const int c_ = (r & 3) + 8 * (r >> 2); if (dq - c_ < 0) p0[r] = 0.f; if (dq - c_ - 32 < 0) p1[r] = 0.f; } \
                    bf16x8 pa0, pa1, pa2, pa3; pack_p(p0, p1, pa0, pa1, pa2, pa3); \
                    pv_tile<SHM_V>(o, (B_) ? vb1 : vb0, pa0, pa1, pa2, pa3); pv_tile<2 * SHM_V>(o + 4, (B_) ? vb1 : vb0, pa0, pa1, pa2, pa3); } } \
            else { pv_tile<SHM_V>(o, (B_) ? vb1 : vb0, qr[4 * ((s_) - 4)], qr[4 * ((s_) - 4) + 1], qr[4 * ((s_) - 4) + 2], qr[4 * ((s_) - 4) + 3]); \
                   pv_tile<2 * SHM_V>(o + 4, (B_) ? vb1 : vb0, qr[4 * ((s_) - 4)], qr[4 * ((s_) - 4) + 1], qr[4 * ((s_) - 4) + 2], qr[4 * ((s_) - 4) + 3]); } } while (0)
        GO_STEP(0, 0); GO_STEP(1, 0); GO_STEP(2, 0); GO_STEP(3, 0); GO_STEP(4, 0); GO_STEP(5, 0);
#undef GO_LOAD
#undef GO_WRITE
#undef GO_STEP
        int hi_e = hi, r32_e = r32; asm volatile("" : "+v"(hi_e), "+v"(r32_e));
        float wv[8];
#pragma unroll
        for (int d0 = 0; d0 < 8; ++d0) wv[d0] = p.gla_norm_w[d0 * 32 + r32_e];
        const bf16_t* ggp = proj + (tok0 + wid * 32) * NPROJ + C_GG + h * GDV + r32_e;
        bf16_t* op = mixed + (tok0 + wid * 32) * DM + 1024 + h * GDV + r32_e;
#pragma unroll
        for (int r = 0; r < 16; ++r) { const int orow = crow(r, hi_e);
            float g[8];
#pragma unroll
            for (int d0 = 0; d0 < 8; ++d0) g[d0] = bf2f(ggp[(size_t)orow * NPROJ + d0 * 32]);
            float ss = 0.f;
#pragma unroll
            for (int d0 = 0; d0 < 8; ++d0) ss += o[d0][r] * o[d0][r];
            ss += __shfl_xor(ss, 1); ss += __shfl_xor(ss, 2); ss += __shfl_xor(ss, 4); ss += __shfl_xor(ss, 8); ss += __shfl_xor(ss, 16);
            const float rsr = 1.0f / sqrtf(ss * (1.0f / GDV) + EPS);
#pragma unroll
            for (int d0 = 0; d0 < 8; ++d0) { const float sg = g[d0] * __builtin_amdgcn_rcpf(1.0f + __expf(-g[d0]));
                const float v = o[d0][r] * rsr * wv[d0] * sg; const float vn = __shfl_xor(v, 1);
                if ((r32_e & 1) == 0) *(unsigned*)(op + (size_t)orow * DM + d0 * 32) = cvt_pk_bf16(v, vn); }
            asm volatile("" ::: "memory"); }
    }
    __syncthreads();
}
}

__device__ __forceinline__ void phase_route(const Params& p, const Ctx& c0) { const Ctx c = fresh_ctx(c0);
    const int* hist = (const int*)(p.ws + WS_HIST); const int* topi = (const int*)(p.ws + WS_TOPI); const float* rstd2 = (const float*)(p.ws + WS_RSTD2);
    int* dest = (int*)(p.ws + WS_DEST); int* row_tok = (int*)(p.ws + WS_ROWTOK); float* row_rstd = (float*)(p.ws + WS_ROWRSTD); int* blk = (int*)(p.ws + WS_BLKE);
    LAS int* cnt = (LAS int*)c.lds; LAS int* before = cnt + 32; LAS int* pstart = cnt + 64; LAS int* ea = cnt + 128;
    for (int g = blockIdx.x; g < T / 64; g += gridDim.x) {
        if (c.tid < 64) cnt[c.tid] = 0;
        __syncthreads();
        { const int e = c.tid & 31, part = c.tid >> 5; int tot = 0, bef = 0;
#pragma unroll
            for (int i = 0; i < 16; ++i) { const int gg = part * 16 + i; const int v = hist[gg * 32 + e]; tot += v; bef += (gg < g) ? v : 0; }
            atomicAdd((int*)&cnt[e], tot); atomicAdd((int*)&before[e], bef); }
        __syncthreads();
        if (c.tid == 0) { int acc = 0; for (int e = 0; e < NE; ++e) { pstart[e] = acc; acc += ((cnt[e] + 255) >> 8) << 8; } pstart[NE] = acc; }
        if (c.tid < 256) ea[c.tid] = topi[(size_t)g * 256 + c.tid];
        __syncthreads();
        if (c.tid < 256) {
            const int e = ea[c.tid]; int rank = 0;
            for (int a = 0; a < c.tid; ++a) rank += (ea[a] == e) ? 1 : 0;
            const int d = pstart[e] + before[e] + rank; const int tok = g * 64 + (c.tid >> 2);
            dest[(size_t)g * 256 + c.tid] = d; row_tok[d] = tok; row_rstd[d] = rstd2[tok];
        }
        if (g == 0 && c.tid < 64) {
            const int nb = pstart[NE] >> 8; if (c.tid == 0) blk[0] = nb;
            for (int bq = c.tid; bq < nb; bq += 64) { int e = 0; for (int q = 0; q < NE; ++q) e += (pstart[q + 1] <= bq * 256) ? 1 : 0; blk[64 + bq] = e < NE ? e : NE - 1; }
        }
        __syncthreads();
    }
}

__device__ __forceinline__ void phase_combine(const Params& p, const Ctx& c0) { const Ctx c = fresh_ctx(c0);
    const float* X1 = (const float*)(p.ws + WS_X1); const unsigned char* Y = (const unsigned char*)(p.ws + WS_Y); const int* dest = (const int*)(p.ws + WS_DEST); const float* topg = (const float*)(p.ws + WS_TOPG);
    for (int t = blockIdx.x * NWAVES + c.wave; t < T; t += gridDim.x * NWAVES) {
        const int4 d4 = *(const int4*)(dest + (size_t)t * 4); const float4 g4 = *(const float4*)(topg + (size_t)t * 4);
        const int dd[4] = {d4.x, d4.y, d4.z, d4.w}; const float gg[4] = {g4.x * (1.0f / Y_SCALE), g4.y * (1.0f / Y_SCALE), g4.z * (1.0f / Y_SCALE), g4.w * (1.0f / Y_SCALE)};
        f32x4 v[8]; u32x2 yw[4][4]; float ss = 0.f;
#pragma unroll
        for (int j = 0; j < 4; ++j) { v[2 * j] = *(const f32x4*)(X1 + (size_t)t * DM + j * 512 + c.lane * 8); v[2 * j + 1] = *(const f32x4*)(X1 + (size_t)t * DM + j * 512 + c.lane * 8 + 4); }
#pragma unroll
        for (int k = 0; k < 4; ++k)
#pragma unroll
            for (int j = 0; j < 4; ++j) yw[k][j] = *(const u32x2*)(Y + (size_t)dd[k] * DM + j * 512 + c.lane * 8);
#pragma unroll
        for (int k = 0; k < 4; ++k)
#pragma unroll
            for (int j = 0; j < 4; ++j) { const f32x2 a = __builtin_amdgcn_cvt_pk_f32_fp8(yw[k][j].x, false), b = __builtin_amdgcn_cvt_pk_f32_fp8(yw[k][j].x, true);
                const f32x2 cc = __builtin_amdgcn_cvt_pk_f32_fp8(yw[k][j].y, false), d = __builtin_amdgcn_cvt_pk_f32_fp8(yw[k][j].y, true);
                v[2 * j][0] += gg[k] * a[0]; v[2 * j][1] += gg[k] * a[1]; v[2 * j][2] += gg[k] * b[0]; v[2 * j][3] += gg[k] * b[1];
                v[2 * j + 1][0] += gg[k] * cc[0]; v[2 * j + 1][1] += gg[k] * cc[1]; v[2 * j + 1][2] += gg[k] * d[0]; v[2 * j + 1][3] += gg[k] * d[1]; }
#pragma unroll
        for (int j = 0; j < 8; ++j) ss += (v[j][0] * v[j][0] + v[j][1] * v[j][1]) + (v[j][2] * v[j][2] + v[j][3] * v[j][3]);
        const float rs = 1.0f / sqrtf(wave_sum(ss) * (1.0f / DM) + EPS);
#pragma unroll
        for (int j = 0; j < 8; ++j) { const int col = (j >> 1) * 512 + c.lane * 8 + (j & 1) * 4; const f32x4 w = *(const f32x4*)(p.final_norm_w + col);
            *(f32x4*)(p.out + (size_t)t * DM + col) = v[j] * rs * w; }
    }
}
__device__ __forceinline__ Ctx make_ctx(unsigned char* lds_generic) {
    Ctx c; c.lds = (LAS unsigned char*)lds_generic; c.tid = threadIdx.x; c.lane = c.tid & 63; c.wave = __builtin_amdgcn_readfirstlane(c.tid >> 6); return c;
}
__device__ __forceinline__ void phase_gemm_inproj16(const Params& p, const Ctx& c, int i0, int i1, int G, int cidx) {
    if (i0 >= i1) return;
    g8::DenseProbIn P{(const bf16_t*)(p.ws + WS_H), (const bf16_t*)(p.ws + WS_WIN), T / 256, NPROJ / 256, DM, G, cidx, i0, i1};
    g8::EpiProj E{(bf16_t*)(p.ws + WS_PROJ), (const float*)(p.ws + WS_RSTD1), 1.0f, 0};
    g8::gemm_phase(c.lds, P, E);
}
__device__ __forceinline__ void phase_gemm_outproj(const Params& p, const Ctx& c, int i0, int i1) {
    if (i0 >= i1) return;
    g8::DenseProbOut P{(const bf16_t*)(p.ws + WS_MIXED), (const bf16_t*)(p.ws + WS_WOUT), T / 256, DM / 256, DM, (int)gridDim.x, (int)blockIdx.x, i0, i1};
    g8::EpiX1 E{p.x, (float*)(p.ws + WS_X1)};
    g8::gemm_phase(c.lds, P, E);
}
__device__ __forceinline__ void phase_gemm_moe1(const Params& p, const Ctx& c, int i0, int i1) {
    g8::MoeProb1 P{(const bf16_t*)(p.ws + WS_H), (const bf16_t*)(p.ws + WS_WGU), (const int*)(p.ws + WS_ROWTOK), (const int*)(p.ws + WS_BLKE), DM / 2, __builtin_amdgcn_readfirstlane(*(const int*)(p.ws + WS_BLKE)), i0, i1};
    g8::EpiSwiglu E{(unsigned char*)(p.ws + WS_ACT), (const float*)(p.ws + WS_ROWRSTD), p.b_gu};
    g8::gemm_phase(c.lds, P, E);
}
__device__ __forceinline__ void phase_gemm_moe2(const Params& p, const Ctx& c) {
    g8::MoeProb2 P{(const bf16_t*)(p.ws + WS_ACT), (const bf16_t*)(p.ws + WS_WD), (const int*)(p.ws + WS_BLKE), FF / 2, __builtin_amdgcn_readfirstlane(*(const int*)(p.ws + WS_BLKE))};
    g8::EpiDown E{(unsigned char*)(p.ws + WS_Y), p.b_d};
    g8::gemm_phase(c.lds, P, E);
}


constexpr int CW_BAR = 4096;
__global__ void __launch_bounds__(NTHREADS, 2) fwd(Params p) {
    extern __shared__ __attribute__((aligned(16))) unsigned char lds_raw[];
    const Ctx c = make_ctx(lds_raw);
    if (c.tid < 64) ((LAS unsigned*)(c.lds + LDS_MISC))[c.tid] = 0u;
    __syncthreads();
    const XcdBarrier bar = xcd_barrier_post((unsigned*)(p.ws + WS_CTL) + CW_BAR, (volatile LAS unsigned*)(c.lds + LDS_MISC + 32));
    const att::lptr al = (att::lptr)c.lds;
    phase_convert(p, c); phase_norm1(p, c);
    xcd_barrier(bar);
    {
        const int bx = blockIdx.x, G = gridDim.x;
        const int cut = (G == 256) ? (bx >> 3) % 7 : 0;
        if (cut > 0) phase_gemm_inproj16(p, c, 0, cut, G, bx);
        phase_convert_share(p, c, 0, CT_GU, G, bx);
        phase_gemm_inproj16(p, c, cut, 1 << 20, G, bx);
    }
    xcd_barrier(bar);
    phase_rope_kmean(p, c); phase_gla_prep(p, c);
    xcd_barrier(bar);
    att::phase_gla_state(p, al, c.tid); att::phase_moba_select(p, al, c.tid);
    xcd_barrier(bar);
    att::phase_gla_scan(p, c.tid);
    xcd_barrier(bar);
    att::phase_gla_out(p, al, c.tid); att::phase_moba(p, al);
    xcd_barrier(bar);
    phase_gemm_outproj(p, c, 0, 1 << 20);
    xcd_barrier(bar);
    phase_norm2_router(p, c);
    xcd_barrier(bar);
    phase_route(p, c);
    xcd_barrier(bar);
    {
        const int cut = 2 * ((blockIdx.x >> 3) & 7);
        if (cut > 0) phase_gemm_moe1(p, c, 0, cut);
        phase_convert_share(p, c, CT_GU, CT_TOTAL, (int)gridDim.x, (int)blockIdx.x);
        phase_gemm_moe1(p, c, cut, 1 << 20);
    }
    xcd_barrier(bar);
    phase_gemm_moe2(p, c);
    xcd_barrier(bar);
    phase_combine(p, c);
}

extern "C" void kernel_launch(void* const* d_in, const int* in_sizes, int n_in, void* d_out, int out_size, void* d_ws, size_t ws_size, hipStream_t stream) {
    static int grid = 0;
    if (grid == 0) {
        if (n_in != 15 || ws_size < WS_END) { fprintf(stderr, "kernel_launch: unexpected inputs (n_in %d, ws %zu)\n", n_in, ws_size); grid = -1; return; }
        int dev = 0, cus = 0, per_cu = 0;
        if (hipGetDevice(&dev) != hipSuccess || hipDeviceGetAttribute(&cus, hipDeviceAttributeMultiprocessorCount, dev) != hipSuccess) { grid = -1; return; }
        if (hipFuncSetAttribute((const void*)fwd, hipFuncAttributeMaxDynamicSharedMemorySize, LDS_BYTES) != hipSuccess) { fprintf(stderr, "kernel_launch: hipFuncSetAttribute failed\n"); grid = -1; return; }
        if (hipOccupancyMaxActiveBlocksPerMultiprocessor(&per_cu, (const void*)fwd, NTHREADS, LDS_BYTES) != hipSuccess || per_cu < 1) { fprintf(stderr, "kernel_launch: occupancy query says %d blocks per CU\n", per_cu); }
        (void)hipGetLastError();
        grid = cus > 0 ? cus : 256;
    }
    if (grid < 0) return;
    Params p{};
    p.x = (const float*)d_in[0]; p.attn_norm_w = (const float*)d_in[1]; p.w_in = (const float*)d_in[2]; p.gate_w2 = (const float*)d_in[3]; p.gate_b = (const float*)d_in[4];
    p.gla_norm_w = (const float*)d_in[5]; p.w_out = (const float*)d_in[6]; p.ffn_norm_w = (const float*)d_in[7]; p.router_w = (const float*)d_in[8]; p.router_b = (const float*)d_in[9];
    p.w_gu = (const float*)d_in[10]; p.b_gu = (const float*)d_in[11]; p.w_d = (const float*)d_in[12]; p.b_d = (const float*)d_in[13]; p.final_norm_w = (const float*)d_in[14];
    p.out = (float*)d_out; p.ws = (unsigned char*)d_ws;
    if (hipMemsetAsync((char*)d_ws + WS_CTL, 0, CTL_BYTES, stream) != hipSuccess) return;
    hipLaunchKernelGGL(fwd, dim3(grid), dim3(NTHREADS), LDS_BYTES, stream, p);
}
```

```cpp
#include <hip/hip_runtime.h>
#include <stdint.h>
#include <stdio.h>

#define LAS __attribute__((address_space(3)))
typedef unsigned short bf16_t;
typedef short bf16x8 __attribute__((ext_vector_type(8)));
typedef short s16x4 __attribute__((ext_vector_type(4)));
typedef float f32x2 __attribute__((ext_vector_type(2)));
typedef float f32x4 __attribute__((ext_vector_type(4)));
typedef float f32x16 __attribute__((ext_vector_type(16)));
typedef unsigned u32x2 __attribute__((ext_vector_type(2)));
typedef unsigned u32x4 __attribute__((ext_vector_type(4)));
typedef int i32x8 __attribute__((ext_vector_type(8)));

constexpr int NBATCH = 4, SEQ = 4096, T = NBATCH * SEQ, DM = 2048;
constexpr int HD = 128, MH = 8, MBLK = 256, NBLK = SEQ / MBLK;
constexpr int GH = 4, GDK = 128, GDV = 256;
constexpr int LDW_IN = 6160, NPROJ = 6144;
constexpr int C_MQ = 0, C_MK = 1024, C_MV = 2048, C_GQ = 3072, C_GK = 3584, C_GV = 4096, C_GG = 5120, C_GZ = 6144;
constexpr int NE = 32, TOPK = 4, FF = 2048, NASSIGN = T * TOPK;
constexpr int MAXBLK = (NASSIGN + NE * 255) / 256, PROWS = MAXBLK * 256;
constexpr float EPS = 1e-5f;
constexpr float ACT_SCALE = 4.0f, W_SCALE = 64.0f, F8_UNSCALE = 1.0f / (ACT_SCALE * W_SCALE);
constexpr float Y_SCALE = 16.0f;

constexpr size_t MiB = (size_t)1 << 20;
constexpr size_t WS_CTL = 0, CTL_BYTES = 64 * 1024;
constexpr size_t WS_WIN = 16 * MiB;
constexpr size_t WS_WOUT = 40 * MiB;
constexpr size_t WS_ROPE = 48 * MiB;
constexpr size_t WS_RSTD1 = 50 * MiB;
constexpr size_t WS_GZ = 51 * MiB;
constexpr size_t WS_KMEAN = 52 * MiB;
constexpr size_t WS_DEND = 52 * MiB + 512 * 1024;
constexpr size_t WS_RSTD2 = 53 * MiB;
constexpr size_t WS_SEL = 54 * MiB;
constexpr size_t WS_TOPI = 55 * MiB;
constexpr size_t WS_TOPG = 55 * MiB + 512 * 1024;
constexpr size_t WS_HIST = 56 * MiB;
constexpr size_t WS_DEST = 56 * MiB + 512 * 1024;
constexpr size_t WS_ROWTOK = 57 * MiB;
constexpr size_t WS_ROWRSTD = 57 * MiB + 512 * 1024;
constexpr size_t WS_BLKE = 58 * MiB;
constexpr size_t WS_H = 64 * MiB;
constexpr size_t WS_PROJ = 128 * MiB;
constexpr size_t WS_MIXED = 320 * MiB;
constexpr size_t WS_X1 = 384 * MiB;
constexpr size_t WS_U = 512 * MiB;
constexpr size_t WS_SJ = 544 * MiB;
constexpr size_t WS_WGU = 640 * MiB;
constexpr size_t WS_WD = 1152 * MiB;
constexpr size_t WS_ACT = 1408 * MiB;
constexpr size_t WS_Y = 1696 * MiB;
constexpr size_t WS_END = 1984 * MiB;

constexpr int NTHREADS = 512, NWAVES = 8;
constexpr int LDS_BYTES = 149504;
constexpr int LDS_MISC = LDS_BYTES - 256;

struct Params {
    const float* x; const float* attn_norm_w; const float* w_in; const float* gate_w2; const float* gate_b; const float* gla_norm_w;
    const float* w_out; const float* ffn_norm_w; const float* router_w; const float* router_b; const float* w_gu; const float* b_gu;
    const float* w_d; const float* b_d; const float* final_norm_w;
    float* out; unsigned char* ws;
};

__device__ __forceinline__ unsigned cvt_pk_bf16(float lo, float hi) { unsigned r; asm volatile("v_cvt_pk_bf16_f32 %0, %1, %2" : "=v"(r) : "v"(lo), "v"(hi)); return r; }
__device__ __forceinline__ unsigned cvt4_fp8(float a, float b, float c, float d) { unsigned w = 0u; w = __builtin_amdgcn_cvt_pk_fp8_f32(a, b, w, false); w = __builtin_amdgcn_cvt_pk_fp8_f32(c, d, w, true); return w; }
__device__ __forceinline__ float bf2f(unsigned short b) { return __uint_as_float(((unsigned)b) << 16); }
__device__ __forceinline__ float bflo(unsigned w) { return __uint_as_float(w << 16); }
__device__ __forceinline__ float bfhi(unsigned w) { return __uint_as_float(w & 0xffff0000u); }
__device__ __forceinline__ bf16x8 pack8(f32x4 a, f32x4 b) {
    u32x4 w = {cvt_pk_bf16(a[0], a[1]), cvt_pk_bf16(a[2], a[3]), cvt_pk_bf16(b[0], b[1]), cvt_pk_bf16(b[2], b[3])};
    return __builtin_bit_cast(bf16x8, w);
}
__device__ __forceinline__ float wave_sum(float v) {
#pragma unroll
    for (int o = 1; o < 64; o <<= 1) v += __shfl_xor(v, o);
    return v;
}
#define LDS_WAIT() asm volatile("s_waitcnt lgkmcnt(0)" ::: "memory")
#define VM_WAIT() asm volatile("s_waitcnt vmcnt(0)" ::: "memory")
#define SBAR() __builtin_amdgcn_sched_barrier(0)
#define XB_TMO      128
#define XB_XCNT(j)  (256  + 64 * (j))
#define XB_XSUB(j)  (1280 + 64 * (j))
#define XB_XGEN(j)  (2304 + 64 * (j))
#define XB_TOP      3328
#define XB_TOPGEN   3392
#define XCD_BAR_WORDS 3456
#define XB_SPIN_CAP (1u << 18)

__device__ __forceinline__ unsigned xb_ld(unsigned* p)              { return __hip_atomic_load(p, __ATOMIC_RELAXED, __HIP_MEMORY_SCOPE_AGENT); }
__device__ __forceinline__ unsigned xb_add(unsigned* p, unsigned v) { return __hip_atomic_fetch_add(p, v, __ATOMIC_RELAXED, __HIP_MEMORY_SCOPE_AGENT); }
__device__ __forceinline__ unsigned xb_xcc_id() { return (unsigned)__builtin_amdgcn_s_getreg((3 << 11) | 20) & 0xFu; }
#define XB_SPIN(cond, bar) do { unsigned _sp = 0; while (cond) { __builtin_amdgcn_s_sleep(1); \
    if ((++_sp & 255u) == 0u) { if (xb_ld(&(bar)[XB_TMO])) break; if (_sp > XB_SPIN_CAP) { atomicAdd(&(bar)[XB_TMO], 1u); break; } } } } while (0)

struct XcdBarrier {
    unsigned* bar; unsigned x;
    volatile LAS unsigned* st;
};

__device__ __forceinline__ XcdBarrier xcd_barrier_post(unsigned* bar, volatile LAS unsigned* st) {
    XcdBarrier b; b.bar = bar; b.x = xb_xcc_id(); b.st = st;
    if (threadIdx.x == 0) (void)xb_add(&bar[XB_XCNT(b.x)], 1u);
    return b;
}
__device__ __forceinline__ void xcd_barrier_complete(unsigned* bar, unsigned x, unsigned& nloc, unsigned& nx) {
    const unsigned G = gridDim.x * gridDim.y * gridDim.z;
    unsigned sum, cnt, mine, sp = 0u;
    for (;;) {
        sum = 0u; cnt = 0u; mine = 0u;
#pragma unroll
        for (unsigned j = 0; j < 16; ++j) { const unsigned c = xb_ld(&bar[XB_XCNT(j)]); sum += c; cnt += (c > 0u) ? 1u : 0u; mine = (j == x) ? c : mine; }
        if (sum == G) break;
        __builtin_amdgcn_s_sleep(1);
        if ((++sp & 255u) == 0u) { if (xb_ld(&bar[XB_TMO])) break; if (sp > XB_SPIN_CAP) { atomicAdd(&bar[XB_TMO], 1u); break; } }
    }
    nloc = mine > 0u ? mine : 1u; nx = cnt > 0u ? cnt : 1u;
}

__device__ __forceinline__ void xcd_barrier(const XcdBarrier& b) {
    asm volatile("s_waitcnt vmcnt(0)" ::: "memory");
    __syncthreads();
    if (threadIdx.x == 0) {
        unsigned* bar = b.bar;
        __builtin_amdgcn_s_waitcnt(0);
        unsigned nloc = b.st[0], nx = b.st[1];
        if (nloc == 0u) { xcd_barrier_complete(bar, b.x, nloc, nx); b.st[0] = nloc; b.st[1] = nx; }
        const unsigned old = xb_add(&bar[XB_XSUB(b.x)], 1u);
        const unsigned gen = old / nloc;
        if (old + 1u == (gen + 1u) * nloc) {
            __builtin_amdgcn_fence(__ATOMIC_RELEASE, "agent");
            asm volatile("s_waitcnt vmcnt(0)" ::: "memory");
            const unsigned og = xb_add(&bar[XB_TOP], 1u);
            const unsigned tg = og / nx;
            if (og + 1u == (tg + 1u) * nx) xb_add(&bar[XB_TOPGEN], 1u);
            else XB_SPIN(xb_ld(&bar[XB_TOPGEN]) == tg, bar);
            __builtin_amdgcn_fence(__ATOMIC_ACQUIRE, "agent");
            xb_add(&bar[XB_XGEN(b.x)], 1u);
            asm volatile("s_waitcnt vmcnt(0)" ::: "memory");
        } else {
            XB_SPIN(xb_ld(&bar[XB_XGEN(b.x)]) == gen, bar);
            __builtin_amdgcn_fence(__ATOMIC_ACQUIRE, "agent");
            asm volatile("s_waitcnt vmcnt(0)" ::: "memory");
        }
    }
    __syncthreads();
}

namespace g8 {
constexpr int BM = 256, BK = 64, HALF = 128, HTB = HALF * BK * 2, STAGE_BYTES = 8 * HTB, NXCD = 8, WGM = 8;
__host__ __device__ __forceinline__ int lds_byte(int r, int c) { const int st = (r >> 4) * 2 + (c >> 5), rr = r & 15, cc = c & 31, ob = rr * 64 + cc * 2; return st * 1024 + (ob ^ (((ob >> 9) & 1) << 5)); }
__host__ __device__ __forceinline__ void stage_rc(int b, int& R, int& C) { const int st = b / 1024, sb = b % 1024, swz = sb ^ (((sb >> 9) & 1) << 5); R = (st >> 1) * 16 + swz / 64; C = (st & 1) * 32 + (swz % 64) / 2; }
__host__ __device__ __forceinline__ int perm32(int rho) { const int n = rho >> 4, i = rho & 15; return 8 * (i >> 2) + 4 * n + (i & 3); }

struct Unit { int pm, pn, e; };

template <int WGM_>
__device__ __forceinline__ bool static_next(int i, int nM, int nN, int G, int c, Unit& u) {
    const int nwg = nM * nN; const long L = (long)i * G + c; if (L >= nwg) return false;
    int wgid = (int)L; { const int q = nwg / NXCD, r = nwg % NXCD, xcd = wgid % NXCD, off = wgid / NXCD; wgid = (xcd < r ? xcd * (q + 1) : r * (q + 1) + (xcd - r) * q) + off; }
    const int nig = WGM_ * nN, gid = wgid / nig, fm = gid * WGM_, gsz = (nM - fm) < WGM_ ? (nM - fm) : WGM_;
    u.pm = fm + ((wgid % nig) % gsz); u.pn = (wgid % nig) / gsz; u.e = 0; return true;
}

template <class Prob, class Epi>
__device__ __forceinline__ void gemm_phase(LAS unsigned char* lds, const Prob& P, const Epi& E) {
    int tid = threadIdx.x; asm volatile("" : "+v"(tid));
    const int wid = __builtin_amdgcn_readfirstlane(tid >> 6), lane = tid & 63, wr = wid >> 2, wc = wid & 3, fr = lane & 15, fq = lane >> 4;
    const int K = P.K, nt = K / BK;
    int RA[2], CA[2]; unsigned voffB[2];
#pragma unroll
    for (int i = 0; i < 2; ++i) { int R, C; stage_rc(tid * 16 + i * 8192, R, C); const int Rb = Epi::PERM ? ((R & ~31) + perm32(R & 31)) : R;
        RA[i] = R; CA[i] = C; voffB[i] = (unsigned)(Rb * K + C) * 2u; }
    const size_t kstep = (size_t)(BK * 2);
    const size_t hstep = (size_t)HALF * K * 2;
    const unsigned ldsw = (unsigned)wid * 1024u;
    const int aoff = lds_byte(wr * 64 + fr, fq * 8), boff = lds_byte(wc * 32 + fr, fq * 8);
#define G8_SA(b, h) (((b) * 2 + (h)) * HTB)
#define G8_SB(b, h) ((4 + (b) * 2 + (h)) * HTB)
#define G8_STAGE_B(bufoff, gbase) do { _Pragma("unroll") for (int _i = 0; _i < 2; ++_i) \
        __builtin_amdgcn_global_load_lds((const unsigned*)((const char*)(gbase) + voffB[_i]), (LAS unsigned*)(lds + (bufoff) + ldsw + _i * 8192), 16, 0, 0); } while (0)
#define G8_STAGE_A(bufoff, o0, o1) do { \
        __builtin_amdgcn_global_load_lds((const unsigned*)(Ab + (o0)), (LAS unsigned*)(lds + (bufoff) + ldsw), 16, 0, 0); \
        __builtin_amdgcn_global_load_lds((const unsigned*)(Ab + (o1)), (LAS unsigned*)(lds + (bufoff) + ldsw + 8192), 16, 0, 0); } while (0)
#define G8_CAT(lo, hi) __builtin_bit_cast(i32x8, __builtin_shufflevector(lo, hi, 0, 1, 2, 3, 4, 5, 6, 7))
#define G8_LO(v) __builtin_bit_cast(bf16x8, __builtin_shufflevector(v, v, 0, 1, 2, 3))
#define G8_HI(v) __builtin_bit_cast(bf16x8, __builtin_shufflevector(v, v, 4, 5, 6, 7))
#define G8_LDA(dst, b, h) do { _Pragma("unroll") for (int m = 0; m < 4; ++m) { const u32x4 _l = *(const LAS u32x4*)(lds + G8_SA(b, h) + aoff + m * 2048), _h = *(const LAS u32x4*)(lds + G8_SA(b, h) + aoff + m * 2048 + 1024); dst[m] = G8_CAT(_l, _h); } } while (0)
#define G8_LDB(dst, b, h) do { _Pragma("unroll") for (int n = 0; n < 2; ++n) { const u32x4 _l = *(const LAS u32x4*)(lds + G8_SB(b, h) + boff + n * 2048), _h = *(const LAS u32x4*)(lds + G8_SB(b, h) + boff + n * 2048 + 1024); dst[n] = G8_CAT(_l, _h); } } while (0)
#define G8_MMA(ai, bj, At, Bt) do { __builtin_amdgcn_s_setprio(1); \
        if constexpr (Prob::FP8) { _Pragma("unroll") for (int m = 0; m < 4; ++m) _Pragma("unroll") for (int n = 0; n < 2; ++n) \
            asm volatile("v_mfma_scale_f32_16x16x128_f8f6f4 %0, %1, %2, %0, %3, %3 op_sel_hi:[0,0,0]" : "+v"(acc[ai][bj][m][n]) : "v"(Bt[n]), "v"(At[m]), "v"(f8scale)); } \
        else { _Pragma("unroll") for (int m = 0; m < 4; ++m) _Pragma("unroll") for (int n = 0; n < 2; ++n) { \
            acc[ai][bj][m][n] = __builtin_amdgcn_mfma_f32_16x16x32_bf16(G8_LO(Bt[n]), G8_LO(At[m]), acc[ai][bj][m][n], 0, 0, 0); \
            acc[ai][bj][m][n] = __builtin_amdgcn_mfma_f32_16x16x32_bf16(G8_HI(Bt[n]), G8_HI(At[m]), acc[ai][bj][m][n], 0, 0, 0); } } \
        __builtin_amdgcn_s_setprio(0); } while (0)
#define G8_WAIT_V(n) asm volatile("s_waitcnt vmcnt(" #n ")" ::: "memory")
#define G8_WAIT_L(n) asm volatile("s_waitcnt lgkmcnt(" #n ")" ::: "memory")
#define G8_BAR __builtin_amdgcn_s_barrier()
#define G8_SCHED __builtin_amdgcn_sched_barrier(0)
    Unit cur, nxt, nn; int ui = 0;
    if (!P.next(0, cur)) return;
    const int f8scale = 0x7f7f7f7f;
    f32x4 acc[2][2][4][2];
#pragma unroll
    for (int a = 0; a < 2; ++a)
#pragma unroll
        for (int b = 0; b < 2; ++b)
#pragma unroll
            for (int m = 0; m < 4; ++m)
#pragma unroll
                for (int n = 0; n < 2; ++n) acc[a][b][m][n] = (f32x4){0.f, 0.f, 0.f, 0.f};
    i32x8 At[4], B0[2], B1[2];
    const char* Ab = (const char*)P.a_base();
    unsigned aoc[2][2], aon[2][2]; int raw[2][2];
    P.a_fetch(cur, RA, raw); P.a_finish(raw, CA, aoc);
    bool has_next = P.next(1, nxt);
    if (has_next) { P.a_fetch(nxt, RA, raw); P.a_finish(raw, CA, aon); }
    else { aon[0][0] = aoc[0][0]; aon[0][1] = aoc[0][1]; aon[1][0] = aoc[1][0]; aon[1][1] = aoc[1][1]; }
    const char* cB = (const char*)P.b_ptr(cur);
    const char* nB = has_next ? (const char*)P.b_ptr(nxt) : cB;
    typename Epi::Pre pre = E.fetch(cur, wr, wc, fr, fq);
    G8_STAGE_B(G8_SB(0, 0), cB); G8_STAGE_B(G8_SB(0, 1), cB + hstep); G8_STAGE_A(G8_SA(0, 0), aoc[0][0], aoc[0][1]); G8_STAGE_A(G8_SA(0, 1), aoc[1][0], aoc[1][1]);
    if (wr == 1) G8_BAR;
    G8_WAIT_V(2); G8_BAR;
    G8_STAGE_B(G8_SB(1, 0), cB + kstep); G8_STAGE_A(G8_SA(1, 0), aoc[0][0] + 128u, aoc[0][1] + 128u); G8_STAGE_B(G8_SB(1, 1), cB + hstep + kstep);
    G8_WAIT_V(6); G8_BAR;
    for (;;) {
        for (int t = 0; t < nt; t += 2) {
            const bool last = (t == nt - 2);
            const unsigned k1 = (unsigned)(t + 1) * 128u;
            const unsigned k2 = last ? 0u : (unsigned)(t + 2) * 128u;
            const unsigned a2_00 = (last ? aon[0][0] : aoc[0][0]) + k2, a2_01 = (last ? aon[0][1] : aoc[0][1]) + k2;
            const unsigned a2_10 = (last ? aon[1][0] : aoc[1][0]) + k2, a2_11 = (last ? aon[1][1] : aoc[1][1]) + k2;
            const char* b2 = last ? nB : cB + (size_t)(t + 2) * kstep;
            const char* b3 = b2 + kstep;
            G8_LDB(B0, 0, 0); G8_LDB(B1, 0, 1); G8_SCHED; G8_LDA(At, 0, 0); G8_STAGE_A(G8_SA(1, 1), aoc[1][0] + k1, aoc[1][1] + k1);
            G8_WAIT_V(8); G8_WAIT_L(0); G8_BAR; G8_MMA(0, 0, At, B0); G8_MMA(0, 1, At, B1); G8_BAR; G8_SCHED;
            G8_LDA(At, 0, 1); G8_STAGE_B(G8_SB(0, 0), b2); G8_STAGE_B(G8_SB(0, 1), b2 + hstep); G8_STAGE_A(G8_SA(0, 0), a2_00, a2_01);
            G8_WAIT_V(8); G8_WAIT_L(0); G8_BAR; G8_MMA(1, 0, At, B0); G8_MMA(1, 1, At, B1); G8_BAR; G8_SCHED;
            G8_LDB(B0, 1, 0); G8_LDB(B1, 1, 1); G8_SCHED; G8_LDA(At, 1, 0); G8_STAGE_A(G8_SA(0, 1), a2_10, a2_11);
            G8_WAIT_V(8); G8_WAIT_L(0); G8_BAR; G8_MMA(0, 0, At, B0); G8_MMA(0, 1, At, B1); G8_BAR; G8_SCHED;
            G8_LDA(At, 1, 1); G8_STAGE_B(G8_SB(1, 0), b3); G8_STAGE_B(G8_SB(1, 1), b3 + hstep); G8_STAGE_A(G8_SA(1, 0), a2_00 + 128u, a2_01 + 128u);
            G8_WAIT_V(8); G8_WAIT_L(0); G8_BAR; G8_MMA(1, 0, At, B0); G8_MMA(1, 1, At, B1); G8_BAR; G8_SCHED;
        }
        if (wr == 0) G8_BAR;
        if constexpr (Prob::FP8) asm volatile("s_nop 15\n\ts_nop 15" ::: "memory");
        const bool has_nn = has_next && P.next(ui + 2, nn);
        if (has_nn) P.a_fetch(nn, RA, raw);
        typename Epi::Pre pren = pre; if (has_next) pren = E.fetch(nxt, wr, wc, fr, fq);
        E(acc, cur, pre, wr, wc, fr, fq); pre = pren;
        if (!has_next) break;
#pragma unroll
        for (int a = 0; a < 2; ++a)
#pragma unroll
            for (int b = 0; b < 2; ++b)
#pragma unroll
                for (int m = 0; m < 4; ++m)
#pragma unroll
                    for (int n = 0; n < 2; ++n) acc[a][b][m][n] = (f32x4){0.f, 0.f, 0.f, 0.f};
        cur = nxt; cB = nB; ++ui;
        aoc[0][0] = aon[0][0]; aoc[0][1] = aon[0][1]; aoc[1][0] = aon[1][0]; aoc[1][1] = aon[1][1];
        nxt = nn; has_next = has_nn;
        if (has_next) { P.a_finish(raw, CA, aon); nB = (const char*)P.b_ptr(nxt); }
        else { nB = cB; }
        if (wr == 1) G8_BAR;
    }
    G8_WAIT_V(0);
    G8_BAR;
#undef G8_SA
#undef G8_SB
#undef G8_STAGE_A
#undef G8_STAGE_B
#undef G8_LDA
#undef G8_LDB
#undef G8_MMA
#undef G8_CAT
#undef G8_LO
#undef G8_HI
#undef G8_WAIT_V
#undef G8_WAIT_L
#undef G8_BAR
#undef G8_SCHED
}
}
namespace g8 {
#ifndef WGM_IN
#define WGM_IN 8
#endif
#ifndef WGM_OUT
#define WGM_OUT 8
#endif
#ifndef WGM_M1
#define WGM_M1 4
#endif
#ifndef WGM_M2
#define WGM_M2 4
#endif
template <bool F8, int WG_ = 8> struct DenseProbT {
    static constexpr bool FP8 = F8;
    const bf16_t* A; const bf16_t* Bt; int nM, nN, K, G, c, i0, i1;
    __device__ __forceinline__ bool next(int i, Unit& u) const { return (i0 + i < i1) && static_next<WG_>(i0 + i, nM, nN, G, c, u); }
    __device__ __forceinline__ const void* a_base() const { return A; }
    __device__ __forceinline__ void a_fetch(const Unit& u, const int (&RA)[2], int (&raw)[2][2]) const {
#pragma unroll
        for (int h = 0; h < 2; ++h)
#pragma unroll
            for (int i = 0; i < 2; ++i) raw[h][i] = u.pm * BM + h * HALF + RA[i];
    }
    __device__ __forceinline__ void a_finish(const int (&raw)[2][2], const int (&CA)[2], unsigned (&ao)[2][2]) const {
#pragma unroll
        for (int h = 0; h < 2; ++h)
#pragma unroll
            for (int i = 0; i < 2; ++i) ao[h][i] = (unsigned)((raw[h][i] * K + CA[i]) * 2);
    }
    __device__ __forceinline__ const void* b_ptr(const Unit& u) const { return Bt + (size_t)u.pn * BM * K; }
};
typedef DenseProbT<false, WGM_IN> DenseProbIn; typedef DenseProbT<false, WGM_OUT> DenseProbOut;
struct MoeProb1 {
    static constexpr bool FP8 = true;
    const bf16_t* A; const bf16_t* Bt; const int* row_tok; const int* blk; int K; int nM; int i0, i1;
    __device__ __forceinline__ bool next(int i, Unit& u) const {
        if (i0 + i >= i1 || !static_next<WGM_M1>(i0 + i, nM, 2 * FF / BM, gridDim.x, blockIdx.x, u)) return false;
        u.e = blk[64 + u.pm]; return true; }
    __device__ __forceinline__ const void* a_base() const { return A; }
    __device__ __forceinline__ void a_fetch(const Unit& u, const int (&RA)[2], int (&raw)[2][2]) const {
#pragma unroll
        for (int h = 0; h < 2; ++h)
#pragma unroll
            for (int i = 0; i < 2; ++i) raw[h][i] = row_tok[u.pm * BM + h * HALF + RA[i]];
    }
    __device__ __forceinline__ void a_finish(const int (&raw)[2][2], const int (&CA)[2], unsigned (&ao)[2][2]) const {
#pragma unroll
        for (int h = 0; h < 2; ++h)
#pragma unroll
            for (int i = 0; i < 2; ++i) ao[h][i] = (unsigned)((raw[h][i] * K + CA[i]) * 2);
    }
    __device__ __forceinline__ const void* b_ptr(const Unit& u) const { return Bt + ((size_t)__builtin_amdgcn_readfirstlane(u.e) * (2 * FF) + (size_t)u.pn * BM) * K; }
};
struct MoeProb2 {
    static constexpr bool FP8 = true;
    const bf16_t* A; const bf16_t* Bt; const int* blk; int K; int nM;
    __device__ __forceinline__ bool next(int i, Unit& u) const {
        if (!static_next<WGM_M2>(i, nM, DM / BM, gridDim.x, blockIdx.x, u)) return false;
        u.e = blk[64 + u.pm]; return true; }
    __device__ __forceinline__ const void* a_base() const { return A; }
    __device__ __forceinline__ void a_fetch(const Unit& u, const int (&RA)[2], int (&raw)[2][2]) const {
#pragma unroll
        for (int h = 0; h < 2; ++h)
#pragma unroll
            for (int i = 0; i < 2; ++i) raw[h][i] = u.pm * BM + h * HALF + RA[i];
    }
    __device__ __forceinline__ void a_finish(const int (&raw)[2][2], const int (&CA)[2], unsigned (&ao)[2][2]) const {
#pragma unroll
        for (int h = 0; h < 2; ++h)
#pragma unroll
            for (int i = 0; i < 2; ++i) ao[h][i] = (unsigned)((raw[h][i] * K + CA[i]) * 2);
    }
    __device__ __forceinline__ const void* b_ptr(const Unit& u) const { return Bt + ((size_t)__builtin_amdgcn_readfirstlane(u.e) * DM + (size_t)u.pn * BM) * K; }
};

struct EpiProj {
    static constexpr bool PERM = true;
    bf16_t* __restrict__ O; const float* __restrict__ rstd; float scale; int colbase;
    struct Pre { float rs[2][4]; };
    __device__ __forceinline__ Pre fetch(const Unit& u, int wr, int wc, int fr, int fq) const {
        Pre q; const int row0 = u.pm * BM + wr * 64 + fr;
#pragma unroll
        for (int ai = 0; ai < 2; ++ai)
#pragma unroll
            for (int m = 0; m < 4; ++m) q.rs[ai][m] = rstd[row0 + ai * HALF + m * 16];
        return q; }
    __device__ __forceinline__ void operator()(const f32x4 (&acc)[2][2][4][2], const Unit& u, const Pre& q, int wr, int wc, int fr, int fq) const {
        const int row0 = u.pm * BM + wr * 64 + fr, col0 = colbase + u.pn * BM + wc * 32 + 8 * fq;
#pragma unroll
        for (int ai = 0; ai < 2; ++ai)
#pragma unroll
            for (int m = 0; m < 4; ++m) { const int row = row0 + ai * HALF + m * 16; bf16_t* rowp = O + (size_t)row * NPROJ + col0; const float rsc = q.rs[ai][m] * scale;
#pragma unroll
                for (int bj = 0; bj < 2; ++bj) { const f32x4 v0 = acc[ai][bj][m][0] * rsc, v1 = acc[ai][bj][m][1] * rsc;
                    u32x4 w; w.x = cvt_pk_bf16(v0[0], v0[1]); w.y = cvt_pk_bf16(v0[2], v0[3]); w.z = cvt_pk_bf16(v1[0], v1[1]); w.w = cvt_pk_bf16(v1[2], v1[3]);
                    *(u32x4*)(rowp + bj * HALF) = w; } }
    }
};
struct EpiX1 {
    static constexpr bool PERM = false;
    const float* __restrict__ X; float* __restrict__ O;
    struct Pre {};
    __device__ __forceinline__ Pre fetch(const Unit&, int, int, int, int) const { return Pre{}; }
    __device__ __forceinline__ void operator()(const f32x4 (&acc)[2][2][4][2], const Unit& u, const Pre&, int wr, int wc, int fr, int fq) const {
        const int row0 = u.pm * BM + wr * 64 + fr, col0 = u.pn * BM + wc * 32 + 4 * fq;
#pragma unroll
        for (int ai = 0; ai < 2; ++ai) {
            f32x4 xv[4][2][2];
#pragma unroll
            for (int m = 0; m < 4; ++m) { const size_t off = (size_t)(row0 + ai * HALF + m * 16) * DM + col0;
#pragma unroll
                for (int bj = 0; bj < 2; ++bj)
#pragma unroll
                    for (int n = 0; n < 2; ++n) xv[m][bj][n] = __builtin_nontemporal_load((const f32x4*)(X + off + bj * HALF + n * 16)); }
#pragma unroll
            for (int m = 0; m < 4; ++m) { const size_t off = (size_t)(row0 + ai * HALF + m * 16) * DM + col0;
#pragma unroll
                for (int bj = 0; bj < 2; ++bj)
#pragma unroll
                    for (int n = 0; n < 2; ++n) *(f32x4*)(O + off + bj * HALF + n * 16) = xv[m][bj][n] + acc[ai][bj][m][n]; }
        }
    }
};
struct EpiSwiglu {
    static constexpr bool PERM = true;
    unsigned char* __restrict__ O; const float* __restrict__ row_rstd; const float* __restrict__ bgu;
    struct Pre { float rsv[2][4]; };
    __device__ __forceinline__ Pre fetch(const Unit& u, int wr, int wc, int fr, int fq) const {
        Pre q; const int row0 = u.pm * BM + wr * 64 + fr;
#pragma unroll
        for (int ai = 0; ai < 2; ++ai)
#pragma unroll
            for (int m = 0; m < 4; ++m) q.rsv[ai][m] = row_rstd[row0 + ai * HALF + m * 16];
        return q; }
    __device__ __forceinline__ void operator()(const f32x4 (&acc)[2][2][4][2], const Unit& u, const Pre& q, int wr, int wc, int fr, int fq) const {
        const int row0 = u.pm * BM + wr * 64 + fr, colg = u.pn * HALF + wc * 32 + 8 * fq;
        const float* bg = bgu + (size_t)__builtin_amdgcn_readfirstlane(u.e) * (2 * FF) + colg; const float* bu = bg + FF;
        const f32x4 bg0 = *(const f32x4*)bg, bg1 = *(const f32x4*)(bg + 4), bu0 = *(const f32x4*)bu, bu1 = *(const f32x4*)(bu + 4);
#pragma unroll
        for (int ai = 0; ai < 2; ++ai)
#pragma unroll
            for (int m = 0; m < 4; ++m) { const int row = row0 + ai * HALF + m * 16; const float rs = q.rsv[ai][m] * F8_UNSCALE;
                f32x4 g0 = acc[ai][0][m][0] * rs + bg0, g1 = acc[ai][0][m][1] * rs + bg1, u0 = acc[ai][1][m][0] * rs + bu0, u1 = acc[ai][1][m][1] * rs + bu1;
                float o[8];
#pragma unroll
                for (int j = 0; j < 8; ++j) { float g = j < 4 ? g0[j] : g1[j - 4], uu = j < 4 ? u0[j] : u1[j - 4];
                    g = fminf(g, 7.0f); uu = __builtin_amdgcn_fmed3f(uu, -7.0f, 7.0f);
                    const float sg = __builtin_amdgcn_rcpf(1.0f + __builtin_amdgcn_exp2f(g * (-1.702f * 1.4426950408889634f)));
                    o[j] = (uu * ACT_SCALE + ACT_SCALE) * (g * sg); }
                u32x2 w; w.x = cvt4_fp8(o[0], o[1], o[2], o[3]); w.y = cvt4_fp8(o[4], o[5], o[6], o[7]);
                *(u32x2*)(O + (size_t)row * FF + colg) = w; }
    }
};
struct EpiDown {
    static constexpr bool PERM = true;
    unsigned char* __restrict__ O; const float* __restrict__ bd;
    struct Pre { f32x4 bv[2][2]; };
    __device__ __forceinline__ Pre fetch(const Unit& u, int wr, int wc, int fr, int fq) const {
        Pre q; const int col0 = u.pn * BM + wc * 32 + 8 * fq;
        const float* bp = bd + (size_t)__builtin_amdgcn_readfirstlane(u.e) * DM + col0;
#pragma unroll
        for (int bj = 0; bj < 2; ++bj)
#pragma unroll
            for (int n = 0; n < 2; ++n) q.bv[bj][n] = *(const f32x4*)(bp + bj * HALF + 4 * n) * Y_SCALE;
        return q; }
    __device__ __forceinline__ void operator()(const f32x4 (&acc)[2][2][4][2], const Unit& u, const Pre& q, int wr, int wc, int fr, int fq) const {
        const int row0 = u.pm * BM + wr * 64 + fr, col0 = u.pn * BM + wc * 32 + 8 * fq;
#pragma unroll
        for (int ai = 0; ai < 2; ++ai)
#pragma unroll
            for (int m = 0; m < 4; ++m) { unsigned char* rowp = O + (size_t)(row0 + ai * HALF + m * 16) * DM + col0;
#pragma unroll
                for (int bj = 0; bj < 2; ++bj) { const f32x4 v0 = acc[ai][bj][m][0] * (F8_UNSCALE * Y_SCALE) + q.bv[bj][0], v1 = acc[ai][bj][m][1] * (F8_UNSCALE * Y_SCALE) + q.bv[bj][1];
                    u32x2 w; w.x = cvt4_fp8(v0[0], v0[1], v0[2], v0[3]); w.y = cvt4_fp8(v1[0], v1[1], v1[2], v1[3]);
                    *(u32x2*)(rowp + bj * HALF) = w; } }
    }
};
}
struct Ctx { LAS unsigned char* lds; int tid, lane, wave; };
__device__ __forceinline__ Ctx fresh_ctx(const Ctx& c0) { Ctx c; c.lds = c0.lds; int t = threadIdx.x; asm volatile("" : "+v"(t)); c.tid = t; c.lane = t & 63; c.wave = __builtin_amdgcn_readfirstlane(t >> 6); return c; }

__device__ __forceinline__ void transpose_item(const float* W, int ld, int K, int k0, int n0, bf16_t* WT_row0  , LAS float* scr, int lane) {
    float tv[32];
#pragma unroll
    for (int i = 0; i < 32; ++i) { const int kk = 2 * i + (lane >> 5); tv[i] = __builtin_nontemporal_load(W + (size_t)(k0 + kk) * ld + n0 + (lane & 31)); }
#pragma unroll
    for (int i = 0; i < 32; ++i) { const int kk = 2 * i + (lane >> 5); scr[kk * 33 + (lane & 31)] = tv[i]; }
    LDS_WAIT(); asm volatile("" ::: "memory");
    const int c = lane & 7;
#pragma unroll
    for (int j = 0; j < 4; ++j) { const int n = (lane >> 3) + 8 * j; const LAS float* s = scr + (8 * c) * 33 + n;
        u32x4 o; o.x = cvt_pk_bf16(s[0 * 33], s[1 * 33]); o.y = cvt_pk_bf16(s[2 * 33], s[3 * 33]); o.z = cvt_pk_bf16(s[4 * 33], s[5 * 33]); o.w = cvt_pk_bf16(s[6 * 33], s[7 * 33]);
        *(u32x4*)(WT_row0 + (size_t)n * K + k0 + 8 * c) = o; }
    LDS_WAIT(); asm volatile("" ::: "memory");
}
__device__ __forceinline__ void phase_convert(const Params& p, const Ctx& c0) { const Ctx c = fresh_ctx(c0);
    LAS float* scr = (LAS float*)(c.lds + c.wave * 18432);
    const int gw = blockIdx.x * NWAVES + c.wave, NGW = gridDim.x * NWAVES;
    bf16_t* WinT = (bf16_t*)(p.ws + WS_WIN); bf16_t* WoutT = (bf16_t*)(p.ws + WS_WOUT);
    constexpr int KB = DM / 64;
    constexpr int I_IN = KB * (NPROJ / 32), I_OUT = KB * (DM / 32), NITEMS = I_IN + I_OUT;
    for (int it = gw; it < NITEMS; it += NGW) {
        int r = it;
        if (r < I_IN) { const int nb = r % (NPROJ / 32), kb = r / (NPROJ / 32); transpose_item(p.w_in, LDW_IN, DM, 64 * kb, 32 * nb, WinT + (size_t)(32 * nb) * DM, scr, c.lane); continue; } r -= I_IN;
        { const int nb = r % (DM / 32), kb = r / (DM / 32); transpose_item(p.w_out, DM, DM, 64 * kb, 32 * nb, WoutT + (size_t)(32 * nb) * DM, scr, c.lane); }
    }
    float* rc = (float*)(p.ws + WS_ROPE); float* rs = rc + SEQ * 64;
    for (int i = blockIdx.x * NTHREADS + c.tid; i < SEQ * 64; i += gridDim.x * NTHREADS) {
        const int pos = i >> 6, j = i & 63;
        const float inv = 1.0f / powf(10000.0f, (float)(2 * j) / 128.0f);
        const float ang = (float)pos * inv; float sn, cs; sincosf(ang, &sn, &cs); rc[i] = cs; rs[i] = sn; }
}
constexpr int CT_GU1 = (DM / 128) * (2 * FF / 256), CT_D1 = (FF / 128) * (DM / 256), CT_GU = NE * CT_GU1, CT_D = NE * CT_D1, CT_TOTAL = CT_GU + CT_D;
struct ConvTile { const float* src; unsigned char* dst; int ld; int gu; };
__device__ __forceinline__ ConvTile ctile_decode(const Params& p, int r) {
    ConvTile t;
    if (r < CT_GU) { const int e = r / CT_GU1, q = r % CT_GU1, nt = q % (2 * FF / 256), kt = q / (2 * FF / 256);
        t.src = p.w_gu + (size_t)e * DM * (2 * FF) + (size_t)(128 * kt) * (2 * FF) + 256 * nt; t.ld = 2 * FF; t.gu = 256 * nt;
        t.dst = (unsigned char*)(p.ws + WS_WGU) + (size_t)e * (2 * FF) * DM + 128 * kt; }
    else { r -= CT_GU; const int e = r / CT_D1, q = r % CT_D1, nt = q % (DM / 256), kt = q / (DM / 256);
        t.src = p.w_d + (size_t)e * FF * DM + (size_t)(128 * kt) * DM + 256 * nt; t.ld = DM; t.gu = -1;
        t.dst = (unsigned char*)(p.ws + WS_WD) + ((size_t)e * DM + 256 * nt) * FF + 128 * kt; }
    return t;
}
__device__ __forceinline__ void ctile_load(const ConvTile& t, f32x4 (&tv)[16], int wave, int lane) {
    const float* s = t.src + (size_t)(16 * wave) * t.ld + 4 * lane;
#pragma unroll
    for (int i = 0; i < 16; ++i) tv[i] = __builtin_nontemporal_load((const f32x4*)(s + (size_t)i * t.ld));
}
__device__ __forceinline__ void ctile_store(const ConvTile& t, const f32x4 (&tv)[16], LAS unsigned char* lds, int tid, int wave, int lane) {
#pragma unroll
    for (int c = 0; c < 4; ++c) { u32x4 o;
#pragma unroll
        for (int q = 0; q < 4; ++q) o[q] = cvt4_fp8(tv[4 * q][c] * W_SCALE, tv[4 * q + 1][c] * W_SCALE, tv[4 * q + 2][c] * W_SCALE, tv[4 * q + 3][c] * W_SCALE);
        const int n = 4 * lane + c; *(LAS u32x4*)(lds + n * 128 + ((wave ^ (lane & 7)) << 4)) = o; }
    __syncthreads();
#pragma unroll
    for (int j = 0; j < 4; ++j) { const int n = 64 * j + (tid >> 3), ch = tid & 7;
        const u32x4 o = *(const LAS u32x4*)(lds + n * 128 + ((ch ^ ((n >> 2) & 7)) << 4));
        int orow = n;
        if (t.gu >= 0) { const int ng = t.gu + n; const int nn = ng < FF ? ng : ng - FF; orow = 256 * (nn / 128) + (nn % 128) + (ng < FF ? 0 : 128); }
        *(u32x4*)(t.dst + (size_t)orow * DM + 16 * ch) = o; }
    __syncthreads();
}
__device__ __forceinline__ void phase_convert_share(const Params& p, const Ctx& c0, int lo, int hi, int G, int w) { const Ctx c = fresh_ctx(c0);
    for (int it = lo + w; it < hi; it += 2 * G) {
        const int i1 = it + G < hi ? it + G : it;
        f32x4 ta[16], tb[16];
        const ConvTile A = ctile_decode(p, it), B = ctile_decode(p, i1);
        ctile_load(A, ta, c.wave, c.lane); ctile_load(B, tb, c.wave, c.lane);
        __builtin_amdgcn_sched_barrier(0);
        ctile_store(A, ta, c.lds, c.tid, c.wave, c.lane); ctile_store(B, tb, c.lds, c.tid, c.wave, c.lane);
        __builtin_amdgcn_sched_barrier(0);
    }
}

template <int NTL, int OUT8  >
__device__ __forceinline__ void norm_skinny_half(const float* xrows, const float* wn, const float* Wsk, int ldw, void* hrows_, void* hrows8_, int hk, int lane, f32x4 (&acc)[NTL], float& ss) {
    const int row = lane & 15, kq = lane >> 4;
    ss = 0.f;
#pragma unroll
    for (int t = 0; t < NTL; ++t) acc[t] = (f32x4){0.f, 0.f, 0.f, 0.f};
#pragma unroll 4
    for (int ks = 0; ks < 32; ++ks) {
        const int d0 = 1024 * hk + 32 * ks + 8 * kq;
        f32x4 xa = *(const f32x4*)(xrows + (size_t)row * DM + d0), xb = *(const f32x4*)(xrows + (size_t)row * DM + d0 + 4);
        const f32x4 wa = *(const f32x4*)(wn + d0), wb = *(const f32x4*)(wn + d0 + 4);
        ss += (xa[0] * xa[0] + xa[1] * xa[1]) + (xa[2] * xa[2] + xa[3] * xa[3]) + (xb[0] * xb[0] + xb[1] * xb[1]) + (xb[2] * xb[2] + xb[3] * xb[3]);
        xa = xa * wa; xb = xb * wb;
        u32x4 hw; hw.x = cvt_pk_bf16(xa[0], xa[1]); hw.y = cvt_pk_bf16(xa[2], xa[3]); hw.z = cvt_pk_bf16(xb[0], xb[1]); hw.w = cvt_pk_bf16(xb[2], xb[3]);
        if constexpr (OUT8 >= 1) { u32x2 q; q.x = cvt4_fp8(xa[0] * ACT_SCALE, xa[1] * ACT_SCALE, xa[2] * ACT_SCALE, xa[3] * ACT_SCALE); q.y = cvt4_fp8(xb[0] * ACT_SCALE, xb[1] * ACT_SCALE, xb[2] * ACT_SCALE, xb[3] * ACT_SCALE);
            *(u32x2*)((unsigned char*)hrows8_ + (size_t)row * DM + d0) = q; }
        if constexpr (OUT8 != 1) *(u32x4*)((bf16_t*)hrows_ + (size_t)row * DM + d0) = hw;
        const f32x4 ra = {xa[0] - bflo(hw.x), xa[1] - bfhi(hw.x), xa[2] - bflo(hw.y), xa[3] - bfhi(hw.y)}, rb = {xb[0] - bflo(hw.z), xb[1] - bfhi(hw.z), xb[2] - bflo(hw.w), xb[3] - bfhi(hw.w)};
        const bf16x8 ah = __builtin_bit_cast(bf16x8, hw), al = pack8(ra, rb);
#pragma unroll
        for (int t = 0; t < NTL; ++t) {
            float wv[8];
#pragma unroll
            for (int i = 0; i < 8; ++i) wv[i] = Wsk[(size_t)(d0 + i) * ldw + t * 16 + row];
            u32x4 bw; bw.x = cvt_pk_bf16(wv[0], wv[1]); bw.y = cvt_pk_bf16(wv[2], wv[3]); bw.z = cvt_pk_bf16(wv[4], wv[5]); bw.w = cvt_pk_bf16(wv[6], wv[7]);
            const f32x4 r0 = {wv[0] - bflo(bw.x), wv[1] - bfhi(bw.x), wv[2] - bflo(bw.y), wv[3] - bfhi(bw.y)}, r1 = {wv[4] - bflo(bw.z), wv[5] - bfhi(bw.z), wv[6] - bflo(bw.w), wv[7] - bfhi(bw.w)};
            const bf16x8 bh = __builtin_bit_cast(bf16x8, bw), bl = pack8(r0, r1);
            acc[t] = __builtin_amdgcn_mfma_f32_16x16x32_bf16(ah, bh, acc[t], 0, 0, 0);
            acc[t] = __builtin_amdgcn_mfma_f32_16x16x32_bf16(al, bh, acc[t], 0, 0, 0);
            acc[t] = __builtin_amdgcn_mfma_f32_16x16x32_bf16(ah, bl, acc[t], 0, 0, 0);
        }
    }
    ss += __shfl_xor(ss, 16); ss += __shfl_xor(ss, 32);
}

__device__ __forceinline__ void phase_norm1(const Params& p, const Ctx& c0) { const Ctx c = fresh_ctx(c0);
    bf16_t* H = (bf16_t*)(p.ws + WS_H); float* rstd = (float*)(p.ws + WS_RSTD1); float* gz = (float*)(p.ws + WS_GZ);
    const int pair = c.wave >> 1, hk = c.wave & 1;
    LAS float* scr = (LAS float*)(c.lds + pair * 4096);
    for (int u = blockIdx.x * 4 + pair; u < T / 16; u += gridDim.x * 4) {
        f32x4 acc[1]; float ss;
        norm_skinny_half<1, 0>(p.x + (size_t)u * 16 * DM, p.attn_norm_w, p.w_in + C_GZ, LDW_IN, H + (size_t)u * 16 * DM, nullptr, hk, c.lane, acc, ss);
        if (hk == 1) { *(LAS f32x4*)(scr + c.lane * 4) = acc[0]; if (c.lane < 16) scr[256 + c.lane] = ss; }
        __syncthreads();
        if (hk == 0) {
            const f32x4 o = *(LAS f32x4*)(scr + c.lane * 4); const float tot = ss + scr[256 + (c.lane & 15)];
            const float rs = 1.0f / sqrtf(tot * (1.0f / DM) + EPS);
            if (c.lane < 16) { rstd[u * 16 + c.lane] = rs; scr[512 + c.lane] = rs; }
            LDS_WAIT();
#pragma unroll
            for (int r = 0; r < 4; ++r) { const int row = (c.lane >> 4) * 4 + r; gz[(size_t)(u * 16 + row) * 16 + (c.lane & 15)] = (acc[0][r] + o[r]) * scr[512 + row]; }
        }
        __syncthreads();
    }
}

__device__ __forceinline__ void phase_norm2_router(const Params& p, const Ctx& c0) { const Ctx c = fresh_ctx(c0);
    bf16_t* H = (bf16_t*)(p.ws + WS_H); float* rstd = (float*)(p.ws + WS_RSTD2); const float* X1 = (const float*)(p.ws + WS_X1);
    int* topi = (int*)(p.ws + WS_TOPI); float* topg = (float*)(p.ws + WS_TOPG); int* hist = (int*)(p.ws + WS_HIST); int* row_tok = (int*)(p.ws + WS_ROWTOK);
    const int pair = c.wave >> 1, hk = c.wave & 1;
    LAS float* scr = (LAS float*)(c.lds + pair * 8192);
    LAS int* hcnt = (LAS int*)(c.lds + 65536);
    { float* row_rstd = (float*)(p.ws + WS_ROWRSTD);
      for (int i = blockIdx.x * NTHREADS + c.tid; i < PROWS; i += gridDim.x * NTHREADS) { row_tok[i] = 0; row_rstd[i] = 0.f; } }
    for (int g = blockIdx.x; g < T / 64; g += gridDim.x) {
        if (c.tid < 32) hcnt[c.tid] = 0;
        __syncthreads();
        const int u = g * 4 + pair;
        f32x4 acc[2]; float ss;
        norm_skinny_half<2, 1>(X1 + (size_t)u * 16 * DM, p.ffn_norm_w, p.router_w, NE, nullptr, (unsigned char*)H + (size_t)u * 16 * DM, hk, c.lane, acc, ss);
        if (hk == 1) { *(LAS f32x4*)(scr + c.lane * 4) = acc[0]; *(LAS f32x4*)(scr + 256 + c.lane * 4) = acc[1]; if (c.lane < 16) scr[512 + c.lane] = ss; }
        __syncthreads();
        if (hk == 0) {
            const f32x4 o0 = *(LAS f32x4*)(scr + c.lane * 4), o1 = *(LAS f32x4*)(scr + 256 + c.lane * 4); const float tot = ss + scr[512 + (c.lane & 15)];
            const float rs = 1.0f / sqrtf(tot * (1.0f / DM) + EPS);
            if (c.lane < 16) { rstd[u * 16 + c.lane] = rs; scr[528 + c.lane] = rs; }
            LDS_WAIT();
            const float b0 = p.router_b[c.lane & 15], b1 = p.router_b[16 + (c.lane & 15)];
#pragma unroll
            for (int r = 0; r < 4; ++r) { const int row = (c.lane >> 4) * 4 + r; const float rr = scr[528 + row];
                scr[1024 + row * 32 + (c.lane & 15)] = (acc[0][r] + o0[r]) * rr + b0; scr[1024 + row * 32 + 16 + (c.lane & 15)] = (acc[1][r] + o1[r]) * rr + b1; }
            LDS_WAIT();
            if (c.lane < 16) {
                float lv[32];
#pragma unroll
                for (int j = 0; j < 32; ++j) lv[j] = scr[1024 + c.lane * 32 + j];
                int bi[4]; float bv[4];
#pragma unroll
                for (int k = 0; k < 4; ++k) { float best = -__builtin_inff(); int bidx = 0;
#pragma unroll
                    for (int j = 0; j < 32; ++j) { const bool tk = lv[j] > best; best = tk ? lv[j] : best; bidx = tk ? j : bidx; }
                    bi[k] = bidx; bv[k] = best;
#pragma unroll
                    for (int j = 0; j < 32; ++j) lv[j] = (j == bidx) ? -__builtin_inff() : lv[j]; }
                const float e1 = __expf(bv[1] - bv[0]), e2 = __expf(bv[2] - bv[0]), e3 = __expf(bv[3] - bv[0]); const float inv = 1.0f / (1.0f + e1 + e2 + e3);
                const int tok = u * 16 + c.lane;
                *(int4*)(topi + (size_t)tok * 4) = make_int4(bi[0], bi[1], bi[2], bi[3]);
                *(float4*)(topg + (size_t)tok * 4) = make_float4(inv, e1 * inv, e2 * inv, e3 * inv);
#pragma unroll
                for (int k = 0; k < 4; ++k) atomicAdd((int*)&hcnt[bi[k]], 1);
            }
        }
        __syncthreads();
        if (c.tid < 32) hist[g * 32 + c.tid] = hcnt[c.tid];
        __syncthreads();
    }
}

__device__ __forceinline__ void phase_rope_kmean(const Params& p, const Ctx& c0) { const Ctx c = fresh_ctx(c0);
    bf16_t* proj = (bf16_t*)(p.ws + WS_PROJ); const float* rc = (const float*)(p.ws + WS_ROPE); const float* rsn = rc + SEQ * 64; float* kmean = (float*)(p.ws + WS_KMEAN);
    LAS float* red = (LAS float*)c.lds;
    const int cg = c.tid & 7, tk = c.tid >> 3;
    for (int u = blockIdx.x; u < NBATCH * MH * NBLK; u += gridDim.x) {
        const int b = u / (MH * NBLK), h = (u / NBLK) % MH, blk = u % NBLK;
        float s1[8], s2[8];
#pragma unroll
        for (int j = 0; j < 8; ++j) { s1[j] = 0.f; s2[j] = 0.f; }
        f32x4 ca[4], cb[4], sa[4], sb[4]; u32x4 t1[4][2], t2[4][2];
#pragma unroll
        for (int ps = 0; ps < 4; ++ps) {
            const int pos = blk * MBLK + ps * 64 + tk; const size_t row = (size_t)(b * SEQ + pos) * NPROJ;
            ca[ps] = *(const f32x4*)(rc + pos * 64 + 8 * cg); cb[ps] = *(const f32x4*)(rc + pos * 64 + 8 * cg + 4); sa[ps] = *(const f32x4*)(rsn + pos * 64 + 8 * cg); sb[ps] = *(const f32x4*)(rsn + pos * 64 + 8 * cg + 4);
#pragma unroll
            for (int qk = 0; qk < 2; ++qk) { const bf16_t* base = proj + row + (qk ? C_MK : C_MQ) + h * HD + 8 * cg; t1[ps][qk] = *(const u32x4*)base; t2[ps][qk] = *(const u32x4*)(base + 64); }
        }
#pragma unroll
        for (int ps = 0; ps < 4; ++ps) {
            const int pos = blk * MBLK + ps * 64 + tk; const size_t row = (size_t)(b * SEQ + pos) * NPROJ;
            const float cs[8] = {ca[ps][0], ca[ps][1], ca[ps][2], ca[ps][3], cb[ps][0], cb[ps][1], cb[ps][2], cb[ps][3]}, sn[8] = {sa[ps][0], sa[ps][1], sa[ps][2], sa[ps][3], sb[ps][0], sb[ps][1], sb[ps][2], sb[ps][3]};
#pragma unroll
            for (int qk = 0; qk < 2; ++qk) {
                bf16_t* base = proj + row + (qk ? C_MK : C_MQ) + h * HD + 8 * cg;
                float a[8], bb[8];
#pragma unroll
                for (int j = 0; j < 4; ++j) { a[2 * j] = bflo(t1[ps][qk][j]); a[2 * j + 1] = bfhi(t1[ps][qk][j]); bb[2 * j] = bflo(t2[ps][qk][j]); bb[2 * j + 1] = bfhi(t2[ps][qk][j]); }
                float o1[8], o2[8];
#pragma unroll
                for (int j = 0; j < 8; ++j) { o1[j] = a[j] * cs[j] - bb[j] * sn[j]; o2[j] = bb[j] * cs[j] + a[j] * sn[j]; }
                u32x4 w1, w2;
#pragma unroll
                for (int j = 0; j < 4; ++j) { w1[j] = cvt_pk_bf16(o1[2 * j], o1[2 * j + 1]); w2[j] = cvt_pk_bf16(o2[2 * j], o2[2 * j + 1]); }
                *(u32x4*)base = w1; *(u32x4*)(base + 64) = w2;
                if (qk) {
#pragma unroll
                    for (int j = 0; j < 8; ++j) { s1[j] += o1[j]; s2[j] += o2[j]; } }
            }
        }
#pragma unroll
        for (int j = 0; j < 8; ++j) {
#pragma unroll
            for (int o = 8; o < 64; o <<= 1) { s1[j] += __shfl_xor(s1[j], o); s2[j] += __shfl_xor(s2[j], o); } }
        if (c.lane < 8) {
#pragma unroll
            for (int j = 0; j < 8; ++j) { red[c.wave * 128 + 8 * cg + j] = s1[j]; red[c.wave * 128 + 64 + 8 * cg + j] = s2[j]; } }
        __syncthreads();
        if (c.tid < 128) { float s = 0.f;
#pragma unroll
            for (int w = 0; w < 8; ++w) s += red[w * 128 + c.tid];
            kmean[(size_t)u * HD + c.tid] = s * (1.0f / MBLK); }
        __syncthreads();
    }
}

__device__ __forceinline__ void phase_gla_prep(const Params& p, const Ctx& c0) { const Ctx c = fresh_ctx(c0);
    bf16_t* proj = (bf16_t*)(p.ws + WS_PROJ); const float* gz = (const float*)(p.ws + WS_GZ); float* dend = (float*)(p.ws + WS_DEND);
    LAS float* gzl = (LAS float*)c.lds;
    LAS float* seg = (LAS float*)(c.lds + 16384);
    const int ch = c.tid & 127, tq = __builtin_amdgcn_readfirstlane(c.tid >> 7);
    for (int u = blockIdx.x; u < NBATCH * GH * NBLK; u += gridDim.x) {
        const int b = u / (GH * NBLK), h = (u / NBLK) % GH, j = u % NBLK;
        const int tok0 = b * SEQ + j * MBLK;
        for (int i = c.tid; i < 256 * 4; i += NTHREADS) *(LAS f32x4*)(gzl + i * 4) = *(const f32x4*)(gz + (size_t)tok0 * 16 + i * 4);
        float w2[16];
#pragma unroll
        for (int r = 0; r < 16; ++r) w2[r] = p.gate_w2[r * 512 + h * GDK + ch];
        const float bias = p.gate_b[h * GDK + ch];
        __syncthreads();
        float run = 0.f; float Bv[64];
#pragma unroll
        for (int i = 0; i < 64; ++i) {
            const LAS float* g = gzl + (tq * 64 + i) * 16;
            const f32x4 g0 = *(const LAS f32x4*)g, g1 = *(const LAS f32x4*)(g + 4), g2 = *(const LAS f32x4*)(g + 8), g3 = *(const LAS f32x4*)(g + 12);
            float lg = bias;
            lg += g0[0] * w2[0] + g0[1] * w2[1] + g0[2] * w2[2] + g0[3] * w2[3]; lg += g1[0] * w2[4] + g1[1] * w2[5] + g1[2] * w2[6] + g1[3] * w2[7];
            lg += g2[0] * w2[8] + g2[1] * w2[9] + g2[2] * w2[10] + g2[3] * w2[11]; lg += g3[0] * w2[12] + g3[1] * w2[13] + g3[2] * w2[14] + g3[3] * w2[15];
            const float ls = fminf(lg, 0.f) - __logf(1.0f + __expf(-fabsf(lg)));
            run += ls * (1.0f / 16.0f); Bv[i] = run; }
        seg[tq * 128 + ch] = run;
        __syncthreads();
        float off = 0.f, tot = 0.f;
#pragma unroll
        for (int s = 0; s < 4; ++s) { const float v = seg[s * 128 + ch]; tot += v; off += (s < tq) ? v : 0.f; }
        if (tq == 0) dend[(size_t)u * GDK + ch] = __expf(tot);
        bf16_t* qp = proj + (size_t)(tok0 + tq * 64) * NPROJ + C_GQ + h * GDK + ch; bf16_t* kp = proj + (size_t)(tok0 + tq * 64) * NPROJ + C_GK + h * GDK + ch;
#pragma unroll
        for (int i0 = 0; i0 < 64; i0 += 16) {
            bf16_t qraw[16], kraw[16];
#pragma unroll
            for (int i = 0; i < 16; ++i) { qraw[i] = qp[(size_t)(i0 + i) * NPROJ]; kraw[i] = kp[(size_t)(i0 + i) * NPROJ]; }
#pragma unroll
            for (int i = 0; i < 16; ++i) { const float Bt = off + Bv[i0 + i];
                const float q = bf2f(qraw[i]), k = bf2f(kraw[i]);
                const float qt = q * __expf(Bt) * 0.08838834764831845f, kt = k * __expf(-Bt);
                qp[(size_t)(i0 + i) * NPROJ] = (bf16_t)(cvt_pk_bf16(qt, 0.f) & 0xffffu); kp[(size_t)(i0 + i) * NPROJ] = (bf16_t)(cvt_pk_bf16(kt, 0.f) & 0xffffu); }
        }
        __syncthreads();
    }
}
namespace att {
constexpr int NW = 8, QBLK = 32, KVBLK = 64, QB = 256, D = 128;
constexpr int SHM_V = KVBLK * D * 2, SHM_K = KVBLK * D * 2;
constexpr int ATT_LDS = 2 * SHM_V + 2 * SHM_K + NW * 64 * 4;
constexpr float SCALE = 0.08838834764831845f;
constexpr float THR = 8.f;
constexpr int APITCH = NPROJ, OPITCH = DM;
typedef LAS char* lptr;
typedef const LAS char* lcptr;

#define KSWZ(row, colB) ((row) * 256 + ((colB) ^ (((row) & 7) << 4)))
__device__ __forceinline__ int v_st(int k, int c) { const int kk = (k & ~0xC) | ((k & 4) << 1) | ((k & 8) >> 1); return ((kk >> 3) * 4 + (c >> 5)) * 512 + ((kk & 7) * 32 + (c & 31)) * 2; }
__device__ __forceinline__ int v_rd_base(int lane) { return ((lane & 3) << 3) | (((lane >> 2) & 3) << 6) | (((lane >> 4) & 1) << 5) | (((lane >> 5) & 1) << 8); }
constexpr int v_rd_off(int d0, int ks, int half) { return d0 * 512 + ks * 4096 + half * 2048; }
__device__ __forceinline__ int crow(int r, int hi) { return (r & 3) + 8 * (r >> 2) + 4 * hi; }
__device__ __forceinline__ bf16x8 load8(const bf16_t* p) { return *reinterpret_cast<const bf16x8*>(p); }

__device__ __forceinline__ void pack_p(const f32x16& p0, const f32x16& p1, bf16x8& pa0, bf16x8& pa1, bf16x8& pa2, bf16x8& pa3) {
#define PK4(P, B_, OUT) do { unsigned a0 = cvt_pk_bf16(P[B_+0], P[B_+1]), a1 = cvt_pk_bf16(P[B_+2], P[B_+3]);                          \
        unsigned b0 = cvt_pk_bf16(P[B_+4], P[B_+5]), b1 = cvt_pk_bf16(P[B_+6], P[B_+7]);                                             \
        auto r0 = __builtin_amdgcn_permlane32_swap(a0, b0, false, false); auto r1 = __builtin_amdgcn_permlane32_swap(a1, b1, false, false); \
        u32x4 w = {r0[0], r1[0], r0[1], r1[1]}; OUT = __builtin_bit_cast(bf16x8, w); } while (0)
    PK4(p0, 0, pa0); PK4(p0, 8, pa1); PK4(p1, 0, pa2); PK4(p1, 8, pa3);
#undef PK4
}
__device__ __forceinline__ void partialSM(f32x16& p0, f32x16& p1, float& m_reg, float& mn, float& alpha) {
    float pmax = p0[0];
#pragma unroll
    for (int r = 1; r < 16; ++r) pmax = fmaxf(pmax, p0[r]);
#pragma unroll
    for (int r = 0; r < 16; ++r) pmax = fmaxf(pmax, p1[r]);
    { auto rr = __builtin_amdgcn_permlane32_swap(__float_as_uint(pmax), __float_as_uint(pmax), false, false);
      pmax = fmaxf(__uint_as_float(rr[0]), __uint_as_float(rr[1])); }
    constexpr float C2 = 1.4426950408889634f * SCALE;
    if (__builtin_expect(__all((pmax - m_reg) * SCALE <= THR), 1)) { mn = m_reg; alpha = 1.f; }
    else { mn = fmaxf(m_reg, pmax); alpha = __builtin_amdgcn_exp2f((m_reg - mn) * C2); m_reg = mn; }
    const float mnL = -mn * C2;
#pragma unroll
    for (int r = 0; r < 16; ++r) p0[r] = fmaf(p0[r], C2, mnL);
#pragma unroll
    for (int r = 0; r < 16; ++r) p1[r] = fmaf(p1[r], C2, mnL);
#pragma unroll
    for (int r = 0; r < 16; ++r) p0[r] = __builtin_amdgcn_exp2f(p0[r]);
}
__device__ __forceinline__ void finishSM(f32x16& p0, f32x16& p1, float alpha, float& l_reg, bf16x8& pa0, bf16x8& pa1, bf16x8& pa2, bf16x8& pa3) {
#pragma unroll
    for (int r = 0; r < 16; ++r) p1[r] = __builtin_amdgcn_exp2f(p1[r]);
    float ps = 0;
#pragma unroll
    for (int r = 0; r < 16; ++r) ps += p0[r];
#pragma unroll
    for (int r = 0; r < 16; ++r) ps += p1[r];
    { auto rr = __builtin_amdgcn_permlane32_swap(__float_as_uint(ps), __float_as_uint(ps), false, false);
      ps = __uint_as_float(rr[0]) + __uint_as_float(rr[1]); }
    l_reg = l_reg * alpha + ps;
    pack_p(p0, p1, pa0, pa1, pa2, pa3);
}
template <int KB>
__device__ __forceinline__ void qkt(f32x16& p0, f32x16& p1, lcptr K_lds, int r32, int hi, const bf16x8* qr, float init = 0.f) {
#pragma unroll
    for (int r = 0; r < 16; ++r) { p0[r] = init; p1[r] = init; }
    lcptr kb[4];
#pragma unroll
    for (int dd = 0; dd < 4; ++dd) kb[dd] = K_lds + KB * SHM_K + KSWZ(r32, (dd * 16 + hi * 8) * 2);
#pragma unroll
    for (int d0 = 0; d0 < 8; ++d0) { lcptr a = kb[d0 & 3] + (d0 >> 2) * 128;
        bf16x8 b0 = *reinterpret_cast<const LAS bf16x8*>(a);
        bf16x8 b1 = *reinterpret_cast<const LAS bf16x8*>(a + 32 * 256);
        p0 = __builtin_amdgcn_mfma_f32_32x32x16_bf16(b0, qr[d0], p0, 0, 0, 0);
        p1 = __builtin_amdgcn_mfma_f32_32x32x16_bf16(b1, qr[d0], p1, 0, 0, 0); }
}
#define TRRD(dst, vb, off) asm volatile("ds_read_b64_tr_b16 %0, %1 offset:%2" : "=&v"(dst) : "v"(vb), "i"(off) : "memory")
template <int VOFF>
__device__ __forceinline__ void pv_tile(f32x16* o, int vb0, bf16x8 pa0, bf16x8 pa1, bf16x8 pa2, bf16x8 pa3) {
#define PV_D0(d0) do { s16x4 l0, l1, l2, l3, h0, h1, h2, h3; constexpr int b_ = VOFF + v_rd_off(d0, 0, 0); \
        TRRD(l0, vb0, b_); TRRD(h0, vb0, b_ + 2048); TRRD(l1, vb0, b_ + 4096); TRRD(h1, vb0, b_ + 6144); TRRD(l2, vb0, b_ + 8192); TRRD(h2, vb0, b_ + 10240); TRRD(l3, vb0, b_ + 12288); TRRD(h3, vb0, b_ + 14336); \
        asm volatile("s_waitcnt lgkmcnt(0)" ::: "memory"); SBAR(); \
        o[d0] = __builtin_amdgcn_mfma_f32_32x32x16_bf16(pa0, (bf16x8){l0[0], l0[1], l0[2], l0[3], h0[0], h0[1], h0[2], h0[3]}, o[d0], 0, 0, 0);   \
        o[d0] = __builtin_amdgcn_mfma_f32_32x32x16_bf16(pa1, (bf16x8){l1[0], l1[1], l1[2], l1[3], h1[0], h1[1], h1[2], h1[3]}, o[d0], 0, 0, 0);   \
        o[d0] = __builtin_amdgcn_mfma_f32_32x32x16_bf16(pa2, (bf16x8){l2[0], l2[1], l2[2], l2[3], h2[0], h2[1], h2[2], h2[3]}, o[d0], 0, 0, 0);   \
        o[d0] = __builtin_amdgcn_mfma_f32_32x32x16_bf16(pa3, (bf16x8){l3[0], l3[1], l3[2], l3[3], h3[0], h3[1], h3[2], h3[3]}, o[d0], 0, 0, 0); } while (0)
    PV_D0(0); PV_D0(1); PV_D0(2); PV_D0(3);
#undef PV_D0
}
template <int VOFF, int D0>
__device__ __forceinline__ void tr_frags(int vb0, bf16x8& f0, bf16x8& f1, bf16x8& f2, bf16x8& f3) {
    s16x4 l0, l1, l2, l3, h0, h1, h2, h3; constexpr int b_ = VOFF + v_rd_off(D0, 0, 0);
    TRRD(l0, vb0, b_); TRRD(h0, vb0, b_ + 2048); TRRD(l1, vb0, b_ + 4096); TRRD(h1, vb0, b_ + 6144); TRRD(l2, vb0, b_ + 8192); TRRD(h2, vb0, b_ + 10240); TRRD(l3, vb0, b_ + 12288); TRRD(h3, vb0, b_ + 14336);
    asm volatile("s_waitcnt lgkmcnt(0)" ::: "memory"); SBAR();
    f0 = (bf16x8){l0[0], l0[1], l0[2], l0[3], h0[0], h0[1], h0[2], h0[3]}; f1 = (bf16x8){l1[0], l1[1], l1[2], l1[3], h1[0], h1[1], h1[2], h1[3]};
    f2 = (bf16x8){l2[0], l2[1], l2[2], l2[3], h2[0], h2[1], h2[2], h2[3]}; f3 = (bf16x8){l3[0], l3[1], l3[2], l3[3], h3[0], h3[1], h3[2], h3[3]};
}

struct MobaRef { const bf16_t* Q; const bf16_t* K; const bf16_t* V; bf16_t* O; const unsigned* sel; int qb; };
struct MobaSeam { bf16x8 qr[8]; bf16x8 st_v0, st_v1, st_k0, st_k1; unsigned sel; };
#define AROW(p, k0, rr) ((p) + (size_t)((k0) + (rr)) * APITCH + sc)
#define VMW() asm volatile("s_waitcnt vmcnt(0)" ::: "memory")
#define VMWN(n) asm volatile("s_waitcnt vmcnt(%0)" :: "i"(n) : "memory")
#define SLOAD_H(Kp, Vp, k0) do { S.st_v0 = load8(AROW(Vp, k0, sr)); S.st_v1 = load8(AROW(Vp, k0, 32 + sr));              \
                         S.st_k0 = load8(AROW(Kp, k0, sr)); S.st_k1 = load8(AROW(Kp, k0, 32 + sr)); } while (0)
#define SWRITE_HK(bf) do { *(LAS bf16x8*)(K_lds + (bf) * SHM_K + kws) = S.st_k0; *(LAS bf16x8*)(K_lds + (bf) * SHM_K + kws + 32 * 256) = S.st_k1; } while (0)
#define SWRITE_HV(bf) do { *(LAS bf16x8*)(V_lds + (bf) * SHM_V + vst0) = S.st_v0; *(LAS bf16x8*)(V_lds + (bf) * SHM_V + vst1) = S.st_v1; } while (0)
#define SWRITE_H(bf) do { SWRITE_HV(bf); SWRITE_HK(bf); } while (0)

__device__ __forceinline__ void moba_prime(const MobaRef& cur, lptr lds, MobaSeam& S) {
    int tid = threadIdx.x; asm volatile("" : "+v"(tid)); const int wid = __builtin_amdgcn_readfirstlane(tid >> 6), lane = tid & 63, r32 = lane & 31, hi = lane >> 5;
    const int sr = tid >> 4, sc = (tid & 15) * 8, kws = KSWZ(sr, sc * 2); lptr K_lds = lds + 2 * SHM_V;
#pragma unroll
    for (int d0 = 0; d0 < 8; ++d0) S.qr[d0] = load8(cur.Q + (size_t)(wid * QBLK + r32) * APITCH + d0 * 16 + hi * 8);
    S.sel = cur.sel[wid * QBLK + r32];
    SLOAD_H(cur.K, cur.V, 0); VMW(); SWRITE_HK(0);
    __syncthreads();
}
__device__ __forceinline__ void moba_block(const MobaRef& cur, const MobaRef& nxt, lptr lds, MobaSeam& S) {
    int tid = threadIdx.x; asm volatile("" : "+v"(tid)); const int wid = __builtin_amdgcn_readfirstlane(tid >> 6), lane = tid & 63, r32 = lane & 31, hi = lane >> 5;
    const int qb = cur.qb, NT = 4 * (qb + 1);
    const int qlo = qb * QB + wid * QBLK, qm = qlo + r32 - 4 * hi;
    const unsigned sel = S.sel;
    lptr V_lds = lds; lptr K_lds = lds + 2 * SHM_V;
    LAS float* ws = (LAS float*)(lds + 2 * SHM_V + 2 * SHM_K) + wid * 64; LAS float* li_l = ws; LAS float* al_l = ws + 32;
    float m_reg = -1e30f, l_reg = 0; f32x16 o[4] = {};
    const int sr = tid >> 4, sc = (tid & 15) * 8, vst0 = v_st(sr, sc), vst1 = v_st(32 + sr, sc), kws = KSWZ(sr, sc * 2);
    const int vb0 = (int)(uintptr_t)V_lds + v_rd_base(lane);
    const bf16_t* Kh = cur.K; const bf16_t* Vh = cur.V;
    const float NEG = -__builtin_inff();
#define RESC(a) do { if (__any((a) < 1.f)) { if (hi == 0) al_l[r32] = (a); asm volatile("s_waitcnt lgkmcnt(0)" ::: "memory");              \
                     _Pragma("unroll") for (int d_ = 0; d_ < 4; ++d_) _Pragma("unroll") for (int r = 0; r < 16; ++r) o[d_][r] *= al_l[crow(r, hi)]; } } while (0)
#define KBASE(t) ((t) * KVBLK)
#define MASKT(P0_, P1_, t) do { const int kb_ = KBASE(t); const int jb_ = (t) >> 2;                                              \
        if (jb_ == qb) { if (kb_ + KVBLK - 1 > qlo) { const int dq_ = qm - kb_;                                                    \
            _Pragma("unroll") for (int r = 0; r < 16; ++r) { const int c_ = (r & 3) + 8 * (r >> 2);                                \
                if (dq_ - c_ < 0) P0_[r] = NEG; if (dq_ - c_ - 32 < 0) P1_[r] = NEG; } } }                                         \
        } while (0)
#define SELINIT(t) ((((t) >> 2) == qb || ((sel >> ((t) >> 2)) & 1u)) ? 0.f : NEG)
    constexpr int NQL = 9;
#define SEAM_K0() do { VMWN(NQL); SWRITE_HK(0); SBAR(); } while (0)
    f32x16 pA0, pA1, pB0, pB1; float mnA, mnB, alA, alB; bf16x8 pa0, pa1, pa2, pa3;
    SWRITE_HV(0); SBAR();
    SLOAD_H(Kh, Vh, KBASE(1));
    SBAR(); qkt<0>(pA0, pA1, K_lds, r32, hi, S.qr, SELINIT(0));
    MASKT(pA0, pA1, 0); partialSM(pA0, pA1, m_reg, mnA, alA);
    VMW(); SWRITE_H(1);
    __syncthreads();
#define HALF_STEP(PX0, PX1, mnX, alX, PY0, PY1, alY, t, KB, VB, SB) do {                                                      \
        SBAR(); qkt<KB>(PX0, PX1, K_lds, r32, hi, S.qr, SELINIT(t));                                                           \
        finishSM(PY0, PY1, alY, l_reg, pa0, pa1, pa2, pa3); SBAR();                                                           \
        if ((t) + 1 < NT) { SLOAD_H(Kh, Vh, KBASE((t) + 1)); SBAR(); }                                                        \
        pv_tile<VB * SHM_V>(o, vb0, pa0, pa1, pa2, pa3); MASKT(PX0, PX1, (t)); partialSM(PX0, PX1, m_reg, mnX, alX);          \
        __syncthreads();                                                                                                      \
        if ((t) + 1 < NT) { VMW(); SWRITE_H(SB); }                                                                            \
        RESC(alX); __syncthreads(); } while (0)
    for (int t = 1; t + 1 < NT; t += 2) {
        HALF_STEP(pB0, pB1, mnB, alB, pA0, pA1, alA, t, 1, 0, 0);
        HALF_STEP(pA0, pA1, mnA, alA, pB0, pB1, alB, t + 1, 0, 1, 1);
    }
    SBAR(); qkt<1>(pB0, pB1, K_lds, r32, hi, S.qr, SELINIT(NT - 1)); SBAR();
    SLOAD_H(nxt.K, nxt.V, 0); SBAR();
#pragma unroll
    for (int d0 = 0; d0 < 8; ++d0) S.qr[d0] = load8(nxt.Q + (size_t)(wid * QBLK + r32) * APITCH + d0 * 16 + hi * 8);
    S.sel = nxt.sel[wid * QBLK + r32];
    SBAR();
    finishSM(pA0, pA1, alA, l_reg, pa0, pa1, pa2, pa3); SBAR();
    pv_tile<0>(o, vb0, pa0, pa1, pa2, pa3);
    MASKT(pB0, pB1, NT - 1); partialSM(pB0, pB1, m_reg, mnB, alB); __syncthreads(); RESC(alB);
    finishSM(pB0, pB1, alB, l_reg, pa0, pa1, pa2, pa3); SBAR(); pv_tile<SHM_V>(o, vb0, pa0, pa1, pa2, pa3);
    SBAR(); SEAM_K0();
    if (hi == 0) li_l[r32] = l_reg; asm volatile("s_waitcnt lgkmcnt(0)" ::: "memory");
    float rli[16];
#pragma unroll
    for (int r = 0; r < 16; ++r) rli[r] = __builtin_amdgcn_rcpf(li_l[crow(r, hi)]);
    bf16_t* Ow = cur.O + (size_t)(wid * QBLK) * OPITCH;
#pragma unroll
    for (int r = 0; r < 16; ++r) { const int orow = crow(r, hi);
#pragma unroll
        for (int d0 = 0; d0 < 4; ++d0) { const float v = o[d0][r] * rli[r];
            const float vn = __shfl_xor(v, 1);
            if ((r32 & 1) == 0) *(unsigned*)(Ow + (size_t)orow * OPITCH + d0 * 32 + r32) = cvt_pk_bf16(v, vn); } }
    __syncthreads();
#undef RESC
#undef KBASE
#undef MASKT
#undef SELINIT
#undef SEAM_K0
#undef HALF_STEP
}

__device__ __forceinline__ MobaRef moba_ref(const Params& p, int bh, int qb) {
    const int b = bh / MH, h = bh % MH;
    const bf16_t* proj = (const bf16_t*)(p.ws + WS_PROJ); bf16_t* mixed = (bf16_t*)(p.ws + WS_MIXED); const unsigned* selp = (const unsigned*)(p.ws + WS_SEL);
    MobaRef r; const size_t tok0 = (size_t)b * SEQ;
    r.Q = proj + (tok0 + (size_t)qb * QB) * APITCH + C_MQ + h * HD; r.K = proj + tok0 * APITCH + C_MK + h * HD; r.V = proj + tok0 * APITCH + C_MV + h * HD;
    r.O = mixed + (tok0 + (size_t)qb * QB) * OPITCH + h * HD; r.sel = selp + (size_t)bh * SEQ + qb * QB; r.qb = qb; return r;
}
__device__ __forceinline__ void phase_moba(const Params& p, lptr lds) {
    const int G = gridDim.x; const int bx = blockIdx.x; const int vcu = (G % 8 == 0) ? (bx % 8) * (G / 8) + bx / 8 : bx;
    constexpr int NITEM = NBATCH * MH * 8;
    int L = vcu; if (L >= NITEM) return;
    int pass = 0;
    MobaRef cur = moba_ref(p, L >> 3, L & 7);
    MobaSeam S;
    moba_prime(cur, lds, S);
    for (;;) {
        const bool more_pass = pass == 0, more_item = L + G < NITEM, last = !more_pass && !more_item;
        int Ln = L, passn = 1;
        if (!more_pass) { passn = 0; Ln = more_item ? L + G : L; }
        const MobaRef nxt = last ? cur : moba_ref(p, Ln >> 3, passn ? 15 - (Ln & 7) : (Ln & 7));
        moba_block(cur, nxt, lds, S);
        if (last) break;
        cur = nxt; pass = passn; L = Ln;
    }
}
#undef SLOAD_H
#undef SWRITE_HK
#undef SWRITE_HV
#undef SWRITE_H
#undef VMWN
}
namespace att {
__device__ __forceinline__ void stage_vstyle(lptr dst, const bf16_t* src, size_t pitch, int tid) {
    const int sr = tid >> 4, sc = (tid & 15) * 8;
    const bf16x8 a = load8(src + (size_t)sr * pitch + sc), b = load8(src + (size_t)(32 + sr) * pitch + sc);
    *(LAS bf16x8*)(dst + v_st(sr, sc)) = a; *(LAS bf16x8*)(dst + v_st(32 + sr, sc)) = b;
}
__device__ __forceinline__ void stage_kstyle(lptr dst, const bf16_t* src, size_t pitch, int tid) {
    const int sr = tid >> 4, sc = (tid & 15) * 8;
    const bf16x8 a = load8(src + (size_t)sr * pitch + sc), b = load8(src + (size_t)(32 + sr) * pitch + sc);
    *(LAS bf16x8*)(dst + KSWZ(sr, sc * 2)) = a; *(LAS bf16x8*)(dst + KSWZ(sr, sc * 2) + 32 * 256) = b;
}

__device__ __forceinline__ void phase_moba_select(const Params& p, lptr lds, int tid_) { int tid = tid_; asm volatile("" : "+v"(tid));
    const bf16_t* proj = (const bf16_t*)(p.ws + WS_PROJ); const float* kmean = (const float*)(p.ws + WS_KMEAN); unsigned* selp = (unsigned*)(p.ws + WS_SEL);
    constexpr int QP = 272;
    lptr ql = lds; LAS float* kml = (LAS float*)(lds + 256 * QP); LAS float* gl = (LAS float*)(lds + 256 * QP + 8192);
    for (int u = blockIdx.x; u < NBATCH * MH * NBLK; u += gridDim.x) {
        const int bh = u / NBLK, qb = u % NBLK, b = bh / MH, h = bh % MH;
        if (qb == 0) { if (tid < 256) selp[(size_t)bh * SEQ + tid] = 0u; continue; }
        const bf16_t* qsrc = proj + ((size_t)b * SEQ + qb * 256) * NPROJ + C_MQ + h * HD;
        for (int i = tid; i < 256 * 16; i += NTHREADS) { const int r = i >> 4, ch = i & 15; *(LAS bf16x8*)(ql + r * QP + ch * 16) = load8(qsrc + (size_t)r * NPROJ + ch * 8); }
        for (int i = tid; i < 16 * 128 / 4; i += NTHREADS) *(LAS f32x4*)(kml + i * 4) = *(const f32x4*)(kmean + (size_t)bh * NBLK * HD + i * 4);
        __syncthreads();
        const int q = tid & 255, ng = tid >> 8;
        float g[8];
#pragma unroll
        for (int n = 0; n < 8; ++n) g[n] = 0.f;
        for (int ch = 0; ch < 16; ++ch) {
            const u32x4 qw = *(const LAS u32x4*)(ql + q * QP + ch * 16);
            const float qv[8] = {bflo(qw.x), bfhi(qw.x), bflo(qw.y), bfhi(qw.y), bflo(qw.z), bfhi(qw.z), bflo(qw.w), bfhi(qw.w)};
#pragma unroll
            for (int n = 0; n < 8; ++n) { if (ng * 8 + n < qb) {
                const f32x4 k0 = *(const LAS f32x4*)(kml + (ng * 8 + n) * 128 + ch * 8), k1 = *(const LAS f32x4*)(kml + (ng * 8 + n) * 128 + ch * 8 + 4);
                g[n] += qv[0] * k0[0] + qv[1] * k0[1] + qv[2] * k0[2] + qv[3] * k0[3] + qv[4] * k1[0] + qv[5] * k1[1] + qv[6] * k1[2] + qv[7] * k1[3]; } }
        }
#pragma unroll
        for (int n = 0; n < 8; ++n) gl[q * 16 + ng * 8 + n] = g[n];
        __syncthreads();
        if (tid < 256) {
            float gv[16];
#pragma unroll
            for (int n = 0; n < 16; ++n) gv[n] = (n < qb) ? gl[tid * 16 + n] : -__builtin_inff();
            unsigned m = 0u;
#pragma unroll
            for (int k = 0; k < 3; ++k) { float best = -__builtin_inff(); int bi = -1;
#pragma unroll
                for (int n = 0; n < 16; ++n) { const bool tk = gv[n] > best; best = tk ? gv[n] : best; bi = tk ? n : bi; }
                if (bi >= 0) m |= 1u << bi;
#pragma unroll
                for (int n = 0; n < 16; ++n) gv[n] = (n == bi) ? -__builtin_inff() : gv[n]; }
            selp[(size_t)bh * SEQ + qb * 256 + tid] = m;
        }
        __syncthreads();
    }
}

__device__ __forceinline__ void phase_gla_state(const Params& p, lptr lds, int tid_) { int tid = tid_; asm volatile("" : "+v"(tid));
    const bf16_t* proj = (const bf16_t*)(p.ws + WS_PROJ); const float* dend = (const float*)(p.ws + WS_DEND); float* U = (float*)(p.ws + WS_U);
    const int wid = __builtin_amdgcn_readfirstlane(tid >> 6), lane = tid & 63, r32 = lane & 31, hi = lane >> 5;
    const int dkb = wid & 3, half = wid >> 2;
    const int vb0 = (int)(uintptr_t)lds + v_rd_base(lane);
    for (int u = blockIdx.x; u < NBATCH * GH * NBLK; u += gridDim.x) {
        const int bh = u / NBLK, j = u % NBLK, b = bh / GH, h = bh % GH;
        const size_t tok0 = (size_t)b * SEQ + j * 256;
        f32x16 o[4] = {};
        for (int t = 0; t < 4; ++t) {
            __syncthreads();
            const bf16_t* rowp = proj + (tok0 + t * 64) * NPROJ;
            stage_vstyle(lds, rowp + C_GK + h * GDK, NPROJ, tid);
            stage_vstyle(lds + SHM_V, rowp + C_GV + h * GDV, NPROJ, tid);
            stage_vstyle(lds + 2 * SHM_V, rowp + C_GV + h * GDV + 128, NPROJ, tid);
            __syncthreads();
            bf16x8 a0, a1, a2, a3;
            if (dkb == 0) tr_frags<0, 0>(vb0, a0, a1, a2, a3); else if (dkb == 1) tr_frags<0, 1>(vb0, a0, a1, a2, a3); else if (dkb == 2) tr_frags<0, 2>(vb0, a0, a1, a2, a3); else tr_frags<0, 3>(vb0, a0, a1, a2, a3);
            if (half == 0) pv_tile<SHM_V>(o, vb0, a0, a1, a2, a3); else pv_tile<2 * SHM_V>(o, vb0, a0, a1, a2, a3);
        }
        float dv[16];
#pragma unroll
        for (int r = 0; r < 16; ++r) dv[r] = dend[(size_t)u * GDK + dkb * 32 + crow(r, hi)];
        float* Uo = U + (size_t)u * (GDK * GDV);
#pragma unroll
        for (int r = 0; r < 16; ++r) { const int k = dkb * 32 + crow(r, hi);
#pragma unroll
            for (int d0 = 0; d0 < 4; ++d0) Uo[(size_t)k * GDV + half * 128 + d0 * 32 + r32] = o[d0][r] * dv[r]; }
    }
    __syncthreads();
}

__device__ __forceinline__ void phase_gla_scan(const Params& p, int tid_) { int tid = tid_; asm volatile("" : "+v"(tid));
    const float* U = (const float*)(p.ws + WS_U); const float* dend = (const float*)(p.ws + WS_DEND); bf16_t* Sj = (bf16_t*)(p.ws + WS_SJ);
    constexpr int NEL = NBATCH * GH * GDK * GDV / 4;
    for (int i = blockIdx.x * NTHREADS + tid; i < NEL; i += gridDim.x * NTHREADS) {
        const int bh = i / (GDK * GDV / 4), e4 = i % (GDK * GDV / 4), k = e4 / (GDV / 4);
        f32x4 S = {0.f, 0.f, 0.f, 0.f};
        f32x4 uv[NBLK]; float dd[NBLK];
#pragma unroll
        for (int j = 0; j < NBLK; ++j) { uv[j] = *(const f32x4*)(U + ((size_t)(bh * NBLK + j) * (GDK * GDV)) + (size_t)e4 * 4); dd[j] = dend[(size_t)(bh * NBLK + j) * GDK + k]; }
#pragma unroll
        for (int j = 0; j < NBLK; ++j) {
            u32x2 w; w.x = cvt_pk_bf16(S[0], S[1]); w.y = cvt_pk_bf16(S[2], S[3]);
            *(u32x2*)(Sj + ((size_t)(bh * NBLK + j) * (GDK * GDV)) + (size_t)e4 * 4) = w;
            S = S * dd[j] + uv[j]; }
    }
}

__device__ __forceinline__ void phase_gla_out(const Params& p, lptr lds, int tid_) { int tid = tid_; asm volatile("" : "+v"(tid));
    const bf16_t* proj = (const bf16_t*)(p.ws + WS_PROJ); const bf16_t* Sj = (const bf16_t*)(p.ws + WS_SJ); bf16_t* mixed = (bf16_t*)(p.ws + WS_MIXED);
    const int wid = __builtin_amdgcn_readfirstlane(tid >> 6), lane = tid & 63, r32 = lane & 31, hi = lane >> 5;
    constexpr int BUF = 3 * SHM_V;
    const int vb0 = (int)(uintptr_t)lds + v_rd_base(lane), vb1 = vb0 + BUF;
    const int sr = tid >> 4, sc = (tid & 15) * 8;
    const int kws = KSWZ(sr, sc * 2), vst0 = v_st(sr, sc), vst1 = v_st(32 + sr, sc);
    for (int u = blockIdx.x; u < NBATCH * GH * NBLK; u += gridDim.x) {
        const int bh = u / NBLK, j = u % NBLK, b = bh / GH, h = bh % GH;
        const size_t tok0 = (size_t)b * SEQ + j * 256;
        bf16x8 qr[8];
#pragma unroll
        for (int d0 = 0; d0 < 8; ++d0) qr[d0] = load8(proj + (tok0 + wid * 32 + r32) * NPROJ + C_GQ + h * GDK + d0 * 16 + hi * 8);
        f32x16 o[8] = {};
        bf16x8 sk0, sk1, sa0, sa1, sb0, sb1;
        const bf16_t* sp = Sj + (size_t)u * (GDK * GDV);
#define GO_LOAD(s_) do { if ((s_) < 4) { const bf16_t* rp = proj + (tok0 + (s_) * 64) * NPROJ; \
            sk0 = load8(rp + (size_t)sr * NPROJ + C_GK + h * GDK + sc); sk1 = load8(rp + (size_t)(32 + sr) * NPROJ + C_GK + h * GDK + sc); \
            sa0 = load8(rp + (size_t)sr * NPROJ + C_GV + h * GDV + sc); sa1 = load8(rp + (size_t)(32 + sr) * NPROJ + C_GV + h * GDV + sc); \
            sb0 = load8(rp + (size_t)sr * NPROJ + C_GV + h * GDV + 128 + sc); sb1 = load8(rp + (size_t)(32 + sr) * NPROJ + C_GV + h * GDV + 128 + sc); } \
          else { const bf16_t* rp = sp + (size_t)((s_) - 4) * 64 * GDV; \
            sa0 = load8(rp + (size_t)sr * GDV + sc); sa1 = load8(rp + (size_t)(32 + sr) * GDV + sc); \
            sb0 = load8(rp + (size_t)sr * GDV + 128 + sc); sb1 = load8(rp + (size_t)(32 + sr) * GDV + 128 + sc); } } while (0)
#define GO_WRITE(s_, bufo) do { if ((s_) < 4) { *(LAS bf16x8*)(lds + (bufo) + kws) = sk0; *(LAS bf16x8*)(lds + (bufo) + kws + 32 * 256) = sk1; } \
            *(LAS bf16x8*)(lds + (bufo) + SHM_V + vst0) = sa0; *(LAS bf16x8*)(lds + (bufo) + SHM_V + vst1) = sa1; \
            *(LAS bf16x8*)(lds + (bufo) + 2 * SHM_V + vst0) = sb0; *(LAS bf16x8*)(lds + (bufo) + 2 * SHM_V + vst1) = sb1; } while (0)
#define GO_STEP(s_, B_) do { GO_LOAD(s_); __syncthreads(); GO_WRITE(s_, (B_) * BUF); __syncthreads(); \
            if ((s_) < 4) { if ((s_) * 64 <= wid * 32 + 31) { f32x16 p0, p1; qkt<0>(p0, p1, lds + (B_) * BUF, r32, hi, qr); \
                    const int dq = wid * 32 + r32 - 4 * hi - (s_) * 64; \
                    _Pragma("unroll") for (int r = 0; r < 16; ++r) { const int c_ = (r & 3) + 8 * (r >> 2); if (dq - c_ < 0) p0[r] = 0.f; if (dq - c_ - 32 < 0) p1[r] = 0.f; } \
                    bf16x8 pa0, pa1, pa2, pa3; pack_p(p0, p1, pa0, pa1, pa2, pa3); \
                    pv_tile<SHM_V>(o, (B_) ? vb1 : vb0, pa0, pa1, pa2, pa3); pv_tile<2 * SHM_V>(o + 4, (B_) ? vb1 : vb0, pa0, pa1, pa2, pa3); } } \
            else { pv_tile<SHM_V>(o, (B_) ? vb1 : vb0, qr[4 * ((s_) - 4)], qr[4 * ((s_) - 4) + 1], qr[4 * ((s_) - 4) + 2], qr[4 * ((s_) - 4) + 3]); \
                   pv_tile<2 * SHM_V>(o + 4, (B_) ? vb1 : vb0, qr[4 * ((s_) - 4)], qr[4 * ((s_) - 4) + 1], qr[4 * ((s_) - 4) + 2], qr[4 * ((s_) - 4) + 3]); } } while (0)
        GO_STEP(0, 0); GO_STEP(1, 0); GO_STEP(2, 0); GO_STEP(3, 0); GO_STEP(4, 0); GO_STEP(5, 0);
#undef GO_LOAD
#undef GO_WRITE
#undef GO_STEP
        int hi_e = hi, r32_e = r32; asm volatile("" : "+v"(hi_e), "+v"(r32_e));
        float wv[8];
#pragma unroll
        for (int d0 = 0; d0 < 8; ++d0) wv[d0] = p.gla_norm_w[d0 * 32 + r32_e];
        const bf16_t* ggp = proj + (tok0 + wid * 32) * NPROJ + C_GG + h * GDV + r32_e;
        bf16_t* op = mixed + (tok0 + wid * 32) * DM + 1024 + h * GDV + r32_e;
#pragma unroll
        for (int r = 0; r < 16; ++r) { const int orow = crow(r, hi_e);
            float g[8];
#pragma unroll
            for (int d0 = 0; d0 < 8; ++d0) g[d0] = bf2f(ggp[(size_t)orow * NPROJ + d0 * 32]);
            float ss = 0.f;
#pragma unroll
            for (int d0 = 0; d0 < 8; ++d0) ss += o[d0][r] * o[d0][r];
            ss += __shfl_xor(ss, 1); ss += __shfl_xor(ss, 2); ss += __shfl_xor(ss, 4); ss += __shfl_xor(ss, 8); ss += __shfl_xor(ss, 16);
            const float rsr = 1.0f / sqrtf(ss * (1.0f / GDV) + EPS);
#pragma unroll
            for (int d0 = 0; d0 < 8; ++d0) { const float sg = g[d0] * __builtin_amdgcn_rcpf(1.0f + __expf(-g[d0]));
                const float v = o[d0][r] * rsr * wv[d0] * sg; const float vn = __shfl_xor(v, 1);
                if ((r32_e & 1) == 0) *(unsigned*)(op + (size_t)orow * DM + d0 * 32) = cvt_pk_bf16(v, vn); }
            asm volatile("" ::: "memory"); }
    }
    __syncthreads();
}
}

__device__ __forceinline__ void phase_route(const Params& p, const Ctx& c0) { const Ctx c = fresh_ctx(c0);
    const int* hist = (const int*)(p.ws + WS_HIST); const int* topi = (const int*)(p.ws + WS_TOPI); const float* rstd2 = (const float*)(p.ws + WS_RSTD2);
    int* dest = (int*)(p.ws + WS_DEST); int* row_tok = (int*)(p.ws + WS_ROWTOK); float* row_rstd = (float*)(p.ws + WS_ROWRSTD); int* blk = (int*)(p.ws + WS_BLKE);
    LAS int* cnt = (LAS int*)c.lds; LAS int* before = cnt + 32; LAS int* pstart = cnt + 64; LAS int* ea = cnt + 128;
    for (int g = blockIdx.x; g < T / 64; g += gridDim.x) {
        if (c.tid < 64) cnt[c.tid] = 0;
        __syncthreads();
        { const int e = c.tid & 31, part = c.tid >> 5; int tot = 0, bef = 0;
#pragma unroll
            for (int i = 0; i < 16; ++i) { const int gg = part * 16 + i; const int v = hist[gg * 32 + e]; tot += v; bef += (gg < g) ? v : 0; }
            atomicAdd((int*)&cnt[e], tot); atomicAdd((int*)&before[e], bef); }
        __syncthreads();
        if (c.tid == 0) { int acc = 0; for (int e = 0; e < NE; ++e) { pstart[e] = acc; acc += ((cnt[e] + 255) >> 8) << 8; } pstart[NE] = acc; }
        if (c.tid < 256) ea[c.tid] = topi[(size_t)g * 256 + c.tid];
        __syncthreads();
        if (c.tid < 256) {
            const int e = ea[c.tid]; int rank = 0;
            for (int a = 0; a < c.tid; ++a) rank += (ea[a] == e) ? 1 : 0;
            const int d = pstart[e] + before[e] + rank; const int tok = g * 64 + (c.tid >> 2);
            dest[(size_t)g * 256 + c.tid] = d; row_tok[d] = tok; row_rstd[d] = rstd2[tok];
        }
        if (g == 0 && c.tid < 64) {
            const int nb = pstart[NE] >> 8; if (c.tid == 0) blk[0] = nb;
            for (int bq = c.tid; bq < nb; bq += 64) { int e = 0; for (int q = 0; q < NE; ++q) e += (pstart[q + 1] <= bq * 256) ? 1 : 0; blk[64 + bq] = e < NE ? e : NE - 1; }
        }
        __syncthreads();
    }
}

__device__ __forceinline__ void phase_combine(const Params& p, const Ctx& c0) { const Ctx c = fresh_ctx(c0);
    const float* X1 = (const float*)(p.ws + WS_X1); const unsigned char* Y = (const unsigned char*)(p.ws + WS_Y); const int* dest = (const int*)(p.ws + WS_DEST); const float* topg = (const float*)(p.ws + WS_TOPG);
    for (int t = blockIdx.x * NWAVES + c.wave; t < T; t += gridDim.x * NWAVES) {
        const int4 d4 = *(const int4*)(dest + (size_t)t * 4); const float4 g4 = *(const float4*)(topg + (size_t)t * 4);
        const int dd[4] = {d4.x, d4.y, d4.z, d4.w}; const float gg[4] = {g4.x * (1.0f / Y_SCALE), g4.y * (1.0f / Y_SCALE), g4.z * (1.0f / Y_SCALE), g4.w * (1.0f / Y_SCALE)};
        f32x4 v[8]; u32x2 yw[4][4]; float ss = 0.f;
#pragma unroll
        for (int j = 0; j < 4; ++j) { v[2 * j] = *(const f32x4*)(X1 + (size_t)t * DM + j * 512 + c.lane * 8); v[2 * j + 1] = *(const f32x4*)(X1 + (size_t)t * DM + j * 512 + c.lane * 8 + 4); }
#pragma unroll
        for (int k = 0; k < 4; ++k)
#pragma unroll
            for (int j = 0; j < 4; ++j) yw[k][j] = *(const u32x2*)(Y + (size_t)dd[k] * DM + j * 512 + c.lane * 8);
#pragma unroll
        for (int k = 0; k < 4; ++k)
#pragma unroll
            for (int j = 0; j < 4; ++j) { const f32x2 a = __builtin_amdgcn_cvt_pk_f32_fp8(yw[k][j].x, false), b = __builtin_amdgcn_cvt_pk_f32_fp8(yw[k][j].x, true);
                const f32x2 cc = __builtin_amdgcn_cvt_pk_f32_fp8(yw[k][j].y, false), d = __builtin_amdgcn_cvt_pk_f32_fp8(yw[k][j].y, true);
                v[2 * j][0] += gg[k] * a[0]; v[2 * j][1] += gg[k] * a[1]; v[2 * j][2] += gg[k] * b[0]; v[2 * j][3] += gg[k] * b[1];
                v[2 * j + 1][0] += gg[k] * cc[0]; v[2 * j + 1][1] += gg[k] * cc[1]; v[2 * j + 1][2] += gg[k] * d[0]; v[2 * j + 1][3] += gg[k] * d[1]; }
#pragma unroll
        for (int j = 0; j < 8; ++j) ss += (v[j][0] * v[j][0] + v[j][1] * v[j][1]) + (v[j][2] * v[j][2] + v[j][3] * v[j][3]);
        const float rs = 1.0f / sqrtf(wave_sum(ss) * (1.0f / DM) + EPS);
#pragma unroll
        for (int j = 0; j < 8; ++j) { const int col = (j >> 1) * 512 + c.lane * 8 + (j & 1) * 4; const f32x4 w = *(const f32x4*)(p.final_norm_w + col);
            *(f32x4*)(p.out + (size_t)t * DM + col) = v[j] * rs * w; }
    }
}
__device__ __forceinline__ Ctx make_ctx(unsigned char* lds_generic) {
    Ctx c; c.lds = (LAS unsigned char*)lds_generic; c.tid = threadIdx.x; c.lane = c.tid & 63; c.wave = __builtin_amdgcn_readfirstlane(c.tid >> 6); return c;
}
__device__ __forceinline__ void phase_gemm_inproj16(const Params& p, const Ctx& c, int i0, int i1, int G, int cidx) {
    if (i0 >= i1) return;
    g8::DenseProbIn P{(const bf16_t*)(p.ws + WS_H), (const bf16_t*)(p.ws + WS_WIN), T / 256, NPROJ / 256, DM, G, cidx, i0, i1};
    g8::EpiProj E{(bf16_t*)(p.ws + WS_PROJ), (const float*)(p.ws + WS_RSTD1), 1.0f, 0};
    g8::gemm_phase(c.lds, P, E);
}
__device__ __forceinline__ void phase_gemm_outproj(const Params& p, const Ctx& c, int i0, int i1) {
    if (i0 >= i1) return;
    g8::DenseProbOut P{(const bf16_t*)(p.ws + WS_MIXED), (const bf16_t*)(p.ws + WS_WOUT), T / 256, DM / 256, DM, (int)gridDim.x, (int)blockIdx.x, i0, i1};
    g8::EpiX1 E{p.x, (float*)(p.ws + WS_X1)};
    g8::gemm_phase(c.lds, P, E);
}
__device__ __forceinline__ void phase_gemm_moe1(const Params& p, const Ctx& c, int i0, int i1) {
    g8::MoeProb1 P{(const bf16_t*)(p.ws + WS_H), (const bf16_t*)(p.ws + WS_WGU), (const int*)(p.ws + WS_ROWTOK), (const int*)(p.ws + WS_BLKE), DM / 2, __builtin_amdgcn_readfirstlane(*(const int*)(p.ws + WS_BLKE)), i0, i1};
    g8::EpiSwiglu E{(unsigned char*)(p.ws + WS_ACT), (const float*)(p.ws + WS_ROWRSTD), p.b_gu};
    g8::gemm_phase(c.lds, P, E);
}
__device__ __forceinline__ void phase_gemm_moe2(const Params& p, const Ctx& c) {
    g8::MoeProb2 P{(const bf16_t*)(p.ws + WS_ACT), (const bf16_t*)(p.ws + WS_WD), (const int*)(p.ws + WS_BLKE), FF / 2, __builtin_amdgcn_readfirstlane(*(const int*)(p.ws + WS_BLKE))};
    g8::EpiDown E{(unsigned char*)(p.ws + WS_Y), p.b_d};
    g8::gemm_phase(c.lds, P, E);
}


constexpr int CW_BAR = 4096;
__global__ void __launch_bounds__(NTHREADS, 2) fwd(Params p) {
    extern __shared__ __attribute__((aligned(16))) unsigned char lds_raw[];
    const Ctx c = make_ctx(lds_raw);
    if (c.tid < 64) ((LAS unsigned*)(c.lds + LDS_MISC))[c.tid] = 0u;
    __syncthreads();
    const XcdBarrier bar = xcd_barrier_post((unsigned*)(p.ws + WS_CTL) + CW_BAR, (volatile LAS unsigned*)(c.lds + LDS_MISC + 32));
    const att::lptr al = (att::lptr)c.lds;
    phase_convert(p, c); phase_norm1(p, c);
    xcd_barrier(bar);
    {
        const int bx = blockIdx.x, G = gridDim.x;
        const int cut = (G == 256) ? (bx >> 3) % 7 : 0;
        if (cut > 0) phase_gemm_inproj16(p, c, 0, cut, G, bx);
        phase_convert_share(p, c, 0, CT_GU, G, bx);
        phase_gemm_inproj16(p, c, cut, 1 << 20, G, bx);
    }
    xcd_barrier(bar);
    phase_rope_kmean(p, c); phase_gla_prep(p, c);
    xcd_barrier(bar);
    att::phase_gla_state(p, al, c.tid); att::phase_moba_select(p, al, c.tid);
    xcd_barrier(bar);
    att::phase_gla_scan(p, c.tid);
    xcd_barrier(bar);
    att::phase_gla_out(p, al, c.tid); att::phase_moba(p, al);
    xcd_barrier(bar);
    phase_gemm_outproj(p, c, 0, 1 << 20);
    xcd_barrier(bar);
    phase_norm2_router(p, c);
    xcd_barrier(bar);
    phase_route(p, c);
    xcd_barrier(bar);
    {
        const int cut = 2 * ((blockIdx.x >> 3) & 7);
        if (cut > 0) phase_gemm_moe1(p, c, 0, cut);
        phase_convert_share(p, c, CT_GU, CT_TOTAL, (int)gridDim.x, (int)blockIdx.x);
        phase_gemm_moe1(p, c, cut, 1 << 20);
    }
    xcd_barrier(bar);
    phase_gemm_moe2(p, c);
    xcd_barrier(bar);
    phase_combine(p, c);
}

extern "C" void kernel_launch(void* const* d_in, const int* in_sizes, int n_in, void* d_out, int out_size, void* d_ws, size_t ws_size, hipStream_t stream) {
    static int grid = 0;
    if (grid == 0) {
        if (n_in != 15 || ws_size < WS_END) { fprintf(stderr, "kernel_launch: unexpected inputs (n_in %d, ws %zu)\n", n_in, ws_size); grid = -1; return; }
        int dev = 0, cus = 0, per_cu = 0;
        if (hipGetDevice(&dev) != hipSuccess || hipDeviceGetAttribute(&cus, hipDeviceAttributeMultiprocessorCount, dev) != hipSuccess) { grid = -1; return; }
        if (hipFuncSetAttribute((const void*)fwd, hipFuncAttributeMaxDynamicSharedMemorySize, LDS_BYTES) != hipSuccess) { fprintf(stderr, "kernel_launch: hipFuncSetAttribute failed\n"); grid = -1; return; }
        if (hipOccupancyMaxActiveBlocksPerMultiprocessor(&per_cu, (const void*)fwd, NTHREADS, LDS_BYTES) != hipSuccess || per_cu < 1) { fprintf(stderr, "kernel_launch: occupancy query says %d blocks per CU\n", per_cu); }
        (void)hipGetLastError();
        grid = cus > 0 ? cus : 256;
    }
    if (grid < 0) return;
    Params p{};
    p.x = (const float*)d_in[0]; p.attn_norm_w = (const float*)d_in[1]; p.w_in = (const float*)d_in[2]; p.gate_w2 = (const float*)d_in[3]; p.gate_b = (const float*)d_in[4];
    p.gla_norm_w = (const float*)d_in[5]; p.w_out = (const float*)d_in[6]; p.ffn_norm_w = (const float*)d_in[7]; p.router_w = (const float*)d_in[8]; p.router_b = (const float*)d_in[9];
    p.w_gu = (const float*)d_in[10]; p.b_gu = (const float*)d_in[11]; p.w_d = (const float*)d_in[12]; p.b_d = (const float*)d_in[13]; p.final_norm_w = (const float*)d_in[14];
    p.out = (float*)d_out; p.ws = (unsigned char*)d_ws;
    if (hipMemsetAsync((char*)d_ws + WS_CTL, 0, CTL_BYTES, stream) != hipSuccess) return;
    hipLaunchKernelGGL(fwd, dim3(grid), dim3(NTHREADS), LDS_BYTES, stream, p);
}
```

```cpp
#include <hip/hip_runtime.h>
#include <stdint.h>
#include <stdio.h>

#define LAS __attribute__((address_space(3)))
typedef unsigned short bf16_t;
typedef short bf16x8 __attribute__((ext_vector_type(8)));
typedef short s16x4 __attribute__((ext_vector_type(4)));
typedef float f32x2 __attribute__((ext_vector_type(2)));
typedef float f32x4 __attribute__((ext_vector_type(4)));
typedef float f32x16 __attribute__((ext_vector_type(16)));
typedef unsigned u32x2 __attribute__((ext_vector_type(2)));
typedef unsigned u32x4 __attribute__((ext_vector_type(4)));
typedef int i32x8 __attribute__((ext_vector_type(8)));

constexpr int NBATCH = 4, SEQ = 4096, T = NBATCH * SEQ, DM = 2048;
constexpr int HD = 128, MH = 8, MBLK = 256, NBLK = SEQ / MBLK;
constexpr int GH = 4, GDK = 128, GDV = 256;
constexpr int LDW_IN = 6160, NPROJ = 6144;
constexpr int C_MQ = 0, C_MK = 1024, C_MV = 2048, C_GQ = 3072, C_GK = 3584, C_GV = 4096, C_GG = 5120, C_GZ = 6144;
constexpr int NE = 32, TOPK = 4, FF = 2048, NASSIGN = T * TOPK;
constexpr int MAXBLK = (NASSIGN + NE * 255) / 256, PROWS = MAXBLK * 256;
constexpr float EPS = 1e-5f;
constexpr float ACT_SCALE = 4.0f, W_SCALE = 64.0f, F8_UNSCALE = 1.0f / (ACT_SCALE * W_SCALE);
constexpr float Y_SCALE = 16.0f;

constexpr size_t MiB = (size_t)1 << 20;
constexpr size_t WS_CTL = 0, CTL_BYTES = 64 * 1024;
constexpr size_t WS_WIN = 16 * MiB;
constexpr size_t WS_WOUT = 40 * MiB;
constexpr size_t WS_ROPE = 48 * MiB;
constexpr size_t WS_RSTD1 = 50 * MiB;
constexpr size_t WS_GZ = 51 * MiB;
constexpr size_t WS_KMEAN = 52 * MiB;
constexpr size_t WS_DEND = 52 * MiB + 512 * 1024;
constexpr size_t WS_RSTD2 = 53 * MiB;
constexpr size_t WS_SEL = 54 * MiB;
constexpr size_t WS_TOPI = 55 * MiB;
constexpr size_t WS_TOPG = 55 * MiB + 512 * 1024;
constexpr size_t WS_HIST = 56 * MiB;
constexpr size_t WS_DEST = 56 * MiB + 512 * 1024;
constexpr size_t WS_ROWTOK = 57 * MiB;
constexpr size_t WS_ROWRSTD = 57 * MiB + 512 * 1024;
constexpr size_t WS_BLKE = 58 * MiB;
constexpr size_t WS_H = 64 * MiB;
constexpr size_t WS_PROJ = 128 * MiB;
constexpr size_t WS_MIXED = 320 * MiB;
constexpr size_t WS_X1 = 384 * MiB;
constexpr size_t WS_U = 512 * MiB;
constexpr size_t WS_SJ = 544 * MiB;
constexpr size_t WS_WGU = 640 * MiB;
constexpr size_t WS_WD = 1152 * MiB;
constexpr size_t WS_ACT = 1408 * MiB;
constexpr size_t WS_Y = 1696 * MiB;
constexpr size_t WS_END = 1984 * MiB;

constexpr int NTHREADS = 512, NWAVES = 8;
constexpr int LDS_BYTES = 149504;
constexpr int LDS_MISC = LDS_BYTES - 256;

struct Params {
    const float* x; const float* attn_norm_w; const float* w_in; const float* gate_w2; const float* gate_b; const float* gla_norm_w;
    const float* w_out; const float* ffn_norm_w; const float* router_w; const float* router_b; const float* w_gu; const float* b_gu;
    const float* w_d; const float* b_d; const float* final_norm_w;
    float* out; unsigned char* ws;
};

__device__ __forceinline__ unsigned cvt_pk_bf16(float lo, float hi) { unsigned r; asm volatile("v_cvt_pk_bf16_f32 %0, %1, %2" : "=v"(r) : "v"(lo), "v"(hi)); return r; }
__device__ __forceinline__ unsigned cvt4_fp8(float a, float b, float c, float d) { unsigned w = 0u; w = __builtin_amdgcn_cvt_pk_fp8_f32(a, b, w, false); w = __builtin_amdgcn_cvt_pk_fp8_f32(c, d, w, true); return w; }
__device__ __forceinline__ float bf2f(unsigned short b) { return __uint_as_float(((unsigned)b) << 16); }
__device__ __forceinline__ float bflo(unsigned w) { return __uint_as_float(w << 16); }
__device__ __forceinline__ float bfhi(unsigned w) { return __uint_as_float(w & 0xffff0000u); }
__device__ __forceinline__ bf16x8 pack8(f32x4 a, f32x4 b) {
    u32x4 w = {cvt_pk_bf16(a[0], a[1]), cvt_pk_bf16(a[2], a[3]), cvt_pk_bf16(b[0], b[1]), cvt_pk_bf16(b[2], b[3])};
    return __builtin_bit_cast(bf16x8, w);
}
__device__ __forceinline__ float wave_sum(float v) {
#pragma unroll
    for (int o = 1; o < 64; o <<= 1) v += __shfl_xor(v, o);
    return v;
}
#define LDS_WAIT() asm volatile("s_waitcnt lgkmcnt(0)" ::: "memory")
#define VM_WAIT() asm volatile("s_waitcnt vmcnt(0)" ::: "memory")
#define SBAR() __builtin_amdgcn_sched_barrier(0)
#define XB_TMO      128
#define XB_XCNT(j)  (256  + 64 * (j))
#define XB_XSUB(j)  (1280 + 64 * (j))
#define XB_XGEN(j)  (2304 + 64 * (j))
#define XB_TOP      3328
#define XB_TOPGEN   3392
#define XCD_BAR_WORDS 3456
#define XB_SPIN_CAP (1u << 18)

__device__ __forceinline__ unsigned xb_ld(unsigned* p)              { return __hip_atomic_load(p, __ATOMIC_RELAXED, __HIP_MEMORY_SCOPE_AGENT); }
__device__ __forceinline__ unsigned xb_add(unsigned* p, unsigned v) { return __hip_atomic_fetch_add(p, v, __ATOMIC_RELAXED, __HIP_MEMORY_SCOPE_AGENT); }
__device__ __forceinline__ unsigned xb_xcc_id() { return (unsigned)__builtin_amdgcn_s_getreg((3 << 11) | 20) & 0xFu; }
#define XB_SPIN(cond, bar) do { unsigned _sp = 0; while (cond) { __builtin_amdgcn_s_sleep(1); \
    if ((++_sp & 255u) == 0u) { if (xb_ld(&(bar)[XB_TMO])) break; if (_sp > XB_SPIN_CAP) { atomicAdd(&(bar)[XB_TMO], 1u); break; } } } } while (0)

struct XcdBarrier {
    unsigned* bar; unsigned x;
    volatile LAS unsigned* st;
};

__device__ __forceinline__ XcdBarrier xcd_barrier_post(unsigned* bar, volatile LAS unsigned* st) {
    XcdBarrier b; b.bar = bar; b.x = xb_xcc_id(); b.st = st;
    if (threadIdx.x == 0) (void)xb_add(&bar[XB_XCNT(b.x)], 1u);
    return b;
}
__device__ __forceinline__ void xcd_barrier_complete(unsigned* bar, unsigned x, unsigned& nloc, unsigned& nx) {
    const unsigned G = gridDim.x * gridDim.y * gridDim.z;
    unsigned sum, cnt, mine, sp = 0u;
    for (;;) {
        sum = 0u; cnt = 0u; mine = 0u;
#pragma unroll
        for (unsigned j = 0; j < 16; ++j) { const unsigned c = xb_ld(&bar[XB_XCNT(j)]); sum += c; cnt += (c > 0u) ? 1u : 0u; mine = (j == x) ? c : mine; }
        if (sum == G) break;
        __builtin_amdgcn_s_sleep(1);
        if ((++sp & 255u) == 0u) { if (xb_ld(&bar[XB_TMO])) break; if (sp > XB_SPIN_CAP) { atomicAdd(&bar[XB_TMO], 1u); break; } }
    }
    nloc = mine > 0u ? mine : 1u; nx = cnt > 0u ? cnt : 1u;
}

__device__ __forceinline__ void xcd_barrier(const XcdBarrier& b) {
    asm volatile("s_waitcnt vmcnt(0)" ::: "memory");
    __syncthreads();
    if (threadIdx.x == 0) {
        unsigned* bar = b.bar;
        __builtin_amdgcn_s_waitcnt(0);
        unsigned nloc = b.st[0], nx = b.st[1];
        if (nloc == 0u) { xcd_barrier_complete(bar, b.x, nloc, nx); b.st[0] = nloc; b.st[1] = nx; }
        const unsigned old = xb_add(&bar[XB_XSUB(b.x)], 1u);
        const unsigned gen = old / nloc;
        if (old + 1u == (gen + 1u) * nloc) {
            __builtin_amdgcn_fence(__ATOMIC_RELEASE, "agent");
            asm volatile("s_waitcnt vmcnt(0)" ::: "memory");
            const unsigned og = xb_add(&bar[XB_TOP], 1u);
            const unsigned tg = og / nx;
            if (og + 1u == (tg + 1u) * nx) xb_add(&bar[XB_TOPGEN], 1u);
            else XB_SPIN(xb_ld(&bar[XB_TOPGEN]) == tg, bar);
            __builtin_amdgcn_fence(__ATOMIC_ACQUIRE, "agent");
            xb_add(&bar[XB_XGEN(b.x)], 1u);
            asm volatile("s_waitcnt vmcnt(0)" ::: "memory");
        } else {
            XB_SPIN(xb_ld(&bar[XB_XGEN(b.x)]) == gen, bar);
            __builtin_amdgcn_fence(__ATOMIC_ACQUIRE, "agent");
            asm volatile("s_waitcnt vmcnt(0)" ::: "memory");
        }
    }
    __syncthreads();
}

namespace g8 {
constexpr int BM = 256, BK = 64, HALF = 128, HTB = HALF * BK * 2, STAGE_BYTES = 8 * HTB, NXCD = 8, WGM = 8;
__host__ __device__ __forceinline__ int lds_byte(int r, int c) { const int st = (r >> 4) * 2 + (c >> 5), rr = r & 15, cc = c & 31, ob = rr * 64 + cc * 2; return st * 1024 + (ob ^ (((ob >> 9) & 1) << 5)); }
__host__ __device__ __forceinline__ void stage_rc(int b, int& R, int& C) { const int st = b / 1024, sb = b % 1024, swz = sb ^ (((sb >> 9) & 1) << 5); R = (st >> 1) * 16 + swz / 64; C = (st & 1) * 32 + (swz % 64) / 2; }
__host__ __device__ __forceinline__ int perm32(int rho) { const int n = rho >> 4, i = rho & 15; return 8 * (i >> 2) + 4 * n + (i & 3); }

struct Unit { int pm, pn, e; };

template <int WGM_>
__device__ __forceinline__ bool static_next(int i, int nM, int nN, int G, int c, Unit& u) {
    const int nwg = nM * nN; const long L = (long)i * G + c; if (L >= nwg) return false;
    int wgid = (int)L; { const int q = nwg / NXCD, r = nwg % NXCD, xcd = wgid % NXCD, off = wgid / NXCD; wgid = (xcd < r ? xcd * (q + 1) : r * (q + 1) + (xcd - r) * q) + off; }
    const int nig = WGM_ * nN, gid = wgid / nig, fm = gid * WGM_, gsz = (nM - fm) < WGM_ ? (nM - fm) : WGM_;
    u.pm = fm + ((wgid % nig) % gsz); u.pn = (wgid % nig) / gsz; u.e = 0; return true;
}

template <class Prob, class Epi>
__device__ __forceinline__ void gemm_phase(LAS unsigned char* lds, const Prob& P, const Epi& E) {
    int tid = threadIdx.x; asm volatile("" : "+v"(tid));
    const int wid = __builtin_amdgcn_readfirstlane(tid >> 6), lane = tid & 63, wr = wid >> 2, wc = wid & 3, fr = lane & 15, fq = lane >> 4;
    const int K = P.K, nt = K / BK;
    int RA[2], CA[2]; unsigned voffB[2];
#pragma unroll
    for (int i = 0; i < 2; ++i) { int R, C; stage_rc(tid * 16 + i * 8192, R, C); const int Rb = Epi::PERM ? ((R & ~31) + perm32(R & 31)) : R;
        RA[i] = R; CA[i] = C; voffB[i] = (unsigned)(Rb * K + C) * 2u; }
    const size_t kstep = (size_t)(BK * 2);
    const size_t hstep = (size_t)HALF * K * 2;
    const unsigned ldsw = (unsigned)wid * 1024u;
    const int aoff = lds_byte(wr * 64 + fr, fq * 8), boff = lds_byte(wc * 32 + fr, fq * 8);
#define G8_SA(b, h) (((b) * 2 + (h)) * HTB)
#define G8_SB(b, h) ((4 + (b) * 2 + (h)) * HTB)
#define G8_STAGE_B(bufoff, gbase) do { _Pragma("unroll") for (int _i = 0; _i < 2; ++_i) \
        __builtin_amdgcn_global_load_lds((const unsigned*)((const char*)(gbase) + voffB[_i]), (LAS unsigned*)(lds + (bufoff) + ldsw + _i * 8192), 16, 0, 0); } while (0)
#define G8_STAGE_A(bufoff, o0, o1) do { \
        __builtin_amdgcn_global_load_lds((const unsigned*)(Ab + (o0)), (LAS unsigned*)(lds + (bufoff) + ldsw), 16, 0, 0); \
        __builtin_amdgcn_global_load_lds((const unsigned*)(Ab + (o1)), (LAS unsigned*)(lds + (bufoff) + ldsw + 8192), 16, 0, 0); } while (0)
#define G8_CAT(lo, hi) __builtin_bit_cast(i32x8, __builtin_shufflevector(lo, hi, 0, 1, 2, 3, 4, 5, 6, 7))
#define G8_LO(v) __builtin_bit_cast(bf16x8, __builtin_shufflevector(v, v, 0, 1, 2, 3))
#define G8_HI(v) __builtin_bit_cast(bf16x8, __builtin_shufflevector(v, v, 4, 5, 6, 7))
#define G8_LDA(dst, b, h) do { _Pragma("unroll") for (int m = 0; m < 4; ++m) { const u32x4 _l = *(const LAS u32x4*)(lds + G8_SA(b, h) + aoff + m * 2048), _h = *(const LAS u32x4*)(lds + G8_SA(b, h) + aoff + m * 2048 + 1024); dst[m] = G8_CAT(_l, _h); } } while (0)
#define G8_LDB(dst, b, h) do { _Pragma("unroll") for (int n = 0; n < 2; ++n) { const u32x4 _l = *(const LAS u32x4*)(lds + G8_SB(b, h) + boff + n * 2048), _h = *(const LAS u32x4*)(lds + G8_SB(b, h) + boff + n * 2048 + 1024); dst[n] = G8_CAT(_l, _h); } } while (0)
#define G8_MMA(ai, bj, At, Bt) do { __builtin_amdgcn_s_setprio(1); \
        if constexpr (Prob::FP8) { _Pragma("unroll") for (int m = 0; m < 4; ++m) _Pragma("unroll") for (int n = 0; n < 2; ++n) \
            asm volatile("v_mfma_scale_f32_16x16x128_f8f6f4 %0, %1, %2, %0, %3, %3 op_sel_hi:[0,0,0]" : "+v"(acc[ai][bj][m][n]) : "v"(Bt[n]), "v"(At[m]), "v"(f8scale)); } \
        else { _Pragma("unroll") for (int m = 0; m < 4; ++m) _Pragma("unroll") for (int n = 0; n < 2; ++n) { \
            acc[ai][bj][m][n] = __builtin_amdgcn_mfma_f32_16x16x32_bf16(G8_LO(Bt[n]), G8_LO(At[m]), acc[ai][bj][m][n], 0, 0, 0); \
            acc[ai][bj][m][n] = __builtin_amdgcn_mfma_f32_16x16x32_bf16(G8_HI(Bt[n]), G8_HI(At[m]), acc[ai][bj][m][n], 0, 0, 0); } } \
        __builtin_amdgcn_s_setprio(0); } while (0)
#define G8_WAIT_V(n) asm volatile("s_waitcnt vmcnt(" #n ")" ::: "memory")
#define G8_WAIT_L(n) asm volatile("s_waitcnt lgkmcnt(" #n ")" ::: "memory")
#define G8_BAR __builtin_amdgcn_s_barrier()
#define G8_SCHED __builtin_amdgcn_sched_barrier(0)
    Unit cur, nxt, nn; int ui = 0;
    if (!P.next(0, cur)) return;
    const int f8scale = 0x7f7f7f7f;
    f32x4 acc[2][2][4][2];
#pragma unroll
    for (int a = 0; a < 2; ++a)
#pragma unroll
        for (int b = 0; b < 2; ++b)
#pragma unroll
            for (int m = 0; m < 4; ++m)
#pragma unroll
                for (int n = 0; n < 2; ++n) acc[a][b][m][n] = (f32x4){0.f, 0.f, 0.f, 0.f};
    i32x8 At[4], B0[2], B1[2];
    const char* Ab = (const char*)P.a_base();
    unsigned aoc[2][2], aon[2][2]; int raw[2][2];
    P.a_fetch(cur, RA, raw); P.a_finish(raw, CA, aoc);
    bool has_next = P.next(1, nxt);
    if (has_next) { P.a_fetch(nxt, RA, raw); P.a_finish(raw, CA, aon); }
    else { aon[0][0] = aoc[0][0]; aon[0][1] = aoc[0][1]; aon[1][0] = aoc[1][0]; aon[1][1] = aoc[1][1]; }
    const char* cB = (const char*)P.b_ptr(cur);
    const char* nB = has_next ? (const char*)P.b_ptr(nxt) : cB;
    typename Epi::Pre pre = E.fetch(cur, wr, wc, fr, fq);
    G8_STAGE_B(G8_SB(0, 0), cB); G8_STAGE_B(G8_SB(0, 1), cB + hstep); G8_STAGE_A(G8_SA(0, 0), aoc[0][0], aoc[0][1]); G8_STAGE_A(G8_SA(0, 1), aoc[1][0], aoc[1][1]);
    if (wr == 1) G8_BAR;
    G8_WAIT_V(2); G8_BAR;
    G8_STAGE_B(G8_SB(1, 0), cB + kstep); G8_STAGE_A(G8_SA(1, 0), aoc[0][0] + 128u, aoc[0][1] + 128u); G8_STAGE_B(G8_SB(1, 1), cB + hstep + kstep);
    G8_WAIT_V(6); G8_BAR;
    for (;;) {
        for (int t = 0; t < nt; t += 2) {
            const bool last = (t == nt - 2);
            const unsigned k1 = (unsigned)(t + 1) * 128u;
            const unsigned k2 = last ? 0u : (unsigned)(t + 2) * 128u;
            const unsigned a2_00 = (last ? aon[0][0] : aoc[0][0]) + k2, a2_01 = (last ? aon[0][1] : aoc[0][1]) + k2;
            const unsigned a2_10 = (last ? aon[1][0] : aoc[1][0]) + k2, a2_11 = (last ? aon[1][1] : aoc[1][1]) + k2;
            const char* b2 = last ? nB : cB + (size_t)(t + 2) * kstep;
            const char* b3 = b2 + kstep;
            G8_LDB(B0, 0, 0); G8_LDB(B1, 0, 1); G8_SCHED; G8_LDA(At, 0, 0); G8_STAGE_A(G8_SA(1, 1), aoc[1][0] + k1, aoc[1][1] + k1);
            G8_WAIT_V(8); G8_WAIT_L(0); G8_BAR; G8_MMA(0, 0, At, B0); G8_MMA(0, 1, At, B1); G8_BAR; G8_SCHED;
            G8_LDA(At, 0, 1); G8_STAGE_B(G8_SB(0, 0), b2); G8_STAGE_B(G8_SB(0, 1), b2 + hstep); G8_STAGE_A(G8_SA(0, 0), a2_00, a2_01);
            G8_WAIT_V(8); G8_WAIT_L(0); G8_BAR; G8_MMA(1, 0, At, B0); G8_MMA(1, 1, At, B1); G8_BAR; G8_SCHED;
            G8_LDB(B0, 1, 0); G8_LDB(B1, 1, 1); G8_SCHED; G8_LDA(At, 1, 0); G8_STAGE_A(G8_SA(0, 1), a2_10, a2_11);
            G8_WAIT_V(8); G8_WAIT_L(0); G8_BAR; G8_MMA(0, 0, At, B0); G8_MMA(0, 1, At, B1); G8_BAR; G8_SCHED;
            G8_LDA(At, 1, 1); G8_STAGE_B(G8_SB(1, 0), b3); G8_STAGE_B(G8_SB(1, 1), b3 + hstep); G8_STAGE_A(G8_SA(1, 0), a2_00 + 128u, a2_01 + 128u);
            G8_WAIT_V(8); G8_WAIT_L(0); G8_BAR; G8_MMA(1, 0, At, B0); G8_MMA(1, 1, At, B1); G8_BAR; G8_SCHED;
        }
        if (wr == 0) G8_BAR;
        if constexpr (Prob::FP8) asm volatile("s_nop 15\n\ts_nop 15" ::: "memory");
        const bool has_nn = has_next && P.next(ui + 2, nn);
        if (has_nn) P.a_fetch(nn, RA, raw);
        typename Epi::Pre pren = pre; if (has_next) pren = E.fetch(nxt, wr, wc, fr, fq);
        E(acc, cur, pre, wr, wc, fr, fq); pre = pren;
        if (!has_next) break;
#pragma unroll
        for (int a = 0; a < 2; ++a)
#pragma unroll
            for (int b = 0; b < 2; ++b)
#pragma unroll
                for (int m = 0; m < 4; ++m)
#pragma unroll
                    for (int n = 0; n < 2; ++n) acc[a][b][m][n] = (f32x4){0.f, 0.f, 0.f, 0.f};
        cur = nxt; cB = nB; ++ui;
        aoc[0][0] = aon[0][0]; aoc[0][1] = aon[0][1]; aoc[1][0] = aon[1][0]; aoc[1][1] = aon[1][1];
        nxt = nn; has_next = has_nn;
        if (has_next) { P.a_finish(raw, CA, aon); nB = (const char*)P.b_ptr(nxt); }
        else { nB = cB; }
        if (wr == 1) G8_BAR;
    }
    G8_WAIT_V(0);
    G8_BAR;
#undef G8_SA
#undef G8_SB
#undef G8_STAGE_A
#undef G8_STAGE_B
#undef G8_LDA
#undef G8_LDB
#undef G8_MMA
#undef G8_CAT
#undef G8_LO
#undef G8_HI
#undef G8_WAIT_V
#undef G8_WAIT_L
#undef G8_BAR
#undef G8_SCHED
}
}
namespace g8 {
#ifndef WGM_IN
#define WGM_IN 8
#endif
#ifndef WGM_OUT
#define WGM_OUT 8
#endif
#ifndef WGM_M1
#define WGM_M1 4
#endif
#ifndef WGM_M2
#define WGM_M2 4
#endif
template <bool F8, int WG_ = 8> struct DenseProbT {
    static constexpr bool FP8 = F8;
    const bf16_t* A; const bf16_t* Bt; int nM, nN, K, G, c, i0, i1;
    __device__ __forceinline__ bool next(int i, Unit& u) const { return (i0 + i < i1) && static_next<WG_>(i0 + i, nM, nN, G, c, u); }
    __device__ __forceinline__ const void* a_base() const { return A; }
    __device__ __forceinline__ void a_fetch(const Unit& u, const int (&RA)[2], int (&raw)[2][2]) const {
#pragma unroll
        for (int h = 0; h < 2; ++h)
#pragma unroll
            for (int i = 0; i < 2; ++i) raw[h][i] = u.pm * BM + h * HALF + RA[i];
    }
    __device__ __forceinline__ void a_finish(const int (&raw)[2][2], const int (&CA)[2], unsigned (&ao)[2][2]) const {
#pragma unroll
        for (int h = 0; h < 2; ++h)
#pragma unroll
            for (int i = 0; i < 2; ++i) ao[h][i] = (unsigned)((raw[h][i] * K + CA[i]) * 2);
    }
    __device__ __forceinline__ const void* b_ptr(const Unit& u) const { return Bt + (size_t)u.pn * BM * K; }
};
typedef DenseProbT<false, WGM_IN> DenseProbIn; typedef DenseProbT<false, WGM_OUT> DenseProbOut;
struct MoeProb1 {
    static constexpr bool FP8 = true;
    const bf16_t* A; const bf16_t* Bt; const int* row_tok; const int* blk; int K; int nM; int i0, i1;
    __device__ __forceinline__ bool next(int i, Unit& u) const {
        if (i0 + i >= i1 || !static_next<WGM_M1>(i0 + i, nM, 2 * FF / BM, gridDim.x, blockIdx.x, u)) return false;
        u.e = blk[64 + u.pm]; return true; }
    __device__ __forceinline__ const void* a_base() const { return A; }
    __device__ __forceinline__ void a_fetch(const Unit& u, const int (&RA)[2], int (&raw)[2][2]) const {
#pragma unroll
        for (int h = 0; h < 2; ++h)
#pragma unroll
            for (int i = 0; i < 2; ++i) raw[h][i] = row_tok[u.pm * BM + h * HALF + RA[i]];
    }
    __device__ __forceinline__ void a_finish(const int (&raw)[2][2], const int (&CA)[2], unsigned (&ao)[2][2]) const {
#pragma unroll
        for (int h = 0; h < 2; ++h)
#pragma unroll
            for (int i = 0; i < 2; ++i) ao[h][i] = (unsigned)((raw[h][i] * K + CA[i]) * 2);
    }
    __device__ __forceinline__ const void* b_ptr(const Unit& u) const { return Bt + ((size_t)__builtin_amdgcn_readfirstlane(u.e) * (2 * FF) + (size_t)u.pn * BM) * K; }
};
struct MoeProb2 {
    static constexpr bool FP8 = true;
    const bf16_t* A; const bf16_t* Bt; const int* blk; int K; int nM;
    __device__ __forceinline__ bool next(int i, Unit& u) const {
        if (!static_next<WGM_M2>(i, nM, DM / BM, gridDim.x, blockIdx.x, u)) return false;
        u.e = blk[64 + u.pm]; return true; }
    __device__ __forceinline__ const void* a_base() const { return A; }
    __device__ __forceinline__ void a_fetch(const Unit& u, const int (&RA)[2], int (&raw)[2][2]) const {
#pragma unroll
        for (int h = 0; h < 2; ++h)
#pragma unroll
            for (int i = 0; i < 2; ++i) raw[h][i] = u.pm * BM + h * HALF + RA[i];
    }
    __device__ __forceinline__ void a_finish(const int (&raw)[2][2], const int (&CA)[2], unsigned (&ao)[2][2]) const {
#pragma unroll
        for (int h = 0; h < 2; ++h)
#pragma unroll
            for (int i = 0; i < 2; ++i) ao[h][i] = (unsigned)((raw[h][i] * K + CA[i]) * 2);
    }
    __device__ __forceinline__ const void* b_ptr(const Unit& u) const { return Bt + ((size_t)__builtin_amdgcn_readfirstlane(u.e) * DM + (size_t)u.pn * BM) * K; }
};

struct EpiProj {
    static constexpr bool PERM = true;
    bf16_t* __restrict__ O; const float* __restrict__ rstd; float scale; int colbase;
    struct Pre { float rs[2][4]; };
    __device__ __forceinline__ Pre fetch(const Unit& u, int wr, int wc, int fr, int fq) const {
        Pre q; const int row0 = u.pm * BM + wr * 64 + fr;
#pragma unroll
        for (int ai = 0; ai < 2; ++ai)
#pragma unroll
            for (int m = 0; m < 4; ++m) q.rs[ai][m] = rstd[row0 + ai * HALF + m * 16];
        return q; }
    __device__ __forceinline__ void operator()(const f32x4 (&acc)[2][2][4][2], const Unit& u, const Pre& q, int wr, int wc, int fr, int fq) const {
        const int row0 = u.pm * BM + wr * 64 + fr, col0 = colbase + u.pn * BM + wc * 32 + 8 * fq;
#pragma unroll
        for (int ai = 0; ai < 2; ++ai)
#pragma unroll
            for (int m = 0; m < 4; ++m) { const int row = row0 + ai * HALF + m * 16; bf16_t* rowp = O + (size_t)row * NPROJ + col0; const float rsc = q.rs[ai][m] * scale;
#pragma unroll
                for (int bj = 0; bj < 2; ++bj) { const f32x4 v0 = acc[ai][bj][m][0] * rsc, v1 = acc[ai][bj][m][1] * rsc;
                    u32x4 w; w.x = cvt_pk_bf16(v0[0], v0[1]); w.y = cvt_pk_bf16(v0[2], v0[3]); w.z = cvt_pk_bf16(v1[0], v1[1]); w.w = cvt_pk_bf16(v1[2], v1[3]);
                    *(u32x4*)(rowp + bj * HALF) = w; } }
    }
};
struct EpiX1 {
    static constexpr bool PERM = false;
    const float* __restrict__ X; float* __restrict__ O;
    struct Pre {};
    __device__ __forceinline__ Pre fetch(const Unit&, int, int, int, int) const { return Pre{}; }
    __device__ __forceinline__ void operator()(const f32x4 (&acc)[2][2][4][2], const Unit& u, const Pre&, int wr, int wc, int fr, int fq) const {
        const int row0 = u.pm * BM + wr * 64 + fr, col0 = u.pn * BM + wc * 32 + 4 * fq;
#pragma unroll
        for (int ai = 0; ai < 2; ++ai) {
            f32x4 xv[4][2][2];
#pragma unroll
            for (int m = 0; m < 4; ++m) { const size_t off = (size_t)(row0 + ai * HALF + m * 16) * DM + col0;
#pragma unroll
                for (int bj = 0; bj < 2; ++bj)
#pragma unroll
                    for (int n = 0; n < 2; ++n) xv[m][bj][n] = __builtin_nontemporal_load((const f32x4*)(X + off + bj * HALF + n * 16)); }
#pragma unroll
            for (int m = 0; m < 4; ++m) { const size_t off = (size_t)(row0 + ai * HALF + m * 16) * DM + col0;
#pragma unroll
                for (int bj = 0; bj < 2; ++bj)
#pragma unroll
                    for (int n = 0; n < 2; ++n) *(f32x4*)(O + off + bj * HALF + n * 16) = xv[m][bj][n] + acc[ai][bj][m][n]; }
        }
    }
};
struct EpiSwiglu {
    static constexpr bool PERM = true;
    unsigned char* __restrict__ O; const float* __restrict__ row_rstd; const float* __restrict__ bgu;
    struct Pre { float rsv[2][4]; };
    __device__ __forceinline__ Pre fetch(const Unit& u, int wr, int wc, int fr, int fq) const {
        Pre q; const int row0 = u.pm * BM + wr * 64 + fr;
#pragma unroll
        for (int ai = 0; ai < 2; ++ai)
#pragma unroll
            for (int m = 0; m < 4; ++m) q.rsv[ai][m] = row_rstd[row0 + ai * HALF + m * 16];
        return q; }
    __device__ __forceinline__ void operator()(const f32x4 (&acc)[2][2][4][2], const Unit& u, const Pre& q, int wr, int wc, int fr, int fq) const {
        const int row0 = u.pm * BM + wr * 64 + fr, colg = u.pn * HALF + wc * 32 + 8 * fq;
        const float* bg = bgu + (size_t)__builtin_amdgcn_readfirstlane(u.e) * (2 * FF) + colg; const float* bu = bg + FF;
        const f32x4 bg0 = *(const f32x4*)bg, bg1 = *(const f32x4*)(bg + 4), bu0 = *(const f32x4*)bu, bu1 = *(const f32x4*)(bu + 4);
#pragma unroll
        for (int ai = 0; ai < 2; ++ai)
#pragma unroll
            for (int m = 0; m < 4; ++m) { const int row = row0 + ai * HALF + m * 16; const float rs = q.rsv[ai][m] * F8_UNSCALE;
                f32x4 g0 = acc[ai][0][m][0] * rs + bg0, g1 = acc[ai][0][m][1] * rs + bg1, u0 = acc[ai][1][m][0] * rs + bu0, u1 = acc[ai][1][m][1] * rs + bu1;
                float o[8];
#pragma unroll
                for (int j = 0; j < 8; ++j) { float g = j < 4 ? g0[j] : g1[j - 4], uu = j < 4 ? u0[j] : u1[j - 4];
                    g = fminf(g, 7.0f); uu = __builtin_amdgcn_fmed3f(uu, -7.0f, 7.0f);
                    const float sg = __builtin_amdgcn_rcpf(1.0f + __builtin_amdgcn_exp2f(g * (-1.702f * 1.4426950408889634f)));
                    o[j] = (uu * ACT_SCALE + ACT_SCALE) * (g * sg); }
                u32x2 w; w.x = cvt4_fp8(o[0], o[1], o[2], o[3]); w.y = cvt4_fp8(o[4], o[5], o[6], o[7]);
                *(u32x2*)(O + (size_t)row * FF + colg) = w; }
    }
};
struct EpiDown {
    static constexpr bool PERM = true;
    unsigned char* __restrict__ O; const float* __restrict__ bd;
    struct Pre { f32x4 bv[2][2]; };
    __device__ __forceinline__ Pre fetch(const Unit& u, int wr, int wc, int fr, int fq) const {
        Pre q; const int col0 = u.pn * BM + wc * 32 + 8 * fq;
        const float* bp = bd + (size_t)__builtin_amdgcn_readfirstlane(u.e) * DM + col0;
#pragma unroll
        for (int bj = 0; bj < 2; ++bj)
#pragma unroll
            for (int n = 0; n < 2; ++n) q.bv[bj][n] = *(const f32x4*)(bp + bj * HALF + 4 * n) * Y_SCALE;
        return q; }
    __device__ __forceinline__ void operator()(const f32x4 (&acc)[2][2][4][2], const Unit& u, const Pre& q, int wr, int wc, int fr, int fq) const {
        const int row0 = u.pm * BM + wr * 64 + fr, col0 = u.pn * BM + wc * 32 + 8 * fq;
#pragma unroll
        for (int ai = 0; ai < 2; ++ai)
#pragma unroll
            for (int m = 0; m < 4; ++m) { unsigned char* rowp = O + (size_t)(row0 + ai * HALF + m * 16) * DM + col0;
#pragma unroll
                for (int bj = 0; bj < 2; ++bj) { const f32x4 v0 = acc[ai][bj][m][0] * (F8_UNSCALE * Y_SCALE) + q.bv[bj][0], v1 = acc[ai][bj][m][1] * (F8_UNSCALE * Y_SCALE) + q.bv[bj][1];
                    u32x2 w; w.x = cvt4_fp8(v0[0], v0[1], v0[2], v0[3]); w.y = cvt4_fp8(v1[0], v1[1], v1[2], v1[3]);
                    *(u32x2*)(rowp + bj * HALF) = w; } }
    }
};
}
struct Ctx { LAS unsigned char* lds; int tid, lane, wave; };
__device__ __forceinline__ Ctx fresh_ctx(const Ctx& c0) { Ctx c; c.lds = c0.lds; int t = threadIdx.x; asm volatile("" : "+v"(t)); c.tid = t; c.lane = t & 63; c.wave = __builtin_amdgcn_readfirstlane(t >> 6); return c; }

__device__ __forceinline__ void transpose_item(const float* W, int ld, int K, int k0, int n0, bf16_t* WT_row0  , LAS float* scr, int lane) {
    float tv[32];
#pragma unroll
    for (int i = 0; i < 32; ++i) { const int kk = 2 * i + (lane >> 5); tv[i] = __builtin_nontemporal_load(W + (size_t)(k0 + kk) * ld + n0 + (lane & 31)); }
#pragma unroll
    for (int i = 0; i < 32; ++i) { const int kk = 2 * i + (lane >> 5); scr[kk * 33 + (lane & 31)] = tv[i]; }
    LDS_WAIT(); asm volatile("" ::: "memory");
    const int c = lane & 7;
#pragma unroll
    for (int j = 0; j < 4; ++j) { const int n = (lane >> 3) + 8 * j; const LAS float* s = scr + (8 * c) * 33 + n;
        u32x4 o; o.x = cvt_pk_bf16(s[0 * 33], s[1 * 33]); o.y = cvt_pk_bf16(s[2 * 33], s[3 * 33]); o.z = cvt_pk_bf16(s[4 * 33], s[5 * 33]); o.w = cvt_pk_bf16(s[6 * 33], s[7 * 33]);
        *(u32x4*)(WT_row0 + (size_t)n * K + k0 + 8 * c) = o; }
    LDS_WAIT(); asm volatile("" ::: "memory");
}
__device__ __forceinline__ void phase_convert(const Params& p, const Ctx& c0) { const Ctx c = fresh_ctx(c0);
    LAS float* scr = (LAS float*)(c.lds + c.wave * 18432);
    const int gw = blockIdx.x * NWAVES + c.wave, NGW = gridDim.x * NWAVES;
    bf16_t* WinT = (bf16_t*)(p.ws + WS_WIN); bf16_t* WoutT = (bf16_t*)(p.ws + WS_WOUT);
    constexpr int KB = DM / 64;
    constexpr int I_IN = KB * (NPROJ / 32), I_OUT = KB * (DM / 32), NITEMS = I_IN + I_OUT;
    for (int it = gw; it < NITEMS; it += NGW) {
        int r = it;
        if (r < I_IN) { const int nb = r % (NPROJ / 32), kb = r / (NPROJ / 32); transpose_item(p.w_in, LDW_IN, DM, 64 * kb, 32 * nb, WinT + (size_t)(32 * nb) * DM, scr, c.lane); continue; } r -= I_IN;
        { const int nb = r % (DM / 32), kb = r / (DM / 32); transpose_item(p.w_out, DM, DM, 64 * kb, 32 * nb, WoutT + (size_t)(32 * nb) * DM, scr, c.lane); }
    }
    float* rc = (float*)(p.ws + WS_ROPE); float* rs = rc + SEQ * 64;
    for (int i = blockIdx.x * NTHREADS + c.tid; i < SEQ * 64; i += gridDim.x * NTHREADS) {
        const int pos = i >> 6, j = i & 63;
        const float inv = 1.0f / powf(10000.0f, (float)(2 * j) / 128.0f);
        const float ang = (float)pos * inv; float sn, cs; sincosf(ang, &sn, &cs); rc[i] = cs; rs[i] = sn; }
}
constexpr int CT_GU1 = (DM / 128) * (2 * FF / 256), CT_D1 = (FF / 128) * (DM / 256), CT_GU = NE * CT_GU1, CT_D = NE * CT_D1, CT_TOTAL = CT_GU + CT_D;
struct ConvTile { const float* src; unsigned char* dst; int ld; int gu; };
__device__ __forceinline__ ConvTile ctile_decode(const Params& p, int r) {
    ConvTile t;
    if (r < CT_GU) { const int e = r / CT_GU1, q = r % CT_GU1, nt = q % (2 * FF / 256), kt = q / (2 * FF / 256);
        t.src = p.w_gu + (size_t)e * DM * (2 * FF) + (size_t)(128 * kt) * (2 * FF) + 256 * nt; t.ld = 2 * FF; t.gu = 256 * nt;
        t.dst = (unsigned char*)(p.ws + WS_WGU) + (size_t)e * (2 * FF) * DM + 128 * kt; }
    else { r -= CT_GU; const int e = r / CT_D1, q = r % CT_D1, nt = q % (DM / 256), kt = q / (DM / 256);
        t.src = p.w_d + (size_t)e * FF * DM + (size_t)(128 * kt) * DM + 256 * nt; t.ld = DM; t.gu = -1;
        t.dst = (unsigned char*)(p.ws + WS_WD) + ((size_t)e * DM + 256 * nt) * FF + 128 * kt; }
    return t;
}
__device__ __forceinline__ void ctile_load(const ConvTile& t, f32x4 (&tv)[16], int wave, int lane) {
    const float* s = t.src + (size_t)(16 * wave) * t.ld + 4 * lane;
#pragma unroll
    for (int i = 0; i < 16; ++i) tv[i] = __builtin_nontemporal_load((const f32x4*)(s + (size_t)i * t.ld));
}
__device__ __forceinline__ void ctile_store(const ConvTile& t, const f32x4 (&tv)[16], LAS unsigned char* lds, int tid, int wave, int lane) {
#pragma unroll
    for (int c = 0; c < 4; ++c) { u32x4 o;
#pragma unroll
        for (int q = 0; q < 4; ++q) o[q] = cvt4_fp8(tv[4 * q][c] * W_SCALE, tv[4 * q + 1][c] * W_SCALE, tv[4 * q + 2][c] * W_SCALE, tv[4 * q + 3][c] * W_SCALE);
        const int n = 4 * lane + c; *(LAS u32x4*)(lds + n * 128 + ((wave ^ (lane & 7)) << 4)) = o; }
    __syncthreads();
#pragma unroll
    for (int j = 0; j < 4; ++j) { const int n = 64 * j + (tid >> 3), ch = tid & 7;
        const u32x4 o = *(const LAS u32x4*)(lds + n * 128 + ((ch ^ ((n >> 2) & 7)) << 4));
        int orow = n;
        if (t.gu >= 0) { const int ng = t.gu + n; const int nn = ng < FF ? ng : ng - FF; orow = 256 * (nn / 128) + (nn % 128) + (ng < FF ? 0 : 128); }
        *(u32x4*)(t.dst + (size_t)orow * DM + 16 * ch) = o; }
    __syncthreads();
}
__device__ __forceinline__ void phase_convert_share(const Params& p, const Ctx& c0, int lo, int hi, int G, int w) { const Ctx c = fresh_ctx(c0);
    for (int it = lo + w; it < hi; it += 2 * G) {
        const int i1 = it + G < hi ? it + G : it;
        f32x4 ta[16], tb[16];
        const ConvTile A = ctile_decode(p, it), B = ctile_decode(p, i1);
        ctile_load(A, ta, c.wave, c.lane); ctile_load(B, tb, c.wave, c.lane);
        __builtin_amdgcn_sched_barrier(0);
        ctile_store(A, ta, c.lds, c.tid, c.wave, c.lane); ctile_store(B, tb, c.lds, c.tid, c.wave, c.lane);
        __builtin_amdgcn_sched_barrier(0);
    }
}

template <int NTL, int OUT8  >
__device__ __forceinline__ void norm_skinny_half(const float* __restrict__ xrows, const float* __restrict__ wn, const float* __restrict__ Wsk, int ldw, void* __restrict__ hrows_, void* __restrict__ hrows8_, int hk, int lane, f32x4 (&acc)[NTL], float& ss) {
    const int row = lane & 15, kq = lane >> 4;
    ss = 0.f;
#pragma unroll
    for (int t = 0; t < NTL; ++t) acc[t] = (f32x4){0.f, 0.f, 0.f, 0.f};
    for (int ks0 = 0; ks0 < 32; ks0 += 4) {
        f32x4 xa[4], xb[4], wa[4], wb[4]; float wv[4][NTL][8];
#pragma unroll
        for (int q = 0; q < 4; ++q) { const int d0 = 1024 * hk + 32 * (ks0 + q) + 8 * kq;
            xa[q] = *(const f32x4*)(xrows + (size_t)row * DM + d0); xb[q] = *(const f32x4*)(xrows + (size_t)row * DM + d0 + 4);
            wa[q] = *(const f32x4*)(wn + d0); wb[q] = *(const f32x4*)(wn + d0 + 4);
#pragma unroll
            for (int t = 0; t < NTL; ++t)
#pragma unroll
                for (int i = 0; i < 8; ++i) wv[q][t][i] = Wsk[(size_t)(d0 + i) * ldw + t * 16 + row]; }
#pragma unroll
        for (int q = 0; q < 4; ++q) { const int d0 = 1024 * hk + 32 * (ks0 + q) + 8 * kq;
            f32x4 a = xa[q], b = xb[q];
            ss += (a[0] * a[0] + a[1] * a[1]) + (a[2] * a[2] + a[3] * a[3]) + (b[0] * b[0] + b[1] * b[1]) + (b[2] * b[2] + b[3] * b[3]);
            a = a * wa[q]; b = b * wb[q];
            u32x4 hw; hw.x = cvt_pk_bf16(a[0], a[1]); hw.y = cvt_pk_bf16(a[2], a[3]); hw.z = cvt_pk_bf16(b[0], b[1]); hw.w = cvt_pk_bf16(b[2], b[3]);
            if constexpr (OUT8 >= 1) { u32x2 f8; f8.x = cvt4_fp8(a[0] * ACT_SCALE, a[1] * ACT_SCALE, a[2] * ACT_SCALE, a[3] * ACT_SCALE); f8.y = cvt4_fp8(b[0] * ACT_SCALE, b[1] * ACT_SCALE, b[2] * ACT_SCALE, b[3] * ACT_SCALE);
                *(u32x2*)((unsigned char*)hrows8_ + (size_t)row * DM + d0) = f8; }
            if constexpr (OUT8 != 1) *(u32x4*)((bf16_t*)hrows_ + (size_t)row * DM + d0) = hw;
            const f32x4 ra = {a[0] - bflo(hw.x), a[1] - bfhi(hw.x), a[2] - bflo(hw.y), a[3] - bfhi(hw.y)}, rb = {b[0] - bflo(hw.z), b[1] - bfhi(hw.z), b[2] - bflo(hw.w), b[3] - bfhi(hw.w)};
            const bf16x8 ah = __builtin_bit_cast(bf16x8, hw), al = pack8(ra, rb);
#pragma unroll
            for (int t = 0; t < NTL; ++t) { const float* w8 = wv[q][t];
                u32x4 bw; bw.x = cvt_pk_bf16(w8[0], w8[1]); bw.y = cvt_pk_bf16(w8[2], w8[3]); bw.z = cvt_pk_bf16(w8[4], w8[5]); bw.w = cvt_pk_bf16(w8[6], w8[7]);
                const f32x4 r0 = {w8[0] - bflo(bw.x), w8[1] - bfhi(bw.x), w8[2] - bflo(bw.y), w8[3] - bfhi(bw.y)}, r1 = {w8[4] - bflo(bw.z), w8[5] - bfhi(bw.z), w8[6] - bflo(bw.w), w8[7] - bfhi(bw.w)};
                const bf16x8 bh = __builtin_bit_cast(bf16x8, bw), bl = pack8(r0, r1);
                acc[t] = __builtin_amdgcn_mfma_f32_16x16x32_bf16(ah, bh, acc[t], 0, 0, 0);
                acc[t] = __builtin_amdgcn_mfma_f32_16x16x32_bf16(al, bh, acc[t], 0, 0, 0);
                acc[t] = __builtin_amdgcn_mfma_f32_16x16x32_bf16(ah, bl, acc[t], 0, 0, 0); }
        }
    }
    ss += __shfl_xor(ss, 16); ss += __shfl_xor(ss, 32);
}

__device__ __forceinline__ void phase_norm1(const Params& p, const Ctx& c0) { const Ctx c = fresh_ctx(c0);
    bf16_t* H = (bf16_t*)(p.ws + WS_H); float* rstd = (float*)(p.ws + WS_RSTD1); float* gz = (float*)(p.ws + WS_GZ);
    const int pair = c.wave >> 1, hk = c.wave & 1;
    LAS float* scr = (LAS float*)(c.lds + pair * 4096);
    for (int u = blockIdx.x * 4 + pair; u < T / 16; u += gridDim.x * 4) {
        f32x4 acc[1]; float ss;
        norm_skinny_half<1, 0>(p.x + (size_t)u * 16 * DM, p.attn_norm_w, p.w_in + C_GZ, LDW_IN, H + (size_t)u * 16 * DM, nullptr, hk, c.lane, acc, ss);
        if (hk == 1) { *(LAS f32x4*)(scr + c.lane * 4) = acc[0]; if (c.lane < 16) scr[256 + c.lane] = ss; }
        __syncthreads();
        if (hk == 0) {
            const f32x4 o = *(LAS f32x4*)(scr + c.lane * 4); const float tot = ss + scr[256 + (c.lane & 15)];
            const float rs = 1.0f / sqrtf(tot * (1.0f / DM) + EPS);
            if (c.lane < 16) { rstd[u * 16 + c.lane] = rs; scr[512 + c.lane] = rs; }
            LDS_WAIT();
#pragma unroll
            for (int r = 0; r < 4; ++r) { const int row = (c.lane >> 4) * 4 + r; gz[(size_t)(u * 16 + row) * 16 + (c.lane & 15)] = (acc[0][r] + o[r]) * scr[512 + row]; }
        }
        __syncthreads();
    }
}

__device__ __forceinline__ void phase_norm2_router(const Params& p, const Ctx& c0) { const Ctx c = fresh_ctx(c0);
    bf16_t* H = (bf16_t*)(p.ws + WS_H); float* rstd = (float*)(p.ws + WS_RSTD2); const float* X1 = (const float*)(p.ws + WS_X1);
    int* topi = (int*)(p.ws + WS_TOPI); float* topg = (float*)(p.ws + WS_TOPG); int* hist = (int*)(p.ws + WS_HIST); int* row_tok = (int*)(p.ws + WS_ROWTOK);
    const int pair = c.wave >> 1, hk = c.wave & 1;
    LAS float* scr = (LAS float*)(c.lds + pair * 8192);
    LAS int* hcnt = (LAS int*)(c.lds + 65536);
    { float* row_rstd = (float*)(p.ws + WS_ROWRSTD);
      for (int i = blockIdx.x * NTHREADS + c.tid; i < PROWS; i += gridDim.x * NTHREADS) { row_tok[i] = 0; row_rstd[i] = 0.f; } }
    for (int g = blockIdx.x; g < T / 64; g += gridDim.x) {
        if (c.tid < 32) hcnt[c.tid] = 0;
        __syncthreads();
        const int u = g * 4 + pair;
        f32x4 acc[2]; float ss;
        norm_skinny_half<2, 1>(X1 + (size_t)u * 16 * DM, p.ffn_norm_w, p.router_w, NE, nullptr, (unsigned char*)H + (size_t)u * 16 * DM, hk, c.lane, acc, ss);
        if (hk == 1) { *(LAS f32x4*)(scr + c.lane * 4) = acc[0]; *(LAS f32x4*)(scr + 256 + c.lane * 4) = acc[1]; if (c.lane < 16) scr[512 + c.lane] = ss; }
        __syncthreads();
        if (hk == 0) {
            const f32x4 o0 = *(LAS f32x4*)(scr + c.lane * 4), o1 = *(LAS f32x4*)(scr + 256 + c.lane * 4); const float tot = ss + scr[512 + (c.lane & 15)];
            const float rs = 1.0f / sqrtf(tot * (1.0f / DM) + EPS);
            if (c.lane < 16) { rstd[u * 16 + c.lane] = rs; scr[528 + c.lane] = rs; }
            LDS_WAIT();
            const float b0 = p.router_b[c.lane & 15], b1 = p.router_b[16 + (c.lane & 15)];
#pragma unroll
            for (int r = 0; r < 4; ++r) { const int row = (c.lane >> 4) * 4 + r; const float rr = scr[528 + row];
                scr[1024 + row * 32 + (c.lane & 15)] = (acc[0][r] + o0[r]) * rr + b0; scr[1024 + row * 32 + 16 + (c.lane & 15)] = (acc[1][r] + o1[r]) * rr + b1; }
            LDS_WAIT();
            if (c.lane < 16) {
                float lv[32];
#pragma unroll
                for (int j = 0; j < 32; ++j) lv[j] = scr[1024 + c.lane * 32 + j];
                int bi[4]; float bv[4];
#pragma unroll
                for (int k = 0; k < 4; ++k) { float best = -__builtin_inff(); int bidx = 0;
#pragma unroll
                    for (int j = 0; j < 32; ++j) { const bool tk = lv[j] > best; best = tk ? lv[j] : best; bidx = tk ? j : bidx; }
                    bi[k] = bidx; bv[k] = best;
#pragma unroll
                    for (int j = 0; j < 32; ++j) lv[j] = (j == bidx) ? -__builtin_inff() : lv[j]; }
                const float e1 = __expf(bv[1] - bv[0]), e2 = __expf(bv[2] - bv[0]), e3 = __expf(bv[3] - bv[0]); const float inv = 1.0f / (1.0f + e1 + e2 + e3);
                const int tok = u * 16 + c.lane;
                *(int4*)(topi + (size_t)tok * 4) = make_int4(bi[0], bi[1], bi[2], bi[3]);
                *(float4*)(topg + (size_t)tok * 4) = make_float4(inv, e1 * inv, e2 * inv, e3 * inv);
#pragma unroll
                for (int k = 0; k < 4; ++k) atomicAdd((int*)&hcnt[bi[k]], 1);
            }
        }
        __syncthreads();
        if (c.tid < 32) hist[g * 32 + c.tid] = hcnt[c.tid];
        __syncthreads();
    }
}

__device__ __forceinline__ void phase_rope_kmean(const Params& p, const Ctx& c0) { const Ctx c = fresh_ctx(c0);
    bf16_t* proj = (bf16_t*)(p.ws + WS_PROJ); const float* rc = (const float*)(p.ws + WS_ROPE); const float* rsn = rc + SEQ * 64; float* kmean = (float*)(p.ws + WS_KMEAN);
    LAS float* red = (LAS float*)c.lds;
    const int cg = c.tid & 7, tk = c.tid >> 3;
    for (int u = blockIdx.x; u < NBATCH * MH * NBLK; u += gridDim.x) {
        const int b = u / (MH * NBLK), h = (u / NBLK) % MH, blk = u % NBLK;
        float s1[8], s2[8];
#pragma unroll
        for (int j = 0; j < 8; ++j) { s1[j] = 0.f; s2[j] = 0.f; }
        f32x4 ca[4], cb[4], sa[4], sb[4]; u32x4 t1[4][2], t2[4][2];
#pragma unroll
        for (int ps = 0; ps < 4; ++ps) {
            const int pos = blk * MBLK + ps * 64 + tk; const size_t row = (size_t)(b * SEQ + pos) * NPROJ;
            ca[ps] = *(const f32x4*)(rc + pos * 64 + 8 * cg); cb[ps] = *(const f32x4*)(rc + pos * 64 + 8 * cg + 4); sa[ps] = *(const f32x4*)(rsn + pos * 64 + 8 * cg); sb[ps] = *(const f32x4*)(rsn + pos * 64 + 8 * cg + 4);
#pragma unroll
            for (int qk = 0; qk < 2; ++qk) { const bf16_t* base = proj + row + (qk ? C_MK : C_MQ) + h * HD + 8 * cg; t1[ps][qk] = *(const u32x4*)base; t2[ps][qk] = *(const u32x4*)(base + 64); }
        }
#pragma unroll
        for (int ps = 0; ps < 4; ++ps) {
            const int pos = blk * MBLK + ps * 64 + tk; const size_t row = (size_t)(b * SEQ + pos) * NPROJ;
            const float cs[8] = {ca[ps][0], ca[ps][1], ca[ps][2], ca[ps][3], cb[ps][0], cb[ps][1], cb[ps][2], cb[ps][3]}, sn[8] = {sa[ps][0], sa[ps][1], sa[ps][2], sa[ps][3], sb[ps][0], sb[ps][1], sb[ps][2], sb[ps][3]};
#pragma unroll
            for (int qk = 0; qk < 2; ++qk) {
                bf16_t* base = proj + row + (qk ? C_MK : C_MQ) + h * HD + 8 * cg;
                float a[8], bb[8];
#pragma unroll
                for (int j = 0; j < 4; ++j) { a[2 * j] = bflo(t1[ps][qk][j]); a[2 * j + 1] = bfhi(t1[ps][qk][j]); bb[2 * j] = bflo(t2[ps][qk][j]); bb[2 * j + 1] = bfhi(t2[ps][qk][j]); }
                float o1[8], o2[8];
#pragma unroll
                for (int j = 0; j < 8; ++j) { o1[j] = a[j] * cs[j] - bb[j] * sn[j]; o2[j] = bb[j] * cs[j] + a[j] * sn[j]; }
                u32x4 w1, w2;
#pragma unroll
                for (int j = 0; j < 4; ++j) { w1[j] = cvt_pk_bf16(o1[2 * j], o1[2 * j + 1]); w2[j] = cvt_pk_bf16(o2[2 * j], o2[2 * j + 1]); }
                *(u32x4*)base = w1; *(u32x4*)(base + 64) = w2;
                if (qk) {
#pragma unroll
                    for (int j = 0; j < 8; ++j) { s1[j] += o1[j]; s2[j] += o2[j]; } }
            }
        }
#pragma unroll
        for (int j = 0; j < 8; ++j) {
#pragma unroll
            for (int o = 8; o < 64; o <<= 1) { s1[j] += __shfl_xor(s1[j], o); s2[j] += __shfl_xor(s2[j], o); } }
        if (c.lane < 8) {
#pragma unroll
            for (int j = 0; j < 8; ++j) { red[c.wave * 128 + 8 * cg + j] = s1[j]; red[c.wave * 128 + 64 + 8 * cg + j] = s2[j]; } }
        __syncthreads();
        if (c.tid < 128) { float s = 0.f;
#pragma unroll
            for (int w = 0; w < 8; ++w) s += red[w * 128 + c.tid];
            kmean[(size_t)u * HD + c.tid] = s * (1.0f / MBLK); }
        __syncthreads();
    }
}

__device__ __forceinline__ void phase_gla_prep(const Params& p, const Ctx& c0) { const Ctx c = fresh_ctx(c0);
    bf16_t* proj = (bf16_t*)(p.ws + WS_PROJ); const float* gz = (const float*)(p.ws + WS_GZ); float* dend = (float*)(p.ws + WS_DEND);
    LAS float* gzl = (LAS float*)c.lds;
    LAS float* seg = (LAS float*)(c.lds + 16384);
    const int ch = c.tid & 127, tq = __builtin_amdgcn_readfirstlane(c.tid >> 7);
    for (int u = blockIdx.x; u < NBATCH * GH * NBLK; u += gridDim.x) {
        const int b = u / (GH * NBLK), h = (u / NBLK) % GH, j = u % NBLK;
        const int tok0 = b * SEQ + j * MBLK;
        for (int i = c.tid; i < 256 * 4; i += NTHREADS) *(LAS f32x4*)(gzl + i * 4) = *(const f32x4*)(gz + (size_t)tok0 * 16 + i * 4);
        float w2[16];
#pragma unroll
        for (int r = 0; r < 16; ++r) w2[r] = p.gate_w2[r * 512 + h * GDK + ch];
        const float bias = p.gate_b[h * GDK + ch];
        __syncthreads();
        float run = 0.f; float Bv[64];
#pragma unroll
        for (int i = 0; i < 64; ++i) {
            const LAS float* g = gzl + (tq * 64 + i) * 16;
            const f32x4 g0 = *(const LAS f32x4*)g, g1 = *(const LAS f32x4*)(g + 4), g2 = *(const LAS f32x4*)(g + 8), g3 = *(const LAS f32x4*)(g + 12);
            float lg = bias;
            lg += g0[0] * w2[0] + g0[1] * w2[1] + g0[2] * w2[2] + g0[3] * w2[3]; lg += g1[0] * w2[4] + g1[1] * w2[5] + g1[2] * w2[6] + g1[3] * w2[7];
            lg += g2[0] * w2[8] + g2[1] * w2[9] + g2[2] * w2[10] + g2[3] * w2[11]; lg += g3[0] * w2[12] + g3[1] * w2[13] + g3[2] * w2[14] + g3[3] * w2[15];
            const float ls = fminf(lg, 0.f) - __logf(1.0f + __expf(-fabsf(lg)));
            run += ls * (1.0f / 16.0f); Bv[i] = run; }
        seg[tq * 128 + ch] = run;
        __syncthreads();
        float off = 0.f, tot = 0.f;
#pragma unroll
        for (int s = 0; s < 4; ++s) { const float v = seg[s * 128 + ch]; tot += v; off += (s < tq) ? v : 0.f; }
        if (tq == 0) dend[(size_t)u * GDK + ch] = __expf(tot);
        bf16_t* qp = proj + (size_t)(tok0 + tq * 64) * NPROJ + C_GQ + h * GDK + ch; bf16_t* kp = proj + (size_t)(tok0 + tq * 64) * NPROJ + C_GK + h * GDK + ch;
#pragma unroll
        for (int i0 = 0; i0 < 64; i0 += 16) {
            bf16_t qraw[16], kraw[16];
#pragma unroll
            for (int i = 0; i < 16; ++i) { qraw[i] = qp[(size_t)(i0 + i) * NPROJ]; kraw[i] = kp[(size_t)(i0 + i) * NPROJ]; }
#pragma unroll
            for (int i = 0; i < 16; ++i) { const float Bt = off + Bv[i0 + i];
                const float q = bf2f(qraw[i]), k = bf2f(kraw[i]);
                const float qt = q * __expf(Bt) * 0.08838834764831845f, kt = k * __expf(-Bt);
                qp[(size_t)(i0 + i) * NPROJ] = (bf16_t)(cvt_pk_bf16(qt, 0.f) & 0xffffu); kp[(size_t)(i0 + i) * NPROJ] = (bf16_t)(cvt_pk_bf16(kt, 0.f) & 0xffffu); }
        }
        __syncthreads();
    }
}
namespace att {
constexpr int NW = 8, QBLK = 32, KVBLK = 64, QB = 256, D = 128;
constexpr int SHM_V = KVBLK * D * 2, SHM_K = KVBLK * D * 2;
constexpr int ATT_LDS = 2 * SHM_V + 2 * SHM_K + NW * 64 * 4;
constexpr float SCALE = 0.08838834764831845f;
constexpr float THR = 8.f;
constexpr int APITCH = NPROJ, OPITCH = DM;
typedef LAS char* lptr;
typedef const LAS char* lcptr;

#define KSWZ(row, colB) ((row) * 256 + ((colB) ^ (((row) & 7) << 4)))
__device__ __forceinline__ int v_st(int k, int c) { const int kk = (k & ~0xC) | ((k & 4) << 1) | ((k & 8) >> 1); return ((kk >> 3) * 4 + (c >> 5)) * 512 + ((kk & 7) * 32 + (c & 31)) * 2; }
__device__ __forceinline__ int v_rd_base(int lane) { return ((lane & 3) << 3) | (((lane >> 2) & 3) << 6) | (((lane >> 4) & 1) << 5) | (((lane >> 5) & 1) << 8); }
constexpr int v_rd_off(int d0, int ks, int half) { return d0 * 512 + ks * 4096 + half * 2048; }
__device__ __forceinline__ int crow(int r, int hi) { return (r & 3) + 8 * (r >> 2) + 4 * hi; }
__device__ __forceinline__ bf16x8 load8(const bf16_t* p) { return *reinterpret_cast<const bf16x8*>(p); }

__device__ __forceinline__ void pack_p(const f32x16& p0, const f32x16& p1, bf16x8& pa0, bf16x8& pa1, bf16x8& pa2, bf16x8& pa3) {
#define PK4(P, B_, OUT) do { unsigned a0 = cvt_pk_bf16(P[B_+0], P[B_+1]), a1 = cvt_pk_bf16(P[B_+2], P[B_+3]);                          \
        unsigned b0 = cvt_pk_bf16(P[B_+4], P[B_+5]), b1 = cvt_pk_bf16(P[B_+6], P[B_+7]);                                             \
        auto r0 = __builtin_amdgcn_permlane32_swap(a0, b0, false, false); auto r1 = __builtin_amdgcn_permlane32_swap(a1, b1, false, false); \
        u32x4 w = {r0[0], r1[0], r0[1], r1[1]}; OUT = __builtin_bit_cast(bf16x8, w); } while (0)
    PK4(p0, 0, pa0); PK4(p0, 8, pa1); PK4(p1, 0, pa2); PK4(p1, 8, pa3);
#undef PK4
}
__device__ __forceinline__ void partialSM(f32x16& p0, f32x16& p1, float& m_reg, float& mn, float& alpha) {
    float pmax = p0[0];
#pragma unroll
    for (int r = 1; r < 16; ++r) pmax = fmaxf(pmax, p0[r]);
#pragma unroll
    for (int r = 0; r < 16; ++r) pmax = fmaxf(pmax, p1[r]);
    { auto rr = __builtin_amdgcn_permlane32_swap(__float_as_uint(pmax), __float_as_uint(pmax), false, false);
      pmax = fmaxf(__uint_as_float(rr[0]), __uint_as_float(rr[1])); }
    constexpr float C2 = 1.4426950408889634f * SCALE;
    if (__builtin_expect(__all((pmax - m_reg) * SCALE <= THR), 1)) { mn = m_reg; alpha = 1.f; }
    else { mn = fmaxf(m_reg, pmax); alpha = __builtin_amdgcn_exp2f((m_reg - mn) * C2); m_reg = mn; }
    const float mnL = -mn * C2;
#pragma unroll
    for (int r = 0; r < 16; ++r) p0[r] = fmaf(p0[r], C2, mnL);
#pragma unroll
    for (int r = 0; r < 16; ++r) p1[r] = fmaf(p1[r], C2, mnL);
#pragma unroll
    for (int r = 0; r < 16; ++r) p0[r] = __builtin_amdgcn_exp2f(p0[r]);
}
__device__ __forceinline__ void finishSM(f32x16& p0, f32x16& p1, float alpha, float& l_reg, bf16x8& pa0, bf16x8& pa1, bf16x8& pa2, bf16x8& pa3) {
#pragma unroll
    for (int r = 0; r < 16; ++r) p1[r] = __builtin_amdgcn_exp2f(p1[r]);
    float ps = 0;
#pragma unroll
    for (int r = 0; r < 16; ++r) ps += p0[r];
#pragma unroll
    for (int r = 0; r < 16; ++r) ps += p1[r];
    { auto rr = __builtin_amdgcn_permlane32_swap(__float_as_uint(ps), __float_as_uint(ps), false, false);
      ps = __uint_as_float(rr[0]) + __uint_as_float(rr[1]); }
    l_reg = l_reg * alpha + ps;
    pack_p(p0, p1, pa0, pa1, pa2, pa3);
}
template <int KB>
__device__ __forceinline__ void qkt(f32x16& p0, f32x16& p1, lcptr K_lds, int r32, int hi, const bf16x8* qr, float init = 0.f) {
#pragma unroll
    for (int r = 0; r < 16; ++r) { p0[r] = init; p1[r] = init; }
    lcptr kb[4];
#pragma unroll
    for (int dd = 0; dd < 4; ++dd) kb[dd] = K_lds + KB * SHM_K + KSWZ(r32, (dd * 16 + hi * 8) * 2);
#pragma unroll
    for (int d0 = 0; d0 < 8; ++d0) { lcptr a = kb[d0 & 3] + (d0 >> 2) * 128;
        bf16x8 b0 = *reinterpret_cast<const LAS bf16x8*>(a);
        bf16x8 b1 = *reinterpret_cast<const LAS bf16x8*>(a + 32 * 256);
        p0 = __builtin_amdgcn_mfma_f32_32x32x16_bf16(b0, qr[d0], p0, 0, 0, 0);
        p1 = __builtin_amdgcn_mfma_f32_32x32x16_bf16(b1, qr[d0], p1, 0, 0, 0); }
}
#define TRRD(dst, vb, off) asm volatile("ds_read_b64_tr_b16 %0, %1 offset:%2" : "=&v"(dst) : "v"(vb), "i"(off) : "memory")
template <int VOFF>
__device__ __forceinline__ void pv_tile(f32x16* o, int vb0, bf16x8 pa0, bf16x8 pa1, bf16x8 pa2, bf16x8 pa3) {
#define PV_D0(d0) do { s16x4 l0, l1, l2, l3, h0, h1, h2, h3; constexpr int b_ = VOFF + v_rd_off(d0, 0, 0); \
        TRRD(l0, vb0, b_); TRRD(h0, vb0, b_ + 2048); TRRD(l1, vb0, b_ + 4096); TRRD(h1, vb0, b_ + 6144); TRRD(l2, vb0, b_ + 8192); TRRD(h2, vb0, b_ + 10240); TRRD(l3, vb0, b_ + 12288); TRRD(h3, vb0, b_ + 14336); \
        asm volatile("s_waitcnt lgkmcnt(0)" ::: "memory"); SBAR(); \
        o[d0] = __builtin_amdgcn_mfma_f32_32x32x16_bf16(pa0, (bf16x8){l0[0], l0[1], l0[2], l0[3], h0[0], h0[1], h0[2], h0[3]}, o[d0], 0, 0, 0);   \
        o[d0] = __builtin_amdgcn_mfma_f32_32x32x16_bf16(pa1, (bf16x8){l1[0], l1[1], l1[2], l1[3], h1[0], h1[1], h1[2], h1[3]}, o[d0], 0, 0, 0);   \
        o[d0] = __builtin_amdgcn_mfma_f32_32x32x16_bf16(pa2, (bf16x8){l2[0], l2[1], l2[2], l2[3], h2[0], h2[1], h2[2], h2[3]}, o[d0], 0, 0, 0);   \
        o[d0] = __builtin_amdgcn_mfma_f32_32x32x16_bf16(pa3, (bf16x8){l3[0], l3[1], l3[2], l3[3], h3[0], h3[1], h3[2], h3[3]}, o[d0], 0, 0, 0); } while (0)
    PV_D0(0); PV_D0(1); PV_D0(2); PV_D0(3);
#undef PV_D0
}
template <int VOFF, int D0>
__device__ __forceinline__ void tr_frags(int vb0, bf16x8& f0, bf16x8& f1, bf16x8& f2, bf16x8& f3) {
    s16x4 l0, l1, l2, l3, h0, h1, h2, h3; constexpr int b_ = VOFF + v_rd_off(D0, 0, 0);
    TRRD(l0, vb0, b_); TRRD(h0, vb0, b_ + 2048); TRRD(l1, vb0, b_ + 4096); TRRD(h1, vb0, b_ + 6144); TRRD(l2, vb0, b_ + 8192); TRRD(h2, vb0, b_ + 10240); TRRD(l3, vb0, b_ + 12288); TRRD(h3, vb0, b_ + 14336);
    asm volatile("s_waitcnt lgkmcnt(0)" ::: "memory"); SBAR();
    f0 = (bf16x8){l0[0], l0[1], l0[2], l0[3], h0[0], h0[1], h0[2], h0[3]}; f1 = (bf16x8){l1[0], l1[1], l1[2], l1[3], h1[0], h1[1], h1[2], h1[3]};
    f2 = (bf16x8){l2[0], l2[1], l2[2], l2[3], h2[0], h2[1], h2[2], h2[3]}; f3 = (bf16x8){l3[0], l3[1], l3[2], l3[3], h3[0], h3[1], h3[2], h3[3]};
}

struct MobaRef { const bf16_t* Q; const bf16_t* K; const bf16_t* V; bf16_t* O; const unsigned* sel; int qb; };
struct MobaSeam { bf16x8 qr[8]; bf16x8 st_v0, st_v1, st_k0, st_k1; unsigned sel; };
#define AROW(p, k0, rr) ((p) + (size_t)((k0) + (rr)) * APITCH + sc)
#define VMW() asm volatile("s_waitcnt vmcnt(0)" ::: "memory")
#define VMWN(n) asm volatile("s_waitcnt vmcnt(%0)" :: "i"(n) : "memory")
#define SLOAD_H(Kp, Vp, k0) do { S.st_v0 = load8(AROW(Vp, k0, sr)); S.st_v1 = load8(AROW(Vp, k0, 32 + sr));              \
                         S.st_k0 = load8(AROW(Kp, k0, sr)); S.st_k1 = load8(AROW(Kp, k0, 32 + sr)); } while (0)
#define SWRITE_HK(bf) do { *(LAS bf16x8*)(K_lds + (bf) * SHM_K + kws) = S.st_k0; *(LAS bf16x8*)(K_lds + (bf) * SHM_K + kws + 32 * 256) = S.st_k1; } while (0)
#define SWRITE_HV(bf) do { *(LAS bf16x8*)(V_lds + (bf) * SHM_V + vst0) = S.st_v0; *(LAS bf16x8*)(V_lds + (bf) * SHM_V + vst1) = S.st_v1; } while (0)
#define SWRITE_H(bf) do { SWRITE_HV(bf); SWRITE_HK(bf); } while (0)

__device__ __forceinline__ void moba_prime(const MobaRef& cur, lptr lds, MobaSeam& S) {
    int tid = threadIdx.x; asm volatile("" : "+v"(tid)); const int wid = __builtin_amdgcn_readfirstlane(tid >> 6), lane = tid & 63, r32 = lane & 31, hi = lane >> 5;
    const int sr = tid >> 4, sc = (tid & 15) * 8, kws = KSWZ(sr, sc * 2); lptr K_lds = lds + 2 * SHM_V;
#pragma unroll
    for (int d0 = 0; d0 < 8; ++d0) S.qr[d0] = load8(cur.Q + (size_t)(wid * QBLK + r32) * APITCH + d0 * 16 + hi * 8);
    S.sel = cur.sel[wid * QBLK + r32];
    SLOAD_H(cur.K, cur.V, 0); VMW(); SWRITE_HK(0);
    __syncthreads();
}
__device__ __forceinline__ void moba_block(const MobaRef& cur, const MobaRef& nxt, lptr lds, MobaSeam& S) {
    int tid = threadIdx.x; asm volatile("" : "+v"(tid)); const int wid = __builtin_amdgcn_readfirstlane(tid >> 6), lane = tid & 63, r32 = lane & 31, hi = lane >> 5;
    const int qb = cur.qb, NT = 4 * (qb + 1);
    const int qlo = qb * QB + wid * QBLK, qm = qlo + r32 - 4 * hi;
    const unsigned sel = S.sel;
    lptr V_lds = lds; lptr K_lds = lds + 2 * SHM_V;
    LAS float* ws = (LAS float*)(lds + 2 * SHM_V + 2 * SHM_K) + wid * 64; LAS float* li_l = ws; LAS float* al_l = ws + 32;
    float m_reg = -1e30f, l_reg = 0; f32x16 o[4] = {};
    const int sr = tid >> 4, sc = (tid & 15) * 8, vst0 = v_st(sr, sc), vst1 = v_st(32 + sr, sc), kws = KSWZ(sr, sc * 2);
    const int vb0 = (int)(uintptr_t)V_lds + v_rd_base(lane);
    const bf16_t* Kh = cur.K; const bf16_t* Vh = cur.V;
    const float NEG = -__builtin_inff();
#define RESC(a) do { if (__any((a) < 1.f)) { if (hi == 0) al_l[r32] = (a); asm volatile("s_waitcnt lgkmcnt(0)" ::: "memory");              \
                     _Pragma("unroll") for (int d_ = 0; d_ < 4; ++d_) _Pragma("unroll") for (int r = 0; r < 16; ++r) o[d_][r] *= al_l[crow(r, hi)]; } } while (0)
#define KBASE(t) ((t) * KVBLK)
#define MASKT(P0_, P1_, t) do { const int kb_ = KBASE(t); const int jb_ = (t) >> 2;                                              \
        if (jb_ == qb) { if (kb_ + KVBLK - 1 > qlo) { const int dq_ = qm - kb_;                                                    \
            _Pragma("unroll") for (int r = 0; r < 16; ++r) { const int c_ = (r & 3) + 8 * (r >> 2);                                \
                if (dq_ - c_ < 0) P0_[r] = NEG; if (dq_ - c_ - 32 < 0) P1_[r] = NEG; } } }                                         \
        } while (0)
#define SELINIT(t) ((((t) >> 2) == qb || ((sel >> ((t) >> 2)) & 1u)) ? 0.f : NEG)
    constexpr int NQL = 9;
#define SEAM_K0() do { VMWN(NQL); SWRITE_HK(0); SBAR(); } while (0)
    f32x16 pA0, pA1, pB0, pB1; float mnA, mnB, alA, alB; bf16x8 pa0, pa1, pa2, pa3;
    SWRITE_HV(0); SBAR();
    SLOAD_H(Kh, Vh, KBASE(1));
    SBAR(); qkt<0>(pA0, pA1, K_lds, r32, hi, S.qr, SELINIT(0));
    MASKT(pA0, pA1, 0); partialSM(pA0, pA1, m_reg, mnA, alA);
    VMW(); SWRITE_H(1);
    __syncthreads();
#define HALF_STEP(PX0, PX1, mnX, alX, PY0, PY1, alY, t, KB, VB, SB) do {                                                      \
        SBAR(); qkt<KB>(PX0, PX1, K_lds, r32, hi, S.qr, SELINIT(t));                                                           \
        finishSM(PY0, PY1, alY, l_reg, pa0, pa1, pa2, pa3); SBAR();                                                           \
        if ((t) + 1 < NT) { SLOAD_H(Kh, Vh, KBASE((t) + 1)); SBAR(); }                                                        \
        pv_tile<VB * SHM_V>(o, vb0, pa0, pa1, pa2, pa3); MASKT(PX0, PX1, (t)); partialSM(PX0, PX1, m_reg, mnX, alX);          \
        __syncthreads();                                                                                                      \
        if ((t) + 1 < NT) { VMW(); SWRITE_H(SB); }                                                                            \
        RESC(alX); __syncthreads(); } while (0)
    for (int t = 1; t + 1 < NT; t += 2) {
        HALF_STEP(pB0, pB1, mnB, alB, pA0, pA1, alA, t, 1, 0, 0);
        HALF_STEP(pA0, pA1, mnA, alA, pB0, pB1, alB, t + 1, 0, 1, 1);
    }
    SBAR(); qkt<1>(pB0, pB1, K_lds, r32, hi, S.qr, SELINIT(NT - 1)); SBAR();
    SLOAD_H(nxt.K, nxt.V, 0); SBAR();
#pragma unroll
    for (int d0 = 0; d0 < 8; ++d0) S.qr[d0] = load8(nxt.Q + (size_t)(wid * QBLK + r32) * APITCH + d0 * 16 + hi * 8);
    S.sel = nxt.sel[wid * QBLK + r32];
    SBAR();
    finishSM(pA0, pA1, alA, l_reg, pa0, pa1, pa2, pa3); SBAR();
    pv_tile<0>(o, vb0, pa0, pa1, pa2, pa3);
    MASKT(pB0, pB1, NT - 1); partialSM(pB0, pB1, m_reg, mnB, alB); __syncthreads(); RESC(alB);
    finishSM(pB0, pB1, alB, l_reg, pa0, pa1, pa2, pa3); SBAR(); pv_tile<SHM_V>(o, vb0, pa0, pa1, pa2, pa3);
    SBAR(); SEAM_K0();
    if (hi == 0) li_l[r32] = l_reg; asm volatile("s_waitcnt lgkmcnt(0)" ::: "memory");
    float rli[16];
#pragma unroll
    for (int r = 0; r < 16; ++r) rli[r] = __builtin_amdgcn_rcpf(li_l[crow(r, hi)]);
    bf16_t* Ow = cur.O + (size_t)(wid * QBLK) * OPITCH;
#pragma unroll
    for (int r = 0; r < 16; ++r) { const int orow = crow(r, hi);
#pragma unroll
        for (int d0 = 0; d0 < 4; ++d0) { const float v = o[d0][r] * rli[r];
            const float vn = __shfl_xor(v, 1);
            if ((r32 & 1) == 0) *(unsigned*)(Ow + (size_t)orow * OPITCH + d0 * 32 + r32) = cvt_pk_bf16(v, vn); } }
    __syncthreads();
#undef RESC
#undef KBASE
#undef MASKT
#undef SELINIT
#undef SEAM_K0
#undef HALF_STEP
}

__device__ __forceinline__ MobaRef moba_ref(const Params& p, int bh, int qb) {
    const int b = bh / MH, h = bh % MH;
    const bf16_t* proj = (const bf16_t*)(p.ws + WS_PROJ); bf16_t* mixed = (bf16_t*)(p.ws + WS_MIXED); const unsigned* selp = (const unsigned*)(p.ws + WS_SEL);
    MobaRef r; const size_t tok0 = (size_t)b * SEQ;
    r.Q = proj + (tok0 + (size_t)qb * QB) * APITCH + C_MQ + h * HD; r.K = proj + tok0 * APITCH + C_MK + h * HD; r.V = proj + tok0 * APITCH + C_MV + h * HD;
    r.O = mixed + (tok0 + (size_t)qb * QB) * OPITCH + h * HD; r.sel = selp + (size_t)bh * SEQ + qb * QB; r.qb = qb; return r;
}
__device__ __forceinline__ void phase_moba(const Params& p, lptr lds) {
    const int G = gridDim.x; const int bx = blockIdx.x; const int vcu = (G % 8 == 0) ? (bx % 8) * (G / 8) + bx / 8 : bx;
    constexpr int NITEM = NBATCH * MH * 8;
    int L = vcu; if (L >= NITEM) return;
    int pass = 0;
    MobaRef cur = moba_ref(p, L >> 3, L & 7);
    MobaSeam S;
    moba_prime(cur, lds, S);
    for (;;) {
        const bool more_pass = pass == 0, more_item = L + G < NITEM, last = !more_pass && !more_item;
        int Ln = L, passn = 1;
        if (!more_pass) { passn = 0; Ln = more_item ? L + G : L; }
        const MobaRef nxt = last ? cur : moba_ref(p, Ln >> 3, passn ? 15 - (Ln & 7) : (Ln & 7));
        moba_block(cur, nxt, lds, S);
        if (last) break;
        cur = nxt; pass = passn; L = Ln;
    }
}
#undef SLOAD_H
#undef SWRITE_HK
#undef SWRITE_HV
#undef SWRITE_H
#undef VMWN
}
namespace att {
__device__ __forceinline__ void stage_vstyle(lptr dst, const bf16_t* src, size_t pitch, int tid) {
    const int sr = tid >> 4, sc = (tid & 15) * 8;
    const bf16x8 a = load8(src + (size_t)sr * pitch + sc), b = load8(src + (size_t)(32 + sr) * pitch + sc);
    *(LAS bf16x8*)(dst + v_st(sr, sc)) = a; *(LAS bf16x8*)(dst + v_st(32 + sr, sc)) = b;
}
__device__ __forceinline__ void stage_kstyle(lptr dst, const bf16_t* src, size_t pitch, int tid) {
    const int sr = tid >> 4, sc = (tid & 15) * 8;
    const bf16x8 a = load8(src + (size_t)sr * pitch + sc), b = load8(src + (size_t)(32 + sr) * pitch + sc);
    *(LAS bf16x8*)(dst + KSWZ(sr, sc * 2)) = a; *(LAS bf16x8*)(dst + KSWZ(sr, sc * 2) + 32 * 256) = b;
}

__device__ __forceinline__ void phase_moba_select(const Params& p, lptr lds, int tid_) { int tid = tid_; asm volatile("" : "+v"(tid));
    const bf16_t* proj = (const bf16_t*)(p.ws + WS_PROJ); const float* kmean = (const float*)(p.ws + WS_KMEAN); unsigned* selp = (unsigned*)(p.ws + WS_SEL);
    constexpr int QP = 272;
    lptr ql = lds; LAS float* kml = (LAS float*)(lds + 256 * QP); LAS float* gl = (LAS float*)(lds + 256 * QP + 8192);
    for (int u = blockIdx.x; u < NBATCH * MH * NBLK; u += gridDim.x) {
        const int bh = u / NBLK, qb = u % NBLK, b = bh / MH, h = bh % MH;
        if (qb == 0) { if (tid < 256) selp[(size_t)bh * SEQ + tid] = 0u; continue; }
        const bf16_t* qsrc = proj + ((size_t)b * SEQ + qb * 256) * NPROJ + C_MQ + h * HD;
        for (int i = tid; i < 256 * 16; i += NTHREADS) { const int r = i >> 4, ch = i & 15; *(LAS bf16x8*)(ql + r * QP + ch * 16) = load8(qsrc + (size_t)r * NPROJ + ch * 8); }
        for (int i = tid; i < 16 * 128 / 4; i += NTHREADS) *(LAS f32x4*)(kml + i * 4) = *(const f32x4*)(kmean + (size_t)bh * NBLK * HD + i * 4);
        __syncthreads();
        const int q = tid & 255, ng = tid >> 8;
        float g[8];
#pragma unroll
        for (int n = 0; n < 8; ++n) g[n] = 0.f;
        for (int ch = 0; ch < 16; ++ch) {
            const u32x4 qw = *(const LAS u32x4*)(ql + q * QP + ch * 16);
            const float qv[8] = {bflo(qw.x), bfhi(qw.x), bflo(qw.y), bfhi(qw.y), bflo(qw.z), bfhi(qw.z), bflo(qw.w), bfhi(qw.w)};
#pragma unroll
            for (int n = 0; n < 8; ++n) { if (ng * 8 + n < qb) {
                const f32x4 k0 = *(const LAS f32x4*)(kml + (ng * 8 + n) * 128 + ch * 8), k1 = *(const LAS f32x4*)(kml + (ng * 8 + n) * 128 + ch * 8 + 4);
                g[n] += qv[0] * k0[0] + qv[1] * k0[1] + qv[2] * k0[2] + qv[3] * k0[3] + qv[4] * k1[0] + qv[5] * k1[1] + qv[6] * k1[2] + qv[7] * k1[3]; } }
        }
#pragma unroll
        for (int n = 0; n < 8; ++n) gl[q * 16 + ng * 8 + n] = g[n];
        __syncthreads();
        if (tid < 256) {
            float gv[16];
#pragma unroll
            for (int n = 0; n < 16; ++n) gv[n] = (n < qb) ? gl[tid * 16 + n] : -__builtin_inff();
            unsigned m = 0u;
#pragma unroll
            for (int k = 0; k < 3; ++k) { float best = -__builtin_inff(); int bi = -1;
#pragma unroll
                for (int n = 0; n < 16; ++n) { const bool tk = gv[n] > best; best = tk ? gv[n] : best; bi = tk ? n : bi; }
                if (bi >= 0) m |= 1u << bi;
#pragma unroll
                for (int n = 0; n < 16; ++n) gv[n] = (n == bi) ? -__builtin_inff() : gv[n]; }
            selp[(size_t)bh * SEQ + qb * 256 + tid] = m;
        }
        __syncthreads();
    }
}

__device__ __forceinline__ void phase_gla_state(const Params& p, lptr lds, int tid_) { int tid = tid_; asm volatile("" : "+v"(tid));
    const bf16_t* proj = (const bf16_t*)(p.ws + WS_PROJ); const float* dend = (const float*)(p.ws + WS_DEND); float* U = (float*)(p.ws + WS_U);
    const int wid = __builtin_amdgcn_readfirstlane(tid >> 6), lane = tid & 63, r32 = lane & 31, hi = lane >> 5;
    const int dkb = wid & 3, half = wid >> 2;
    const int vb0 = (int)(uintptr_t)lds + v_rd_base(lane);
    for (int u = blockIdx.x; u < NBATCH * GH * NBLK; u += gridDim.x) {
        const int bh = u / NBLK, j = u % NBLK, b = bh / GH, h = bh % GH;
        const size_t tok0 = (size_t)b * SEQ + j * 256;
        f32x16 o[4] = {};
        for (int t = 0; t < 4; ++t) {
            __syncthreads();
            const bf16_t* rowp = proj + (tok0 + t * 64) * NPROJ;
            stage_vstyle(lds, rowp + C_GK + h * GDK, NPROJ, tid);
            stage_vstyle(lds + SHM_V, rowp + C_GV + h * GDV, NPROJ, tid);
            stage_vstyle(lds + 2 * SHM_V, rowp + C_GV + h * GDV + 128, NPROJ, tid);
            __syncthreads();
            bf16x8 a0, a1, a2, a3;
            if (dkb == 0) tr_frags<0, 0>(vb0, a0, a1, a2, a3); else if (dkb == 1) tr_frags<0, 1>(vb0, a0, a1, a2, a3); else if (dkb == 2) tr_frags<0, 2>(vb0, a0, a1, a2, a3); else tr_frags<0, 3>(vb0, a0, a1, a2, a3);
            if (half == 0) pv_tile<SHM_V>(o, vb0, a0, a1, a2, a3); else pv_tile<2 * SHM_V>(o, vb0, a0, a1, a2, a3);
        }
        float dv[16];
#pragma unroll
        for (int r = 0; r < 16; ++r) dv[r] = dend[(size_t)u * GDK + dkb * 32 + crow(r, hi)];
        float* Uo = U + (size_t)u * (GDK * GDV);
#pragma unroll
        for (int r = 0; r < 16; ++r) { const int k = dkb * 32 + crow(r, hi);
#pragma unroll
            for (int d0 = 0; d0 < 4; ++d0) Uo[(size_t)k * GDV + half * 128 + d0 * 32 + r32] = o[d0][r] * dv[r]; }
    }
    __syncthreads();
}

__device__ __forceinline__ void phase_gla_scan(const Params& p, int tid_) { int tid = tid_; asm volatile("" : "+v"(tid));
    const float* U = (const float*)(p.ws + WS_U); const float* dend = (const float*)(p.ws + WS_DEND); bf16_t* Sj = (bf16_t*)(p.ws + WS_SJ);
    constexpr int NEL = NBATCH * GH * GDK * GDV / 4;
    for (int i = blockIdx.x * NTHREADS + tid; i < NEL; i += gridDim.x * NTHREADS) {
        const int bh = i / (GDK * GDV / 4), e4 = i % (GDK * GDV / 4), k = e4 / (GDV / 4);
        f32x4 S = {0.f, 0.f, 0.f, 0.f};
        f32x4 uv[NBLK]; float dd[NBLK];
#pragma unroll
        for (int j = 0; j < NBLK; ++j) { uv[j] = *(const f32x4*)(U + ((size_t)(bh * NBLK + j) * (GDK * GDV)) + (size_t)e4 * 4); dd[j] = dend[(size_t)(bh * NBLK + j) * GDK + k]; }
#pragma unroll
        for (int j = 0; j < NBLK; ++j) {
            u32x2 w; w.x = cvt_pk_bf16(S[0], S[1]); w.y = cvt_pk_bf16(S[2], S[3]);
            *(u32x2*)(Sj + ((size_t)(bh * NBLK + j) * (GDK * GDV)) + (size_t)e4 * 4) = w;
            S = S * dd[j] + uv[j]; }
    }
}

__device__ __forceinline__ void phase_gla_out(const Params& p, lptr lds, int tid_) { int tid = tid_; asm volatile("" : "+v"(tid));
    const bf16_t* proj = (const bf16_t*)(p.ws + WS_PROJ); const bf16_t* Sj = (const bf16_t*)(p.ws + WS_SJ); bf16_t* mixed = (bf16_t*)(p.ws + WS_MIXED);
    const int wid = __builtin_amdgcn_readfirstlane(tid >> 6), lane = tid & 63, r32 = lane & 31, hi = lane >> 5;
    constexpr int BUF = 3 * SHM_V;
    const int vb0 = (int)(uintptr_t)lds + v_rd_base(lane), vb1 = vb0 + BUF;
    const int sr = tid >> 4, sc = (tid & 15) * 8;
    const int kws = KSWZ(sr, sc * 2), vst0 = v_st(sr, sc), vst1 = v_st(32 + sr, sc);
    for (int u = blockIdx.x; u < NBATCH * GH * NBLK; u += gridDim.x) {
        const int bh = u / NBLK, j = u % NBLK, b = bh / GH, h = bh % GH;
        const size_t tok0 = (size_t)b * SEQ + j * 256;
        bf16x8 qr[8];
#pragma unroll
        for (int d0 = 0; d0 < 8; ++d0) qr[d0] = load8(proj + (tok0 + wid * 32 + r32) * NPROJ + C_GQ + h * GDK + d0 * 16 + hi * 8);
        f32x16 o[8] = {};
        bf16x8 sk0, sk1, sa0, sa1, sb0, sb1;
        const bf16_t* sp = Sj + (size_t)u * (GDK * GDV);
#define GO_LOAD(s_) do { if ((s_) < 4) { const bf16_t* rp = proj + (tok0 + (s_) * 64) * NPROJ; \
            sk0 = load8(rp + (size_t)sr * NPROJ + C_GK + h * GDK + sc); sk1 = load8(rp + (size_t)(32 + sr) * NPROJ + C_GK + h * GDK + sc); \
            sa0 = load8(rp + (size_t)sr * NPROJ + C_GV + h * GDV + sc); sa1 = load8(rp + (size_t)(32 + sr) * NPROJ + C_GV + h * GDV + sc); \
            sb0 = load8(rp + (size_t)sr * NPROJ + C_GV + h * GDV + 128 + sc); sb1 = load8(rp + (size_t)(32 + sr) * NPROJ + C_GV + h * GDV + 128 + sc); } \
          else { const bf16_t* rp = sp + (size_t)((s_) - 4) * 64 * GDV; \
            sa0 = load8(rp + (size_t)sr * GDV + sc); sa1 = load8(rp + (size_t)(32 + sr) * GDV + sc); \
            sb0 = load8(rp + (size_t)sr * GDV + 128 + sc); sb1 = load8(rp + (size_t)(32 + sr) * GDV + 128 + sc); } } while (0)
#define GO_WRITE(s_, bufo) do { if ((s_) < 4) { *(LAS bf16x8*)(lds + (bufo) + kws) = sk0; *(LAS bf16x8*)(lds + (bufo) + kws + 32 * 256) = sk1; } \
            *(LAS bf16x8*)(lds + (bufo) + SHM_V + vst0) = sa0; *(LAS bf16x8*)(lds + (bufo) + SHM_V + vst1) = sa1; \
            *(LAS bf16x8*)(lds + (bufo) + 2 * SHM_V + vst0) = sb0; *(LAS bf16x8*)(lds + (bufo) + 2 * SHM_V + vst1) = sb1; } while (0)
#define GO_STEP(s_, B_) do { GO_LOAD(s_); __syncthreads(); GO_WRITE(s_, (B_) * BUF); __syncthreads(); \
            if ((s_) < 4) { if ((s_) * 64 <= wid * 32 + 31) { f32x16 p0, p1; qkt<0>(p0, p1, lds + (B_) * BUF, r32, hi, qr); \
                    const int dq = wid * 32 + r32 - 4 * hi - (s_) * 64; \
                    _Pragma("unroll") for (int r = 0; r < 16; ++r) { const int c_ = (r & 3) + 8 * (r >> 2); if (dq - c_ < 0) p0[r] = 0.f; if (dq - c_ - 32 < 0) p1[r] = 0.f; } \
                    bf16x8 pa0, pa1, pa2, pa3; pack_p(p0, p1, pa0, pa1, pa2, pa3); \
                    pv_tile<SHM_V>(o, (B_) ? vb1 : vb0, pa0, pa1, pa2, pa3); pv_tile<2 * SHM_V>(o + 4, (B_) ? vb1 : vb0, pa0, pa1, pa2, pa3); } } \
            else { pv_tile<SHM_V>(o, (B_) ? vb1 : vb0, qr[4 * ((s_) - 4)], qr[4 * ((s_) - 4) + 1], qr[4 * ((s_) - 4) + 2], qr[4 * ((s_) - 4) + 3]); \
                   pv_tile<2 * SHM_V>(o + 4, (B_) ? vb1 : vb0, qr[4 * ((s_) - 4)], qr[4 * ((s_) - 4) + 1], qr[4 * ((s_) - 4) + 2], qr[4 * ((s_) - 4) + 3]); } } while (0)
        GO_STEP(0, 0); GO_STEP(1, 0); GO_STEP(2, 0); GO_STEP(3, 0); GO_STEP(4, 0); GO_STEP(5, 0);
#undef GO_LOAD
#undef GO_WRITE
#undef GO_STEP
        int hi_e = hi, r32_e = r32; asm volatile("" : "+v"(hi_e), "+v"(r32_e));
        float wv[8];
#pragma unroll
        for (int d0 = 0; d0 < 8; ++d0) wv[d0] = p.gla_norm_w[d0 * 32 + r32_e];
        const bf16_t* ggp = proj + (tok0 + wid * 32) * NPROJ + C_GG + h * GDV + r32_e;
        bf16_t* op = mixed + (tok0 + wid * 32) * DM + 1024 + h * GDV + r32_e;
#pragma unroll
        for (int rb = 0; rb < 16; rb += 4) {
            bf16_t graw[4][8];
#pragma unroll
            for (int q = 0; q < 4; ++q)
#pragma unroll
                for (int d0 = 0; d0 < 8; ++d0) graw[q][d0] = ggp[(size_t)crow(rb + q, hi_e) * NPROJ + d0 * 32];
#pragma unroll
            for (int q = 0; q < 4; ++q) { const int r = rb + q, orow = crow(r, hi_e);
                float ss = 0.f;
#pragma unroll
                for (int d0 = 0; d0 < 8; ++d0) ss += o[d0][r] * o[d0][r];
                ss += __shfl_xor(ss, 1); ss += __shfl_xor(ss, 2); ss += __shfl_xor(ss, 4); ss += __shfl_xor(ss, 8); ss += __shfl_xor(ss, 16);
                const float rsr = 1.0f / sqrtf(ss * (1.0f / GDV) + EPS);
#pragma unroll
                for (int d0 = 0; d0 < 8; ++d0) { const float g = bf2f(graw[q][d0]); const float sg = g * __builtin_amdgcn_rcpf(1.0f + __expf(-g));
                    const float v = o[d0][r] * rsr * wv[d0] * sg; const float vn = __shfl_xor(v, 1);
                    if ((r32_e & 1) == 0) *(unsigned*)(op + (size_t)orow * DM + d0 * 32) = cvt_pk_bf16(v, vn); } }
            asm volatile("" ::: "memory"); }
    }
    __syncthreads();
}
}

__device__ __forceinline__ void phase_route(const Params& p, const Ctx& c0) { const Ctx c = fresh_ctx(c0);
    const int* hist = (const int*)(p.ws + WS_HIST); const int* topi = (const int*)(p.ws + WS_TOPI); const float* rstd2 = (const float*)(p.ws + WS_RSTD2);
    int* dest = (int*)(p.ws + WS_DEST); int* row_tok = (int*)(p.ws + WS_ROWTOK); float* row_rstd = (float*)(p.ws + WS_ROWRSTD); int* blk = (int*)(p.ws + WS_BLKE);
    LAS int* cnt = (LAS int*)c.lds; LAS int* before = cnt + 32; LAS int* pstart = cnt + 64; LAS int* ea = cnt + 128;
    for (int g = blockIdx.x; g < T / 64; g += gridDim.x) {
        if (c.tid < 64) cnt[c.tid] = 0;
        __syncthreads();
        { const int e = c.tid & 31, part = c.tid >> 5; int tot = 0, bef = 0;
#pragma unroll
            for (int i = 0; i < 16; ++i) { const int gg = part * 16 + i; const int v = hist[gg * 32 + e]; tot += v; bef += (gg < g) ? v : 0; }
            atomicAdd((int*)&cnt[e], tot); atomicAdd((int*)&before[e], bef); }
        __syncthreads();
        if (c.tid == 0) { int acc = 0; for (int e = 0; e < NE; ++e) { pstart[e] = acc; acc += ((cnt[e] + 255) >> 8) << 8; } pstart[NE] = acc; }
        if (c.tid < 256) ea[c.tid] = topi[(size_t)g * 256 + c.tid];
        __syncthreads();
        if (c.tid < 256) {
            const int e = ea[c.tid]; int rank = 0;
            for (int a = 0; a < c.tid; ++a) rank += (ea[a] == e) ? 1 : 0;
            const int d = pstart[e] + before[e] + rank; const int tok = g * 64 + (c.tid >> 2);
            dest[(size_t)g * 256 + c.tid] = d; row_tok[d] = tok; row_rstd[d] = rstd2[tok];
        }
        if (g == 0 && c.tid < 64) {
            const int nb = pstart[NE] >> 8; if (c.tid == 0) blk[0] = nb;
            for (int bq = c.tid; bq < nb; bq += 64) { int e = 0; for (int q = 0; q < NE; ++q) e += (pstart[q + 1] <= bq * 256) ? 1 : 0; blk[64 + bq] = e < NE ? e : NE - 1; }
        }
        __syncthreads();
    }
}

__device__ __forceinline__ void phase_combine(const Params& p, const Ctx& c0) { const Ctx c = fresh_ctx(c0);
    const float* X1 = (const float*)(p.ws + WS_X1); const unsigned char* Y = (const unsigned char*)(p.ws + WS_Y); const int* dest = (const int*)(p.ws + WS_DEST); const float* topg = (const float*)(p.ws + WS_TOPG);
    for (int t = blockIdx.x * NWAVES + c.wave; t < T; t += gridDim.x * NWAVES) {
        const int4 d4 = *(const int4*)(dest + (size_t)t * 4); const float4 g4 = *(const float4*)(topg + (size_t)t * 4);
        const int dd[4] = {d4.x, d4.y, d4.z, d4.w}; const float gg[4] = {g4.x * (1.0f / Y_SCALE), g4.y * (1.0f / Y_SCALE), g4.z * (1.0f / Y_SCALE), g4.w * (1.0f / Y_SCALE)};
        f32x4 v[8]; u32x2 yw[4][4]; float ss = 0.f;
#pragma unroll
        for (int j = 0; j < 4; ++j) { v[2 * j] = *(const f32x4*)(X1 + (size_t)t * DM + j * 512 + c.lane * 8); v[2 * j + 1] = *(const f32x4*)(X1 + (size_t)t * DM + j * 512 + c.lane * 8 + 4); }
#pragma unroll
        for (int k = 0; k < 4; ++k)
#pragma unroll
            for (int j = 0; j < 4; ++j) yw[k][j] = *(const u32x2*)(Y + (size_t)dd[k] * DM + j * 512 + c.lane * 8);
#pragma unroll
        for (int k = 0; k < 4; ++k)
#pragma unroll
            for (int j = 0; j < 4; ++j) { const f32x2 a = __builtin_amdgcn_cvt_pk_f32_fp8(yw[k][j].x, false), b = __builtin_amdgcn_cvt_pk_f32_fp8(yw[k][j].x, true);
                const f32x2 cc = __builtin_amdgcn_cvt_pk_f32_fp8(yw[k][j].y, false), d = __builtin_amdgcn_cvt_pk_f32_fp8(yw[k][j].y, true);
                v[2 * j][0] += gg[k] * a[0]; v[2 * j][1] += gg[k] * a[1]; v[2 * j][2] += gg[k] * b[0]; v[2 * j][3] += gg[k] * b[1];
                v[2 * j + 1][0] += gg[k] * cc[0]; v[2 * j + 1][1] += gg[k] * cc[1]; v[2 * j + 1][2] += gg[k] * d[0]; v[2 * j + 1][3] += gg[k] * d[1]; }
#pragma unroll
        for (int j = 0; j < 8; ++j) ss += (v[j][0] * v[j][0] + v[j][1] * v[j][1]) + (v[j][2] * v[j][2] + v[j][3] * v[j][3]);
        const float rs = 1.0f / sqrtf(wave_sum(ss) * (1.0f / DM) + EPS);
#pragma unroll
        for (int j = 0; j < 8; ++j) { const int col = (j >> 1) * 512 + c.lane * 8 + (j & 1) * 4; const f32x4 w = *(const f32x4*)(p.final_norm_w + col);
            *(f32x4*)(p.out + (size_t)t * DM + col) = v[j] * rs * w; }
    }
}
__device__ __forceinline__ Ctx make_ctx(unsigned char* lds_generic) {
    Ctx c; c.lds = (LAS unsigned char*)lds_generic; c.tid = threadIdx.x; c.lane = c.tid & 63; c.wave = __builtin_amdgcn_readfirstlane(c.tid >> 6); return c;
}
__device__ __forceinline__ void phase_gemm_inproj16(const Params& p, const Ctx& c, int i0, int i1, int G, int cidx) {
    if (i0 >= i1) return;
    g8::DenseProbIn P{(const bf16_t*)(p.ws + WS_H), (const bf16_t*)(p.ws + WS_WIN), T / 256, NPROJ / 256, DM, G, cidx, i0, i1};
    g8::EpiProj E{(bf16_t*)(p.ws + WS_PROJ), (const float*)(p.ws + WS_RSTD1), 1.0f, 0};
    g8::gemm_phase(c.lds, P, E);
}
__device__ __forceinline__ void phase_gemm_outproj(const Params& p, const Ctx& c, int i0, int i1) {
    if (i0 >= i1) return;
    g8::DenseProbOut P{(const bf16_t*)(p.ws + WS_MIXED), (const bf16_t*)(p.ws + WS_WOUT), T / 256, DM / 256, DM, (int)gridDim.x, (int)blockIdx.x, i0, i1};
    g8::EpiX1 E{p.x, (float*)(p.ws + WS_X1)};
    g8::gemm_phase(c.lds, P, E);
}
__device__ __forceinline__ void phase_gemm_moe1(const Params& p, const Ctx& c, int i0, int i1) {
    g8::MoeProb1 P{(const bf16_t*)(p.ws + WS_H), (const bf16_t*)(p.ws + WS_WGU), (const int*)(p.ws + WS_ROWTOK), (const int*)(p.ws + WS_BLKE), DM / 2, __builtin_amdgcn_readfirstlane(*(const int*)(p.ws + WS_BLKE)), i0, i1};
    g8::EpiSwiglu E{(unsigned char*)(p.ws + WS_ACT), (const float*)(p.ws + WS_ROWRSTD), p.b_gu};
    g8::gemm_phase(c.lds, P, E);
}
__device__ __forceinline__ void phase_gemm_moe2(const Params& p, const Ctx& c) {
    g8::MoeProb2 P{(const bf16_t*)(p.ws + WS_ACT), (const bf16_t*)(p.ws + WS_WD), (const int*)(p.ws + WS_BLKE), FF / 2, __builtin_amdgcn_readfirstlane(*(const int*)(p.ws + WS_BLKE))};
    g8::EpiDown E{(unsigned char*)(p.ws + WS_Y), p.b_d};
    g8::gemm_phase(c.lds, P, E);
}


constexpr int CW_BAR = 4096;
__global__ void __launch_bounds__(NTHREADS, 2) fwd(Params p) {
    extern __shared__ __attribute__((aligned(16))) unsigned char lds_raw[];
    const Ctx c = make_ctx(lds_raw);
    if (c.tid < 64) ((LAS unsigned*)(c.lds + LDS_MISC))[c.tid] = 0u;
    __syncthreads();
    const XcdBarrier bar = xcd_barrier_post((unsigned*)(p.ws + WS_CTL) + CW_BAR, (volatile LAS unsigned*)(c.lds + LDS_MISC + 32));
    const att::lptr al = (att::lptr)c.lds;
    phase_convert(p, c); phase_norm1(p, c);
    xcd_barrier(bar);
    {
        const int bx = blockIdx.x, G = gridDim.x;
        const int cut = (G == 256) ? (bx >> 3) % 7 : 0;
        if (cut > 0) phase_gemm_inproj16(p, c, 0, cut, G, bx);
        phase_convert_share(p, c, 0, CT_GU, G, bx);
        phase_gemm_inproj16(p, c, cut, 1 << 20, G, bx);
    }
    xcd_barrier(bar);
    phase_rope_kmean(p, c); phase_gla_prep(p, c);
    xcd_barrier(bar);
    att::phase_gla_state(p, al, c.tid); att::phase_moba_select(p, al, c.tid);
    xcd_barrier(bar);
    att::phase_gla_scan(p, c.tid);
    xcd_barrier(bar);
    att::phase_gla_out(p, al, c.tid); att::phase_moba(p, al);
    xcd_barrier(bar);
    phase_gemm_outproj(p, c, 0, 1 << 20);
    xcd_barrier(bar);
    phase_norm2_router(p, c);
    xcd_barrier(bar);
    phase_route(p, c);
    xcd_barrier(bar);
    {
        const int cut = 2 * ((blockIdx.x >> 3) & 7);
        if (cut > 0) phase_gemm_moe1(p, c, 0, cut);
        phase_convert_share(p, c, CT_GU, CT_TOTAL, (int)gridDim.x, (int)blockIdx.x);
        phase_gemm_moe1(p, c, cut, 1 << 20);
    }
    xcd_barrier(bar);
    phase_gemm_moe2(p, c);
    xcd_barrier(bar);
    phase_combine(p, c);
}

extern "C" void kernel_launch(void* const* d_in, const int* in_sizes, int n_in, void* d_out, int out_size, void* d_ws, size_t ws_size, hipStream_t stream) {
    static int grid = 0;
    if (grid == 0) {
        if (n_in != 15 || ws_size < WS_END) { fprintf(stderr, "kernel_launch: unexpected inputs (n_in %d, ws %zu)\n", n_in, ws_size); grid = -1; return; }
        int dev = 0, cus = 0, per_cu = 0;
        if (hipGetDevice(&dev) != hipSuccess || hipDeviceGetAttribute(&cus, hipDeviceAttributeMultiprocessorCount, dev) != hipSuccess) { grid = -1; return; }
        if (hipFuncSetAttribute((const void*)fwd, hipFuncAttributeMaxDynamicSharedMemorySize, LDS_BYTES) != hipSuccess) { fprintf(stderr, "kernel_launch: hipFuncSetAttribute failed\n"); grid = -1; return; }
        if (hipOccupancyMaxActiveBlocksPerMultiprocessor(&per_cu, (const void*)fwd, NTHREADS, LDS_BYTES) != hipSuccess || per_cu < 1) { fprintf(stderr, "kernel_launch: occupancy query says %d blocks per CU\n", per_cu); }
        (void)hipGetLastError();
        grid = cus > 0 ? cus : 256;
    }
    if (grid < 0) return;
    Params p{};
    p.x = (const float*)d_in[0]; p.attn_norm_w = (const float*)d_in[1]; p.w_in = (const float*)d_in[2]; p.gate_w2 = (const float*)d_in[3]; p.gate_b = (const float*)d_in[4];
    p.gla_norm_w = (const float*)d_in[5]; p.w_out = (const float*)d_in[6]; p.ffn_norm_w = (const float*)d_in[7]; p.router_w = (const float*)d_in[8]; p.router_b = (const float*)d_in[9];
    p.w_gu = (const float*)d_in[10]; p.b_gu = (const float*)d_in[11]; p.w_d = (const float*)d_in[12]; p.b_d = (const float*)d_in[13]; p.final_norm_w = (const float*)d_in[14];
    p.out = (float*)d_out; p.ws = (unsigned char*)d_ws;
    if (hipMemsetAsync((char*)d_ws + WS_CTL, 0, CTL_BYTES, stream) != hipSuccess) return;
    hipLaunchKernelGGL(fwd, dim3(grid), dim3(NTHREADS), LDS_BYTES, stream, p);
}
```

```cpp
#include <hip/hip_runtime.h>
#include <stdint.h>
#include <stdio.h>

#define LAS __attribute__((address_space(3)))
typedef unsigned short bf16_t;
typedef short bf16x8 __attribute__((ext_vector_type(8)));
typedef short s16x4 __attribute__((ext_vector_type(4)));
typedef float f32x2 __attribute__((ext_vector_type(2)));
typedef float f32x4 __attribute__((ext_vector_type(4)));
typedef float f32x16 __attribute__((ext_vector_type(16)));
typedef unsigned u32x2 __attribute__((ext_vector_type(2)));
typedef unsigned u32x4 __attribute__((ext_vector_type(4)));
typedef int i32x8 __attribute__((ext_vector_type(8)));

constexpr int NBATCH = 4, SEQ = 4096, T = NBATCH * SEQ, DM = 2048;
constexpr int HD = 128, MH = 8, MBLK = 256, NBLK = SEQ / MBLK;
constexpr int GH = 4, GDK = 128, GDV = 256;
constexpr int LDW_IN = 6160, NPROJ = 6144;
constexpr int C_MQ = 0, C_MK = 1024, C_MV = 2048, C_GQ = 3072, C_GK = 3584, C_GV = 4096, C_GG = 5120, C_GZ = 6144;
constexpr int NE = 32, TOPK = 4, FF = 2048, NASSIGN = T * TOPK;
constexpr int MAXBLK = (NASSIGN + NE * 255) / 256, PROWS = MAXBLK * 256;
constexpr float EPS = 1e-5f;
constexpr float ACT_SCALE = 4.0f, W_SCALE = 64.0f, F8_UNSCALE = 1.0f / (ACT_SCALE * W_SCALE);
constexpr float Y_SCALE = 16.0f;

constexpr size_t MiB = (size_t)1 << 20;
constexpr size_t WS_CTL = 0, CTL_BYTES = 64 * 1024;
constexpr size_t WS_WIN = 16 * MiB;
constexpr size_t WS_WOUT = 40 * MiB;
constexpr size_t WS_ROPE = 48 * MiB;
constexpr size_t WS_RSTD1 = 50 * MiB;
constexpr size_t WS_GZ = 51 * MiB;
constexpr size_t WS_KMEAN = 52 * MiB;
constexpr size_t WS_DEND = 52 * MiB + 512 * 1024;
constexpr size_t WS_RSTD2 = 53 * MiB;
constexpr size_t WS_SEL = 54 * MiB;
constexpr size_t WS_TOPI = 55 * MiB;
constexpr size_t WS_TOPG = 55 * MiB + 512 * 1024;
constexpr size_t WS_HIST = 56 * MiB;
constexpr size_t WS_DEST = 56 * MiB + 512 * 1024;
constexpr size_t WS_ROWTOK = 57 * MiB;
constexpr size_t WS_ROWRSTD = 57 * MiB + 512 * 1024;
constexpr size_t WS_BLKE = 58 * MiB;
constexpr size_t WS_H = 64 * MiB;
constexpr size_t WS_PROJ = 128 * MiB;
constexpr size_t WS_MIXED = 320 * MiB;
constexpr size_t WS_X1 = 384 * MiB;
constexpr size_t WS_U = 512 * MiB;
constexpr size_t WS_SJ = 544 * MiB;
constexpr size_t WS_WGU = 640 * MiB;
constexpr size_t WS_WD = 1152 * MiB;
constexpr size_t WS_ACT = 1408 * MiB;
constexpr size_t WS_Y = 1696 * MiB;
constexpr size_t WS_END = 1984 * MiB;

constexpr int NTHREADS = 512, NWAVES = 8;
constexpr int LDS_BYTES = 149504;
constexpr int LDS_MISC = LDS_BYTES - 256;

struct Params {
    const float* x; const float* attn_norm_w; const float* w_in; const float* gate_w2; const float* gate_b; const float* gla_norm_w;
    const float* w_out; const float* ffn_norm_w; const float* router_w; const float* router_b; const float* w_gu; const float* b_gu;
    const float* w_d; const float* b_d; const float* final_norm_w;
    float* out; unsigned char* ws;
};

__device__ __forceinline__ unsigned cvt_pk_bf16(float lo, float hi) { unsigned r; asm volatile("v_cvt_pk_bf16_f32 %0, %1, %2" : "=v"(r) : "v"(lo), "v"(hi)); return r; }
__device__ __forceinline__ unsigned cvt4_fp8(float a, float b, float c, float d) { unsigned w = 0u; w = __builtin_amdgcn_cvt_pk_fp8_f32(a, b, w, false); w = __builtin_amdgcn_cvt_pk_fp8_f32(c, d, w, true); return w; }
__device__ __forceinline__ float bf2f(unsigned short b) { return __uint_as_float(((unsigned)b) << 16); }
__device__ __forceinline__ float bflo(unsigned w) { return __uint_as_float(w << 16); }
__device__ __forceinline__ float bfhi(unsigned w) { return __uint_as_float(w & 0xffff0000u); }
__device__ __forceinline__ bf16x8 pack8(f32x4 a, f32x4 b) {
    u32x4 w = {cvt_pk_bf16(a[0], a[1]), cvt_pk_bf16(a[2], a[3]), cvt_pk_bf16(b[0], b[1]), cvt_pk_bf16(b[2], b[3])};
    return __builtin_bit_cast(bf16x8, w);
}
__device__ __forceinline__ float wave_sum(float v) {
#pragma unroll
    for (int o = 1; o < 64; o <<= 1) v += __shfl_xor(v, o);
    return v;
}
__device__ __forceinline__ int lane_id() { return (int)__builtin_amdgcn_mbcnt_hi(~0u, __builtin_amdgcn_mbcnt_lo(~0u, 0u)); }
#define LDS_WAIT() asm volatile("s_waitcnt lgkmcnt(0)" ::: "memory")
#define VM_WAIT() asm volatile("s_waitcnt vmcnt(0)" ::: "memory")
#define SBAR() __builtin_amdgcn_sched_barrier(0)
#define XB_TMO      128
#define XB_XCNT(j)  (256  + 64 * (j))
#define XB_XSUB(j)  (1280 + 64 * (j))
#define XB_XGEN(j)  (2304 + 64 * (j))
#define XB_TOP      3328
#define XB_TOPGEN   3392
#define XCD_BAR_WORDS 3456
#define XB_SPIN_CAP (1u << 18)

__device__ __forceinline__ unsigned xb_ld(unsigned* p)              { return __hip_atomic_load(p, __ATOMIC_RELAXED, __HIP_MEMORY_SCOPE_AGENT); }
__device__ __forceinline__ unsigned xb_add(unsigned* p, unsigned v) { return __hip_atomic_fetch_add(p, v, __ATOMIC_RELAXED, __HIP_MEMORY_SCOPE_AGENT); }
__device__ __forceinline__ unsigned xb_xcc_id() { return (unsigned)__builtin_amdgcn_s_getreg((3 << 11) | 20) & 0xFu; }
#define XB_SPIN(cond, bar) do { unsigned _sp = 0; while (cond) { __builtin_amdgcn_s_sleep(1); \
    if ((++_sp & 255u) == 0u) { if (xb_ld(&(bar)[XB_TMO])) break; if (_sp > XB_SPIN_CAP) { atomicAdd(&(bar)[XB_TMO], 1u); break; } } } } while (0)

struct XcdBarrier {
    unsigned* bar; unsigned x; bool t0;
    volatile LAS unsigned* st;
};

__device__ __forceinline__ XcdBarrier xcd_barrier_post(unsigned* bar, volatile LAS unsigned* st) {
    XcdBarrier b; b.bar = bar; b.x = xb_xcc_id(); b.st = st; b.t0 = (threadIdx.x == 0);
    if (b.t0) (void)xb_add(&bar[XB_XCNT(b.x)], 1u);
    return b;
}
__device__ __forceinline__ void xcd_barrier_complete(unsigned* bar, unsigned x, unsigned& nloc, unsigned& nx) {
    const unsigned G = gridDim.x * gridDim.y * gridDim.z;
    unsigned sum, cnt, mine, sp = 0u;
    for (;;) {
        sum = 0u; cnt = 0u; mine = 0u;
#pragma unroll
        for (unsigned j = 0; j < 16; ++j) { const unsigned c = xb_ld(&bar[XB_XCNT(j)]); sum += c; cnt += (c > 0u) ? 1u : 0u; mine = (j == x) ? c : mine; }
        if (sum == G) break;
        __builtin_amdgcn_s_sleep(1);
        if ((++sp & 255u) == 0u) { if (xb_ld(&bar[XB_TMO])) break; if (sp > XB_SPIN_CAP) { atomicAdd(&bar[XB_TMO], 1u); break; } }
    }
    nloc = mine > 0u ? mine : 1u; nx = cnt > 0u ? cnt : 1u;
}

__device__ __forceinline__ void xcd_barrier(const XcdBarrier& b) {
    asm volatile("s_waitcnt vmcnt(0)" ::: "memory");
    __syncthreads();
    if (b.t0) {
        unsigned* bar = b.bar;
        __builtin_amdgcn_s_waitcnt(0);
        unsigned nloc = b.st[0], nx = b.st[1];
        if (nloc == 0u) { xcd_barrier_complete(bar, b.x, nloc, nx); b.st[0] = nloc; b.st[1] = nx; }
        const unsigned old = xb_add(&bar[XB_XSUB(b.x)], 1u);
        const unsigned gen = old / nloc;
        if (old + 1u == (gen + 1u) * nloc) {
            __builtin_amdgcn_fence(__ATOMIC_RELEASE, "agent");
            asm volatile("s_waitcnt vmcnt(0)" ::: "memory");
            const unsigned og = xb_add(&bar[XB_TOP], 1u);
            const unsigned tg = og / nx;
            if (og + 1u == (tg + 1u) * nx) xb_add(&bar[XB_TOPGEN], 1u);
            else XB_SPIN(xb_ld(&bar[XB_TOPGEN]) == tg, bar);
            __builtin_amdgcn_fence(__ATOMIC_ACQUIRE, "agent");
            xb_add(&bar[XB_XGEN(b.x)], 1u);
            asm volatile("s_waitcnt vmcnt(0)" ::: "memory");
        } else {
            XB_SPIN(xb_ld(&bar[XB_XGEN(b.x)]) == gen, bar);
            __builtin_amdgcn_fence(__ATOMIC_ACQUIRE, "agent");
            asm volatile("s_waitcnt vmcnt(0)" ::: "memory");
        }
    }
    __syncthreads();
}

namespace g8 {
constexpr int BM = 256, BK = 64, HALF = 128, HTB = HALF * BK * 2, STAGE_BYTES = 8 * HTB, NXCD = 8, WGM = 8;
__host__ __device__ __forceinline__ int lds_byte(int r, int c) { const int st = (r >> 4) * 2 + (c >> 5), rr = r & 15, cc = c & 31, ob = rr * 64 + cc * 2; return st * 1024 + (ob ^ (((ob >> 9) & 1) << 5)); }
__host__ __device__ __forceinline__ void stage_rc(int b, int& R, int& C) { const int st = b / 1024, sb = b % 1024, swz = sb ^ (((sb >> 9) & 1) << 5); R = (st >> 1) * 16 + swz / 64; C = (st & 1) * 32 + (swz % 64) / 2; }
__host__ __device__ __forceinline__ int perm32(int rho) { const int n = rho >> 4, i = rho & 15; return 8 * (i >> 2) + 4 * n + (i & 3); }

struct Unit { int pm, pn, e; };

template <int WGM_>
__device__ __forceinline__ bool static_next(int i, int nM, int nN, int G, int c, Unit& u) {
    const int nwg = nM * nN; const long L = (long)i * G + c; if (L >= nwg) return false;
    int wgid = (int)L; { const int q = nwg / NXCD, r = nwg % NXCD, xcd = wgid % NXCD, off = wgid / NXCD; wgid = (xcd < r ? xcd * (q + 1) : r * (q + 1) + (xcd - r) * q) + off; }
    const int nig = WGM_ * nN, gid = wgid / nig, fm = gid * WGM_, gsz = (nM - fm) < WGM_ ? (nM - fm) : WGM_;
    u.pm = fm + ((wgid % nig) % gsz); u.pn = (wgid % nig) / gsz; u.e = 0; return true;
}

template <class Prob, class Epi>
__device__ __forceinline__ void gemm_phase(LAS unsigned char* lds, const Prob& P, const Epi& E, int wave_s  ) {
    int tid = wave_s * 64 + lane_id(); asm volatile("" : "+v"(tid));
    const int wid = __builtin_amdgcn_readfirstlane(tid >> 6), lane = tid & 63, wr = wid >> 2, wc = wid & 3, fr = lane & 15, fq = lane >> 4;
    const int K = P.K, nt = K / BK;
    int RA[2], CA[2]; unsigned voffB[2];
#pragma unroll
    for (int i = 0; i < 2; ++i) { int R, C; stage_rc(tid * 16 + i * 8192, R, C); const int Rb = Epi::PERM ? ((R & ~31) + perm32(R & 31)) : R;
        RA[i] = R; CA[i] = C; voffB[i] = (unsigned)(Rb * K + C) * 2u; }
    const size_t kstep = (size_t)(BK * 2);
    const size_t hstep = (size_t)HALF * K * 2;
    const unsigned ldsw = (unsigned)wid * 1024u;
    const int aoff = lds_byte(wr * 64 + fr, fq * 8), boff = lds_byte(wc * 32 + fr, fq * 8);
#define G8_SA(b, h) (((b) * 2 + (h)) * HTB)
#define G8_SB(b, h) ((4 + (b) * 2 + (h)) * HTB)
#define G8_STAGE_B(bufoff, gbase) do { _Pragma("unroll") for (int _i = 0; _i < 2; ++_i) \
        __builtin_amdgcn_global_load_lds((const unsigned*)((const char*)(gbase) + voffB[_i]), (LAS unsigned*)(lds + (bufoff) + ldsw + _i * 8192), 16, 0, 0); } while (0)
#define G8_STAGE_A(bufoff, o0, o1) do { \
        __builtin_amdgcn_global_load_lds((const unsigned*)(Ab + (o0)), (LAS unsigned*)(lds + (bufoff) + ldsw), 16, 0, 0); \
        __builtin_amdgcn_global_load_lds((const unsigned*)(Ab + (o1)), (LAS unsigned*)(lds + (bufoff) + ldsw + 8192), 16, 0, 0); } while (0)
#define G8_CAT(lo, hi) __builtin_bit_cast(i32x8, __builtin_shufflevector(lo, hi, 0, 1, 2, 3, 4, 5, 6, 7))
#define G8_LO(v) __builtin_bit_cast(bf16x8, __builtin_shufflevector(v, v, 0, 1, 2, 3))
#define G8_HI(v) __builtin_bit_cast(bf16x8, __builtin_shufflevector(v, v, 4, 5, 6, 7))
#define G8_LDA(dst, b, h) do { _Pragma("unroll") for (int m = 0; m < 4; ++m) { const u32x4 _l = *(const LAS u32x4*)(lds + G8_SA(b, h) + aoff + m * 2048), _h = *(const LAS u32x4*)(lds + G8_SA(b, h) + aoff + m * 2048 + 1024); dst[m] = G8_CAT(_l, _h); } } while (0)
#define G8_LDB(dst, b, h) do { _Pragma("unroll") for (int n = 0; n < 2; ++n) { const u32x4 _l = *(const LAS u32x4*)(lds + G8_SB(b, h) + boff + n * 2048), _h = *(const LAS u32x4*)(lds + G8_SB(b, h) + boff + n * 2048 + 1024); dst[n] = G8_CAT(_l, _h); } } while (0)
#define G8_MMA(ai, bj, At, Bt) do { __builtin_amdgcn_s_setprio(1); \
        if constexpr (Prob::FP8) { _Pragma("unroll") for (int m = 0; m < 4; ++m) _Pragma("unroll") for (int n = 0; n < 2; ++n) \
            asm volatile("v_mfma_scale_f32_16x16x128_f8f6f4 %0, %1, %2, %0, %3, %3 op_sel_hi:[0,0,0]" : "+v"(acc[ai][bj][m][n]) : "v"(Bt[n]), "v"(At[m]), "v"(f8scale)); } \
        else { _Pragma("unroll") for (int m = 0; m < 4; ++m) _Pragma("unroll") for (int n = 0; n < 2; ++n) { \
            acc[ai][bj][m][n] = __builtin_amdgcn_mfma_f32_16x16x32_bf16(G8_LO(Bt[n]), G8_LO(At[m]), acc[ai][bj][m][n], 0, 0, 0); \
            acc[ai][bj][m][n] = __builtin_amdgcn_mfma_f32_16x16x32_bf16(G8_HI(Bt[n]), G8_HI(At[m]), acc[ai][bj][m][n], 0, 0, 0); } } \
        __builtin_amdgcn_s_setprio(0); } while (0)
#define G8_WAIT_V(n) asm volatile("s_waitcnt vmcnt(" #n ")" ::: "memory")
#define G8_WAIT_L(n) asm volatile("s_waitcnt lgkmcnt(" #n ")" ::: "memory")
#define G8_BAR __builtin_amdgcn_s_barrier()
#define G8_SCHED __builtin_amdgcn_sched_barrier(0)
    Unit cur, nxt, nn; int ui = 0;
    if (!P.next(0, cur)) return;
    const int f8scale = 0x7f7f7f7f;
    f32x4 acc[2][2][4][2];
#pragma unroll
    for (int a = 0; a < 2; ++a)
#pragma unroll
        for (int b = 0; b < 2; ++b)
#pragma unroll
            for (int m = 0; m < 4; ++m)
#pragma unroll
                for (int n = 0; n < 2; ++n) acc[a][b][m][n] = (f32x4){0.f, 0.f, 0.f, 0.f};
    i32x8 At[4], B0[2], B1[2];
    const char* Ab = (const char*)P.a_base();
    unsigned aoc[2][2], aon[2][2]; int raw[2][2];
    P.a_fetch(cur, RA, raw); P.a_finish(raw, CA, aoc);
    bool has_next = P.next(1, nxt);
    if (has_next) { P.a_fetch(nxt, RA, raw); P.a_finish(raw, CA, aon); }
    else { aon[0][0] = aoc[0][0]; aon[0][1] = aoc[0][1]; aon[1][0] = aoc[1][0]; aon[1][1] = aoc[1][1]; }
    const char* cB = (const char*)P.b_ptr(cur);
    const char* nB = has_next ? (const char*)P.b_ptr(nxt) : cB;
    typename Epi::Pre pre = E.fetch(cur, wr, wc, fr, fq);
    G8_STAGE_B(G8_SB(0, 0), cB); G8_STAGE_B(G8_SB(0, 1), cB + hstep); G8_STAGE_A(G8_SA(0, 0), aoc[0][0], aoc[0][1]); G8_STAGE_A(G8_SA(0, 1), aoc[1][0], aoc[1][1]);
    if (wr == 1) G8_BAR;
    G8_WAIT_V(2); G8_BAR;
    G8_STAGE_B(G8_SB(1, 0), cB + kstep); G8_STAGE_A(G8_SA(1, 0), aoc[0][0] + 128u, aoc[0][1] + 128u); G8_STAGE_B(G8_SB(1, 1), cB + hstep + kstep);
    G8_WAIT_V(6); G8_BAR;
    for (;;) {
        for (int t = 0; t < nt; t += 2) {
            const bool last = (t == nt - 2);
            const unsigned k1 = (unsigned)(t + 1) * 128u;
            const unsigned k2 = last ? 0u : (unsigned)(t + 2) * 128u;
            const unsigned a2_00 = (last ? aon[0][0] : aoc[0][0]) + k2, a2_01 = (last ? aon[0][1] : aoc[0][1]) + k2;
            const unsigned a2_10 = (last ? aon[1][0] : aoc[1][0]) + k2, a2_11 = (last ? aon[1][1] : aoc[1][1]) + k2;
            const char* b2 = last ? nB : cB + (size_t)(t + 2) * kstep;
            const char* b3 = b2 + kstep;
            G8_LDB(B0, 0, 0); G8_LDB(B1, 0, 1); G8_SCHED; G8_LDA(At, 0, 0); G8_STAGE_A(G8_SA(1, 1), aoc[1][0] + k1, aoc[1][1] + k1);
            G8_WAIT_V(8); G8_WAIT_L(0); G8_BAR; G8_MMA(0, 0, At, B0); G8_MMA(0, 1, At, B1); G8_BAR; G8_SCHED;
            G8_LDA(At, 0, 1); G8_STAGE_B(G8_SB(0, 0), b2); G8_STAGE_B(G8_SB(0, 1), b2 + hstep); G8_STAGE_A(G8_SA(0, 0), a2_00, a2_01);
            G8_WAIT_V(8); G8_WAIT_L(0); G8_BAR; G8_MMA(1, 0, At, B0); G8_MMA(1, 1, At, B1); G8_BAR; G8_SCHED;
            G8_LDB(B0, 1, 0); G8_LDB(B1, 1, 1); G8_SCHED; G8_LDA(At, 1, 0); G8_STAGE_A(G8_SA(0, 1), a2_10, a2_11);
            G8_WAIT_V(8); G8_WAIT_L(0); G8_BAR; G8_MMA(0, 0, At, B0); G8_MMA(0, 1, At, B1); G8_BAR; G8_SCHED;
            G8_LDA(At, 1, 1); G8_STAGE_B(G8_SB(1, 0), b3); G8_STAGE_B(G8_SB(1, 1), b3 + hstep); G8_STAGE_A(G8_SA(1, 0), a2_00 + 128u, a2_01 + 128u);
            G8_WAIT_V(8); G8_WAIT_L(0); G8_BAR; G8_MMA(1, 0, At, B0); G8_MMA(1, 1, At, B1); G8_BAR; G8_SCHED;
        }
        if (wr == 0) G8_BAR;
        if constexpr (Prob::FP8) asm volatile("s_nop 15\n\ts_nop 15" ::: "memory");
        const bool has_nn = has_next && P.next(ui + 2, nn);
        if (has_nn) P.a_fetch(nn, RA, raw);
        typename Epi::Pre pren = pre; if (has_next) pren = E.fetch(nxt, wr, wc, fr, fq);
        E(acc, cur, pre, wr, wc, fr, fq); pre = pren;
        if (!has_next) break;
#pragma unroll
        for (int a = 0; a < 2; ++a)
#pragma unroll
            for (int b = 0; b < 2; ++b)
#pragma unroll
                for (int m = 0; m < 4; ++m)
#pragma unroll
                    for (int n = 0; n < 2; ++n) acc[a][b][m][n] = (f32x4){0.f, 0.f, 0.f, 0.f};
        cur = nxt; cB = nB; ++ui;
        aoc[0][0] = aon[0][0]; aoc[0][1] = aon[0][1]; aoc[1][0] = aon[1][0]; aoc[1][1] = aon[1][1];
        nxt = nn; has_next = has_nn;
        if (has_next) { P.a_finish(raw, CA, aon); nB = (const char*)P.b_ptr(nxt); }
        else { nB = cB; }
        if (wr == 1) G8_BAR;
    }
    G8_WAIT_V(0);
    G8_BAR;
#undef G8_SA
#undef G8_SB
#undef G8_STAGE_A
#undef G8_STAGE_B
#undef G8_LDA
#undef G8_LDB
#undef G8_MMA
#undef G8_CAT
#undef G8_LO
#undef G8_HI
#undef G8_WAIT_V
#undef G8_WAIT_L
#undef G8_BAR
#undef G8_SCHED
}
}
namespace g8 {
#ifndef WGM_IN
#define WGM_IN 8
#endif
#ifndef WGM_OUT
#define WGM_OUT 8
#endif
#ifndef WGM_M1
#define WGM_M1 4
#endif
#ifndef WGM_M2
#define WGM_M2 4
#endif
template <bool F8, int WG_ = 8> struct DenseProbT {
    static constexpr bool FP8 = F8;
    const bf16_t* A; const bf16_t* Bt; int nM, nN, K, G, c, i0, i1;
    __device__ __forceinline__ bool next(int i, Unit& u) const { return (i0 + i < i1) && static_next<WG_>(i0 + i, nM, nN, G, c, u); }
    __device__ __forceinline__ const void* a_base() const { return A; }
    __device__ __forceinline__ void a_fetch(const Unit& u, const int (&RA)[2], int (&raw)[2][2]) const {
#pragma unroll
        for (int h = 0; h < 2; ++h)
#pragma unroll
            for (int i = 0; i < 2; ++i) raw[h][i] = u.pm * BM + h * HALF + RA[i];
    }
    __device__ __forceinline__ void a_finish(const int (&raw)[2][2], const int (&CA)[2], unsigned (&ao)[2][2]) const {
#pragma unroll
        for (int h = 0; h < 2; ++h)
#pragma unroll
            for (int i = 0; i < 2; ++i) ao[h][i] = (unsigned)((raw[h][i] * K + CA[i]) * 2);
    }
    __device__ __forceinline__ const void* b_ptr(const Unit& u) const { return Bt + (size_t)u.pn * BM * K; }
};
typedef DenseProbT<false, WGM_IN> DenseProbIn; typedef DenseProbT<false, WGM_OUT> DenseProbOut;
struct MoeProb1 {
    static constexpr bool FP8 = true;
    const bf16_t* A; const bf16_t* Bt; const int* row_tok; const int* blk; int K; int nM; int i0, i1;
    __device__ __forceinline__ bool next(int i, Unit& u) const {
        if (i0 + i >= i1 || !static_next<WGM_M1>(i0 + i, nM, 2 * FF / BM, gridDim.x, blockIdx.x, u)) return false;
        u.e = blk[64 + u.pm]; return true; }
    __device__ __forceinline__ const void* a_base() const { return A; }
    __device__ __forceinline__ void a_fetch(const Unit& u, const int (&RA)[2], int (&raw)[2][2]) const {
#pragma unroll
        for (int h = 0; h < 2; ++h)
#pragma unroll
            for (int i = 0; i < 2; ++i) raw[h][i] = row_tok[u.pm * BM + h * HALF + RA[i]];
    }
    __device__ __forceinline__ void a_finish(const int (&raw)[2][2], const int (&CA)[2], unsigned (&ao)[2][2]) const {
#pragma unroll
        for (int h = 0; h < 2; ++h)
#pragma unroll
            for (int i = 0; i < 2; ++i) ao[h][i] = (unsigned)((raw[h][i] * K + CA[i]) * 2);
    }
    __device__ __forceinline__ const void* b_ptr(const Unit& u) const { return Bt + ((size_t)__builtin_amdgcn_readfirstlane(u.e) * (2 * FF) + (size_t)u.pn * BM) * K; }
};
struct MoeProb2 {
    static constexpr bool FP8 = true;
    const bf16_t* A; const bf16_t* Bt; const int* blk; int K; int nM;
    __device__ __forceinline__ bool next(int i, Unit& u) const {
        if (!static_next<WGM_M2>(i, nM, DM / BM, gridDim.x, blockIdx.x, u)) return false;
        u.e = blk[64 + u.pm]; return true; }
    __device__ __forceinline__ const void* a_base() const { return A; }
    __device__ __forceinline__ void a_fetch(const Unit& u, const int (&RA)[2], int (&raw)[2][2]) const {
#pragma unroll
        for (int h = 0; h < 2; ++h)
#pragma unroll
            for (int i = 0; i < 2; ++i) raw[h][i] = u.pm * BM + h * HALF + RA[i];
    }
    __device__ __forceinline__ void a_finish(const int (&raw)[2][2], const int (&CA)[2], unsigned (&ao)[2][2]) const {
#pragma unroll
        for (int h = 0; h < 2; ++h)
#pragma unroll
            for (int i = 0; i < 2; ++i) ao[h][i] = (unsigned)((raw[h][i] * K + CA[i]) * 2);
    }
    __device__ __forceinline__ const void* b_ptr(const Unit& u) const { return Bt + ((size_t)__builtin_amdgcn_readfirstlane(u.e) * DM + (size_t)u.pn * BM) * K; }
};

struct EpiProj {
    static constexpr bool PERM = true;
    bf16_t* __restrict__ O; const float* __restrict__ rstd; float scale; int colbase;
    struct Pre { float rs[2][4]; };
    __device__ __forceinline__ Pre fetch(const Unit& u, int wr, int wc, int fr, int fq) const {
        Pre q; const int row0 = u.pm * BM + wr * 64 + fr;
#pragma unroll
        for (int ai = 0; ai < 2; ++ai)
#pragma unroll
            for (int m = 0; m < 4; ++m) q.rs[ai][m] = rstd[row0 + ai * HALF + m * 16];
        return q; }
    __device__ __forceinline__ void operator()(const f32x4 (&acc)[2][2][4][2], const Unit& u, const Pre& q, int wr, int wc, int fr, int fq) const {
        const int row0 = u.pm * BM + wr * 64 + fr, col0 = colbase + u.pn * BM + wc * 32 + 8 * fq;
#pragma unroll
        for (int ai = 0; ai < 2; ++ai)
#pragma unroll
            for (int m = 0; m < 4; ++m) { const int row = row0 + ai * HALF + m * 16; bf16_t* rowp = O + (size_t)row * NPROJ + col0; const float rsc = q.rs[ai][m] * scale;
#pragma unroll
                for (int bj = 0; bj < 2; ++bj) { const f32x4 v0 = acc[ai][bj][m][0] * rsc, v1 = acc[ai][bj][m][1] * rsc;
                    u32x4 w; w.x = cvt_pk_bf16(v0[0], v0[1]); w.y = cvt_pk_bf16(v0[2], v0[3]); w.z = cvt_pk_bf16(v1[0], v1[1]); w.w = cvt_pk_bf16(v1[2], v1[3]);
                    *(u32x4*)(rowp + bj * HALF) = w; } }
    }
};
struct EpiX1 {
    static constexpr bool PERM = false;
    const float* __restrict__ X; float* __restrict__ O;
    struct Pre {};
    __device__ __forceinline__ Pre fetch(const Unit&, int, int, int, int) const { return Pre{}; }
    __device__ __forceinline__ void operator()(const f32x4 (&acc)[2][2][4][2], const Unit& u, const Pre&, int wr, int wc, int fr, int fq) const {
        const int row0 = u.pm * BM + wr * 64 + fr, col0 = u.pn * BM + wc * 32 + 4 * fq;
#pragma unroll
        for (int ai = 0; ai < 2; ++ai) {
            f32x4 xv[4][2][2];
#pragma unroll
            for (int m = 0; m < 4; ++m) { const size_t off = (size_t)(row0 + ai * HALF + m * 16) * DM + col0;
#pragma unroll
                for (int bj = 0; bj < 2; ++bj)
#pragma unroll
                    for (int n = 0; n < 2; ++n) xv[m][bj][n] = __builtin_nontemporal_load((const f32x4*)(X + off + bj * HALF + n * 16)); }
#pragma unroll
            for (int m = 0; m < 4; ++m) { const size_t off = (size_t)(row0 + ai * HALF + m * 16) * DM + col0;
#pragma unroll
                for (int bj = 0; bj < 2; ++bj)
#pragma unroll
                    for (int n = 0; n < 2; ++n) *(f32x4*)(O + off + bj * HALF + n * 16) = xv[m][bj][n] + acc[ai][bj][m][n]; }
        }
    }
};
struct EpiSwiglu {
    static constexpr bool PERM = true;
    unsigned char* __restrict__ O; const float* __restrict__ row_rstd; const float* __restrict__ bgu;
    struct Pre { float rsv[2][4]; };
    __device__ __forceinline__ Pre fetch(const Unit& u, int wr, int wc, int fr, int fq) const {
        Pre q; const int row0 = u.pm * BM + wr * 64 + fr;
#pragma unroll
        for (int ai = 0; ai < 2; ++ai)
#pragma unroll
            for (int m = 0; m < 4; ++m) q.rsv[ai][m] = row_rstd[row0 + ai * HALF + m * 16];
        return q; }
    __device__ __forceinline__ void operator()(const f32x4 (&acc)[2][2][4][2], const Unit& u, const Pre& q, int wr, int wc, int fr, int fq) const {
        const int row0 = u.pm * BM + wr * 64 + fr, colg = u.pn * HALF + wc * 32 + 8 * fq;
        const float* bg = bgu + (size_t)__builtin_amdgcn_readfirstlane(u.e) * (2 * FF) + colg; const float* bu = bg + FF;
        const f32x4 bg0 = *(const f32x4*)bg, bg1 = *(const f32x4*)(bg + 4), bu0 = *(const f32x4*)bu, bu1 = *(const f32x4*)(bu + 4);
#pragma unroll
        for (int ai = 0; ai < 2; ++ai)
#pragma unroll
            for (int m = 0; m < 4; ++m) { const int row = row0 + ai * HALF + m * 16; const float rs = q.rsv[ai][m] * F8_UNSCALE;
                f32x4 g0 = acc[ai][0][m][0] * rs + bg0, g1 = acc[ai][0][m][1] * rs + bg1, u0 = acc[ai][1][m][0] * rs + bu0, u1 = acc[ai][1][m][1] * rs + bu1;
                float o[8];
#pragma unroll
                for (int j = 0; j < 8; ++j) { float g = j < 4 ? g0[j] : g1[j - 4], uu = j < 4 ? u0[j] : u1[j - 4];
                    g = fminf(g, 7.0f); uu = __builtin_amdgcn_fmed3f(uu, -7.0f, 7.0f);
                    const float sg = __builtin_amdgcn_rcpf(1.0f + __builtin_amdgcn_exp2f(g * (-1.702f * 1.4426950408889634f)));
                    o[j] = (uu * ACT_SCALE + ACT_SCALE) * (g * sg); }
                u32x2 w; w.x = cvt4_fp8(o[0], o[1], o[2], o[3]); w.y = cvt4_fp8(o[4], o[5], o[6], o[7]);
                *(u32x2*)(O + (size_t)row * FF + colg) = w; }
    }
};
struct EpiDown {
    static constexpr bool PERM = true;
    unsigned char* __restrict__ O; const float* __restrict__ bd;
    struct Pre { f32x4 bv[2][2]; };
    __device__ __forceinline__ Pre fetch(const Unit& u, int wr, int wc, int fr, int fq) const {
        Pre q; const int col0 = u.pn * BM + wc * 32 + 8 * fq;
        const float* bp = bd + (size_t)__builtin_amdgcn_readfirstlane(u.e) * DM + col0;
#pragma unroll
        for (int bj = 0; bj < 2; ++bj)
#pragma unroll
            for (int n = 0; n < 2; ++n) q.bv[bj][n] = *(const f32x4*)(bp + bj * HALF + 4 * n) * Y_SCALE;
        return q; }
    __device__ __forceinline__ void operator()(const f32x4 (&acc)[2][2][4][2], const Unit& u, const Pre& q, int wr, int wc, int fr, int fq) const {
        const int row0 = u.pm * BM + wr * 64 + fr, col0 = u.pn * BM + wc * 32 + 8 * fq;
#pragma unroll
        for (int ai = 0; ai < 2; ++ai)
#pragma unroll
            for (int m = 0; m < 4; ++m) { unsigned char* rowp = O + (size_t)(row0 + ai * HALF + m * 16) * DM + col0;
#pragma unroll
                for (int bj = 0; bj < 2; ++bj) { const f32x4 v0 = acc[ai][bj][m][0] * (F8_UNSCALE * Y_SCALE) + q.bv[bj][0], v1 = acc[ai][bj][m][1] * (F8_UNSCALE * Y_SCALE) + q.bv[bj][1];
                    u32x2 w; w.x = cvt4_fp8(v0[0], v0[1], v0[2], v0[3]); w.y = cvt4_fp8(v1[0], v1[1], v1[2], v1[3]);
                    *(u32x2*)(rowp + bj * HALF) = w; } }
    }
};
}
struct Ctx { LAS unsigned char* lds; int tid, lane, wave; };
__device__ __forceinline__ Ctx fresh_ctx(const Ctx& c0) { Ctx c; c.lds = c0.lds; int t = c0.wave * 64 + lane_id(); asm volatile("" : "+v"(t)); c.tid = t; c.lane = t & 63; c.wave = c0.wave; return c; }

__device__ __forceinline__ void transpose_item(const float* W, int ld, int K, int k0, int n0, bf16_t* WT_row0  , LAS float* scr, int lane) {
    float tv[32];
#pragma unroll
    for (int i = 0; i < 32; ++i) { const int kk = 2 * i + (lane >> 5); tv[i] = __builtin_nontemporal_load(W + (size_t)(k0 + kk) * ld + n0 + (lane & 31)); }
#pragma unroll
    for (int i = 0; i < 32; ++i) { const int kk = 2 * i + (lane >> 5); scr[kk * 33 + (lane & 31)] = tv[i]; }
    LDS_WAIT(); asm volatile("" ::: "memory");
    const int c = lane & 7;
#pragma unroll
    for (int j = 0; j < 4; ++j) { const int n = (lane >> 3) + 8 * j; const LAS float* s = scr + (8 * c) * 33 + n;
        u32x4 o; o.x = cvt_pk_bf16(s[0 * 33], s[1 * 33]); o.y = cvt_pk_bf16(s[2 * 33], s[3 * 33]); o.z = cvt_pk_bf16(s[4 * 33], s[5 * 33]); o.w = cvt_pk_bf16(s[6 * 33], s[7 * 33]);
        *(u32x4*)(WT_row0 + (size_t)n * K + k0 + 8 * c) = o; }
    LDS_WAIT(); asm volatile("" ::: "memory");
}
__device__ __forceinline__ void phase_convert(const Params& p, const Ctx& c0) { const Ctx c = fresh_ctx(c0);
    LAS float* scr = (LAS float*)(c.lds + c.wave * 18432);
    const int gw = blockIdx.x * NWAVES + c.wave, NGW = gridDim.x * NWAVES;
    bf16_t* WinT = (bf16_t*)(p.ws + WS_WIN); bf16_t* WoutT = (bf16_t*)(p.ws + WS_WOUT);
    constexpr int KB = DM / 64;
    constexpr int I_IN = KB * (NPROJ / 32), I_OUT = KB * (DM / 32), NITEMS = I_IN + I_OUT;
    for (int it = gw; it < NITEMS; it += NGW) {
        int r = it;
        if (r < I_IN) { const int nb = r % (NPROJ / 32), kb = r / (NPROJ / 32); transpose_item(p.w_in, LDW_IN, DM, 64 * kb, 32 * nb, WinT + (size_t)(32 * nb) * DM, scr, c.lane); continue; } r -= I_IN;
        { const int nb = r % (DM / 32), kb = r / (DM / 32); transpose_item(p.w_out, DM, DM, 64 * kb, 32 * nb, WoutT + (size_t)(32 * nb) * DM, scr, c.lane); }
    }
    float* rc = (float*)(p.ws + WS_ROPE); float* rs = rc + SEQ * 64;
    for (int i = blockIdx.x * NTHREADS + c.tid; i < SEQ * 64; i += gridDim.x * NTHREADS) {
        const int pos = i >> 6, j = i & 63;
        const float inv = 1.0f / powf(10000.0f, (float)(2 * j) / 128.0f);
        const float ang = (float)pos * inv; float sn, cs; sincosf(ang, &sn, &cs); rc[i] = cs; rs[i] = sn; }
}
constexpr int CT_GU1 = (DM / 128) * (2 * FF / 256), CT_D1 = (FF / 128) * (DM / 256), CT_GU = NE * CT_GU1, CT_D = NE * CT_D1, CT_TOTAL = CT_GU + CT_D;
struct ConvTile { const float* src; unsigned char* dst; int ld; int gu; };
__device__ __forceinline__ ConvTile ctile_decode(const Params& p, int r) {
    ConvTile t;
    if (r < CT_GU) { const int e = r / CT_GU1, q = r % CT_GU1, nt = q % (2 * FF / 256), kt = q / (2 * FF / 256);
        t.src = p.w_gu + (size_t)e * DM * (2 * FF) + (size_t)(128 * kt) * (2 * FF) + 256 * nt; t.ld = 2 * FF; t.gu = 256 * nt;
        t.dst = (unsigned char*)(p.ws + WS_WGU) + (size_t)e * (2 * FF) * DM + 128 * kt; }
    else { r -= CT_GU; const int e = r / CT_D1, q = r % CT_D1, nt = q % (DM / 256), kt = q / (DM / 256);
        t.src = p.w_d + (size_t)e * FF * DM + (size_t)(128 * kt) * DM + 256 * nt; t.ld = DM; t.gu = -1;
        t.dst = (unsigned char*)(p.ws + WS_WD) + ((size_t)e * DM + 256 * nt) * FF + 128 * kt; }
    return t;
}
__device__ __forceinline__ void ctile_load(const ConvTile& t, f32x4 (&tv)[16], int wave, int lane) {
    const float* s = t.src + (size_t)(16 * wave) * t.ld + 4 * lane;
#pragma unroll
    for (int i = 0; i < 16; ++i) tv[i] = __builtin_nontemporal_load((const f32x4*)(s + (size_t)i * t.ld));
}
__device__ __forceinline__ void ctile_store(const ConvTile& t, const f32x4 (&tv)[16], LAS unsigned char* lds, int tid, int wave, int lane) {
#pragma unroll
    for (int c = 0; c < 4; ++c) { u32x4 o;
#pragma unroll
        for (int q = 0; q < 4; ++q) o[q] = cvt4_fp8(tv[4 * q][c] * W_SCALE, tv[4 * q + 1][c] * W_SCALE, tv[4 * q + 2][c] * W_SCALE, tv[4 * q + 3][c] * W_SCALE);
        const int n = 4 * lane + c; *(LAS u32x4*)(lds + n * 128 + ((wave ^ (lane & 7)) << 4)) = o; }
    asm volatile("s_waitcnt lgkmcnt(0)" ::: "memory"); __builtin_amdgcn_s_barrier();
#pragma unroll
    for (int j = 0; j < 4; ++j) { const int n = 64 * j + (tid >> 3), ch = tid & 7;
        const u32x4 o = *(const LAS u32x4*)(lds + n * 128 + ((ch ^ ((n >> 2) & 7)) << 4));
        int orow = n;
        if (t.gu >= 0) { const int ng = t.gu + n; const int nn = ng < FF ? ng : ng - FF; orow = 256 * (nn / 128) + (nn % 128) + (ng < FF ? 0 : 128); }
        *(u32x4*)(t.dst + (size_t)orow * DM + 16 * ch) = o; }
    asm volatile("s_waitcnt lgkmcnt(0)" ::: "memory"); __builtin_amdgcn_s_barrier();
}
__device__ __forceinline__ void phase_convert_share(const Params& p, const Ctx& c0, int lo, int hi, int G, int w) { const Ctx c = fresh_ctx(c0);
    for (int base = lo + w; base < hi; base += 8 * G) {
        f32x4 ta[16], tb[16];
#define CT_OK(k) (base + (k) * G < hi)
#define CT_L(k, buf) do { if (CT_OK(k)) { const ConvTile t_ = ctile_decode(p, base + (k) * G); ctile_load(t_, buf, c.wave, c.lane); } __builtin_amdgcn_sched_barrier(0); } while (0)
#define CT_S(k, buf) do { if (CT_OK(k)) { const ConvTile t_ = ctile_decode(p, base + (k) * G); ctile_store(t_, buf, c.lds, c.tid, c.wave, c.lane); } __builtin_amdgcn_sched_barrier(0); } while (0)
        CT_L(0, ta); CT_L(1, tb);
        CT_S(0, ta); CT_L(2, ta);
        CT_S(1, tb); CT_L(3, tb);
        CT_S(2, ta); CT_L(4, ta);
        CT_S(3, tb); CT_L(5, tb);
        CT_S(4, ta); CT_L(6, ta);
        CT_S(5, tb); CT_L(7, tb);
        CT_S(6, ta); CT_S(7, tb);
#undef CT_OK
#undef CT_L
#undef CT_S
    }
}

template <int NTL, int OUT8  >
__device__ __forceinline__ void norm_skinny_half(const float* __restrict__ xrows, const float* __restrict__ wn, const float* __restrict__ Wsk, int ldw, void* __restrict__ hrows_, void* __restrict__ hrows8_, int hk, int lane, f32x4 (&acc)[NTL], float& ss) {
    const int row = lane & 15, kq = lane >> 4;
    ss = 0.f;
#pragma unroll
    for (int t = 0; t < NTL; ++t) acc[t] = (f32x4){0.f, 0.f, 0.f, 0.f};
    for (int ks0 = 0; ks0 < 32; ks0 += 4) {
        f32x4 xa[4], xb[4], wa[4], wb[4]; float wv[4][NTL][8];
#pragma unroll
        for (int q = 0; q < 4; ++q) { const int d0 = 1024 * hk + 32 * (ks0 + q) + 8 * kq;
            xa[q] = *(const f32x4*)(xrows + (size_t)row * DM + d0); xb[q] = *(const f32x4*)(xrows + (size_t)row * DM + d0 + 4);
            wa[q] = *(const f32x4*)(wn + d0); wb[q] = *(const f32x4*)(wn + d0 + 4);
#pragma unroll
            for (int t = 0; t < NTL; ++t)
#pragma unroll
                for (int i = 0; i < 8; ++i) wv[q][t][i] = Wsk[(size_t)(d0 + i) * ldw + t * 16 + row]; }
#pragma unroll
        for (int q = 0; q < 4; ++q) { const int d0 = 1024 * hk + 32 * (ks0 + q) + 8 * kq;
            f32x4 a = xa[q], b = xb[q];
            ss += (a[0] * a[0] + a[1] * a[1]) + (a[2] * a[2] + a[3] * a[3]) + (b[0] * b[0] + b[1] * b[1]) + (b[2] * b[2] + b[3] * b[3]);
            a = a * wa[q]; b = b * wb[q];
            u32x4 hw; hw.x = cvt_pk_bf16(a[0], a[1]); hw.y = cvt_pk_bf16(a[2], a[3]); hw.z = cvt_pk_bf16(b[0], b[1]); hw.w = cvt_pk_bf16(b[2], b[3]);
            if constexpr (OUT8 >= 1) { u32x2 f8; f8.x = cvt4_fp8(a[0] * ACT_SCALE, a[1] * ACT_SCALE, a[2] * ACT_SCALE, a[3] * ACT_SCALE); f8.y = cvt4_fp8(b[0] * ACT_SCALE, b[1] * ACT_SCALE, b[2] * ACT_SCALE, b[3] * ACT_SCALE);
                *(u32x2*)((unsigned char*)hrows8_ + (size_t)row * DM + d0) = f8; }
            if constexpr (OUT8 != 1) *(u32x4*)((bf16_t*)hrows_ + (size_t)row * DM + d0) = hw;
            const f32x4 ra = {a[0] - bflo(hw.x), a[1] - bfhi(hw.x), a[2] - bflo(hw.y), a[3] - bfhi(hw.y)}, rb = {b[0] - bflo(hw.z), b[1] - bfhi(hw.z), b[2] - bflo(hw.w), b[3] - bfhi(hw.w)};
            const bf16x8 ah = __builtin_bit_cast(bf16x8, hw), al = pack8(ra, rb);
#pragma unroll
            for (int t = 0; t < NTL; ++t) { const float* w8 = wv[q][t];
                u32x4 bw; bw.x = cvt_pk_bf16(w8[0], w8[1]); bw.y = cvt_pk_bf16(w8[2], w8[3]); bw.z = cvt_pk_bf16(w8[4], w8[5]); bw.w = cvt_pk_bf16(w8[6], w8[7]);
                const f32x4 r0 = {w8[0] - bflo(bw.x), w8[1] - bfhi(bw.x), w8[2] - bflo(bw.y), w8[3] - bfhi(bw.y)}, r1 = {w8[4] - bflo(bw.z), w8[5] - bfhi(bw.z), w8[6] - bflo(bw.w), w8[7] - bfhi(bw.w)};
                const bf16x8 bh = __builtin_bit_cast(bf16x8, bw), bl = pack8(r0, r1);
                acc[t] = __builtin_amdgcn_mfma_f32_16x16x32_bf16(ah, bh, acc[t], 0, 0, 0);
                acc[t] = __builtin_amdgcn_mfma_f32_16x16x32_bf16(al, bh, acc[t], 0, 0, 0);
                acc[t] = __builtin_amdgcn_mfma_f32_16x16x32_bf16(ah, bl, acc[t], 0, 0, 0); }
        }
    }
    ss += __shfl_xor(ss, 16); ss += __shfl_xor(ss, 32);
}

__device__ __forceinline__ void phase_norm1(const Params& p, const Ctx& c0) { const Ctx c = fresh_ctx(c0);
    bf16_t* H = (bf16_t*)(p.ws + WS_H); float* rstd = (float*)(p.ws + WS_RSTD1); float* gz = (float*)(p.ws + WS_GZ);
    const int pair = c.wave >> 1, hk = c.wave & 1;
    LAS float* scr = (LAS float*)(c.lds + pair * 4096);
    for (int u = blockIdx.x * 4 + pair; u < T / 16; u += gridDim.x * 4) {
        f32x4 acc[1]; float ss;
        norm_skinny_half<1, 0>(p.x + (size_t)u * 16 * DM, p.attn_norm_w, p.w_in + C_GZ, LDW_IN, H + (size_t)u * 16 * DM, nullptr, hk, c.lane, acc, ss);
        if (hk == 1) { *(LAS f32x4*)(scr + c.lane * 4) = acc[0]; if (c.lane < 16) scr[256 + c.lane] = ss; }
        __syncthreads();
        if (hk == 0) {
            const f32x4 o = *(LAS f32x4*)(scr + c.lane * 4); const float tot = ss + scr[256 + (c.lane & 15)];
            const float rs = 1.0f / sqrtf(tot * (1.0f / DM) + EPS);
            if (c.lane < 16) { rstd[u * 16 + c.lane] = rs; scr[512 + c.lane] = rs; }
            LDS_WAIT();
#pragma unroll
            for (int r = 0; r < 4; ++r) { const int row = (c.lane >> 4) * 4 + r; gz[(size_t)(u * 16 + row) * 16 + (c.lane & 15)] = (acc[0][r] + o[r]) * scr[512 + row]; }
        }
        __syncthreads();
    }
}

__device__ __forceinline__ void phase_norm2_router(const Params& p, const Ctx& c0) { const Ctx c = fresh_ctx(c0);
    bf16_t* H = (bf16_t*)(p.ws + WS_H); float* rstd = (float*)(p.ws + WS_RSTD2); const float* X1 = (const float*)(p.ws + WS_X1);
    int* topi = (int*)(p.ws + WS_TOPI); float* topg = (float*)(p.ws + WS_TOPG); int* hist = (int*)(p.ws + WS_HIST); int* row_tok = (int*)(p.ws + WS_ROWTOK);
    const int pair = c.wave >> 1, hk = c.wave & 1;
    LAS float* scr = (LAS float*)(c.lds + pair * 8192);
    LAS int* hcnt = (LAS int*)(c.lds + 65536);
    { float* row_rstd = (float*)(p.ws + WS_ROWRSTD);
      for (int i = blockIdx.x * NTHREADS + c.tid; i < PROWS; i += gridDim.x * NTHREADS) { row_tok[i] = 0; row_rstd[i] = 0.f; } }
    for (int g = blockIdx.x; g < T / 64; g += gridDim.x) {
        if (c.tid < 32) hcnt[c.tid] = 0;
        __syncthreads();
        const int u = g * 4 + pair;
        f32x4 acc[2]; float ss;
        norm_skinny_half<2, 1>(X1 + (size_t)u * 16 * DM, p.ffn_norm_w, p.router_w, NE, nullptr, (unsigned char*)H + (size_t)u * 16 * DM, hk, c.lane, acc, ss);
        if (hk == 1) { *(LAS f32x4*)(scr + c.lane * 4) = acc[0]; *(LAS f32x4*)(scr + 256 + c.lane * 4) = acc[1]; if (c.lane < 16) scr[512 + c.lane] = ss; }
        __syncthreads();
        if (hk == 0) {
            const f32x4 o0 = *(LAS f32x4*)(scr + c.lane * 4), o1 = *(LAS f32x4*)(scr + 256 + c.lane * 4); const float tot = ss + scr[512 + (c.lane & 15)];
            const float rs = 1.0f / sqrtf(tot * (1.0f / DM) + EPS);
            if (c.lane < 16) { rstd[u * 16 + c.lane] = rs; scr[528 + c.lane] = rs; }
            LDS_WAIT();
            const float b0 = p.router_b[c.lane & 15], b1 = p.router_b[16 + (c.lane & 15)];
#pragma unroll
            for (int r = 0; r < 4; ++r) { const int row = (c.lane >> 4) * 4 + r; const float rr = scr[528 + row];
                scr[1024 + row * 32 + (c.lane & 15)] = (acc[0][r] + o0[r]) * rr + b0; scr[1024 + row * 32 + 16 + (c.lane & 15)] = (acc[1][r] + o1[r]) * rr + b1; }
            LDS_WAIT();
            if (c.lane < 16) {
                float lv[32];
#pragma unroll
                for (int j = 0; j < 32; ++j) lv[j] = scr[1024 + c.lane * 32 + j];
                int bi[4]; float bv[4];
#pragma unroll
                for (int k = 0; k < 4; ++k) { float best = -__builtin_inff(); int bidx = 0;
#pragma unroll
                    for (int j = 0; j < 32; ++j) { const bool tk = lv[j] > best; best = tk ? lv[j] : best; bidx = tk ? j : bidx; }
                    bi[k] = bidx; bv[k] = best;
#pragma unroll
                    for (int j = 0; j < 32; ++j) lv[j] = (j == bidx) ? -__builtin_inff() : lv[j]; }
                const float e1 = __expf(bv[1] - bv[0]), e2 = __expf(bv[2] - bv[0]), e3 = __expf(bv[3] - bv[0]); const float inv = 1.0f / (1.0f + e1 + e2 + e3);
                const int tok = u * 16 + c.lane;
                *(int4*)(topi + (size_t)tok * 4) = make_int4(bi[0], bi[1], bi[2], bi[3]);
                *(float4*)(topg + (size_t)tok * 4) = make_float4(inv, e1 * inv, e2 * inv, e3 * inv);
#pragma unroll
                for (int k = 0; k < 4; ++k) atomicAdd((int*)&hcnt[bi[k]], 1);
            }
        }
        __syncthreads();
        if (c.tid < 32) hist[g * 32 + c.tid] = hcnt[c.tid];
        __syncthreads();
    }
}

__device__ __forceinline__ void phase_rope_kmean(const Params& p, const Ctx& c0) { const Ctx c = fresh_ctx(c0);
    bf16_t* proj = (bf16_t*)(p.ws + WS_PROJ); const float* rc = (const float*)(p.ws + WS_ROPE); const float* rsn = rc + SEQ * 64; float* kmean = (float*)(p.ws + WS_KMEAN);
    LAS float* red = (LAS float*)c.lds;
    const int cg = c.tid & 7, tk = c.tid >> 3;
    for (int u = blockIdx.x; u < NBATCH * MH * NBLK; u += gridDim.x) {
        const int b = u / (MH * NBLK), h = (u / NBLK) % MH, blk = u % NBLK;
        float s1[8], s2[8];
#pragma unroll
        for (int j = 0; j < 8; ++j) { s1[j] = 0.f; s2[j] = 0.f; }
        f32x4 ca[4], cb[4], sa[4], sb[4]; u32x4 t1[4][2], t2[4][2];
#pragma unroll
        for (int ps = 0; ps < 4; ++ps) {
            const int pos = blk * MBLK + ps * 64 + tk; const size_t row = (size_t)(b * SEQ + pos) * NPROJ;
            ca[ps] = *(const f32x4*)(rc + pos * 64 + 8 * cg); cb[ps] = *(const f32x4*)(rc + pos * 64 + 8 * cg + 4); sa[ps] = *(const f32x4*)(rsn + pos * 64 + 8 * cg); sb[ps] = *(const f32x4*)(rsn + pos * 64 + 8 * cg + 4);
#pragma unroll
            for (int qk = 0; qk < 2; ++qk) { const bf16_t* base = proj + row + (qk ? C_MK : C_MQ) + h * HD + 8 * cg; t1[ps][qk] = *(const u32x4*)base; t2[ps][qk] = *(const u32x4*)(base + 64); }
        }
#pragma unroll
        for (int ps = 0; ps < 4; ++ps) {
            const int pos = blk * MBLK + ps * 64 + tk; const size_t row = (size_t)(b * SEQ + pos) * NPROJ;
            const float cs[8] = {ca[ps][0], ca[ps][1], ca[ps][2], ca[ps][3], cb[ps][0], cb[ps][1], cb[ps][2], cb[ps][3]}, sn[8] = {sa[ps][0], sa[ps][1], sa[ps][2], sa[ps][3], sb[ps][0], sb[ps][1], sb[ps][2], sb[ps][3]};
#pragma unroll
            for (int qk = 0; qk < 2; ++qk) {
                bf16_t* base = proj + row + (qk ? C_MK : C_MQ) + h * HD + 8 * cg;
                float a[8], bb[8];
#pragma unroll
                for (int j = 0; j < 4; ++j) { a[2 * j] = bflo(t1[ps][qk][j]); a[2 * j + 1] = bfhi(t1[ps][qk][j]); bb[2 * j] = bflo(t2[ps][qk][j]); bb[2 * j + 1] = bfhi(t2[ps][qk][j]); }
                float o1[8], o2[8];
#pragma unroll
                for (int j = 0; j < 8; ++j) { o1[j] = a[j] * cs[j] - bb[j] * sn[j]; o2[j] = bb[j] * cs[j] + a[j] * sn[j]; }
                u32x4 w1, w2;
#pragma unroll
                for (int j = 0; j < 4; ++j) { w1[j] = cvt_pk_bf16(o1[2 * j], o1[2 * j + 1]); w2[j] = cvt_pk_bf16(o2[2 * j], o2[2 * j + 1]); }
                *(u32x4*)base = w1; *(u32x4*)(base + 64) = w2;
                if (qk) {
#pragma unroll
                    for (int j = 0; j < 8; ++j) { s1[j] += o1[j]; s2[j] += o2[j]; } }
            }
        }
#pragma unroll
        for (int j = 0; j < 8; ++j) {
#pragma unroll
            for (int o = 8; o < 64; o <<= 1) { s1[j] += __shfl_xor(s1[j], o); s2[j] += __shfl_xor(s2[j], o); } }
        if (c.lane < 8) {
#pragma unroll
            for (int j = 0; j < 8; ++j) { red[c.wave * 128 + 8 * cg + j] = s1[j]; red[c.wave * 128 + 64 + 8 * cg + j] = s2[j]; } }
        __syncthreads();
        if (c.tid < 128) { float s = 0.f;
#pragma unroll
            for (int w = 0; w < 8; ++w) s += red[w * 128 + c.tid];
            kmean[(size_t)u * HD + c.tid] = s * (1.0f / MBLK); }
        __syncthreads();
    }
}

__device__ __forceinline__ void phase_gla_prep(const Params& p, const Ctx& c0) { const Ctx c = fresh_ctx(c0);
    bf16_t* proj = (bf16_t*)(p.ws + WS_PROJ); const float* gz = (const float*)(p.ws + WS_GZ); float* dend = (float*)(p.ws + WS_DEND);
    LAS float* gzl = (LAS float*)c.lds;
    LAS float* seg = (LAS float*)(c.lds + 16384);
    const int ch = c.tid & 127, tq = __builtin_amdgcn_readfirstlane(c.tid >> 7);
    for (int u = blockIdx.x; u < NBATCH * GH * NBLK; u += gridDim.x) {
        const int b = u / (GH * NBLK), h = (u / NBLK) % GH, j = u % NBLK;
        const int tok0 = b * SEQ + j * MBLK;
        for (int i = c.tid; i < 256 * 4; i += NTHREADS) *(LAS f32x4*)(gzl + i * 4) = *(const f32x4*)(gz + (size_t)tok0 * 16 + i * 4);
        float w2[16];
#pragma unroll
        for (int r = 0; r < 16; ++r) w2[r] = p.gate_w2[r * 512 + h * GDK + ch];
        const float bias = p.gate_b[h * GDK + ch];
        __syncthreads();
        float run = 0.f; float Bv[64];
#pragma unroll
        for (int i = 0; i < 64; ++i) {
            const LAS float* g = gzl + (tq * 64 + i) * 16;
            const f32x4 g0 = *(const LAS f32x4*)g, g1 = *(const LAS f32x4*)(g + 4), g2 = *(const LAS f32x4*)(g + 8), g3 = *(const LAS f32x4*)(g + 12);
            float lg = bias;
            lg += g0[0] * w2[0] + g0[1] * w2[1] + g0[2] * w2[2] + g0[3] * w2[3]; lg += g1[0] * w2[4] + g1[1] * w2[5] + g1[2] * w2[6] + g1[3] * w2[7];
            lg += g2[0] * w2[8] + g2[1] * w2[9] + g2[2] * w2[10] + g2[3] * w2[11]; lg += g3[0] * w2[12] + g3[1] * w2[13] + g3[2] * w2[14] + g3[3] * w2[15];
            const float ls = fminf(lg, 0.f) - __logf(1.0f + __expf(-fabsf(lg)));
            run += ls * (1.0f / 16.0f); Bv[i] = run; }
        seg[tq * 128 + ch] = run;
        __syncthreads();
        float off = 0.f, tot = 0.f;
#pragma unroll
        for (int s = 0; s < 4; ++s) { const float v = seg[s * 128 + ch]; tot += v; off += (s < tq) ? v : 0.f; }
        if (tq == 0) dend[(size_t)u * GDK + ch] = __expf(tot);
        bf16_t* qp = proj + (size_t)(tok0 + tq * 64) * NPROJ + C_GQ + h * GDK + ch; bf16_t* kp = proj + (size_t)(tok0 + tq * 64) * NPROJ + C_GK + h * GDK + ch;
#pragma unroll
        for (int i0 = 0; i0 < 64; i0 += 16) {
            bf16_t qraw[16], kraw[16];
#pragma unroll
            for (int i = 0; i < 16; ++i) { qraw[i] = qp[(size_t)(i0 + i) * NPROJ]; kraw[i] = kp[(size_t)(i0 + i) * NPROJ]; }
#pragma unroll
            for (int i = 0; i < 16; ++i) { const float Bt = off + Bv[i0 + i];
                const float q = bf2f(qraw[i]), k = bf2f(kraw[i]);
                const float qt = q * __expf(Bt) * 0.08838834764831845f, kt = k * __expf(-Bt);
                qp[(size_t)(i0 + i) * NPROJ] = (bf16_t)(cvt_pk_bf16(qt, 0.f) & 0xffffu); kp[(size_t)(i0 + i) * NPROJ] = (bf16_t)(cvt_pk_bf16(kt, 0.f) & 0xffffu); }
        }
        __syncthreads();
    }
}
namespace att {
constexpr int NW = 8, QBLK = 32, KVBLK = 64, QB = 256, D = 128;
constexpr int SHM_V = KVBLK * D * 2, SHM_K = KVBLK * D * 2;
constexpr int ATT_LDS = 2 * SHM_V + 2 * SHM_K + NW * 64 * 4;
constexpr float SCALE = 0.08838834764831845f;
constexpr float THR = 8.f;
constexpr int APITCH = NPROJ, OPITCH = DM;
typedef LAS char* lptr;
typedef const LAS char* lcptr;

#define KSWZ(row, colB) ((row) * 256 + ((colB) ^ (((row) & 7) << 4)))
__device__ __forceinline__ int v_st(int k, int c) { const int kk = (k & ~0xC) | ((k & 4) << 1) | ((k & 8) >> 1); return ((kk >> 3) * 4 + (c >> 5)) * 512 + ((kk & 7) * 32 + (c & 31)) * 2; }
__device__ __forceinline__ int v_rd_base(int lane) { return ((lane & 3) << 3) | (((lane >> 2) & 3) << 6) | (((lane >> 4) & 1) << 5) | (((lane >> 5) & 1) << 8); }
constexpr int v_rd_off(int d0, int ks, int half) { return d0 * 512 + ks * 4096 + half * 2048; }
__device__ __forceinline__ int crow(int r, int hi) { return (r & 3) + 8 * (r >> 2) + 4 * hi; }
__device__ __forceinline__ bf16x8 load8(const bf16_t* p) { return *reinterpret_cast<const bf16x8*>(p); }

__device__ __forceinline__ void pack_p(const f32x16& p0, const f32x16& p1, bf16x8& pa0, bf16x8& pa1, bf16x8& pa2, bf16x8& pa3) {
#define PK4(P, B_, OUT) do { unsigned a0 = cvt_pk_bf16(P[B_+0], P[B_+1]), a1 = cvt_pk_bf16(P[B_+2], P[B_+3]);                          \
        unsigned b0 = cvt_pk_bf16(P[B_+4], P[B_+5]), b1 = cvt_pk_bf16(P[B_+6], P[B_+7]);                                             \
        auto r0 = __builtin_amdgcn_permlane32_swap(a0, b0, false, false); auto r1 = __builtin_amdgcn_permlane32_swap(a1, b1, false, false); \
        u32x4 w = {r0[0], r1[0], r0[1], r1[1]}; OUT = __builtin_bit_cast(bf16x8, w); } while (0)
    PK4(p0, 0, pa0); PK4(p0, 8, pa1); PK4(p1, 0, pa2); PK4(p1, 8, pa3);
#undef PK4
}
__device__ __forceinline__ void partialSM(f32x16& p0, f32x16& p1, float& m_reg, float& mn, float& alpha) {
    float pmax = p0[0];
#pragma unroll
    for (int r = 1; r < 16; ++r) pmax = fmaxf(pmax, p0[r]);
#pragma unroll
    for (int r = 0; r < 16; ++r) pmax = fmaxf(pmax, p1[r]);
    { auto rr = __builtin_amdgcn_permlane32_swap(__float_as_uint(pmax), __float_as_uint(pmax), false, false);
      pmax = fmaxf(__uint_as_float(rr[0]), __uint_as_float(rr[1])); }
    constexpr float C2 = 1.4426950408889634f * SCALE;
    if (__builtin_expect(__all((pmax - m_reg) * SCALE <= THR), 1)) { mn = m_reg; alpha = 1.f; }
    else { mn = fmaxf(m_reg, pmax); alpha = __builtin_amdgcn_exp2f((m_reg - mn) * C2); m_reg = mn; }
    const float mnL = -mn * C2;
#pragma unroll
    for (int r = 0; r < 16; ++r) p0[r] = fmaf(p0[r], C2, mnL);
#pragma unroll
    for (int r = 0; r < 16; ++r) p1[r] = fmaf(p1[r], C2, mnL);
#pragma unroll
    for (int r = 0; r < 16; ++r) p0[r] = __builtin_amdgcn_exp2f(p0[r]);
}
__device__ __forceinline__ void finishSM(f32x16& p0, f32x16& p1, float alpha, float& l_reg, bf16x8& pa0, bf16x8& pa1, bf16x8& pa2, bf16x8& pa3) {
#pragma unroll
    for (int r = 0; r < 16; ++r) p1[r] = __builtin_amdgcn_exp2f(p1[r]);
    float ps = 0;
#pragma unroll
    for (int r = 0; r < 16; ++r) ps += p0[r];
#pragma unroll
    for (int r = 0; r < 16; ++r) ps += p1[r];
    { auto rr = __builtin_amdgcn_permlane32_swap(__float_as_uint(ps), __float_as_uint(ps), false, false);
      ps = __uint_as_float(rr[0]) + __uint_as_float(rr[1]); }
    l_reg = l_reg * alpha + ps;
    pack_p(p0, p1, pa0, pa1, pa2, pa3);
}
template <int KB>
__device__ __forceinline__ void qkt(f32x16& p0, f32x16& p1, lcptr K_lds, int r32, int hi, const bf16x8* qr, float init = 0.f) {
#pragma unroll
    for (int r = 0; r < 16; ++r) { p0[r] = init; p1[r] = init; }
    lcptr kb[4];
#pragma unroll
    for (int dd = 0; dd < 4; ++dd) kb[dd] = K_lds + KB * SHM_K + KSWZ(r32, (dd * 16 + hi * 8) * 2);
#pragma unroll
    for (int d0 = 0; d0 < 8; ++d0) { lcptr a = kb[d0 & 3] + (d0 >> 2) * 128;
        bf16x8 b0 = *reinterpret_cast<const LAS bf16x8*>(a);
        bf16x8 b1 = *reinterpret_cast<const LAS bf16x8*>(a + 32 * 256);
        p0 = __builtin_amdgcn_mfma_f32_32x32x16_bf16(b0, qr[d0], p0, 0, 0, 0);
        p1 = __builtin_amdgcn_mfma_f32_32x32x16_bf16(b1, qr[d0], p1, 0, 0, 0); }
}
#define TRRD(dst, vb, off) asm volatile("ds_read_b64_tr_b16 %0, %1 offset:%2" : "=&v"(dst) : "v"(vb), "i"(off) : "memory")
template <int VOFF>
__device__ __forceinline__ void pv_tile(f32x16* o, int vb0, bf16x8 pa0, bf16x8 pa1, bf16x8 pa2, bf16x8 pa3) {
#define PV_D0(d0) do { s16x4 l0, l1, l2, l3, h0, h1, h2, h3; constexpr int b_ = VOFF + v_rd_off(d0, 0, 0); \
        TRRD(l0, vb0, b_); TRRD(h0, vb0, b_ + 2048); TRRD(l1, vb0, b_ + 4096); TRRD(h1, vb0, b_ + 6144); TRRD(l2, vb0, b_ + 8192); TRRD(h2, vb0, b_ + 10240); TRRD(l3, vb0, b_ + 12288); TRRD(h3, vb0, b_ + 14336); \
        asm volatile("s_waitcnt lgkmcnt(0)" ::: "memory"); SBAR(); \
        o[d0] = __builtin_amdgcn_mfma_f32_32x32x16_bf16(pa0, (bf16x8){l0[0], l0[1], l0[2], l0[3], h0[0], h0[1], h0[2], h0[3]}, o[d0], 0, 0, 0);   \
        o[d0] = __builtin_amdgcn_mfma_f32_32x32x16_bf16(pa1, (bf16x8){l1[0], l1[1], l1[2], l1[3], h1[0], h1[1], h1[2], h1[3]}, o[d0], 0, 0, 0);   \
        o[d0] = __builtin_amdgcn_mfma_f32_32x32x16_bf16(pa2, (bf16x8){l2[0], l2[1], l2[2], l2[3], h2[0], h2[1], h2[2], h2[3]}, o[d0], 0, 0, 0);   \
        o[d0] = __builtin_amdgcn_mfma_f32_32x32x16_bf16(pa3, (bf16x8){l3[0], l3[1], l3[2], l3[3], h3[0], h3[1], h3[2], h3[3]}, o[d0], 0, 0, 0); } while (0)
    PV_D0(0); PV_D0(1); PV_D0(2); PV_D0(3);
#undef PV_D0
}
template <int VOFF, int D0>
__device__ __forceinline__ void tr_frags(int vb0, bf16x8& f0, bf16x8& f1, bf16x8& f2, bf16x8& f3) {
    s16x4 l0, l1, l2, l3, h0, h1, h2, h3; constexpr int b_ = VOFF + v_rd_off(D0, 0, 0);
    TRRD(l0, vb0, b_); TRRD(h0, vb0, b_ + 2048); TRRD(l1, vb0, b_ + 4096); TRRD(h1, vb0, b_ + 6144); TRRD(l2, vb0, b_ + 8192); TRRD(h2, vb0, b_ + 10240); TRRD(l3, vb0, b_ + 12288); TRRD(h3, vb0, b_ + 14336);
    asm volatile("s_waitcnt lgkmcnt(0)" ::: "memory"); SBAR();
    f0 = (bf16x8){l0[0], l0[1], l0[2], l0[3], h0[0], h0[1], h0[2], h0[3]}; f1 = (bf16x8){l1[0], l1[1], l1[2], l1[3], h1[0], h1[1], h1[2], h1[3]};
    f2 = (bf16x8){l2[0], l2[1], l2[2], l2[3], h2[0], h2[1], h2[2], h2[3]}; f3 = (bf16x8){l3[0], l3[1], l3[2], l3[3], h3[0], h3[1], h3[2], h3[3]};
}

struct MobaRef { const bf16_t* Q; const bf16_t* K; const bf16_t* V; bf16_t* O; const unsigned* sel; int qb; };
struct MobaSeam { bf16x8 qr[8]; bf16x8 st_v0, st_v1, st_k0, st_k1; unsigned sel; };
#define AROW(p, k0, rr) ((p) + (size_t)((k0) + (rr)) * APITCH + sc)
#define VMW() asm volatile("s_waitcnt vmcnt(0)" ::: "memory")
#define VMWN(n) asm volatile("s_waitcnt vmcnt(%0)" :: "i"(n) : "memory")
#define SLOAD_H(Kp, Vp, k0) do { S.st_v0 = load8(AROW(Vp, k0, sr)); S.st_v1 = load8(AROW(Vp, k0, 32 + sr));              \
                         S.st_k0 = load8(AROW(Kp, k0, sr)); S.st_k1 = load8(AROW(Kp, k0, 32 + sr)); } while (0)
#define SWRITE_HK(bf) do { *(LAS bf16x8*)(K_lds + (bf) * SHM_K + kws) = S.st_k0; *(LAS bf16x8*)(K_lds + (bf) * SHM_K + kws + 32 * 256) = S.st_k1; } while (0)
#define SWRITE_HV(bf) do { *(LAS bf16x8*)(V_lds + (bf) * SHM_V + vst0) = S.st_v0; *(LAS bf16x8*)(V_lds + (bf) * SHM_V + vst1) = S.st_v1; } while (0)
#define SWRITE_H(bf) do { SWRITE_HV(bf); SWRITE_HK(bf); } while (0)

__device__ __forceinline__ void moba_prime(const MobaRef& cur, lptr lds, MobaSeam& S, int wave_s) {
    int tid = wave_s * 64 + lane_id(); asm volatile("" : "+v"(tid)); const int wid = __builtin_amdgcn_readfirstlane(tid >> 6), lane = tid & 63, r32 = lane & 31, hi = lane >> 5;
    const int sr = tid >> 4, sc = (tid & 15) * 8, kws = KSWZ(sr, sc * 2); lptr K_lds = lds + 2 * SHM_V;
#pragma unroll
    for (int d0 = 0; d0 < 8; ++d0) S.qr[d0] = load8(cur.Q + (size_t)(wid * QBLK + r32) * APITCH + d0 * 16 + hi * 8);
    S.sel = cur.sel[wid * QBLK + r32];
    SLOAD_H(cur.K, cur.V, 0); VMW(); SWRITE_HK(0);
    __syncthreads();
}
__device__ __forceinline__ void moba_block(const MobaRef& cur, const MobaRef& nxt, lptr lds, MobaSeam& S, int wave_s) {
    int tid = wave_s * 64 + lane_id(); asm volatile("" : "+v"(tid)); const int wid = __builtin_amdgcn_readfirstlane(tid >> 6), lane = tid & 63, r32 = lane & 31, hi = lane >> 5;
    const int qb = cur.qb, NT = 4 * (qb + 1);
    const int qlo = qb * QB + wid * QBLK, qm = qlo + r32 - 4 * hi;
    const unsigned sel = S.sel;
    lptr V_lds = lds; lptr K_lds = lds + 2 * SHM_V;
    LAS float* ws = (LAS float*)(lds + 2 * SHM_V + 2 * SHM_K) + wid * 64; LAS float* li_l = ws; LAS float* al_l = ws + 32;
    float m_reg = -1e30f, l_reg = 0; f32x16 o[4] = {};
    const int sr = tid >> 4, sc = (tid & 15) * 8, vst0 = v_st(sr, sc), vst1 = v_st(32 + sr, sc), kws = KSWZ(sr, sc * 2);
    const int vb0 = (int)(uintptr_t)V_lds + v_rd_base(lane);
    const bf16_t* Kh = cur.K; const bf16_t* Vh = cur.V;
    const float NEG = -__builtin_inff();
#define RESC(a) do { if (__any((a) < 1.f)) { if (hi == 0) al_l[r32] = (a); asm volatile("s_waitcnt lgkmcnt(0)" ::: "memory");              \
                     _Pragma("unroll") for (int d_ = 0; d_ < 4; ++d_) _Pragma("unroll") for (int r = 0; r < 16; ++r) o[d_][r] *= al_l[crow(r, hi)]; } } while (0)
#define KBASE(t) ((t) * KVBLK)
#define MASKT(P0_, P1_, t) do { const int kb_ = KBASE(t); const int jb_ = (t) >> 2;                                              \
        if (jb_ == qb) { if (kb_ + KVBLK - 1 > qlo) { const int dq_ = qm - kb_;                                                    \
            _Pragma("unroll") for (int r = 0; r < 16; ++r) { const int c_ = (r & 3) + 8 * (r >> 2);                                \
                if (dq_ - c_ < 0) P0_[r] = NEG; if (dq_ - c_ - 32 < 0) P1_[r] = NEG; } } }                                         \
        } while (0)
#define SELINIT(t) ((((t) >> 2) == qb || ((sel >> ((t) >> 2)) & 1u)) ? 0.f : NEG)
    constexpr int NQL = 9;
#define SEAM_K0() do { VMWN(NQL); SWRITE_HK(0); SBAR(); } while (0)
    f32x16 pA0, pA1, pB0, pB1; float mnA, mnB, alA, alB; bf16x8 pa0, pa1, pa2, pa3;
    SWRITE_HV(0); SBAR();
    SLOAD_H(Kh, Vh, KBASE(1));
    SBAR(); qkt<0>(pA0, pA1, K_lds, r32, hi, S.qr, SELINIT(0));
    MASKT(pA0, pA1, 0); partialSM(pA0, pA1, m_reg, mnA, alA);
    VMW(); SWRITE_H(1);
    __syncthreads();
#define HALF_STEP(PX0, PX1, mnX, alX, PY0, PY1, alY, t, KB, VB, SB) do {                                                      \
        SBAR(); qkt<KB>(PX0, PX1, K_lds, r32, hi, S.qr, SELINIT(t));                                                           \
        finishSM(PY0, PY1, alY, l_reg, pa0, pa1, pa2, pa3); SBAR();                                                           \
        if ((t) + 1 < NT) { SLOAD_H(Kh, Vh, KBASE((t) + 1)); SBAR(); }                                                        \
        pv_tile<VB * SHM_V>(o, vb0, pa0, pa1, pa2, pa3); MASKT(PX0, PX1, (t)); partialSM(PX0, PX1, m_reg, mnX, alX);          \
        __syncthreads();                                                                                                      \
        if ((t) + 1 < NT) { VMW(); SWRITE_H(SB); }                                                                            \
        RESC(alX); __syncthreads(); } while (0)
    for (int t = 1; t + 1 < NT; t += 2) {
        HALF_STEP(pB0, pB1, mnB, alB, pA0, pA1, alA, t, 1, 0, 0);
        HALF_STEP(pA0, pA1, mnA, alA, pB0, pB1, alB, t + 1, 0, 1, 1);
    }
    SBAR(); qkt<1>(pB0, pB1, K_lds, r32, hi, S.qr, SELINIT(NT - 1)); SBAR();
    SLOAD_H(nxt.K, nxt.V, 0); SBAR();
#pragma unroll
    for (int d0 = 0; d0 < 8; ++d0) S.qr[d0] = load8(nxt.Q + (size_t)(wid * QBLK + r32) * APITCH + d0 * 16 + hi * 8);
    S.sel = nxt.sel[wid * QBLK + r32];
    SBAR();
    finishSM(pA0, pA1, alA, l_reg, pa0, pa1, pa2, pa3); SBAR();
    pv_tile<0>(o, vb0, pa0, pa1, pa2, pa3);
    MASKT(pB0, pB1, NT - 1); partialSM(pB0, pB1, m_reg, mnB, alB); __syncthreads(); RESC(alB);
    finishSM(pB0, pB1, alB, l_reg, pa0, pa1, pa2, pa3); SBAR(); pv_tile<SHM_V>(o, vb0, pa0, pa1, pa2, pa3);
    SBAR(); SEAM_K0();
    if (hi == 0) li_l[r32] = l_reg; asm volatile("s_waitcnt lgkmcnt(0)" ::: "memory");
    float rli[16];
#pragma unroll
    for (int r = 0; r < 16; ++r) rli[r] = __builtin_amdgcn_rcpf(li_l[crow(r, hi)]);
    bf16_t* Ow = cur.O + (size_t)(wid * QBLK) * OPITCH;
#pragma unroll
    for (int r = 0; r < 16; ++r) { const int orow = crow(r, hi);
#pragma unroll
        for (int d0 = 0; d0 < 4; ++d0) { const float v = o[d0][r] * rli[r];
            const float vn = __shfl_xor(v, 1);
            if ((r32 & 1) == 0) *(unsigned*)(Ow + (size_t)orow * OPITCH + d0 * 32 + r32) = cvt_pk_bf16(v, vn); } }
    __syncthreads();
#undef RESC
#undef KBASE
#undef MASKT
#undef SELINIT
#undef SEAM_K0
#undef HALF_STEP
}

__device__ __forceinline__ MobaRef moba_ref(const Params& p, int bh, int qb) {
    const int b = bh / MH, h = bh % MH;
    const bf16_t* proj = (const bf16_t*)(p.ws + WS_PROJ); bf16_t* mixed = (bf16_t*)(p.ws + WS_MIXED); const unsigned* selp = (const unsigned*)(p.ws + WS_SEL);
    MobaRef r; const size_t tok0 = (size_t)b * SEQ;
    r.Q = proj + (tok0 + (size_t)qb * QB) * APITCH + C_MQ + h * HD; r.K = proj + tok0 * APITCH + C_MK + h * HD; r.V = proj + tok0 * APITCH + C_MV + h * HD;
    r.O = mixed + (tok0 + (size_t)qb * QB) * OPITCH + h * HD; r.sel = selp + (size_t)bh * SEQ + qb * QB; r.qb = qb; return r;
}
__device__ __forceinline__ void phase_moba(const Params& p, lptr lds, int wave_s) {
    const int G = gridDim.x; const int bx = blockIdx.x; const int vcu = (G % 8 == 0) ? (bx % 8) * (G / 8) + bx / 8 : bx;
    constexpr int NITEM = NBATCH * MH * 8;
    int L = vcu; if (L >= NITEM) return;
    int pass = 0;
    MobaRef cur = moba_ref(p, L >> 3, L & 7);
    MobaSeam S;
    moba_prime(cur, lds, S, wave_s);
    for (;;) {
        const bool more_pass = pass == 0, more_item = L + G < NITEM, last = !more_pass && !more_item;
        int Ln = L, passn = 1;
        if (!more_pass) { passn = 0; Ln = more_item ? L + G : L; }
        const MobaRef nxt = last ? cur : moba_ref(p, Ln >> 3, passn ? 15 - (Ln & 7) : (Ln & 7));
        moba_block(cur, nxt, lds, S, wave_s);
        if (last) break;
        cur = nxt; pass = passn; L = Ln;
    }
}
#undef SLOAD_H
#undef SWRITE_HK
#undef SWRITE_HV
#undef SWRITE_H
#undef VMWN
}
namespace att {
__device__ __forceinline__ void stage_vstyle(lptr dst, const bf16_t* src, size_t pitch, int tid) {
    const int sr = tid >> 4, sc = (tid & 15) * 8;
    const bf16x8 a = load8(src + (size_t)sr * pitch + sc), b = load8(src + (size_t)(32 + sr) * pitch + sc);
    *(LAS bf16x8*)(dst + v_st(sr, sc)) = a; *(LAS bf16x8*)(dst + v_st(32 + sr, sc)) = b;
}
__device__ __forceinline__ void stage_kstyle(lptr dst, const bf16_t* src, size_t pitch, int tid) {
    const int sr = tid >> 4, sc = (tid & 15) * 8;
    const bf16x8 a = load8(src + (size_t)sr * pitch + sc), b = load8(src + (size_t)(32 + sr) * pitch + sc);
    *(LAS bf16x8*)(dst + KSWZ(sr, sc * 2)) = a; *(LAS bf16x8*)(dst + KSWZ(sr, sc * 2) + 32 * 256) = b;
}

__device__ __forceinline__ void phase_moba_select(const Params& p, lptr lds, int tid_) { int tid = tid_; asm volatile("" : "+v"(tid));
    const bf16_t* proj = (const bf16_t*)(p.ws + WS_PROJ); const float* kmean = (const float*)(p.ws + WS_KMEAN); unsigned* selp = (unsigned*)(p.ws + WS_SEL);
    LAS float* gl = (LAS float*)lds;
    const int wave = __builtin_amdgcn_readfirstlane(tid >> 6), lane = tid & 63, row = lane & 15, kq = lane >> 4;
    for (int u = blockIdx.x; u < NBATCH * MH * NBLK; u += gridDim.x) {
        const int bh = u / NBLK, qb = u % NBLK, b = bh / MH, h = bh % MH;
        if (qb == 0) { if (tid < 256) selp[(size_t)bh * SEQ + tid] = 0u; continue; }
        const bf16_t* qsrc = proj + ((size_t)b * SEQ + qb * 256 + wave * 32) * NPROJ + C_MQ + h * HD;
        const float* km = kmean + (size_t)bh * NBLK * HD + (size_t)row * HD;
        bf16x8 a0[4], a1[4]; f32x4 k0[4], k1[4];
#pragma unroll
        for (int ks = 0; ks < 4; ++ks) { a0[ks] = load8(qsrc + (size_t)row * NPROJ + 32 * ks + 8 * kq); a1[ks] = load8(qsrc + (size_t)(16 + row) * NPROJ + 32 * ks + 8 * kq);
            k0[ks] = *(const f32x4*)(km + 32 * ks + 8 * kq); k1[ks] = *(const f32x4*)(km + 32 * ks + 8 * kq + 4); }
        f32x4 g0 = {0.f, 0.f, 0.f, 0.f}, g1 = {0.f, 0.f, 0.f, 0.f};
#pragma unroll
        for (int ks = 0; ks < 4; ++ks) {
            u32x4 bw; bw.x = cvt_pk_bf16(k0[ks][0], k0[ks][1]); bw.y = cvt_pk_bf16(k0[ks][2], k0[ks][3]); bw.z = cvt_pk_bf16(k1[ks][0], k1[ks][1]); bw.w = cvt_pk_bf16(k1[ks][2], k1[ks][3]);
            const f32x4 r0 = {k0[ks][0] - bflo(bw.x), k0[ks][1] - bfhi(bw.x), k0[ks][2] - bflo(bw.y), k0[ks][3] - bfhi(bw.y)}, r1 = {k1[ks][0] - bflo(bw.z), k1[ks][1] - bfhi(bw.z), k1[ks][2] - bflo(bw.w), k1[ks][3] - bfhi(bw.w)};
            const bf16x8 bh_ = __builtin_bit_cast(bf16x8, bw), bl_ = pack8(r0, r1);
            g0 = __builtin_amdgcn_mfma_f32_16x16x32_bf16(a0[ks], bh_, g0, 0, 0, 0); g0 = __builtin_amdgcn_mfma_f32_16x16x32_bf16(a0[ks], bl_, g0, 0, 0, 0);
            g1 = __builtin_amdgcn_mfma_f32_16x16x32_bf16(a1[ks], bh_, g1, 0, 0, 0); g1 = __builtin_amdgcn_mfma_f32_16x16x32_bf16(a1[ks], bl_, g1, 0, 0, 0); }
#pragma unroll
        for (int r = 0; r < 4; ++r) { gl[(wave * 32 + kq * 4 + r) * 16 + row] = g0[r]; gl[(wave * 32 + 16 + kq * 4 + r) * 16 + row] = g1[r]; }
        __syncthreads();
        if (tid < 256) {
            float gv[16];
#pragma unroll
            for (int n = 0; n < 16; ++n) gv[n] = (n < qb) ? gl[tid * 16 + n] : -__builtin_inff();
            unsigned m = 0u;
#pragma unroll
            for (int k = 0; k < 3; ++k) { float best = -__builtin_inff(); int bi = -1;
#pragma unroll
                for (int n = 0; n < 16; ++n) { const bool tk = gv[n] > best; best = tk ? gv[n] : best; bi = tk ? n : bi; }
                if (bi >= 0) m |= 1u << bi;
#pragma unroll
                for (int n = 0; n < 16; ++n) gv[n] = (n == bi) ? -__builtin_inff() : gv[n]; }
            selp[(size_t)bh * SEQ + qb * 256 + tid] = m;
        }
        __syncthreads();
    }
}

__device__ __forceinline__ void phase_gla_state(const Params& p, lptr lds, int tid_) { int tid = tid_; asm volatile("" : "+v"(tid));
    const bf16_t* proj = (const bf16_t*)(p.ws + WS_PROJ); const float* dend = (const float*)(p.ws + WS_DEND); float* U = (float*)(p.ws + WS_U);
    const int wid = __builtin_amdgcn_readfirstlane(tid >> 6), lane = tid & 63, r32 = lane & 31, hi = lane >> 5;
    const int dkb = wid & 3, half = wid >> 2;
    const int vb0 = (int)(uintptr_t)lds + v_rd_base(lane);
    for (int u = blockIdx.x; u < NBATCH * GH * NBLK; u += gridDim.x) {
        const int bh = u / NBLK, j = u % NBLK, b = bh / GH, h = bh % GH;
        const size_t tok0 = (size_t)b * SEQ + j * 256;
        f32x16 o[4] = {};
        for (int t = 0; t < 4; ++t) {
            __syncthreads();
            const bf16_t* rowp = proj + (tok0 + t * 64) * NPROJ;
            stage_vstyle(lds, rowp + C_GK + h * GDK, NPROJ, tid);
            stage_vstyle(lds + SHM_V, rowp + C_GV + h * GDV, NPROJ, tid);
            stage_vstyle(lds + 2 * SHM_V, rowp + C_GV + h * GDV + 128, NPROJ, tid);
            __syncthreads();
            bf16x8 a0, a1, a2, a3;
            if (dkb == 0) tr_frags<0, 0>(vb0, a0, a1, a2, a3); else if (dkb == 1) tr_frags<0, 1>(vb0, a0, a1, a2, a3); else if (dkb == 2) tr_frags<0, 2>(vb0, a0, a1, a2, a3); else tr_frags<0, 3>(vb0, a0, a1, a2, a3);
            if (half == 0) pv_tile<SHM_V>(o, vb0, a0, a1, a2, a3); else pv_tile<2 * SHM_V>(o, vb0, a0, a1, a2, a3);
        }
        float dv[16];
#pragma unroll
        for (int r = 0; r < 16; ++r) dv[r] = dend[(size_t)u * GDK + dkb * 32 + crow(r, hi)];
        float* Uo = U + (size_t)u * (GDK * GDV);
#pragma unroll
        for (int r = 0; r < 16; ++r) { const int k = dkb * 32 + crow(r, hi);
#pragma unroll
            for (int d0 = 0; d0 < 4; ++d0) Uo[(size_t)k * GDV + half * 128 + d0 * 32 + r32] = o[d0][r] * dv[r]; }
    }
    __syncthreads();
}

__device__ __forceinline__ void phase_gla_scan(const Params& p, int tid_) { int tid = tid_; asm volatile("" : "+v"(tid));
    const float* U = (const float*)(p.ws + WS_U); const float* dend = (const float*)(p.ws + WS_DEND); bf16_t* Sj = (bf16_t*)(p.ws + WS_SJ);
    constexpr int NEL = NBATCH * GH * GDK * GDV / 4;
    for (int i = blockIdx.x * NTHREADS + tid; i < NEL; i += gridDim.x * NTHREADS) {
        const int bh = i / (GDK * GDV / 4), e4 = i % (GDK * GDV / 4), k = e4 / (GDV / 4);
        f32x4 S = {0.f, 0.f, 0.f, 0.f};
        f32x4 uv[NBLK]; float dd[NBLK];
#pragma unroll
        for (int j = 0; j < NBLK; ++j) { uv[j] = *(const f32x4*)(U + ((size_t)(bh * NBLK + j) * (GDK * GDV)) + (size_t)e4 * 4); dd[j] = dend[(size_t)(bh * NBLK + j) * GDK + k]; }
#pragma unroll
        for (int j = 0; j < NBLK; ++j) {
            u32x2 w; w.x = cvt_pk_bf16(S[0], S[1]); w.y = cvt_pk_bf16(S[2], S[3]);
            *(u32x2*)(Sj + ((size_t)(bh * NBLK + j) * (GDK * GDV)) + (size_t)e4 * 4) = w;
            S = S * dd[j] + uv[j]; }
    }
}

__device__ __forceinline__ void phase_gla_out(const Params& p, lptr lds, int tid_) { int tid = tid_; asm volatile("" : "+v"(tid));
    const bf16_t* proj = (const bf16_t*)(p.ws + WS_PROJ); const bf16_t* Sj = (const bf16_t*)(p.ws + WS_SJ); bf16_t* mixed = (bf16_t*)(p.ws + WS_MIXED);
    const int wid = __builtin_amdgcn_readfirstlane(tid >> 6), lane = tid & 63, r32 = lane & 31, hi = lane >> 5;
    constexpr int BUF = 3 * SHM_V;
    const int vb0 = (int)(uintptr_t)lds + v_rd_base(lane), vb1 = vb0 + BUF;
    const int sr = tid >> 4, sc = (tid & 15) * 8;
    const int kws = KSWZ(sr, sc * 2), vst0 = v_st(sr, sc), vst1 = v_st(32 + sr, sc);
    for (int u = blockIdx.x; u < NBATCH * GH * NBLK; u += gridDim.x) {
        const int bh = u / NBLK, j = u % NBLK, b = bh / GH, h = bh % GH;
        const size_t tok0 = (size_t)b * SEQ + j * 256;
        bf16x8 qr[8];
#pragma unroll
        for (int d0 = 0; d0 < 8; ++d0) qr[d0] = load8(proj + (tok0 + wid * 32 + r32) * NPROJ + C_GQ + h * GDK + d0 * 16 + hi * 8);
        f32x16 o[8] = {};
        bf16x8 sk0, sk1, sa0, sa1, sb0, sb1;
        const bf16_t* sp = Sj + (size_t)u * (GDK * GDV);
#define GO_LOAD(s_) do { if ((s_) < 4) { const bf16_t* rp = proj + (tok0 + (s_) * 64) * NPROJ; \
            sk0 = load8(rp + (size_t)sr * NPROJ + C_GK + h * GDK + sc); sk1 = load8(rp + (size_t)(32 + sr) * NPROJ + C_GK + h * GDK + sc); \
            sa0 = load8(rp + (size_t)sr * NPROJ + C_GV + h * GDV + sc); sa1 = load8(rp + (size_t)(32 + sr) * NPROJ + C_GV + h * GDV + sc); \
            sb0 = load8(rp + (size_t)sr * NPROJ + C_GV + h * GDV + 128 + sc); sb1 = load8(rp + (size_t)(32 + sr) * NPROJ + C_GV + h * GDV + 128 + sc); } \
          else { const bf16_t* rp = sp + (size_t)((s_) - 4) * 64 * GDV; \
            sa0 = load8(rp + (size_t)sr * GDV + sc); sa1 = load8(rp + (size_t)(32 + sr) * GDV + sc); \
            sb0 = load8(rp + (size_t)sr * GDV + 128 + sc); sb1 = load8(rp + (size_t)(32 + sr) * GDV + 128 + sc); } } while (0)
#define GO_WRITE(s_, bufo) do { if ((s_) < 4) { *(LAS bf16x8*)(lds + (bufo) + kws) = sk0; *(LAS bf16x8*)(lds + (bufo) + kws + 32 * 256) = sk1; } \
            *(LAS bf16x8*)(lds + (bufo) + SHM_V + vst0) = sa0; *(LAS bf16x8*)(lds + (bufo) + SHM_V + vst1) = sa1; \
            *(LAS bf16x8*)(lds + (bufo) + 2 * SHM_V + vst0) = sb0; *(LAS bf16x8*)(lds + (bufo) + 2 * SHM_V + vst1) = sb1; } while (0)
#define GO_STEP(s_, B_) do { GO_LOAD(s_); __syncthreads(); GO_WRITE(s_, (B_) * BUF); __syncthreads(); \
            if ((s_) < 4) { if ((s_) * 64 <= wid * 32 + 31) { f32x16 p0, p1; qkt<0>(p0, p1, lds + (B_) * BUF, r32, hi, qr); \
                    const int dq = wid * 32 + r32 - 4 * hi - (s_) * 64; \
                    _Pragma("unroll") for (int r = 0; r < 16; ++r) { const int c_ = (r & 3) + 8 * (r >> 2); if (dq - c_ < 0) p0[r] = 0.f; if (dq - c_ - 32 < 0) p1[r] = 0.f; } \
                    bf16x8 pa0, pa1, pa2, pa3; pack_p(p0, p1, pa0, pa1, pa2, pa3); \
                    pv_tile<SHM_V>(o, (B_) ? vb1 : vb0, pa0, pa1, pa2, pa3); pv_tile<2 * SHM_V>(o + 4, (B_) ? vb1 : vb0, pa0, pa1, pa2, pa3); } } \
            else { pv_tile<SHM_V>(o, (B_) ? vb1 : vb0, qr[4 * ((s_) - 4)], qr[4 * ((s_) - 4) + 1], qr[4 * ((s_) - 4) + 2], qr[4 * ((s_) - 4) + 3]); \
                   pv_tile<2 * SHM_V>(o + 4, (B_) ? vb1 : vb0, qr[4 * ((s_) - 4)], qr[4 * ((s_) - 4) + 1], qr[4 * ((s_) - 4) + 2], qr[4 * ((s_) - 4) + 3]); } } while (0)
        GO_STEP(0, 0); GO_STEP(1, 0); GO_STEP(2, 0); GO_STEP(3, 0); GO_STEP(4, 0); GO_STEP(5, 0);
#undef GO_LOAD
#undef GO_WRITE
#undef GO_STEP
        int hi_e = hi, r32_e = r32; asm volatile("" : "+v"(hi_e), "+v"(r32_e));
        float wv[8];
#pragma unroll
        for (int d0 = 0; d0 < 8; ++d0) wv[d0] = p.gla_norm_w[d0 * 32 + r32_e];
        const bf16_t* ggp = proj + (tok0 + wid * 32) * NPROJ + C_GG + h * GDV + r32_e;
        bf16_t* op = mixed + (tok0 + wid * 32) * DM + 1024 + h * GDV + r32_e;
#pragma unroll
        for (int rb = 0; rb < 16; rb += 4) {
            bf16_t graw[4][8];
#pragma unroll
            for (int q = 0; q < 4; ++q)
#pragma unroll
                for (int d0 = 0; d0 < 8; ++d0) graw[q][d0] = ggp[(size_t)crow(rb + q, hi_e) * NPROJ + d0 * 32];
#pragma unroll
            for (int q = 0; q < 4; ++q) { const int r = rb + q, orow = crow(r, hi_e);
                float ss = 0.f;
#pragma unroll
                for (int d0 = 0; d0 < 8; ++d0) ss += o[d0][r] * o[d0][r];
                ss += __shfl_xor(ss, 1); ss += __shfl_xor(ss, 2); ss += __shfl_xor(ss, 4); ss += __shfl_xor(ss, 8); ss += __shfl_xor(ss, 16);
                const float rsr = 1.0f / sqrtf(ss * (1.0f / GDV) + EPS);
#pragma unroll
                for (int d0 = 0; d0 < 8; ++d0) { const float g = bf2f(graw[q][d0]); const float sg = g * __builtin_amdgcn_rcpf(1.0f + __expf(-g));
                    const float v = o[d0][r] * rsr * wv[d0] * sg; const float vn = __shfl_xor(v, 1);
                    if ((r32_e & 1) == 0) *(unsigned*)(op + (size_t)orow * DM + d0 * 32) = cvt_pk_bf16(v, vn); } }
            asm volatile("" ::: "memory"); }
    }
    __syncthreads();
}
}

__device__ __forceinline__ void phase_route(const Params& p, const Ctx& c0) { const Ctx c = fresh_ctx(c0);
    const int* hist = (const int*)(p.ws + WS_HIST); const int* topi = (const int*)(p.ws + WS_TOPI); const float* rstd2 = (const float*)(p.ws + WS_RSTD2);
    int* dest = (int*)(p.ws + WS_DEST); int* row_tok = (int*)(p.ws + WS_ROWTOK); float* row_rstd = (float*)(p.ws + WS_ROWRSTD); int* blk = (int*)(p.ws + WS_BLKE);
    LAS int* cnt = (LAS int*)c.lds; LAS int* before = cnt + 32; LAS int* pstart = cnt + 64; LAS int* ea = cnt + 128;
    for (int g = blockIdx.x; g < T / 64; g += gridDim.x) {
        if (c.tid < 64) cnt[c.tid] = 0;
        __syncthreads();
        { const int e = c.tid & 31, part = c.tid >> 5; int tot = 0, bef = 0;
#pragma unroll
            for (int i = 0; i < 16; ++i) { const int gg = part * 16 + i; const int v = hist[gg * 32 + e]; tot += v; bef += (gg < g) ? v : 0; }
            atomicAdd((int*)&cnt[e], tot); atomicAdd((int*)&before[e], bef); }
        __syncthreads();
        if (c.tid == 0) { int acc = 0; for (int e = 0; e < NE; ++e) { pstart[e] = acc; acc += ((cnt[e] + 255) >> 8) << 8; } pstart[NE] = acc; }
        if (c.tid < 256) ea[c.tid] = topi[(size_t)g * 256 + c.tid];
        __syncthreads();
        LAS int* wcnt = cnt + 512;
        int e_my = 0, rank = 0;
        if (c.tid < 256) { e_my = ea[c.tid];
            for (int k = 0; k < NE; ++k) { const unsigned long long mk = __ballot(e_my == k);
                if (e_my == k) rank = __popcll(mk & ((1ull << c.lane) - 1ull));
                if (c.lane == 0) wcnt[c.wave * 32 + k] = __popcll(mk); } }
        __syncthreads();
        if (c.tid < 256) {
            for (int w = 0; w < c.wave; ++w) rank += wcnt[w * 32 + e_my];
            const int d = pstart[e_my] + before[e_my] + rank; const int tok = g * 64 + (c.tid >> 2);
            dest[(size_t)g * 256 + c.tid] = d; row_tok[d] = tok; row_rstd[d] = rstd2[tok];
        }
        if (g == 0 && c.tid < 64) {
            const int nb = pstart[NE] >> 8; if (c.tid == 0) blk[0] = nb;
            for (int bq = c.tid; bq < nb; bq += 64) { int e = 0; for (int q = 0; q < NE; ++q) e += (pstart[q + 1] <= bq * 256) ? 1 : 0; blk[64 + bq] = e < NE ? e : NE - 1; }
        }
        __syncthreads();
    }
}

__device__ __forceinline__ void phase_combine(const Params& p, const Ctx& c0) { const Ctx c = fresh_ctx(c0);
    const float* X1 = (const float*)(p.ws + WS_X1); const unsigned char* Y = (const unsigned char*)(p.ws + WS_Y); const int* dest = (const int*)(p.ws + WS_DEST); const float* topg = (const float*)(p.ws + WS_TOPG);
    for (int t = blockIdx.x * NWAVES + c.wave; t < T; t += gridDim.x * NWAVES) {
        const int4 d4 = *(const int4*)(dest + (size_t)t * 4); const float4 g4 = *(const float4*)(topg + (size_t)t * 4);
        const int dd[4] = {d4.x, d4.y, d4.z, d4.w}; const float gg[4] = {g4.x * (1.0f / Y_SCALE), g4.y * (1.0f / Y_SCALE), g4.z * (1.0f / Y_SCALE), g4.w * (1.0f / Y_SCALE)};
        f32x4 v[8]; u32x2 yw[4][4]; float ss = 0.f;
#pragma unroll
        for (int j = 0; j < 4; ++j) { v[2 * j] = *(const f32x4*)(X1 + (size_t)t * DM + j * 512 + c.lane * 8); v[2 * j + 1] = *(const f32x4*)(X1 + (size_t)t * DM + j * 512 + c.lane * 8 + 4); }
#pragma unroll
        for (int k = 0; k < 4; ++k)
#pragma unroll
            for (int j = 0; j < 4; ++j) yw[k][j] = *(const u32x2*)(Y + (size_t)dd[k] * DM + j * 512 + c.lane * 8);
#pragma unroll
        for (int k = 0; k < 4; ++k)
#pragma unroll
            for (int j = 0; j < 4; ++j) { const f32x2 a = __builtin_amdgcn_cvt_pk_f32_fp8(yw[k][j].x, false), b = __builtin_amdgcn_cvt_pk_f32_fp8(yw[k][j].x, true);
                const f32x2 cc = __builtin_amdgcn_cvt_pk_f32_fp8(yw[k][j].y, false), d = __builtin_amdgcn_cvt_pk_f32_fp8(yw[k][j].y, true);
                v[2 * j][0] += gg[k] * a[0]; v[2 * j][1] += gg[k] * a[1]; v[2 * j][2] += gg[k] * b[0]; v[2 * j][3] += gg[k] * b[1];
                v[2 * j + 1][0] += gg[k] * cc[0]; v[2 * j + 1][1] += gg[k] * cc[1]; v[2 * j + 1][2] += gg[k] * d[0]; v[2 * j + 1][3] += gg[k] * d[1]; }
#pragma unroll
        for (int j = 0; j < 8; ++j) ss += (v[j][0] * v[j][0] + v[j][1] * v[j][1]) + (v[j][2] * v[j][2] + v[j][3] * v[j][3]);
        const float rs = 1.0f / sqrtf(wave_sum(ss) * (1.0f / DM) + EPS);
#pragma unroll
        for (int j = 0; j < 8; ++j) { const int col = (j >> 1) * 512 + c.lane * 8 + (j & 1) * 4; const f32x4 w = *(const f32x4*)(p.final_norm_w + col);
            *(f32x4*)(p.out + (size_t)t * DM + col) = v[j] * rs * w; }
    }
}
__device__ __forceinline__ Ctx make_ctx(unsigned char* lds_generic) {
    Ctx c; c.lds = (LAS unsigned char*)lds_generic; c.tid = threadIdx.x; c.lane = c.tid & 63; c.wave = __builtin_amdgcn_readfirstlane(c.tid >> 6); return c;
}
__device__ __forceinline__ void phase_gemm_inproj16(const Params& p, const Ctx& c, int i0, int i1, int G, int cidx) {
    if (i0 >= i1) return;
    g8::DenseProbIn P{(const bf16_t*)(p.ws + WS_H), (const bf16_t*)(p.ws + WS_WIN), T / 256, NPROJ / 256, DM, G, cidx, i0, i1};
    g8::EpiProj E{(bf16_t*)(p.ws + WS_PROJ), (const float*)(p.ws + WS_RSTD1), 1.0f, 0};
    g8::gemm_phase(c.lds, P, E, c.wave);
}
__device__ __forceinline__ void phase_gemm_outproj(const Params& p, const Ctx& c, int i0, int i1) {
    if (i0 >= i1) return;
    g8::DenseProbOut P{(const bf16_t*)(p.ws + WS_MIXED), (const bf16_t*)(p.ws + WS_WOUT), T / 256, DM / 256, DM, (int)gridDim.x, (int)blockIdx.x, i0, i1};
    g8::EpiX1 E{p.x, (float*)(p.ws + WS_X1)};
    g8::gemm_phase(c.lds, P, E, c.wave);
}
__device__ __forceinline__ void phase_gemm_moe1(const Params& p, const Ctx& c, int i0, int i1) {
    g8::MoeProb1 P{(const bf16_t*)(p.ws + WS_H), (const bf16_t*)(p.ws + WS_WGU), (const int*)(p.ws + WS_ROWTOK), (const int*)(p.ws + WS_BLKE), DM / 2, __builtin_amdgcn_readfirstlane(*(const int*)(p.ws + WS_BLKE)), i0, i1};
    g8::EpiSwiglu E{(unsigned char*)(p.ws + WS_ACT), (const float*)(p.ws + WS_ROWRSTD), p.b_gu};
    g8::gemm_phase(c.lds, P, E, c.wave);
}
__device__ __forceinline__ void phase_gemm_moe2(const Params& p, const Ctx& c) {
    g8::MoeProb2 P{(const bf16_t*)(p.ws + WS_ACT), (const bf16_t*)(p.ws + WS_WD), (const int*)(p.ws + WS_BLKE), FF / 2, __builtin_amdgcn_readfirstlane(*(const int*)(p.ws + WS_BLKE))};
    g8::EpiDown E{(unsigned char*)(p.ws + WS_Y), p.b_d};
    g8::gemm_phase(c.lds, P, E, c.wave);
}


constexpr int CW_BAR = 4096;
__global__ void __launch_bounds__(NTHREADS, 2) fwd(Params p) {
    extern __shared__ __attribute__((aligned(16))) unsigned char lds_raw[];
    const Ctx c = make_ctx(lds_raw);
    if (c.tid < 64) ((LAS unsigned*)(c.lds + LDS_MISC))[c.tid] = 0u;
    __syncthreads();
    const XcdBarrier bar = xcd_barrier_post((unsigned*)(p.ws + WS_CTL) + CW_BAR, (volatile LAS unsigned*)(c.lds + LDS_MISC + 32));
    const att::lptr al = (att::lptr)c.lds;
#ifndef PREFIX_K
#define PREFIX_K 0
#endif
#define PIPE(KMAX) do { \
    if ((KMAX) >= 1) { \
    phase_convert(p, c); phase_norm1(p, c); \
      if ((KMAX) > 1 || (KMAX) < 12) xcd_barrier(bar); } \
    if ((KMAX) >= 2) { \
    { \
        const int bx = blockIdx.x, G = gridDim.x; \
        const int cut = (G == 256) ? (bx >> 3) % 7 : 0; \
        if (cut > 0) phase_gemm_inproj16(p, c, 0, cut, G, bx); \
        phase_convert_share(p, c, 0, CT_GU, G, bx); \
        phase_gemm_inproj16(p, c, cut, 1 << 20, G, bx); \
    } \
      if ((KMAX) > 2 || (KMAX) < 12) xcd_barrier(bar); } \
    if ((KMAX) >= 3) { \
    phase_rope_kmean(p, c); phase_gla_prep(p, c); \
      if ((KMAX) > 3 || (KMAX) < 12) xcd_barrier(bar); } \
    if ((KMAX) >= 4) { \
    att::phase_gla_state(p, al, c.wave * 64 + lane_id()); att::phase_moba_select(p, al, c.wave * 64 + lane_id()); \
      if ((KMAX) > 4 || (KMAX) < 12) xcd_barrier(bar); } \
    if ((KMAX) >= 5) { \
    att::phase_gla_scan(p, c.wave * 64 + lane_id()); \
      if ((KMAX) > 5 || (KMAX) < 12) xcd_barrier(bar); } \
    if ((KMAX) >= 6) { \
    att::phase_gla_out(p, al, c.wave * 64 + lane_id()); att::phase_moba(p, al, c.wave); \
      if ((KMAX) > 6 || (KMAX) < 12) xcd_barrier(bar); } \
    if ((KMAX) >= 7) { \
    phase_gemm_outproj(p, c, 0, 1 << 20); \
      if ((KMAX) > 7 || (KMAX) < 12) xcd_barrier(bar); } \
    if ((KMAX) >= 8) { \
    phase_norm2_router(p, c); \
      if ((KMAX) > 8 || (KMAX) < 12) xcd_barrier(bar); } \
    if ((KMAX) >= 9) { \
    phase_route(p, c); \
      if ((KMAX) > 9 || (KMAX) < 12) xcd_barrier(bar); } \
    if ((KMAX) >= 10) { \
    { \
        const int cut = 2 * ((blockIdx.x >> 3) & 7); \
        if (cut > 0) phase_gemm_moe1(p, c, 0, cut); \
        phase_convert_share(p, c, CT_GU, CT_TOTAL, (int)gridDim.x, (int)blockIdx.x); \
        phase_gemm_moe1(p, c, cut, 1 << 20); \
    } \
      if ((KMAX) > 10 || (KMAX) < 12) xcd_barrier(bar); } \
    if ((KMAX) >= 11) { \
    phase_gemm_moe2(p, c); \
      if ((KMAX) > 11 || (KMAX) < 12) xcd_barrier(bar); } \
    if ((KMAX) >= 12) { \
    phase_combine(p, c); \
      if ((KMAX) > 12 || (KMAX) < 12) xcd_barrier(bar); } \
    } while (0)
    if (PREFIX_K > 0) PIPE(PREFIX_K);
#ifndef PSET
#define PSET 0
#endif
#ifndef PSUB
#define PSUB 0xffff
#endif
    if (PSET) {
        if (PSET & 1) { phase_convert(p, c); phase_norm1(p, c); xcd_barrier(bar); }
        if (PSET & 2) { const int bx = blockIdx.x, G = gridDim.x;
            if (PSUB & 1) phase_gemm_inproj16(p, c, 0, 1 << 20, G, bx);
            if ((PSUB & 2) && (!(PSUB & 4) || ((bx >> 3) & 7) == 0)) phase_convert_share(p, c, 0, CT_GU, G, bx);
            xcd_barrier(bar); }
        if (PSET & 4) { if (PSUB & 1) phase_rope_kmean(p, c); if (PSUB & 2) phase_gla_prep(p, c); xcd_barrier(bar); }
        if (PSET & 8) { if (PSUB & 1) att::phase_gla_state(p, al, c.wave * 64 + lane_id()); if (PSUB & 2) att::phase_moba_select(p, al, c.wave * 64 + lane_id()); xcd_barrier(bar); }
        if (PSET & 16) { att::phase_gla_scan(p, c.wave * 64 + lane_id()); xcd_barrier(bar); }
        if (PSET & 32) { if (PSUB & 1) att::phase_gla_out(p, al, c.wave * 64 + lane_id()); if (PSUB & 2) att::phase_moba(p, al, c.wave); xcd_barrier(bar); }
        if (PSET & 64) { phase_gemm_outproj(p, c, 0, 1 << 20); xcd_barrier(bar); }
        if (PSET & 128) { phase_norm2_router(p, c); xcd_barrier(bar); }
        if (PSET & 256) { phase_route(p, c); xcd_barrier(bar); }
        if (PSET & 512) { if (PSUB & 1) phase_gemm_moe1(p, c, 0, 1 << 20); if (PSUB & 2) phase_convert_share(p, c, CT_GU, CT_TOTAL, (int)gridDim.x, (int)blockIdx.x); xcd_barrier(bar); }
        if (PSET & 1024) { phase_gemm_moe2(p, c); xcd_barrier(bar); }
        if (PSET & 2048) { phase_combine(p, c); xcd_barrier(bar); }
    }
    PIPE(12);
#undef PIPE
}

extern "C" void kernel_launch(void* const* d_in, const int* in_sizes, int n_in, void* d_out, int out_size, void* d_ws, size_t ws_size, hipStream_t stream) {
    static int grid = 0;
    if (grid == 0) {
        if (n_in != 15 || ws_size < WS_END) { fprintf(stderr, "kernel_launch: unexpected inputs (n_in %d, ws %zu)\n", n_in, ws_size); grid = -1; return; }
        int dev = 0, cus = 0, per_cu = 0;
        if (hipGetDevice(&dev) != hipSuccess || hipDeviceGetAttribute(&cus, hipDeviceAttributeMultiprocessorCount, dev) != hipSuccess) { grid = -1; return; }
        if (hipFuncSetAttribute((const void*)fwd, hipFuncAttributeMaxDynamicSharedMemorySize, LDS_BYTES) != hipSuccess) { fprintf(stderr, "kernel_launch: hipFuncSetAttribute failed\n"); grid = -1; return; }
        if (hipOccupancyMaxActiveBlocksPerMultiprocessor(&per_cu, (const void*)fwd, NTHREADS, LDS_BYTES) != hipSuccess || per_cu < 1) { fprintf(stderr, "kernel_launch: occupancy query says %d blocks per CU\n", per_cu); }
        (void)hipGetLastError();
        grid = cus > 0 ? cus : 256;
    }
    if (grid < 0) return;
    Params p{};
    p.x = (const float*)d_in[0]; p.attn_norm_w = (const float*)d_in[1]; p.w_in = (const float*)d_in[2]; p.gate_w2 = (const float*)d_in[3]; p.gate_b = (const float*)d_in[4];
    p.gla_norm_w = (const float*)d_in[5]; p.w_out = (const float*)d_in[6]; p.ffn_norm_w = (const float*)d_in[7]; p.router_w = (const float*)d_in[8]; p.router_b = (const float*)d_in[9];
    p.w_gu = (const float*)d_in[10]; p.b_gu = (const float*)d_in[11]; p.w_d = (const float*)d_in[12]; p.b_d = (const float*)d_in[13]; p.final_norm_w = (const float*)d_in[14];
    p.out = (float*)d_out; p.ws = (unsigned char*)d_ws;
    if (hipMemsetAsync((char*)d_ws + WS_CTL, 0, CTL_BYTES, stream) != hipSuccess) return;
    hipLaunchKernelGGL(fwd, dim3(grid), dim3(NTHREADS), LDS_BYTES, stream, p);
}
```

```cpp
#include <hip/hip_runtime.h>
#include <stdint.h>
#include <stdio.h>

#define LAS __attribute__((address_space(3)))
typedef unsigned short bf16_t;
typedef short bf16x8 __attribute__((ext_vector_type(8)));
typedef short s16x4 __attribute__((ext_vector_type(4)));
typedef float f32x2 __attribute__((ext_vector_type(2)));
typedef float f32x4 __attribute__((ext_vector_type(4)));
typedef float f32x16 __attribute__((ext_vector_type(16)));
typedef unsigned u32x2 __attribute__((ext_vector_type(2)));
typedef unsigned u32x4 __attribute__((ext_vector_type(4)));
typedef int i32x8 __attribute__((ext_vector_type(8)));

constexpr int NBATCH = 4, SEQ = 4096, T = NBATCH * SEQ, DM = 2048;
constexpr int HD = 128, MH = 8, MBLK = 256, NBLK = SEQ / MBLK;
constexpr int GH = 4, GDK = 128, GDV = 256;
constexpr int LDW_IN = 6160, NPROJ = 6144;
constexpr int C_MQ = 0, C_MK = 1024, C_MV = 2048, C_GQ = 3072, C_GK = 3584, C_GV = 4096, C_GG = 5120, C_GZ = 6144;
constexpr int NE = 32, TOPK = 4, FF = 2048, NASSIGN = T * TOPK;
constexpr int MAXBLK = (NASSIGN + NE * 255) / 256, PROWS = MAXBLK * 256;
constexpr float EPS = 1e-5f;
constexpr float ACT_SCALE = 4.0f, W_SCALE = 64.0f, F8_UNSCALE = 1.0f / (ACT_SCALE * W_SCALE);
constexpr float Y_SCALE = 16.0f;

constexpr size_t MiB = (size_t)1 << 20;
constexpr size_t WS_CTL = 0, CTL_BYTES = 64 * 1024;
constexpr size_t WS_WIN = 16 * MiB;
constexpr size_t WS_WOUT = 40 * MiB;
constexpr size_t WS_ROPE = 48 * MiB;
constexpr size_t WS_RSTD1 = 50 * MiB;
constexpr size_t WS_GZ = 51 * MiB;
constexpr size_t WS_KMEAN = 52 * MiB;
constexpr size_t WS_DEND = 52 * MiB + 512 * 1024;
constexpr size_t WS_RSTD2 = 53 * MiB;
constexpr size_t WS_SEL = 54 * MiB;
constexpr size_t WS_TOPI = 55 * MiB;
constexpr size_t WS_TOPG = 55 * MiB + 512 * 1024;
constexpr size_t WS_HIST = 56 * MiB;
constexpr size_t WS_DEST = 56 * MiB + 512 * 1024;
constexpr size_t WS_ROWTOK = 57 * MiB;
constexpr size_t WS_ROWRSTD = 57 * MiB + 512 * 1024;
constexpr size_t WS_BLKE = 58 * MiB;
constexpr size_t WS_H = 64 * MiB;
constexpr size_t WS_PROJ = 128 * MiB;
constexpr size_t WS_MIXED = 320 * MiB;
constexpr size_t WS_X1 = 384 * MiB;
constexpr size_t WS_U = 512 * MiB;
constexpr size_t WS_SJ = 544 * MiB;
constexpr size_t WS_WGU = 640 * MiB;
constexpr size_t WS_WD = 1152 * MiB;
constexpr size_t WS_ACT = 1408 * MiB;
constexpr size_t WS_Y = 1696 * MiB;
constexpr size_t WS_END = 1984 * MiB;

constexpr int NTHREADS = 512, NWAVES = 8;
constexpr int LDS_BYTES = 149504;
constexpr int LDS_MISC = LDS_BYTES - 256;

struct Params {
    const float* x; const float* attn_norm_w; const float* w_in; const float* gate_w2; const float* gate_b; const float* gla_norm_w;
    const float* w_out; const float* ffn_norm_w; const float* router_w; const float* router_b; const float* w_gu; const float* b_gu;
    const float* w_d; const float* b_d; const float* final_norm_w;
    float* out; unsigned char* ws;
};

__device__ __forceinline__ unsigned cvt_pk_bf16(float lo, float hi) { unsigned r; asm volatile("v_cvt_pk_bf16_f32 %0, %1, %2" : "=v"(r) : "v"(lo), "v"(hi)); return r; }
__device__ __forceinline__ unsigned cvt4_fp8(float a, float b, float c, float d) { unsigned w = 0u; w = __builtin_amdgcn_cvt_pk_fp8_f32(a, b, w, false); w = __builtin_amdgcn_cvt_pk_fp8_f32(c, d, w, true); return w; }
__device__ __forceinline__ float bf2f(unsigned short b) { return __uint_as_float(((unsigned)b) << 16); }
__device__ __forceinline__ float bflo(unsigned w) { return __uint_as_float(w << 16); }
__device__ __forceinline__ float bfhi(unsigned w) { return __uint_as_float(w & 0xffff0000u); }
__device__ __forceinline__ bf16x8 pack8(f32x4 a, f32x4 b) {
    u32x4 w = {cvt_pk_bf16(a[0], a[1]), cvt_pk_bf16(a[2], a[3]), cvt_pk_bf16(b[0], b[1]), cvt_pk_bf16(b[2], b[3])};
    return __builtin_bit_cast(bf16x8, w);
}
__device__ __forceinline__ float wave_sum(float v) {
#pragma unroll
    for (int o = 1; o < 64; o <<= 1) v += __shfl_xor(v, o);
    return v;
}
__device__ __forceinline__ int lane_id() { return (int)__builtin_amdgcn_mbcnt_hi(~0u, __builtin_amdgcn_mbcnt_lo(~0u, 0u)); }
#define LDS_WAIT() asm volatile("s_waitcnt lgkmcnt(0)" ::: "memory")
#define VM_WAIT() asm volatile("s_waitcnt vmcnt(0)" ::: "memory")
#define SBAR() __builtin_amdgcn_sched_barrier(0)
#define XB_TMO      128
#define XB_XCNT(j)  (256  + 64 * (j))
#define XB_XSUB(j)  (1280 + 64 * (j))
#define XB_XGEN(j)  (2304 + 64 * (j))
#define XB_TOP      3328
#define XB_TOPGEN   3392
#define XCD_BAR_WORDS 3456
#define XB_SPIN_CAP (1u << 18)

__device__ __forceinline__ unsigned xb_ld(unsigned* p)              { return __hip_atomic_load(p, __ATOMIC_RELAXED, __HIP_MEMORY_SCOPE_AGENT); }
__device__ __forceinline__ unsigned xb_add(unsigned* p, unsigned v) { return __hip_atomic_fetch_add(p, v, __ATOMIC_RELAXED, __HIP_MEMORY_SCOPE_AGENT); }
__device__ __forceinline__ unsigned xb_xcc_id() { return (unsigned)__builtin_amdgcn_s_getreg((3 << 11) | 20) & 0xFu; }
#define XB_SPIN(cond, bar) do { unsigned _sp = 0; while (cond) { __builtin_amdgcn_s_sleep(1); \
    if ((++_sp & 255u) == 0u) { if (xb_ld(&(bar)[XB_TMO])) break; if (_sp > XB_SPIN_CAP) { atomicAdd(&(bar)[XB_TMO], 1u); break; } } } } while (0)

struct XcdBarrier {
    unsigned* bar; unsigned x; bool t0;
    volatile LAS unsigned* st;
};

__device__ __forceinline__ XcdBarrier xcd_barrier_post(unsigned* bar, volatile LAS unsigned* st) {
    XcdBarrier b; b.bar = bar; b.x = xb_xcc_id(); b.st = st; b.t0 = (threadIdx.x == 0);
    if (b.t0) (void)xb_add(&bar[XB_XCNT(b.x)], 1u);
    return b;
}
__device__ __forceinline__ void xcd_barrier_complete(unsigned* bar, unsigned x, unsigned& nloc, unsigned& nx) {
    const unsigned G = gridDim.x * gridDim.y * gridDim.z;
    unsigned sum, cnt, mine, sp = 0u;
    for (;;) {
        sum = 0u; cnt = 0u; mine = 0u;
#pragma unroll
        for (unsigned j = 0; j < 16; ++j) { const unsigned c = xb_ld(&bar[XB_XCNT(j)]); sum += c; cnt += (c > 0u) ? 1u : 0u; mine = (j == x) ? c : mine; }
        if (sum == G) break;
        __builtin_amdgcn_s_sleep(1);
        if ((++sp & 255u) == 0u) { if (xb_ld(&bar[XB_TMO])) break; if (sp > XB_SPIN_CAP) { atomicAdd(&bar[XB_TMO], 1u); break; } }
    }
    nloc = mine > 0u ? mine : 1u; nx = cnt > 0u ? cnt : 1u;
}

__device__ __forceinline__ void xcd_barrier(const XcdBarrier& b) {
    asm volatile("s_waitcnt vmcnt(0)" ::: "memory");
    __syncthreads();
    if (b.t0) {
        unsigned* bar = b.bar;
        __builtin_amdgcn_s_waitcnt(0);
        unsigned nloc = b.st[0], nx = b.st[1];
        if (nloc == 0u) { xcd_barrier_complete(bar, b.x, nloc, nx); b.st[0] = nloc; b.st[1] = nx; }
        const unsigned old = xb_add(&bar[XB_XSUB(b.x)], 1u);
        const unsigned gen = old / nloc;
        if (old + 1u == (gen + 1u) * nloc) {
            __builtin_amdgcn_fence(__ATOMIC_RELEASE, "agent");
            asm volatile("s_waitcnt vmcnt(0)" ::: "memory");
            const unsigned og = xb_add(&bar[XB_TOP], 1u);
            const unsigned tg = og / nx;
            if (og + 1u == (tg + 1u) * nx) xb_add(&bar[XB_TOPGEN], 1u);
            else XB_SPIN(xb_ld(&bar[XB_TOPGEN]) == tg, bar);
            __builtin_amdgcn_fence(__ATOMIC_ACQUIRE, "agent");
            xb_add(&bar[XB_XGEN(b.x)], 1u);
            asm volatile("s_waitcnt vmcnt(0)" ::: "memory");
        } else {
            XB_SPIN(xb_ld(&bar[XB_XGEN(b.x)]) == gen, bar);
            __builtin_amdgcn_fence(__ATOMIC_ACQUIRE, "agent");
            asm volatile("s_waitcnt vmcnt(0)" ::: "memory");
        }
    }
    __syncthreads();
}

namespace g8 {
constexpr int BM = 256, BK = 64, HALF = 128, HTB = HALF * BK * 2, STAGE_BYTES = 8 * HTB, NXCD = 8, WGM = 8;
__host__ __device__ __forceinline__ int lds_byte(int r, int c) { const int st = (r >> 4) * 2 + (c >> 5), rr = r & 15, cc = c & 31, ob = rr * 64 + cc * 2; return st * 1024 + (ob ^ (((ob >> 9) & 1) << 5)); }
__host__ __device__ __forceinline__ void stage_rc(int b, int& R, int& C) { const int st = b / 1024, sb = b % 1024, swz = sb ^ (((sb >> 9) & 1) << 5); R = (st >> 1) * 16 + swz / 64; C = (st & 1) * 32 + (swz % 64) / 2; }
__host__ __device__ __forceinline__ int perm32(int rho) { const int n = rho >> 4, i = rho & 15; return 8 * (i >> 2) + 4 * n + (i & 3); }

struct Unit { int pm, pn, e; };

template <int WGM_>
__device__ __forceinline__ bool static_next(int i, int nM, int nN, int G, int c, Unit& u) {
    const int nwg = nM * nN; const long L = (long)i * G + c; if (L >= nwg) return false;
    int wgid = (int)L; { const int q = nwg / NXCD, r = nwg % NXCD, xcd = wgid % NXCD, off = wgid / NXCD; wgid = (xcd < r ? xcd * (q + 1) : r * (q + 1) + (xcd - r) * q) + off; }
    const int nig = WGM_ * nN, gid = wgid / nig, fm = gid * WGM_, gsz = (nM - fm) < WGM_ ? (nM - fm) : WGM_;
    u.pm = fm + ((wgid % nig) % gsz); u.pn = (wgid % nig) / gsz; u.e = 0; return true;
}

template <class Prob, class Epi>
__device__ __forceinline__ void gemm_phase(LAS unsigned char* lds, const Prob& P, const Epi& E, int wave_s  ) {
    int tid = wave_s * 64 + lane_id(); asm volatile("" : "+v"(tid));
    const int wid = __builtin_amdgcn_readfirstlane(tid >> 6), lane = tid & 63, wr = wid >> 2, wc = wid & 3, fr = lane & 15, fq = lane >> 4;
    const int K = P.K, nt = K / BK;
    int RA[2], CA[2]; unsigned voffB[2];
#pragma unroll
    for (int i = 0; i < 2; ++i) { int R, C; stage_rc(tid * 16 + i * 8192, R, C); const int Rb = Epi::PERM ? ((R & ~31) + perm32(R & 31)) : R;
        RA[i] = R; CA[i] = C; voffB[i] = (unsigned)(Rb * K + C) * 2u; }
    const size_t kstep = (size_t)(BK * 2);
    const size_t hstep = (size_t)HALF * K * 2;
    const unsigned ldsw = (unsigned)wid * 1024u;
    const int aoff = lds_byte(wr * 64 + fr, fq * 8), boff = lds_byte(wc * 32 + fr, fq * 8);
#define G8_SA(b, h) (((b) * 2 + (h)) * HTB)
#define G8_SB(b, h) ((4 + (b) * 2 + (h)) * HTB)
#define G8_STAGE_B(bufoff, gbase) do { _Pragma("unroll") for (int _i = 0; _i < 2; ++_i) \
        __builtin_amdgcn_global_load_lds((const unsigned*)((const char*)(gbase) + voffB[_i]), (LAS unsigned*)(lds + (bufoff) + ldsw + _i * 8192), 16, 0, 0); } while (0)
#define G8_STAGE_A(bufoff, o0, o1) do { \
        __builtin_amdgcn_global_load_lds((const unsigned*)(Ab + (o0)), (LAS unsigned*)(lds + (bufoff) + ldsw), 16, 0, 0); \
        __builtin_amdgcn_global_load_lds((const unsigned*)(Ab + (o1)), (LAS unsigned*)(lds + (bufoff) + ldsw + 8192), 16, 0, 0); } while (0)
#define G8_CAT(lo, hi) __builtin_bit_cast(i32x8, __builtin_shufflevector(lo, hi, 0, 1, 2, 3, 4, 5, 6, 7))
#define G8_LO(v) __builtin_bit_cast(bf16x8, __builtin_shufflevector(v, v, 0, 1, 2, 3))
#define G8_HI(v) __builtin_bit_cast(bf16x8, __builtin_shufflevector(v, v, 4, 5, 6, 7))
#define G8_LDA(dst, b, h) do { _Pragma("unroll") for (int m = 0; m < 4; ++m) { const u32x4 _l = *(const LAS u32x4*)(lds + G8_SA(b, h) + aoff + m * 2048), _h = *(const LAS u32x4*)(lds + G8_SA(b, h) + aoff + m * 2048 + 1024); dst[m] = G8_CAT(_l, _h); } } while (0)
#define G8_LDB(dst, b, h) do { _Pragma("unroll") for (int n = 0; n < 2; ++n) { const u32x4 _l = *(const LAS u32x4*)(lds + G8_SB(b, h) + boff + n * 2048), _h = *(const LAS u32x4*)(lds + G8_SB(b, h) + boff + n * 2048 + 1024); dst[n] = G8_CAT(_l, _h); } } while (0)
#define G8_MMA(ai, bj, At, Bt) do { __builtin_amdgcn_s_setprio(1); \
        if constexpr (Prob::FP8) { _Pragma("unroll") for (int m = 0; m < 4; ++m) _Pragma("unroll") for (int n = 0; n < 2; ++n) \
            asm volatile("v_mfma_scale_f32_16x16x128_f8f6f4 %0, %1, %2, %0, %3, %3 op_sel_hi:[0,0,0]" : "+v"(acc[ai][bj][m][n]) : "v"(Bt[n]), "v"(At[m]), "v"(f8scale)); } \
        else { _Pragma("unroll") for (int m = 0; m < 4; ++m) _Pragma("unroll") for (int n = 0; n < 2; ++n) { \
            acc[ai][bj][m][n] = __builtin_amdgcn_mfma_f32_16x16x32_bf16(G8_LO(Bt[n]), G8_LO(At[m]), acc[ai][bj][m][n], 0, 0, 0); \
            acc[ai][bj][m][n] = __builtin_amdgcn_mfma_f32_16x16x32_bf16(G8_HI(Bt[n]), G8_HI(At[m]), acc[ai][bj][m][n], 0, 0, 0); } } \
        __builtin_amdgcn_s_setprio(0); } while (0)
#define G8_WAIT_V(n) asm volatile("s_waitcnt vmcnt(" #n ")" ::: "memory")
#define G8_WAIT_L(n) asm volatile("s_waitcnt lgkmcnt(" #n ")" ::: "memory")
#define G8_BAR __builtin_amdgcn_s_barrier()
#define G8_SCHED __builtin_amdgcn_sched_barrier(0)
    Unit cur, nxt, nn; int ui = 0;
    if (!P.next(0, cur)) return;
    const int f8scale = 0x7f7f7f7f;
    f32x4 acc[2][2][4][2];
#pragma unroll
    for (int a = 0; a < 2; ++a)
#pragma unroll
        for (int b = 0; b < 2; ++b)
#pragma unroll
            for (int m = 0; m < 4; ++m)
#pragma unroll
                for (int n = 0; n < 2; ++n) acc[a][b][m][n] = (f32x4){0.f, 0.f, 0.f, 0.f};
    i32x8 At[4], B0[2], B1[2];
    const char* Ab = (const char*)P.a_base();
    unsigned aoc[2][2], aon[2][2]; int raw[2][2];
    P.a_fetch(cur, RA, raw); P.a_finish(raw, CA, aoc);
    bool has_next = P.next(1, nxt);
    if (has_next) { P.a_fetch(nxt, RA, raw); P.a_finish(raw, CA, aon); }
    else { aon[0][0] = aoc[0][0]; aon[0][1] = aoc[0][1]; aon[1][0] = aoc[1][0]; aon[1][1] = aoc[1][1]; }
    const char* cB = (const char*)P.b_ptr(cur);
    const char* nB = has_next ? (const char*)P.b_ptr(nxt) : cB;
    typename Epi::Pre pre = E.fetch(cur, wr, wc, fr, fq);
    G8_STAGE_B(G8_SB(0, 0), cB); G8_STAGE_B(G8_SB(0, 1), cB + hstep); G8_STAGE_A(G8_SA(0, 0), aoc[0][0], aoc[0][1]); G8_STAGE_A(G8_SA(0, 1), aoc[1][0], aoc[1][1]);
    if (wr == 1) G8_BAR;
    G8_WAIT_V(2); G8_BAR;
    G8_STAGE_B(G8_SB(1, 0), cB + kstep); G8_STAGE_A(G8_SA(1, 0), aoc[0][0] + 128u, aoc[0][1] + 128u); G8_STAGE_B(G8_SB(1, 1), cB + hstep + kstep);
    G8_WAIT_V(6); G8_BAR;
    for (;;) {
        for (int t = 0; t < nt; t += 2) {
            const bool last = (t == nt - 2);
            const unsigned k1 = (unsigned)(t + 1) * 128u;
            const unsigned k2 = last ? 0u : (unsigned)(t + 2) * 128u;
            const unsigned a2_00 = (last ? aon[0][0] : aoc[0][0]) + k2, a2_01 = (last ? aon[0][1] : aoc[0][1]) + k2;
            const unsigned a2_10 = (last ? aon[1][0] : aoc[1][0]) + k2, a2_11 = (last ? aon[1][1] : aoc[1][1]) + k2;
            const char* b2 = last ? nB : cB + (size_t)(t + 2) * kstep;
            const char* b3 = b2 + kstep;
            G8_LDB(B0, 0, 0); G8_LDB(B1, 0, 1); G8_SCHED; G8_LDA(At, 0, 0); G8_STAGE_A(G8_SA(1, 1), aoc[1][0] + k1, aoc[1][1] + k1);
            G8_WAIT_V(8); G8_WAIT_L(0); G8_BAR; G8_MMA(0, 0, At, B0); G8_MMA(0, 1, At, B1); G8_BAR; G8_SCHED;
            G8_LDA(At, 0, 1); G8_STAGE_B(G8_SB(0, 0), b2); G8_STAGE_B(G8_SB(0, 1), b2 + hstep); G8_STAGE_A(G8_SA(0, 0), a2_00, a2_01);
            G8_WAIT_V(8); G8_WAIT_L(0); G8_BAR; G8_MMA(1, 0, At, B0); G8_MMA(1, 1, At, B1); G8_BAR; G8_SCHED;
            G8_LDB(B0, 1, 0); G8_LDB(B1, 1, 1); G8_SCHED; G8_LDA(At, 1, 0); G8_STAGE_A(G8_SA(0, 1), a2_10, a2_11);
            G8_WAIT_V(8); G8_WAIT_L(0); G8_BAR; G8_MMA(0, 0, At, B0); G8_MMA(0, 1, At, B1); G8_BAR; G8_SCHED;
            G8_LDA(At, 1, 1); G8_STAGE_B(G8_SB(1, 0), b3); G8_STAGE_B(G8_SB(1, 1), b3 + hstep); G8_STAGE_A(G8_SA(1, 0), a2_00 + 128u, a2_01 + 128u);
            G8_WAIT_V(8); G8_WAIT_L(0); G8_BAR; G8_MMA(1, 0, At, B0); G8_MMA(1, 1, At, B1); G8_BAR; G8_SCHED;
        }
        if (wr == 0) G8_BAR;
        if constexpr (Prob::FP8) asm volatile("s_nop 15\n\ts_nop 15" ::: "memory");
        const bool has_nn = has_next && P.next(ui + 2, nn);
        if (has_nn) P.a_fetch(nn, RA, raw);
        typename Epi::Pre pren = pre; if (has_next) pren = E.fetch(nxt, wr, wc, fr, fq);
        E(acc, cur, pre, wr, wc, fr, fq); pre = pren;
        if (!has_next) break;
#pragma unroll
        for (int a = 0; a < 2; ++a)
#pragma unroll
            for (int b = 0; b < 2; ++b)
#pragma unroll
                for (int m = 0; m < 4; ++m)
#pragma unroll
                    for (int n = 0; n < 2; ++n) acc[a][b][m][n] = (f32x4){0.f, 0.f, 0.f, 0.f};
        cur = nxt; cB = nB; ++ui;
        aoc[0][0] = aon[0][0]; aoc[0][1] = aon[0][1]; aoc[1][0] = aon[1][0]; aoc[1][1] = aon[1][1];
        nxt = nn; has_next = has_nn;
        if (has_next) { P.a_finish(raw, CA, aon); nB = (const char*)P.b_ptr(nxt); }
        else { nB = cB; }
        if (wr == 1) G8_BAR;
    }
    G8_WAIT_V(0);
    G8_BAR;
#undef G8_SA
#undef G8_SB
#undef G8_STAGE_A
#undef G8_STAGE_B
#undef G8_LDA
#undef G8_LDB
#undef G8_MMA
#undef G8_CAT
#undef G8_LO
#undef G8_HI
#undef G8_WAIT_V
#undef G8_WAIT_L
#undef G8_BAR
#undef G8_SCHED
}
}
namespace g8 {
#ifndef WGM_IN
#define WGM_IN 8
#endif
#ifndef WGM_OUT
#define WGM_OUT 8
#endif
#ifndef WGM_M1
#define WGM_M1 4
#endif
#ifndef WGM_M2
#define WGM_M2 4
#endif
template <bool F8, int WG_ = 8> struct DenseProbT {
    static constexpr bool FP8 = F8;
    const bf16_t* A; const bf16_t* Bt; int nM, nN, K, G, c, i0, i1;
    __device__ __forceinline__ bool next(int i, Unit& u) const { return (i0 + i < i1) && static_next<WG_>(i0 + i, nM, nN, G, c, u); }
    __device__ __forceinline__ const void* a_base() const { return A; }
    __device__ __forceinline__ void a_fetch(const Unit& u, const int (&RA)[2], int (&raw)[2][2]) const {
#pragma unroll
        for (int h = 0; h < 2; ++h)
#pragma unroll
            for (int i = 0; i < 2; ++i) raw[h][i] = u.pm * BM + h * HALF + RA[i];
    }
    __device__ __forceinline__ void a_finish(const int (&raw)[2][2], const int (&CA)[2], unsigned (&ao)[2][2]) const {
#pragma unroll
        for (int h = 0; h < 2; ++h)
#pragma unroll
            for (int i = 0; i < 2; ++i) ao[h][i] = (unsigned)((raw[h][i] * K + CA[i]) * 2);
    }
    __device__ __forceinline__ const void* b_ptr(const Unit& u) const { return Bt + (size_t)u.pn * BM * K; }
};
typedef DenseProbT<false, WGM_IN> DenseProbIn; typedef DenseProbT<false, WGM_OUT> DenseProbOut;
struct MoeProb1 {
    static constexpr bool FP8 = true;
    const bf16_t* A; const bf16_t* Bt; const int* row_tok; const int* blk; int K; int nM; int i0, i1;
    __device__ __forceinline__ bool next(int i, Unit& u) const {
        if (i0 + i >= i1 || !static_next<WGM_M1>(i0 + i, nM, 2 * FF / BM, gridDim.x, blockIdx.x, u)) return false;
        u.e = blk[64 + u.pm]; return true; }
    __device__ __forceinline__ const void* a_base() const { return A; }
    __device__ __forceinline__ void a_fetch(const Unit& u, const int (&RA)[2], int (&raw)[2][2]) const {
#pragma unroll
        for (int h = 0; h < 2; ++h)
#pragma unroll
            for (int i = 0; i < 2; ++i) raw[h][i] = row_tok[u.pm * BM + h * HALF + RA[i]];
    }
    __device__ __forceinline__ void a_finish(const int (&raw)[2][2], const int (&CA)[2], unsigned (&ao)[2][2]) const {
#pragma unroll
        for (int h = 0; h < 2; ++h)
#pragma unroll
            for (int i = 0; i < 2; ++i) ao[h][i] = (unsigned)((raw[h][i] * K + CA[i]) * 2);
    }
    __device__ __forceinline__ const void* b_ptr(const Unit& u) const { return Bt + ((size_t)__builtin_amdgcn_readfirstlane(u.e) * (2 * FF) + (size_t)u.pn * BM) * K; }
};
struct MoeProb2 {
    static constexpr bool FP8 = true;
    const bf16_t* A; const bf16_t* Bt; const int* blk; int K; int nM;
    __device__ __forceinline__ bool next(int i, Unit& u) const {
        if (!static_next<WGM_M2>(i, nM, DM / BM, gridDim.x, blockIdx.x, u)) return false;
        u.e = blk[64 + u.pm]; return true; }
    __device__ __forceinline__ const void* a_base() const { return A; }
    __device__ __forceinline__ void a_fetch(const Unit& u, const int (&RA)[2], int (&raw)[2][2]) const {
#pragma unroll
        for (int h = 0; h < 2; ++h)
#pragma unroll
            for (int i = 0; i < 2; ++i) raw[h][i] = u.pm * BM + h * HALF + RA[i];
    }
    __device__ __forceinline__ void a_finish(const int (&raw)[2][2], const int (&CA)[2], unsigned (&ao)[2][2]) const {
#pragma unroll
        for (int h = 0; h < 2; ++h)
#pragma unroll
            for (int i = 0; i < 2; ++i) ao[h][i] = (unsigned)((raw[h][i] * K + CA[i]) * 2);
    }
    __device__ __forceinline__ const void* b_ptr(const Unit& u) const { return Bt + ((size_t)__builtin_amdgcn_readfirstlane(u.e) * DM + (size_t)u.pn * BM) * K; }
};

struct EpiProj {
    static constexpr bool PERM = true;
    bf16_t* __restrict__ O; const float* __restrict__ rstd; const float* __restrict__ rope; float* __restrict__ kmean; LAS float* red;
    struct Pre { float rs[2][4]; };
    __device__ __forceinline__ Pre fetch(const Unit& u, int wr, int wc, int fr, int fq) const {
        Pre q; const int row0 = u.pm * BM + wr * 64 + fr;
#pragma unroll
        for (int ai = 0; ai < 2; ++ai)
#pragma unroll
            for (int m = 0; m < 4; ++m) q.rs[ai][m] = rstd[row0 + ai * HALF + m * 16];
        return q; }
    __device__ __forceinline__ void operator()(const f32x4 (&acc)[2][2][4][2], const Unit& u, const Pre& q, int wr, int wc, int fr, int fq) const {
        const int row0 = u.pm * BM + wr * 64 + fr;
        if (u.pn >= 8) {
            const int col0 = u.pn * BM + wc * 32 + 8 * fq;
#pragma unroll
            for (int ai = 0; ai < 2; ++ai)
#pragma unroll
                for (int m = 0; m < 4; ++m) { const int row = row0 + ai * HALF + m * 16; bf16_t* rowp = O + (size_t)row * NPROJ + col0; const float rsc = q.rs[ai][m];
#pragma unroll
                    for (int bj = 0; bj < 2; ++bj) { const f32x4 v0 = acc[ai][bj][m][0] * rsc, v1 = acc[ai][bj][m][1] * rsc;
                        u32x4 w; w.x = cvt_pk_bf16(v0[0], v0[1]); w.y = cvt_pk_bf16(v0[2], v0[3]); w.z = cvt_pk_bf16(v1[0], v1[1]); w.w = cvt_pk_bf16(v1[2], v1[3]);
                        *(u32x4*)(rowp + bj * HALF) = w; } }
            return;
        }
        const int i0 = 32 * (wc & 1) + 8 * fq, col0 = u.pn * BM + (wc >> 1) * HD + i0;
        const bool isk = u.pn >= 4;
        f32x4 s1a = {0.f, 0.f, 0.f, 0.f}, s1b = s1a, s2a = s1a, s2b = s1a;
#pragma unroll
        for (int ai = 0; ai < 2; ++ai)
#pragma unroll
            for (int m = 0; m < 4; ++m) { const int row = row0 + ai * HALF + m * 16; const int pos = row & (SEQ - 1); bf16_t* rowp = O + (size_t)row * NPROJ + col0; const float rsc = q.rs[ai][m];
                const float* cp = rope + pos * 64 + i0; const f32x4 ca = *(const f32x4*)cp, cb = *(const f32x4*)(cp + 4), sa = *(const f32x4*)(cp + SEQ * 64), sb = *(const f32x4*)(cp + SEQ * 64 + 4);
                const f32x4 xa = acc[ai][0][m][0] * rsc, xb = acc[ai][0][m][1] * rsc, ya = acc[ai][1][m][0] * rsc, yb = acc[ai][1][m][1] * rsc;
                const f32x4 o1a = xa * ca - ya * sa, o1b = xb * cb - yb * sb, o2a = ya * ca + xa * sa, o2b = yb * cb + xb * sb;
                u32x4 w1, w2;
                w1.x = cvt_pk_bf16(o1a[0], o1a[1]); w1.y = cvt_pk_bf16(o1a[2], o1a[3]); w1.z = cvt_pk_bf16(o1b[0], o1b[1]); w1.w = cvt_pk_bf16(o1b[2], o1b[3]);
                w2.x = cvt_pk_bf16(o2a[0], o2a[1]); w2.y = cvt_pk_bf16(o2a[2], o2a[3]); w2.z = cvt_pk_bf16(o2b[0], o2b[1]); w2.w = cvt_pk_bf16(o2b[2], o2b[3]);
                *(u32x4*)rowp = w1; *(u32x4*)(rowp + 64) = w2;
                if (isk) { s1a += o1a; s1b += o1b; s2a += o2a; s2b += o2b; } }
        if (isk) {
            float sv[16] = {s1a[0], s1a[1], s1a[2], s1a[3], s1b[0], s1b[1], s1b[2], s1b[3], s2a[0], s2a[1], s2a[2], s2a[3], s2b[0], s2b[1], s2b[2], s2b[3]};
#pragma unroll
            for (int j = 0; j < 16; ++j) {
#pragma unroll
                for (int o = 1; o < 16; o <<= 1) sv[j] += __shfl_xor(sv[j], o); }
            LAS float* rp = red + (wc * 4 + fq) * 16;
            if (wr == 1 && fr == 0) {
#pragma unroll
                for (int j = 0; j < 16; j += 4) *(LAS f32x4*)(rp + j) = (f32x4){sv[j], sv[j + 1], sv[j + 2], sv[j + 3]}; }
            asm volatile("s_waitcnt lgkmcnt(0)" ::: "memory"); __builtin_amdgcn_s_barrier(); asm volatile("" ::: "memory");
            if (wr == 0 && fr == 0) {
                float* kp = kmean + ((size_t)((u.pm >> 4) * MH + 2 * (u.pn - 4) + (wc >> 1)) * NBLK + (u.pm & 15)) * HD + i0;
                const f32x4 r0 = *(const LAS f32x4*)rp, r1 = *(const LAS f32x4*)(rp + 4), r2 = *(const LAS f32x4*)(rp + 8), r3 = *(const LAS f32x4*)(rp + 12);
                const float inv = 1.0f / MBLK;
                *(f32x4*)kp = (f32x4){(sv[0] + r0[0]) * inv, (sv[1] + r0[1]) * inv, (sv[2] + r0[2]) * inv, (sv[3] + r0[3]) * inv};
                *(f32x4*)(kp + 4) = (f32x4){(sv[4] + r1[0]) * inv, (sv[5] + r1[1]) * inv, (sv[6] + r1[2]) * inv, (sv[7] + r1[3]) * inv};
                *(f32x4*)(kp + 64) = (f32x4){(sv[8] + r2[0]) * inv, (sv[9] + r2[1]) * inv, (sv[10] + r2[2]) * inv, (sv[11] + r2[3]) * inv};
                *(f32x4*)(kp + 68) = (f32x4){(sv[12] + r3[0]) * inv, (sv[13] + r3[1]) * inv, (sv[14] + r3[2]) * inv, (sv[15] + r3[3]) * inv};
            }
        }
    }
};
struct EpiX1 {
    static constexpr bool PERM = false;
    const float* __restrict__ X; float* __restrict__ O;
    struct Pre {};
    __device__ __forceinline__ Pre fetch(const Unit&, int, int, int, int) const { return Pre{}; }
    __device__ __forceinline__ void operator()(const f32x4 (&acc)[2][2][4][2], const Unit& u, const Pre&, int wr, int wc, int fr, int fq) const {
        const int row0 = u.pm * BM + wr * 64 + fr, col0 = u.pn * BM + wc * 32 + 4 * fq;
#pragma unroll
        for (int ai = 0; ai < 2; ++ai) {
            f32x4 xv[4][2][2];
#pragma unroll
            for (int m = 0; m < 4; ++m) { const size_t off = (size_t)(row0 + ai * HALF + m * 16) * DM + col0;
#pragma unroll
                for (int bj = 0; bj < 2; ++bj)
#pragma unroll
                    for (int n = 0; n < 2; ++n) xv[m][bj][n] = __builtin_nontemporal_load((const f32x4*)(X + off + bj * HALF + n * 16)); }
#pragma unroll
            for (int m = 0; m < 4; ++m) { const size_t off = (size_t)(row0 + ai * HALF + m * 16) * DM + col0;
#pragma unroll
                for (int bj = 0; bj < 2; ++bj)
#pragma unroll
                    for (int n = 0; n < 2; ++n) *(f32x4*)(O + off + bj * HALF + n * 16) = xv[m][bj][n] + acc[ai][bj][m][n]; }
        }
    }
};
struct EpiSwiglu {
    static constexpr bool PERM = true;
    unsigned char* __restrict__ O; const float* __restrict__ row_rstd; const float* __restrict__ bgu;
    struct Pre { float rsv[2][4]; };
    __device__ __forceinline__ Pre fetch(const Unit& u, int wr, int wc, int fr, int fq) const {
        Pre q; const int row0 = u.pm * BM + wr * 64 + fr;
#pragma unroll
        for (int ai = 0; ai < 2; ++ai)
#pragma unroll
            for (int m = 0; m < 4; ++m) q.rsv[ai][m] = row_rstd[row0 + ai * HALF + m * 16];
        return q; }
    __device__ __forceinline__ void operator()(const f32x4 (&acc)[2][2][4][2], const Unit& u, const Pre& q, int wr, int wc, int fr, int fq) const {
        const int row0 = u.pm * BM + wr * 64 + fr, colg = u.pn * HALF + wc * 32 + 8 * fq;
        const float* bg = bgu + (size_t)__builtin_amdgcn_readfirstlane(u.e) * (2 * FF) + colg; const float* bu = bg + FF;
        const f32x4 bg0 = *(const f32x4*)bg, bg1 = *(const f32x4*)(bg + 4), bu0 = *(const f32x4*)bu, bu1 = *(const f32x4*)(bu + 4);
#pragma unroll
        for (int ai = 0; ai < 2; ++ai)
#pragma unroll
            for (int m = 0; m < 4; ++m) { const int row = row0 + ai * HALF + m * 16; const float rs = q.rsv[ai][m] * F8_UNSCALE;
                f32x4 g0 = acc[ai][0][m][0] * rs + bg0, g1 = acc[ai][0][m][1] * rs + bg1, u0 = acc[ai][1][m][0] * rs + bu0, u1 = acc[ai][1][m][1] * rs + bu1;
                float o[8];
#pragma unroll
                for (int j = 0; j < 8; ++j) { float g = j < 4 ? g0[j] : g1[j - 4], uu = j < 4 ? u0[j] : u1[j - 4];
                    g = fminf(g, 7.0f); uu = __builtin_amdgcn_fmed3f(uu, -7.0f, 7.0f);
                    const float sg = __builtin_amdgcn_rcpf(1.0f + __builtin_amdgcn_exp2f(g * (-1.702f * 1.4426950408889634f)));
                    o[j] = (uu * ACT_SCALE + ACT_SCALE) * (g * sg); }
                u32x2 w; w.x = cvt4_fp8(o[0], o[1], o[2], o[3]); w.y = cvt4_fp8(o[4], o[5], o[6], o[7]);
                *(u32x2*)(O + (size_t)row * FF + colg) = w; }
    }
};
struct EpiDown {
    static constexpr bool PERM = true;
    unsigned char* __restrict__ O; const float* __restrict__ bd;
    struct Pre { f32x4 bv[2][2]; };
    __device__ __forceinline__ Pre fetch(const Unit& u, int wr, int wc, int fr, int fq) const {
        Pre q; const int col0 = u.pn * BM + wc * 32 + 8 * fq;
        const float* bp = bd + (size_t)__builtin_amdgcn_readfirstlane(u.e) * DM + col0;
#pragma unroll
        for (int bj = 0; bj < 2; ++bj)
#pragma unroll
            for (int n = 0; n < 2; ++n) q.bv[bj][n] = *(const f32x4*)(bp + bj * HALF + 4 * n) * Y_SCALE;
        return q; }
    __device__ __forceinline__ void operator()(const f32x4 (&acc)[2][2][4][2], const Unit& u, const Pre& q, int wr, int wc, int fr, int fq) const {
        const int row0 = u.pm * BM + wr * 64 + fr, col0 = u.pn * BM + wc * 32 + 8 * fq;
#pragma unroll
        for (int ai = 0; ai < 2; ++ai)
#pragma unroll
            for (int m = 0; m < 4; ++m) { unsigned char* rowp = O + (size_t)(row0 + ai * HALF + m * 16) * DM + col0;
#pragma unroll
                for (int bj = 0; bj < 2; ++bj) { const f32x4 v0 = acc[ai][bj][m][0] * (F8_UNSCALE * Y_SCALE) + q.bv[bj][0], v1 = acc[ai][bj][m][1] * (F8_UNSCALE * Y_SCALE) + q.bv[bj][1];
                    u32x2 w; w.x = cvt4_fp8(v0[0], v0[1], v0[2], v0[3]); w.y = cvt4_fp8(v1[0], v1[1], v1[2], v1[3]);
                    *(u32x2*)(rowp + bj * HALF) = w; } }
    }
};
}
struct Ctx { LAS unsigned char* lds; int tid, lane, wave; };
__device__ __forceinline__ Ctx fresh_ctx(const Ctx& c0) { Ctx c; c.lds = c0.lds; int t = c0.wave * 64 + lane_id(); asm volatile("" : "+v"(t)); c.tid = t; c.lane = t & 63; c.wave = c0.wave; return c; }

__device__ __forceinline__ void transpose_item(const float* W, int ld, int K, int k0, int n0, bf16_t* WT_row0  , LAS float* scr, int lane) {
    float tv[32];
#pragma unroll
    for (int i = 0; i < 32; ++i) { const int kk = 2 * i + (lane >> 5); tv[i] = __builtin_nontemporal_load(W + (size_t)(k0 + kk) * ld + n0 + (lane & 31)); }
#pragma unroll
    for (int i = 0; i < 32; ++i) { const int kk = 2 * i + (lane >> 5); scr[kk * 33 + (lane & 31)] = tv[i]; }
    LDS_WAIT(); asm volatile("" ::: "memory");
    const int c = lane & 7;
#pragma unroll
    for (int j = 0; j < 4; ++j) { const int n = (lane >> 3) + 8 * j; const LAS float* s = scr + (8 * c) * 33 + n;
        u32x4 o; o.x = cvt_pk_bf16(s[0 * 33], s[1 * 33]); o.y = cvt_pk_bf16(s[2 * 33], s[3 * 33]); o.z = cvt_pk_bf16(s[4 * 33], s[5 * 33]); o.w = cvt_pk_bf16(s[6 * 33], s[7 * 33]);
        *(u32x4*)(WT_row0 + (size_t)n * K + k0 + 8 * c) = o; }
    LDS_WAIT(); asm volatile("" ::: "memory");
}
__device__ __forceinline__ void phase_convert(const Params& p, const Ctx& c0) { const Ctx c = fresh_ctx(c0);
    LAS float* scr = (LAS float*)(c.lds + c.wave * 18432);
    const int gw = blockIdx.x * NWAVES + c.wave, NGW = gridDim.x * NWAVES;
    bf16_t* WinT = (bf16_t*)(p.ws + WS_WIN); bf16_t* WoutT = (bf16_t*)(p.ws + WS_WOUT);
    constexpr int KB = DM / 64;
    constexpr int I_IN = KB * (NPROJ / 32), I_OUT = KB * (DM / 32), NITEMS = I_IN + I_OUT;
    for (int it = gw; it < NITEMS; it += NGW) {
        int r = it;
        if (r < I_IN) { const int nb = r % (NPROJ / 32), kb = r / (NPROJ / 32);
            const int n = 32 * nb, jj = n & 127; const int src = (n < C_MV) ? (n & ~255) + (jj >> 6) * HD + ((n >> 7) & 1) * 64 + (jj & 63) : n;
            transpose_item(p.w_in, LDW_IN, DM, 64 * kb, src, WinT + (size_t)n * DM, scr, c.lane); continue; } r -= I_IN;
        { const int nb = r % (DM / 32), kb = r / (DM / 32); transpose_item(p.w_out, DM, DM, 64 * kb, 32 * nb, WoutT + (size_t)(32 * nb) * DM, scr, c.lane); }
    }
    float* rc = (float*)(p.ws + WS_ROPE); float* rs = rc + SEQ * 64;
    for (int i = blockIdx.x * NTHREADS + c.tid; i < SEQ * 64; i += gridDim.x * NTHREADS) {
        const int pos = i >> 6, j = i & 63;
        const float inv = 1.0f / powf(10000.0f, (float)(2 * j) / 128.0f);
        const float ang = (float)pos * inv; float sn, cs; sincosf(ang, &sn, &cs); rc[i] = cs; rs[i] = sn; }
}
constexpr int CT_GU1 = (DM / 128) * (2 * FF / 256), CT_D1 = (FF / 128) * (DM / 256), CT_GU = NE * CT_GU1, CT_D = NE * CT_D1, CT_TOTAL = CT_GU + CT_D;
struct ConvTile { const float* src; unsigned char* dst; int ld; int gu; };
__device__ __forceinline__ ConvTile ctile_decode(const Params& p, int r) {
    ConvTile t;
    if (r < CT_GU) { const int e = r / CT_GU1, q = r % CT_GU1, nt = q % (2 * FF / 256), kt = q / (2 * FF / 256);
        t.src = p.w_gu + (size_t)e * DM * (2 * FF) + (size_t)(128 * kt) * (2 * FF) + 256 * nt; t.ld = 2 * FF; t.gu = 256 * nt;
        t.dst = (unsigned char*)(p.ws + WS_WGU) + (size_t)e * (2 * FF) * DM + 128 * kt; }
    else { r -= CT_GU; const int e = r / CT_D1, q = r % CT_D1, nt = q % (DM / 256), kt = q / (DM / 256);
        t.src = p.w_d + (size_t)e * FF * DM + (size_t)(128 * kt) * DM + 256 * nt; t.ld = DM; t.gu = -1;
        t.dst = (unsigned char*)(p.ws + WS_WD) + ((size_t)e * DM + 256 * nt) * FF + 128 * kt; }
    return t;
}
__device__ __forceinline__ void ctile_load(const ConvTile& t, f32x4 (&tv)[16], int wave, int lane) {
    const float* s = t.src + (size_t)(16 * wave) * t.ld + 4 * lane;
#pragma unroll
    for (int i = 0; i < 16; ++i) tv[i] = __builtin_nontemporal_load((const f32x4*)(s + (size_t)i * t.ld));
}
__device__ __forceinline__ void ctile_store(const ConvTile& t, const f32x4 (&tv)[16], LAS unsigned char* lds, int tid, int wave, int lane) {
#pragma unroll
    for (int c = 0; c < 4; ++c) { u32x4 o;
#pragma unroll
        for (int q = 0; q < 4; ++q) o[q] = cvt4_fp8(tv[4 * q][c] * W_SCALE, tv[4 * q + 1][c] * W_SCALE, tv[4 * q + 2][c] * W_SCALE, tv[4 * q + 3][c] * W_SCALE);
        const int n = 4 * lane + c; *(LAS u32x4*)(lds + n * 128 + ((wave ^ (lane & 7)) << 4)) = o; }
    asm volatile("s_waitcnt lgkmcnt(0)" ::: "memory"); __builtin_amdgcn_s_barrier();
#pragma unroll
    for (int j = 0; j < 4; ++j) { const int n = 64 * j + (tid >> 3), ch = tid & 7;
        const u32x4 o = *(const LAS u32x4*)(lds + n * 128 + ((ch ^ ((n >> 2) & 7)) << 4));
        int orow = n;
        if (t.gu >= 0) { const int ng = t.gu + n; const int nn = ng < FF ? ng : ng - FF; orow = 256 * (nn / 128) + (nn % 128) + (ng < FF ? 0 : 128); }
        *(u32x4*)(t.dst + (size_t)orow * DM + 16 * ch) = o; }
    asm volatile("s_waitcnt lgkmcnt(0)" ::: "memory"); __builtin_amdgcn_s_barrier();
}
__device__ __forceinline__ void phase_convert_share(const Params& p, const Ctx& c0, int lo, int hi, int G, int w) { const Ctx c = fresh_ctx(c0);
    for (int base = lo + w; base < hi; base += 8 * G) {
        f32x4 ta[16], tb[16];
#define CT_OK(k) (base + (k) * G < hi)
#define CT_L(k, buf) do { if (CT_OK(k)) { const ConvTile t_ = ctile_decode(p, base + (k) * G); ctile_load(t_, buf, c.wave, c.lane); } __builtin_amdgcn_sched_barrier(0); } while (0)
#define CT_S(k, buf) do { if (CT_OK(k)) { const ConvTile t_ = ctile_decode(p, base + (k) * G); ctile_store(t_, buf, c.lds, c.tid, c.wave, c.lane); } __builtin_amdgcn_sched_barrier(0); } while (0)
        CT_L(0, ta); CT_L(1, tb);
        CT_S(0, ta); CT_L(2, ta);
        CT_S(1, tb); CT_L(3, tb);
        CT_S(2, ta); CT_L(4, ta);
        CT_S(3, tb); CT_L(5, tb);
        CT_S(4, ta); CT_L(6, ta);
        CT_S(5, tb); CT_L(7, tb);
        CT_S(6, ta); CT_S(7, tb);
#undef CT_OK
#undef CT_L
#undef CT_S
    }
}

template <int NTL, int OUT8  >
__device__ __forceinline__ void norm_skinny_half(const float* __restrict__ xrows, const float* __restrict__ wn, const float* __restrict__ Wsk, int ldw, void* __restrict__ hrows_, void* __restrict__ hrows8_, int hk, int lane, f32x4 (&acc)[NTL], float& ss) {
    const int row = lane & 15, kq = lane >> 4;
    ss = 0.f;
#pragma unroll
    for (int t = 0; t < NTL; ++t) acc[t] = (f32x4){0.f, 0.f, 0.f, 0.f};
    for (int ks0 = 0; ks0 < 32; ks0 += 4) {
        f32x4 xa[4], xb[4], wa[4], wb[4]; float wv[4][NTL][8];
#pragma unroll
        for (int q = 0; q < 4; ++q) { const int d0 = 1024 * hk + 32 * (ks0 + q) + 8 * kq;
            xa[q] = *(const f32x4*)(xrows + (size_t)row * DM + d0); xb[q] = *(const f32x4*)(xrows + (size_t)row * DM + d0 + 4);
            wa[q] = *(const f32x4*)(wn + d0); wb[q] = *(const f32x4*)(wn + d0 + 4);
#pragma unroll
            for (int t = 0; t < NTL; ++t)
#pragma unroll
                for (int i = 0; i < 8; ++i) wv[q][t][i] = Wsk[(size_t)(d0 + i) * ldw + t * 16 + row]; }
#pragma unroll
        for (int q = 0; q < 4; ++q) { const int d0 = 1024 * hk + 32 * (ks0 + q) + 8 * kq;
            f32x4 a = xa[q], b = xb[q];
            ss += (a[0] * a[0] + a[1] * a[1]) + (a[2] * a[2] + a[3] * a[3]) + (b[0] * b[0] + b[1] * b[1]) + (b[2] * b[2] + b[3] * b[3]);
            a = a * wa[q]; b = b * wb[q];
            u32x4 hw; hw.x = cvt_pk_bf16(a[0], a[1]); hw.y = cvt_pk_bf16(a[2], a[3]); hw.z = cvt_pk_bf16(b[0], b[1]); hw.w = cvt_pk_bf16(b[2], b[3]);
            if constexpr (OUT8 >= 1) { u32x2 f8; f8.x = cvt4_fp8(a[0] * ACT_SCALE, a[1] * ACT_SCALE, a[2] * ACT_SCALE, a[3] * ACT_SCALE); f8.y = cvt4_fp8(b[0] * ACT_SCALE, b[1] * ACT_SCALE, b[2] * ACT_SCALE, b[3] * ACT_SCALE);
                *(u32x2*)((unsigned char*)hrows8_ + (size_t)row * DM + d0) = f8; }
            if constexpr (OUT8 != 1) *(u32x4*)((bf16_t*)hrows_ + (size_t)row * DM + d0) = hw;
            const f32x4 ra = {a[0] - bflo(hw.x), a[1] - bfhi(hw.x), a[2] - bflo(hw.y), a[3] - bfhi(hw.y)}, rb = {b[0] - bflo(hw.z), b[1] - bfhi(hw.z), b[2] - bflo(hw.w), b[3] - bfhi(hw.w)};
            const bf16x8 ah = __builtin_bit_cast(bf16x8, hw), al = pack8(ra, rb);
#pragma unroll
            for (int t = 0; t < NTL; ++t) { const float* w8 = wv[q][t];
                u32x4 bw; bw.x = cvt_pk_bf16(w8[0], w8[1]); bw.y = cvt_pk_bf16(w8[2], w8[3]); bw.z = cvt_pk_bf16(w8[4], w8[5]); bw.w = cvt_pk_bf16(w8[6], w8[7]);
                const f32x4 r0 = {w8[0] - bflo(bw.x), w8[1] - bfhi(bw.x), w8[2] - bflo(bw.y), w8[3] - bfhi(bw.y)}, r1 = {w8[4] - bflo(bw.z), w8[5] - bfhi(bw.z), w8[6] - bflo(bw.w), w8[7] - bfhi(bw.w)};
                const bf16x8 bh = __builtin_bit_cast(bf16x8, bw), bl = pack8(r0, r1);
                acc[t] = __builtin_amdgcn_mfma_f32_16x16x32_bf16(ah, bh, acc[t], 0, 0, 0);
                acc[t] = __builtin_amdgcn_mfma_f32_16x16x32_bf16(al, bh, acc[t], 0, 0, 0);
                acc[t] = __builtin_amdgcn_mfma_f32_16x16x32_bf16(ah, bl, acc[t], 0, 0, 0); }
        }
    }
    ss += __shfl_xor(ss, 16); ss += __shfl_xor(ss, 32);
}

__device__ __forceinline__ void phase_norm1(const Params& p, const Ctx& c0) { const Ctx c = fresh_ctx(c0);
    bf16_t* H = (bf16_t*)(p.ws + WS_H); float* rstd = (float*)(p.ws + WS_RSTD1); float* gz = (float*)(p.ws + WS_GZ);
    const int pair = c.wave >> 1, hk = c.wave & 1;
    LAS float* scr = (LAS float*)(c.lds + pair * 4096);
    for (int u = blockIdx.x * 4 + pair; u < T / 16; u += gridDim.x * 4) {
        f32x4 acc[1]; float ss;
        norm_skinny_half<1, 0>(p.x + (size_t)u * 16 * DM, p.attn_norm_w, p.w_in + C_GZ, LDW_IN, H + (size_t)u * 16 * DM, nullptr, hk, c.lane, acc, ss);
        if (hk == 1) { *(LAS f32x4*)(scr + c.lane * 4) = acc[0]; if (c.lane < 16) scr[256 + c.lane] = ss; }
        __syncthreads();
        if (hk == 0) {
            const f32x4 o = *(LAS f32x4*)(scr + c.lane * 4); const float tot = ss + scr[256 + (c.lane & 15)];
            const float rs = 1.0f / sqrtf(tot * (1.0f / DM) + EPS);
            if (c.lane < 16) { rstd[u * 16 + c.lane] = rs; scr[512 + c.lane] = rs; }
            LDS_WAIT();
#pragma unroll
            for (int r = 0; r < 4; ++r) { const int row = (c.lane >> 4) * 4 + r; gz[(size_t)(u * 16 + row) * 16 + (c.lane & 15)] = (acc[0][r] + o[r]) * scr[512 + row]; }
        }
        __syncthreads();
    }
}

__device__ __forceinline__ void phase_norm2_router(const Params& p, const Ctx& c0) { const Ctx c = fresh_ctx(c0);
    bf16_t* H = (bf16_t*)(p.ws + WS_H); float* rstd = (float*)(p.ws + WS_RSTD2); const float* X1 = (const float*)(p.ws + WS_X1);
    int* topi = (int*)(p.ws + WS_TOPI); float* topg = (float*)(p.ws + WS_TOPG); int* hist = (int*)(p.ws + WS_HIST); int* row_tok = (int*)(p.ws + WS_ROWTOK);
    const int pair = c.wave >> 1, hk = c.wave & 1;
    LAS float* scr = (LAS float*)(c.lds + pair * 8192);
    LAS int* hcnt = (LAS int*)(c.lds + 65536);
    { float* row_rstd = (float*)(p.ws + WS_ROWRSTD);
      for (int i = blockIdx.x * NTHREADS + c.tid; i < PROWS; i += gridDim.x * NTHREADS) { row_tok[i] = 0; row_rstd[i] = 0.f; } }
    for (int g = blockIdx.x; g < T / 64; g += gridDim.x) {
        if (c.tid < 32) hcnt[c.tid] = 0;
        __syncthreads();
        const int u = g * 4 + pair;
        f32x4 acc[2]; float ss;
        norm_skinny_half<2, 1>(X1 + (size_t)u * 16 * DM, p.ffn_norm_w, p.router_w, NE, nullptr, (unsigned char*)H + (size_t)u * 16 * DM, hk, c.lane, acc, ss);
        if (hk == 1) { *(LAS f32x4*)(scr + c.lane * 4) = acc[0]; *(LAS f32x4*)(scr + 256 + c.lane * 4) = acc[1]; if (c.lane < 16) scr[512 + c.lane] = ss; }
        __syncthreads();
        if (hk == 0) {
            const f32x4 o0 = *(LAS f32x4*)(scr + c.lane * 4), o1 = *(LAS f32x4*)(scr + 256 + c.lane * 4); const float tot = ss + scr[512 + (c.lane & 15)];
            const float rs = 1.0f / sqrtf(tot * (1.0f / DM) + EPS);
            if (c.lane < 16) { rstd[u * 16 + c.lane] = rs; scr[528 + c.lane] = rs; }
            LDS_WAIT();
            const float b0 = p.router_b[c.lane & 15], b1 = p.router_b[16 + (c.lane & 15)];
#pragma unroll
            for (int r = 0; r < 4; ++r) { const int row = (c.lane >> 4) * 4 + r; const float rr = scr[528 + row];
                scr[1024 + row * 32 + (c.lane & 15)] = (acc[0][r] + o0[r]) * rr + b0; scr[1024 + row * 32 + 16 + (c.lane & 15)] = (acc[1][r] + o1[r]) * rr + b1; }
            LDS_WAIT();
            if (c.lane < 16) {
                float lv[32];
#pragma unroll
                for (int j = 0; j < 32; ++j) lv[j] = scr[1024 + c.lane * 32 + j];
                int bi[4]; float bv[4];
#pragma unroll
                for (int k = 0; k < 4; ++k) { float best = -__builtin_inff(); int bidx = 0;
#pragma unroll
                    for (int j = 0; j < 32; ++j) { const bool tk = lv[j] > best; best = tk ? lv[j] : best; bidx = tk ? j : bidx; }
                    bi[k] = bidx; bv[k] = best;
#pragma unroll
                    for (int j = 0; j < 32; ++j) lv[j] = (j == bidx) ? -__builtin_inff() : lv[j]; }
                const float e1 = __expf(bv[1] - bv[0]), e2 = __expf(bv[2] - bv[0]), e3 = __expf(bv[3] - bv[0]); const float inv = 1.0f / (1.0f + e1 + e2 + e3);
                const int tok = u * 16 + c.lane;
                *(int4*)(topi + (size_t)tok * 4) = make_int4(bi[0], bi[1], bi[2], bi[3]);
                *(float4*)(topg + (size_t)tok * 4) = make_float4(inv, e1 * inv, e2 * inv, e3 * inv);
#pragma unroll
                for (int k = 0; k < 4; ++k) atomicAdd((int*)&hcnt[bi[k]], 1);
            }
        }
        __syncthreads();
        if (c.tid < 32) hist[g * 32 + c.tid] = hcnt[c.tid];
        __syncthreads();
    }
}

__device__ __forceinline__ void phase_rope_kmean(const Params& p, const Ctx& c0) { const Ctx c = fresh_ctx(c0);
    bf16_t* proj = (bf16_t*)(p.ws + WS_PROJ); const float* rc = (const float*)(p.ws + WS_ROPE); const float* rsn = rc + SEQ * 64; float* kmean = (float*)(p.ws + WS_KMEAN);
    LAS float* red = (LAS float*)c.lds;
    const int cg = c.tid & 7, tk = c.tid >> 3;
    for (int u = blockIdx.x; u < NBATCH * MH * NBLK; u += gridDim.x) {
        const int b = u / (MH * NBLK), h = (u / NBLK) % MH, blk = u % NBLK;
        float s1[8], s2[8];
#pragma unroll
        for (int j = 0; j < 8; ++j) { s1[j] = 0.f; s2[j] = 0.f; }
        f32x4 ca[4], cb[4], sa[4], sb[4]; u32x4 t1[4][2], t2[4][2];
#pragma unroll
        for (int ps = 0; ps < 4; ++ps) {
            const int pos = blk * MBLK + ps * 64 + tk; const size_t row = (size_t)(b * SEQ + pos) * NPROJ;
            ca[ps] = *(const f32x4*)(rc + pos * 64 + 8 * cg); cb[ps] = *(const f32x4*)(rc + pos * 64 + 8 * cg + 4); sa[ps] = *(const f32x4*)(rsn + pos * 64 + 8 * cg); sb[ps] = *(const f32x4*)(rsn + pos * 64 + 8 * cg + 4);
#pragma unroll
            for (int qk = 0; qk < 2; ++qk) { const bf16_t* base = proj + row + (qk ? C_MK : C_MQ) + h * HD + 8 * cg; t1[ps][qk] = *(const u32x4*)base; t2[ps][qk] = *(const u32x4*)(base + 64); }
        }
#pragma unroll
        for (int ps = 0; ps < 4; ++ps) {
            const int pos = blk * MBLK + ps * 64 + tk; const size_t row = (size_t)(b * SEQ + pos) * NPROJ;
            const float cs[8] = {ca[ps][0], ca[ps][1], ca[ps][2], ca[ps][3], cb[ps][0], cb[ps][1], cb[ps][2], cb[ps][3]}, sn[8] = {sa[ps][0], sa[ps][1], sa[ps][2], sa[ps][3], sb[ps][0], sb[ps][1], sb[ps][2], sb[ps][3]};
#pragma unroll
            for (int qk = 0; qk < 2; ++qk) {
                bf16_t* base = proj + row + (qk ? C_MK : C_MQ) + h * HD + 8 * cg;
                float a[8], bb[8];
#pragma unroll
                for (int j = 0; j < 4; ++j) { a[2 * j] = bflo(t1[ps][qk][j]); a[2 * j + 1] = bfhi(t1[ps][qk][j]); bb[2 * j] = bflo(t2[ps][qk][j]); bb[2 * j + 1] = bfhi(t2[ps][qk][j]); }
                float o1[8], o2[8];
#pragma unroll
                for (int j = 0; j < 8; ++j) { o1[j] = a[j] * cs[j] - bb[j] * sn[j]; o2[j] = bb[j] * cs[j] + a[j] * sn[j]; }
                u32x4 w1, w2;
#pragma unroll
                for (int j = 0; j < 4; ++j) { w1[j] = cvt_pk_bf16(o1[2 * j], o1[2 * j + 1]); w2[j] = cvt_pk_bf16(o2[2 * j], o2[2 * j + 1]); }
                *(u32x4*)base = w1; *(u32x4*)(base + 64) = w2;
                if (qk) {
#pragma unroll
                    for (int j = 0; j < 8; ++j) { s1[j] += o1[j]; s2[j] += o2[j]; } }
            }
        }
#pragma unroll
        for (int j = 0; j < 8; ++j) {
#pragma unroll
            for (int o = 8; o < 64; o <<= 1) { s1[j] += __shfl_xor(s1[j], o); s2[j] += __shfl_xor(s2[j], o); } }
        if (c.lane < 8) {
#pragma unroll
            for (int j = 0; j < 8; ++j) { red[c.wave * 128 + 8 * cg + j] = s1[j]; red[c.wave * 128 + 64 + 8 * cg + j] = s2[j]; } }
        __syncthreads();
        if (c.tid < 128) { float s = 0.f;
#pragma unroll
            for (int w = 0; w < 8; ++w) s += red[w * 128 + c.tid];
            kmean[(size_t)u * HD + c.tid] = s * (1.0f / MBLK); }
        __syncthreads();
    }
}

__device__ __forceinline__ void phase_gla_prep(const Params& p, const Ctx& c0) { const Ctx c = fresh_ctx(c0);
    bf16_t* proj = (bf16_t*)(p.ws + WS_PROJ); const float* gz = (const float*)(p.ws + WS_GZ); float* dend = (float*)(p.ws + WS_DEND);
    LAS float* gzl = (LAS float*)c.lds;
    LAS float* seg = (LAS float*)(c.lds + 16384);
    const int ch = c.tid & 127, tq = __builtin_amdgcn_readfirstlane(c.tid >> 7);
    for (int u = blockIdx.x; u < NBATCH * GH * NBLK; u += gridDim.x) {
        const int b = u / (GH * NBLK), h = (u / NBLK) % GH, j = u % NBLK;
        const int tok0 = b * SEQ + j * MBLK;
        for (int i = c.tid; i < 256 * 4; i += NTHREADS) *(LAS f32x4*)(gzl + i * 4) = *(const f32x4*)(gz + (size_t)tok0 * 16 + i * 4);
        float w2[16];
#pragma unroll
        for (int r = 0; r < 16; ++r) w2[r] = p.gate_w2[r * 512 + h * GDK + ch];
        const float bias = p.gate_b[h * GDK + ch];
        __syncthreads();
        float run = 0.f; float Bv[64];
#pragma unroll
        for (int i = 0; i < 64; ++i) {
            const LAS float* g = gzl + (tq * 64 + i) * 16;
            const f32x4 g0 = *(const LAS f32x4*)g, g1 = *(const LAS f32x4*)(g + 4), g2 = *(const LAS f32x4*)(g + 8), g3 = *(const LAS f32x4*)(g + 12);
            float lg = bias;
            lg += g0[0] * w2[0] + g0[1] * w2[1] + g0[2] * w2[2] + g0[3] * w2[3]; lg += g1[0] * w2[4] + g1[1] * w2[5] + g1[2] * w2[6] + g1[3] * w2[7];
            lg += g2[0] * w2[8] + g2[1] * w2[9] + g2[2] * w2[10] + g2[3] * w2[11]; lg += g3[0] * w2[12] + g3[1] * w2[13] + g3[2] * w2[14] + g3[3] * w2[15];
            const float ls = fminf(lg, 0.f) - __logf(1.0f + __expf(-fabsf(lg)));
            run += ls * (1.0f / 16.0f); Bv[i] = run; }
        seg[tq * 128 + ch] = run;
        __syncthreads();
        float off = 0.f, tot = 0.f;
#pragma unroll
        for (int s = 0; s < 4; ++s) { const float v = seg[s * 128 + ch]; tot += v; off += (s < tq) ? v : 0.f; }
        if (tq == 0) dend[(size_t)u * GDK + ch] = __expf(tot);
        bf16_t* qp = proj + (size_t)(tok0 + tq * 64) * NPROJ + C_GQ + h * GDK + ch; bf16_t* kp = proj + (size_t)(tok0 + tq * 64) * NPROJ + C_GK + h * GDK + ch;
#pragma unroll
        for (int i0 = 0; i0 < 64; i0 += 16) {
            bf16_t qraw[16], kraw[16];
#pragma unroll
            for (int i = 0; i < 16; ++i) { qraw[i] = qp[(size_t)(i0 + i) * NPROJ]; kraw[i] = kp[(size_t)(i0 + i) * NPROJ]; }
#pragma unroll
            for (int i = 0; i < 16; ++i) { const float Bt = off + Bv[i0 + i];
                const float q = bf2f(qraw[i]), k = bf2f(kraw[i]);
                const float qt = q * __expf(Bt) * 0.08838834764831845f, kt = k * __expf(-Bt);
                qp[(size_t)(i0 + i) * NPROJ] = (bf16_t)(cvt_pk_bf16(qt, 0.f) & 0xffffu); kp[(size_t)(i0 + i) * NPROJ] = (bf16_t)(cvt_pk_bf16(kt, 0.f) & 0xffffu); }
        }
        __syncthreads();
    }
}
namespace att {
constexpr int NW = 8, QBLK = 32, KVBLK = 64, QB = 256, D = 128;
constexpr int SHM_V = KVBLK * D * 2, SHM_K = KVBLK * D * 2;
constexpr int ATT_LDS = 2 * SHM_V + 2 * SHM_K + NW * 64 * 4;
constexpr float SCALE = 0.08838834764831845f;
constexpr float THR = 8.f;
constexpr int APITCH = NPROJ, OPITCH = DM;
typedef LAS char* lptr;
typedef const LAS char* lcptr;

#define KSWZ(row, colB) ((row) * 256 + ((colB) ^ (((row) & 7) << 4)))
__device__ __forceinline__ int v_st(int k, int c) { const int kk = (k & ~0xC) | ((k & 4) << 1) | ((k & 8) >> 1); return ((kk >> 3) * 4 + (c >> 5)) * 512 + ((kk & 7) * 32 + (c & 31)) * 2; }
__device__ __forceinline__ int v_rd_base(int lane) { return ((lane & 3) << 3) | (((lane >> 2) & 3) << 6) | (((lane >> 4) & 1) << 5) | (((lane >> 5) & 1) << 8); }
constexpr int v_rd_off(int d0, int ks, int half) { return d0 * 512 + ks * 4096 + half * 2048; }
__device__ __forceinline__ int crow(int r, int hi) { return (r & 3) + 8 * (r >> 2) + 4 * hi; }
__device__ __forceinline__ bf16x8 load8(const bf16_t* p) { return *reinterpret_cast<const bf16x8*>(p); }

__device__ __forceinline__ void pack_p(const f32x16& p0, const f32x16& p1, bf16x8& pa0, bf16x8& pa1, bf16x8& pa2, bf16x8& pa3) {
#define PK4(P, B_, OUT) do { unsigned a0 = cvt_pk_bf16(P[B_+0], P[B_+1]), a1 = cvt_pk_bf16(P[B_+2], P[B_+3]);                          \
        unsigned b0 = cvt_pk_bf16(P[B_+4], P[B_+5]), b1 = cvt_pk_bf16(P[B_+6], P[B_+7]);                                             \
        auto r0 = __builtin_amdgcn_permlane32_swap(a0, b0, false, false); auto r1 = __builtin_amdgcn_permlane32_swap(a1, b1, false, false); \
        u32x4 w = {r0[0], r1[0], r0[1], r1[1]}; OUT = __builtin_bit_cast(bf16x8, w); } while (0)
    PK4(p0, 0, pa0); PK4(p0, 8, pa1); PK4(p1, 0, pa2); PK4(p1, 8, pa3);
#undef PK4
}
__device__ __forceinline__ void partialSM(f32x16& p0, f32x16& p1, float& m_reg, float& mn, float& alpha) {
    float pmax = p0[0];
#pragma unroll
    for (int r = 1; r < 16; ++r) pmax = fmaxf(pmax, p0[r]);
#pragma unroll
    for (int r = 0; r < 16; ++r) pmax = fmaxf(pmax, p1[r]);
    { auto rr = __builtin_amdgcn_permlane32_swap(__float_as_uint(pmax), __float_as_uint(pmax), false, false);
      pmax = fmaxf(__uint_as_float(rr[0]), __uint_as_float(rr[1])); }
    constexpr float C2 = 1.4426950408889634f * SCALE;
    if (__builtin_expect(__all((pmax - m_reg) * SCALE <= THR), 1)) { mn = m_reg; alpha = 1.f; }
    else { mn = fmaxf(m_reg, pmax); alpha = __builtin_amdgcn_exp2f((m_reg - mn) * C2); m_reg = mn; }
    const float mnL = -mn * C2;
#pragma unroll
    for (int r = 0; r < 16; ++r) p0[r] = fmaf(p0[r], C2, mnL);
#pragma unroll
    for (int r = 0; r < 16; ++r) p1[r] = fmaf(p1[r], C2, mnL);
#pragma unroll
    for (int r = 0; r < 16; ++r) p0[r] = __builtin_amdgcn_exp2f(p0[r]);
}
__device__ __forceinline__ void finishSM(f32x16& p0, f32x16& p1, float alpha, float& l_reg, bf16x8& pa0, bf16x8& pa1, bf16x8& pa2, bf16x8& pa3) {
#pragma unroll
    for (int r = 0; r < 16; ++r) p1[r] = __builtin_amdgcn_exp2f(p1[r]);
    float ps = 0;
#pragma unroll
    for (int r = 0; r < 16; ++r) ps += p0[r];
#pragma unroll
    for (int r = 0; r < 16; ++r) ps += p1[r];
    { auto rr = __builtin_amdgcn_permlane32_swap(__float_as_uint(ps), __float_as_uint(ps), false, false);
      ps = __uint_as_float(rr[0]) + __uint_as_float(rr[1]); }
    l_reg = l_reg * alpha + ps;
    pack_p(p0, p1, pa0, pa1, pa2, pa3);
}
template <int KB>
__device__ __forceinline__ void qkt(f32x16& p0, f32x16& p1, lcptr K_lds, int r32, int hi, const bf16x8* qr, float init = 0.f) {
#pragma unroll
    for (int r = 0; r < 16; ++r) { p0[r] = init; p1[r] = init; }
    lcptr kb[4];
#pragma unroll
    for (int dd = 0; dd < 4; ++dd) kb[dd] = K_lds + KB * SHM_K + KSWZ(r32, (dd * 16 + hi * 8) * 2);
#pragma unroll
    for (int d0 = 0; d0 < 8; ++d0) { lcptr a = kb[d0 & 3] + (d0 >> 2) * 128;
        bf16x8 b0 = *reinterpret_cast<const LAS bf16x8*>(a);
        bf16x8 b1 = *reinterpret_cast<const LAS bf16x8*>(a + 32 * 256);
        p0 = __builtin_amdgcn_mfma_f32_32x32x16_bf16(b0, qr[d0], p0, 0, 0, 0);
        p1 = __builtin_amdgcn_mfma_f32_32x32x16_bf16(b1, qr[d0], p1, 0, 0, 0); }
}
#define TRRD(dst, vb, off) asm volatile("ds_read_b64_tr_b16 %0, %1 offset:%2" : "=&v"(dst) : "v"(vb), "i"(off) : "memory")
template <int VOFF>
__device__ __forceinline__ void pv_tile(f32x16* o, int vb0, bf16x8 pa0, bf16x8 pa1, bf16x8 pa2, bf16x8 pa3) {
#define PV_D0(d0) do { s16x4 l0, l1, l2, l3, h0, h1, h2, h3; constexpr int b_ = VOFF + v_rd_off(d0, 0, 0); \
        TRRD(l0, vb0, b_); TRRD(h0, vb0, b_ + 2048); TRRD(l1, vb0, b_ + 4096); TRRD(h1, vb0, b_ + 6144); TRRD(l2, vb0, b_ + 8192); TRRD(h2, vb0, b_ + 10240); TRRD(l3, vb0, b_ + 12288); TRRD(h3, vb0, b_ + 14336); \
        asm volatile("s_waitcnt lgkmcnt(0)" ::: "memory"); SBAR(); \
        o[d0] = __builtin_amdgcn_mfma_f32_32x32x16_bf16(pa0, (bf16x8){l0[0], l0[1], l0[2], l0[3], h0[0], h0[1], h0[2], h0[3]}, o[d0], 0, 0, 0);   \
        o[d0] = __builtin_amdgcn_mfma_f32_32x32x16_bf16(pa1, (bf16x8){l1[0], l1[1], l1[2], l1[3], h1[0], h1[1], h1[2], h1[3]}, o[d0], 0, 0, 0);   \
        o[d0] = __builtin_amdgcn_mfma_f32_32x32x16_bf16(pa2, (bf16x8){l2[0], l2[1], l2[2], l2[3], h2[0], h2[1], h2[2], h2[3]}, o[d0], 0, 0, 0);   \
        o[d0] = __builtin_amdgcn_mfma_f32_32x32x16_bf16(pa3, (bf16x8){l3[0], l3[1], l3[2], l3[3], h3[0], h3[1], h3[2], h3[3]}, o[d0], 0, 0, 0); } while (0)
    PV_D0(0); PV_D0(1); PV_D0(2); PV_D0(3);
#undef PV_D0
}
template <int VOFF, int D0>
__device__ __forceinline__ void tr_frags(int vb0, bf16x8& f0, bf16x8& f1, bf16x8& f2, bf16x8& f3) {
    s16x4 l0, l1, l2, l3, h0, h1, h2, h3; constexpr int b_ = VOFF + v_rd_off(D0, 0, 0);
    TRRD(l0, vb0, b_); TRRD(h0, vb0, b_ + 2048); TRRD(l1, vb0, b_ + 4096); TRRD(h1, vb0, b_ + 6144); TRRD(l2, vb0, b_ + 8192); TRRD(h2, vb0, b_ + 10240); TRRD(l3, vb0, b_ + 12288); TRRD(h3, vb0, b_ + 14336);
    asm volatile("s_waitcnt lgkmcnt(0)" ::: "memory"); SBAR();
    f0 = (bf16x8){l0[0], l0[1], l0[2], l0[3], h0[0], h0[1], h0[2], h0[3]}; f1 = (bf16x8){l1[0], l1[1], l1[2], l1[3], h1[0], h1[1], h1[2], h1[3]};
    f2 = (bf16x8){l2[0], l2[1], l2[2], l2[3], h2[0], h2[1], h2[2], h2[3]}; f3 = (bf16x8){l3[0], l3[1], l3[2], l3[3], h3[0], h3[1], h3[2], h3[3]};
}

struct MobaRef { const bf16_t* Q; const bf16_t* K; const bf16_t* V; bf16_t* O; const unsigned* sel; int qb; };
struct MobaSeam { bf16x8 qr[8]; bf16x8 st_v0, st_v1, st_k0, st_k1; unsigned sel; };
#define AROW(p, k0, rr) ((p) + (size_t)((k0) + (rr)) * APITCH + sc)
#define VMW() asm volatile("s_waitcnt vmcnt(0)" ::: "memory")
#define VMWN(n) asm volatile("s_waitcnt vmcnt(%0)" :: "i"(n) : "memory")
#define SLOAD_H(Kp, Vp, k0) do { S.st_v0 = load8(AROW(Vp, k0, sr)); S.st_v1 = load8(AROW(Vp, k0, 32 + sr));              \
                         S.st_k0 = load8(AROW(Kp, k0, sr)); S.st_k1 = load8(AROW(Kp, k0, 32 + sr)); } while (0)
#define SWRITE_HK(bf) do { *(LAS bf16x8*)(K_lds + (bf) * SHM_K + kws) = S.st_k0; *(LAS bf16x8*)(K_lds + (bf) * SHM_K + kws + 32 * 256) = S.st_k1; } while (0)
#define SWRITE_HV(bf) do { *(LAS bf16x8*)(V_lds + (bf) * SHM_V + vst0) = S.st_v0; *(LAS bf16x8*)(V_lds + (bf) * SHM_V + vst1) = S.st_v1; } while (0)
#define SWRITE_H(bf) do { SWRITE_HV(bf); SWRITE_HK(bf); } while (0)

__device__ __forceinline__ void moba_prime(const MobaRef& cur, lptr lds, MobaSeam& S, int wave_s) {
    int tid = wave_s * 64 + lane_id(); asm volatile("" : "+v"(tid)); const int wid = __builtin_amdgcn_readfirstlane(tid >> 6), lane = tid & 63, r32 = lane & 31, hi = lane >> 5;
    const int sr = tid >> 4, sc = (tid & 15) * 8, kws = KSWZ(sr, sc * 2); lptr K_lds = lds + 2 * SHM_V;
#pragma unroll
    for (int d0 = 0; d0 < 8; ++d0) S.qr[d0] = load8(cur.Q + (size_t)(wid * QBLK + r32) * APITCH + d0 * 16 + hi * 8);
    S.sel = cur.sel[wid * QBLK + r32];
    SLOAD_H(cur.K, cur.V, 0); VMW(); SWRITE_HK(0);
    __syncthreads();
}
__device__ __forceinline__ void moba_block(const MobaRef& cur, const MobaRef& nxt, lptr lds, MobaSeam& S, int wave_s) {
    int tid = wave_s * 64 + lane_id(); asm volatile("" : "+v"(tid)); const int wid = __builtin_amdgcn_readfirstlane(tid >> 6), lane = tid & 63, r32 = lane & 31, hi = lane >> 5;
    const int qb = cur.qb, NT = 4 * (qb + 1);
    const int qlo = qb * QB + wid * QBLK, qm = qlo + r32 - 4 * hi;
    const unsigned sel = S.sel;
    lptr V_lds = lds; lptr K_lds = lds + 2 * SHM_V;
    LAS float* ws = (LAS float*)(lds + 2 * SHM_V + 2 * SHM_K) + wid * 64; LAS float* li_l = ws; LAS float* al_l = ws + 32;
    float m_reg = -1e30f, l_reg = 0; f32x16 o[4] = {};
    const int sr = tid >> 4, sc = (tid & 15) * 8, vst0 = v_st(sr, sc), vst1 = v_st(32 + sr, sc), kws = KSWZ(sr, sc * 2);
    const int vb0 = (int)(uintptr_t)V_lds + v_rd_base(lane);
    const bf16_t* Kh = cur.K; const bf16_t* Vh = cur.V;
    const float NEG = -__builtin_inff();
#define RESC(a) do { if (__any((a) < 1.f)) { if (hi == 0) al_l[r32] = (a); asm volatile("s_waitcnt lgkmcnt(0)" ::: "memory");              \
                     _Pragma("unroll") for (int d_ = 0; d_ < 4; ++d_) _Pragma("unroll") for (int r = 0; r < 16; ++r) o[d_][r] *= al_l[crow(r, hi)]; } } while (0)
#define KBASE(t) ((t) * KVBLK)
#define MASKT(P0_, P1_, t) do { const int kb_ = KBASE(t); const int jb_ = (t) >> 2;                                              \
        if (jb_ == qb) { if (kb_ + KVBLK - 1 > qlo) { const int dq_ = qm - kb_;                                                    \
            _Pragma("unroll") for (int r = 0; r < 16; ++r) { const int c_ = (r & 3) + 8 * (r >> 2);                                \
                if (dq_ - c_ < 0) P0_[r] = NEG; if (dq_ - c_ - 32 < 0) P1_[r] = NEG; } } }                                         \
        } while (0)
#define SELINIT(t) ((((t) >> 2) == qb || ((sel >> ((t) >> 2)) & 1u)) ? 0.f : NEG)
    constexpr int NQL = 9;
#define SEAM_K0() do { VMWN(NQL); SWRITE_HK(0); SBAR(); } while (0)
    f32x16 pA0, pA1, pB0, pB1; float mnA, mnB, alA, alB; bf16x8 pa0, pa1, pa2, pa3;
    SWRITE_HV(0); SBAR();
    SLOAD_H(Kh, Vh, KBASE(1));
    SBAR(); qkt<0>(pA0, pA1, K_lds, r32, hi, S.qr, SELINIT(0));
    MASKT(pA0, pA1, 0); partialSM(pA0, pA1, m_reg, mnA, alA);
    VMW(); SWRITE_H(1);
    __syncthreads();
#define HALF_STEP(PX0, PX1, mnX, alX, PY0, PY1, alY, t, KB, VB, SB) do {                                                      \
        SBAR(); qkt<KB>(PX0, PX1, K_lds, r32, hi, S.qr, SELINIT(t));                                                           \
        finishSM(PY0, PY1, alY, l_reg, pa0, pa1, pa2, pa3); SBAR();                                                           \
        if ((t) + 1 < NT) { SLOAD_H(Kh, Vh, KBASE((t) + 1)); SBAR(); }                                                        \
        pv_tile<VB * SHM_V>(o, vb0, pa0, pa1, pa2, pa3); MASKT(PX0, PX1, (t)); partialSM(PX0, PX1, m_reg, mnX, alX);          \
        __syncthreads();                                                                                                      \
        if ((t) + 1 < NT) { VMW(); SWRITE_H(SB); }                                                                            \
        RESC(alX); __syncthreads(); } while (0)
    for (int t = 1; t + 1 < NT; t += 2) {
        HALF_STEP(pB0, pB1, mnB, alB, pA0, pA1, alA, t, 1, 0, 0);
        HALF_STEP(pA0, pA1, mnA, alA, pB0, pB1, alB, t + 1, 0, 1, 1);
    }
    SBAR(); qkt<1>(pB0, pB1, K_lds, r32, hi, S.qr, SELINIT(NT - 1)); SBAR();
    SLOAD_H(nxt.K, nxt.V, 0); SBAR();
#pragma unroll
    for (int d0 = 0; d0 < 8; ++d0) S.qr[d0] = load8(nxt.Q + (size_t)(wid * QBLK + r32) * APITCH + d0 * 16 + hi * 8);
    S.sel = nxt.sel[wid * QBLK + r32];
    SBAR();
    finishSM(pA0, pA1, alA, l_reg, pa0, pa1, pa2, pa3); SBAR();
    pv_tile<0>(o, vb0, pa0, pa1, pa2, pa3);
    MASKT(pB0, pB1, NT - 1); partialSM(pB0, pB1, m_reg, mnB, alB); __syncthreads(); RESC(alB);
    finishSM(pB0, pB1, alB, l_reg, pa0, pa1, pa2, pa3); SBAR(); pv_tile<SHM_V>(o, vb0, pa0, pa1, pa2, pa3);
    SBAR(); SEAM_K0();
    if (hi == 0) li_l[r32] = l_reg; asm volatile("s_waitcnt lgkmcnt(0)" ::: "memory");
    float rli[16];
#pragma unroll
    for (int r = 0; r < 16; ++r) rli[r] = __builtin_amdgcn_rcpf(li_l[crow(r, hi)]);
    bf16_t* Ow = cur.O + (size_t)(wid * QBLK) * OPITCH;
#pragma unroll
    for (int r = 0; r < 16; ++r) { const int orow = crow(r, hi);
#pragma unroll
        for (int d0 = 0; d0 < 4; ++d0) { const float v = o[d0][r] * rli[r];
            const float vn = __shfl_xor(v, 1);
            if ((r32 & 1) == 0) *(unsigned*)(Ow + (size_t)orow * OPITCH + d0 * 32 + r32) = cvt_pk_bf16(v, vn); } }
    __syncthreads();
#undef RESC
#undef KBASE
#undef MASKT
#undef SELINIT
#undef SEAM_K0
#undef HALF_STEP
}

__device__ __forceinline__ MobaRef moba_ref(const Params& p, int bh, int qb) {
    const int b = bh / MH, h = bh % MH;
    const bf16_t* proj = (const bf16_t*)(p.ws + WS_PROJ); bf16_t* mixed = (bf16_t*)(p.ws + WS_MIXED); const unsigned* selp = (const unsigned*)(p.ws + WS_SEL);
    MobaRef r; const size_t tok0 = (size_t)b * SEQ;
    r.Q = proj + (tok0 + (size_t)qb * QB) * APITCH + C_MQ + h * HD; r.K = proj + tok0 * APITCH + C_MK + h * HD; r.V = proj + tok0 * APITCH + C_MV + h * HD;
    r.O = mixed + (tok0 + (size_t)qb * QB) * OPITCH + h * HD; r.sel = selp + (size_t)bh * SEQ + qb * QB; r.qb = qb; return r;
}
__device__ __forceinline__ void phase_moba(const Params& p, lptr lds, int wave_s) {
    const int G = gridDim.x; const int bx = blockIdx.x; const int vcu = (G % 8 == 0) ? (bx % 8) * (G / 8) + bx / 8 : bx;
    constexpr int NITEM = NBATCH * MH * 8;
    int L = vcu; if (L >= NITEM) return;
    int pass = 0;
    MobaRef cur = moba_ref(p, L >> 3, L & 7);
    MobaSeam S;
    moba_prime(cur, lds, S, wave_s);
    for (;;) {
        const bool more_pass = pass == 0, more_item = L + G < NITEM, last = !more_pass && !more_item;
        int Ln = L, passn = 1;
        if (!more_pass) { passn = 0; Ln = more_item ? L + G : L; }
        const MobaRef nxt = last ? cur : moba_ref(p, Ln >> 3, passn ? 15 - (Ln & 7) : (Ln & 7));
        moba_block(cur, nxt, lds, S, wave_s);
        if (last) break;
        cur = nxt; pass = passn; L = Ln;
    }
}
#undef SLOAD_H
#undef SWRITE_HK
#undef SWRITE_HV
#undef SWRITE_H
#undef VMWN
}
namespace att {
__device__ __forceinline__ void stage_vstyle(lptr dst, const bf16_t* src, size_t pitch, int tid) {
    const int sr = tid >> 4, sc = (tid & 15) * 8;
    const bf16x8 a = load8(src + (size_t)sr * pitch + sc), b = load8(src + (size_t)(32 + sr) * pitch + sc);
    *(LAS bf16x8*)(dst + v_st(sr, sc)) = a; *(LAS bf16x8*)(dst + v_st(32 + sr, sc)) = b;
}
__device__ __forceinline__ void stage_kstyle(lptr dst, const bf16_t* src, size_t pitch, int tid) {
    const int sr = tid >> 4, sc = (tid & 15) * 8;
    const bf16x8 a = load8(src + (size_t)sr * pitch + sc), b = load8(src + (size_t)(32 + sr) * pitch + sc);
    *(LAS bf16x8*)(dst + KSWZ(sr, sc * 2)) = a; *(LAS bf16x8*)(dst + KSWZ(sr, sc * 2) + 32 * 256) = b;
}

__device__ __forceinline__ void phase_moba_select(const Params& p, lptr lds, int tid_) { int tid = tid_; asm volatile("" : "+v"(tid));
    const bf16_t* proj = (const bf16_t*)(p.ws + WS_PROJ); const float* kmean = (const float*)(p.ws + WS_KMEAN); unsigned* selp = (unsigned*)(p.ws + WS_SEL);
    LAS float* gl = (LAS float*)lds;
    const int wave = __builtin_amdgcn_readfirstlane(tid >> 6), lane = tid & 63, row = lane & 15, kq = lane >> 4;
    for (int u = blockIdx.x; u < NBATCH * MH * NBLK; u += gridDim.x) {
        const int bh = u / NBLK, qb = u % NBLK, b = bh / MH, h = bh % MH;
        if (qb == 0) { if (tid < 256) selp[(size_t)bh * SEQ + tid] = 0u; continue; }
        const bf16_t* qsrc = proj + ((size_t)b * SEQ + qb * 256 + wave * 32) * NPROJ + C_MQ + h * HD;
        const float* km = kmean + (size_t)bh * NBLK * HD + (size_t)row * HD;
        bf16x8 a0[4], a1[4]; f32x4 k0[4], k1[4];
#pragma unroll
        for (int ks = 0; ks < 4; ++ks) { a0[ks] = load8(qsrc + (size_t)row * NPROJ + 32 * ks + 8 * kq); a1[ks] = load8(qsrc + (size_t)(16 + row) * NPROJ + 32 * ks + 8 * kq);
            k0[ks] = *(const f32x4*)(km + 32 * ks + 8 * kq); k1[ks] = *(const f32x4*)(km + 32 * ks + 8 * kq + 4); }
        f32x4 g0 = {0.f, 0.f, 0.f, 0.f}, g1 = {0.f, 0.f, 0.f, 0.f};
#pragma unroll
        for (int ks = 0; ks < 4; ++ks) {
            u32x4 bw; bw.x = cvt_pk_bf16(k0[ks][0], k0[ks][1]); bw.y = cvt_pk_bf16(k0[ks][2], k0[ks][3]); bw.z = cvt_pk_bf16(k1[ks][0], k1[ks][1]); bw.w = cvt_pk_bf16(k1[ks][2], k1[ks][3]);
            const f32x4 r0 = {k0[ks][0] - bflo(bw.x), k0[ks][1] - bfhi(bw.x), k0[ks][2] - bflo(bw.y), k0[ks][3] - bfhi(bw.y)}, r1 = {k1[ks][0] - bflo(bw.z), k1[ks][1] - bfhi(bw.z), k1[ks][2] - bflo(bw.w), k1[ks][3] - bfhi(bw.w)};
            const bf16x8 bh_ = __builtin_bit_cast(bf16x8, bw), bl_ = pack8(r0, r1);
            g0 = __builtin_amdgcn_mfma_f32_16x16x32_bf16(a0[ks], bh_, g0, 0, 0, 0); g0 = __builtin_amdgcn_mfma_f32_16x16x32_bf16(a0[ks], bl_, g0, 0, 0, 0);
            g1 = __builtin_amdgcn_mfma_f32_16x16x32_bf16(a1[ks], bh_, g1, 0, 0, 0); g1 = __builtin_amdgcn_mfma_f32_16x16x32_bf16(a1[ks], bl_, g1, 0, 0, 0); }
#pragma unroll
        for (int r = 0; r < 4; ++r) { gl[(wave * 32 + kq * 4 + r) * 16 + row] = g0[r]; gl[(wave * 32 + 16 + kq * 4 + r) * 16 + row] = g1[r]; }
        __syncthreads();
        if (tid < 256) {
            float gv[16];
#pragma unroll
            for (int n = 0; n < 16; ++n) gv[n] = (n < qb) ? gl[tid * 16 + n] : -__builtin_inff();
            unsigned m = 0u;
#pragma unroll
            for (int k = 0; k < 3; ++k) { float best = -__builtin_inff(); int bi = -1;
#pragma unroll
                for (int n = 0; n < 16; ++n) { const bool tk = gv[n] > best; best = tk ? gv[n] : best; bi = tk ? n : bi; }
                if (bi >= 0) m |= 1u << bi;
#pragma unroll
                for (int n = 0; n < 16; ++n) gv[n] = (n == bi) ? -__builtin_inff() : gv[n]; }
            selp[(size_t)bh * SEQ + qb * 256 + tid] = m;
        }
        __syncthreads();
    }
}

__device__ __forceinline__ void phase_gla_state(const Params& p, lptr lds, int tid_) { int tid = tid_; asm volatile("" : "+v"(tid));
    const bf16_t* proj = (const bf16_t*)(p.ws + WS_PROJ); const float* dend = (const float*)(p.ws + WS_DEND); float* U = (float*)(p.ws + WS_U);
    const int wid = __builtin_amdgcn_readfirstlane(tid >> 6), lane = tid & 63, r32 = lane & 31, hi = lane >> 5;
    const int dkb = wid & 3, half = wid >> 2;
    const int vb0 = (int)(uintptr_t)lds + v_rd_base(lane);
    for (int u = blockIdx.x; u < NBATCH * GH * NBLK; u += gridDim.x) {
        const int bh = u / NBLK, j = u % NBLK, b = bh / GH, h = bh % GH;
        const size_t tok0 = (size_t)b * SEQ + j * 256;
        f32x16 o[4] = {};
        for (int t = 0; t < 4; ++t) {
            __syncthreads();
            const bf16_t* rowp = proj + (tok0 + t * 64) * NPROJ;
            stage_vstyle(lds, rowp + C_GK + h * GDK, NPROJ, tid);
            stage_vstyle(lds + SHM_V, rowp + C_GV + h * GDV, NPROJ, tid);
            stage_vstyle(lds + 2 * SHM_V, rowp + C_GV + h * GDV + 128, NPROJ, tid);
            __syncthreads();
            bf16x8 a0, a1, a2, a3;
            if (dkb == 0) tr_frags<0, 0>(vb0, a0, a1, a2, a3); else if (dkb == 1) tr_frags<0, 1>(vb0, a0, a1, a2, a3); else if (dkb == 2) tr_frags<0, 2>(vb0, a0, a1, a2, a3); else tr_frags<0, 3>(vb0, a0, a1, a2, a3);
            if (half == 0) pv_tile<SHM_V>(o, vb0, a0, a1, a2, a3); else pv_tile<2 * SHM_V>(o, vb0, a0, a1, a2, a3);
        }
        float dv[16];
#pragma unroll
        for (int r = 0; r < 16; ++r) dv[r] = dend[(size_t)u * GDK + dkb * 32 + crow(r, hi)];
        float* Uo = U + (size_t)u * (GDK * GDV);
#pragma unroll
        for (int r = 0; r < 16; ++r) { const int k = dkb * 32 + crow(r, hi);
#pragma unroll
            for (int d0 = 0; d0 < 4; ++d0) Uo[(size_t)k * GDV + half * 128 + d0 * 32 + r32] = o[d0][r] * dv[r]; }
    }
    __syncthreads();
}

__device__ __forceinline__ void phase_gla_scan(const Params& p, int tid_) { int tid = tid_; asm volatile("" : "+v"(tid));
    const float* U = (const float*)(p.ws + WS_U); const float* dend = (const float*)(p.ws + WS_DEND); bf16_t* Sj = (bf16_t*)(p.ws + WS_SJ);
    constexpr int NEL = NBATCH * GH * GDK * GDV / 4;
    for (int i = blockIdx.x * NTHREADS + tid; i < NEL; i += gridDim.x * NTHREADS) {
        const int bh = i / (GDK * GDV / 4), e4 = i % (GDK * GDV / 4), k = e4 / (GDV / 4);
        f32x4 S = {0.f, 0.f, 0.f, 0.f};
        f32x4 uv[NBLK]; float dd[NBLK];
#pragma unroll
        for (int j = 0; j < NBLK; ++j) { uv[j] = *(const f32x4*)(U + ((size_t)(bh * NBLK + j) * (GDK * GDV)) + (size_t)e4 * 4); dd[j] = dend[(size_t)(bh * NBLK + j) * GDK + k]; }
#pragma unroll
        for (int j = 0; j < NBLK; ++j) {
            u32x2 w; w.x = cvt_pk_bf16(S[0], S[1]); w.y = cvt_pk_bf16(S[2], S[3]);
            *(u32x2*)(Sj + ((size_t)(bh * NBLK + j) * (GDK * GDV)) + (size_t)e4 * 4) = w;
            S = S * dd[j] + uv[j]; }
    }
}

__device__ __forceinline__ void phase_gla_out(const Params& p, lptr lds, int tid_) { int tid = tid_; asm volatile("" : "+v"(tid));
    const bf16_t* proj = (const bf16_t*)(p.ws + WS_PROJ); const bf16_t* Sj = (const bf16_t*)(p.ws + WS_SJ); bf16_t* mixed = (bf16_t*)(p.ws + WS_MIXED);
    const int wid = __builtin_amdgcn_readfirstlane(tid >> 6), lane = tid & 63, r32 = lane & 31, hi = lane >> 5;
    constexpr int BUF = 3 * SHM_V;
    const int vb0 = (int)(uintptr_t)lds + v_rd_base(lane), vb1 = vb0 + BUF;
    const int sr = tid >> 4, sc = (tid & 15) * 8;
    const int kws = KSWZ(sr, sc * 2), vst0 = v_st(sr, sc), vst1 = v_st(32 + sr, sc);
    for (int u = blockIdx.x; u < NBATCH * GH * NBLK; u += gridDim.x) {
        const int bh = u / NBLK, j = u % NBLK, b = bh / GH, h = bh % GH;
        const size_t tok0 = (size_t)b * SEQ + j * 256;
        bf16x8 qr[8];
#pragma unroll
        for (int d0 = 0; d0 < 8; ++d0) qr[d0] = load8(proj + (tok0 + wid * 32 + r32) * NPROJ + C_GQ + h * GDK + d0 * 16 + hi * 8);
        f32x16 o[8] = {};
        bf16x8 sk0, sk1, sa0, sa1, sb0, sb1;
        const bf16_t* sp = Sj + (size_t)u * (GDK * GDV);
#define GO_LOAD(s_) do { if ((s_) < 4) { const bf16_t* rp = proj + (tok0 + (s_) * 64) * NPROJ; \
            sk0 = load8(rp + (size_t)sr * NPROJ + C_GK + h * GDK + sc); sk1 = load8(rp + (size_t)(32 + sr) * NPROJ + C_GK + h * GDK + sc); \
            sa0 = load8(rp + (size_t)sr * NPROJ + C_GV + h * GDV + sc); sa1 = load8(rp + (size_t)(32 + sr) * NPROJ + C_GV + h * GDV + sc); \
            sb0 = load8(rp + (size_t)sr * NPROJ + C_GV + h * GDV + 128 + sc); sb1 = load8(rp + (size_t)(32 + sr) * NPROJ + C_GV + h * GDV + 128 + sc); } \
          else { const bf16_t* rp = sp + (size_t)((s_) - 4) * 64 * GDV; \
            sa0 = load8(rp + (size_t)sr * GDV + sc); sa1 = load8(rp + (size_t)(32 + sr) * GDV + sc); \
            sb0 = load8(rp + (size_t)sr * GDV + 128 + sc); sb1 = load8(rp + (size_t)(32 + sr) * GDV + 128 + sc); } } while (0)
#define GO_WRITE(s_, bufo) do { if ((s_) < 4) { *(LAS bf16x8*)(lds + (bufo) + kws) = sk0; *(LAS bf16x8*)(lds + (bufo) + kws + 32 * 256) = sk1; } \
            *(LAS bf16x8*)(lds + (bufo) + SHM_V + vst0) = sa0; *(LAS bf16x8*)(lds + (bufo) + SHM_V + vst1) = sa1; \
            *(LAS bf16x8*)(lds + (bufo) + 2 * SHM_V + vst0) = sb0; *(LAS bf16x8*)(lds + (bufo) + 2 * SHM_V + vst1) = sb1; } while (0)
#define GO_STEP(s_, B_) do { GO_LOAD(s_); __syncthreads(); GO_WRITE(s_, (B_) * BUF); __syncthreads(); \
            if ((s_) < 4) { if ((s_) * 64 <= wid * 32 + 31) { f32x16 p0, p1; qkt<0>(p0, p1, lds + (B_) * BUF, r32, hi, qr); \
                    const int dq = wid * 32 + r32 - 4 * hi - (s_) * 64; \
                    _Pragma("unroll") for (int r = 0; r < 16; ++r) { const int c_ = (r & 3) + 8 * (r >> 2); if (dq - c_ < 0) p0[r] = 0.f; if (dq - c_ - 32 < 0) p1[r] = 0.f; } \
                    bf16x8 pa0, pa1, pa2, pa3; pack_p(p0, p1, pa0, pa1, pa2, pa3); \
                    pv_tile<SHM_V>(o, (B_) ? vb1 : vb0, pa0, pa1, pa2, pa3); pv_tile<2 * SHM_V>(o + 4, (B_) ? vb1 : vb0, pa0, pa1, pa2, pa3); } } \
            else { pv_tile<SHM_V>(o, (B_) ? vb1 : vb0, qr[4 * ((s_) - 4)], qr[4 * ((s_) - 4) + 1], qr[4 * ((s_) - 4) + 2], qr[4 * ((s_) - 4) + 3]); \
                   pv_tile<2 * SHM_V>(o + 4, (B_) ? vb1 : vb0, qr[4 * ((s_) - 4)], qr[4 * ((s_) - 4) + 1], qr[4 * ((s_) - 4) + 2], qr[4 * ((s_) - 4) + 3]); } } while (0)
        GO_STEP(0, 0); GO_STEP(1, 0); GO_STEP(2, 0); GO_STEP(3, 0); GO_STEP(4, 0); GO_STEP(5, 0);
#undef GO_LOAD
#undef GO_WRITE
#undef GO_STEP
        int hi_e = hi, r32_e = r32; asm volatile("" : "+v"(hi_e), "+v"(r32_e));
        float wv[8];
#pragma unroll
        for (int d0 = 0; d0 < 8; ++d0) wv[d0] = p.gla_norm_w[d0 * 32 + r32_e];
        const bf16_t* ggp = proj + (tok0 + wid * 32) * NPROJ + C_GG + h * GDV + r32_e;
        bf16_t* op = mixed + (tok0 + wid * 32) * DM + 1024 + h * GDV + r32_e;
#pragma unroll
        for (int rb = 0; rb < 16; rb += 4) {
            bf16_t graw[4][8];
#pragma unroll
            for (int q = 0; q < 4; ++q)
#pragma unroll
                for (int d0 = 0; d0 < 8; ++d0) graw[q][d0] = ggp[(size_t)crow(rb + q, hi_e) * NPROJ + d0 * 32];
#pragma unroll
            for (int q = 0; q < 4; ++q) { const int r = rb + q, orow = crow(r, hi_e);
                float ss = 0.f;
#pragma unroll
                for (int d0 = 0; d0 < 8; ++d0) ss += o[d0][r] * o[d0][r];
                ss += __shfl_xor(ss, 1); ss += __shfl_xor(ss, 2); ss += __shfl_xor(ss, 4); ss += __shfl_xor(ss, 8); ss += __shfl_xor(ss, 16);
                const float rsr = 1.0f / sqrtf(ss * (1.0f / GDV) + EPS);
#pragma unroll
                for (int d0 = 0; d0 < 8; ++d0) { const float g = bf2f(graw[q][d0]); const float sg = g * __builtin_amdgcn_rcpf(1.0f + __expf(-g));
                    const float v = o[d0][r] * rsr * wv[d0] * sg; const float vn = __shfl_xor(v, 1);
                    if ((r32_e & 1) == 0) *(unsigned*)(op + (size_t)orow * DM + d0 * 32) = cvt_pk_bf16(v, vn); } }
            asm volatile("" ::: "memory"); }
    }
    __syncthreads();
}
}

__device__ __forceinline__ void phase_route(const Params& p, const Ctx& c0) { const Ctx c = fresh_ctx(c0);
    const int* hist = (const int*)(p.ws + WS_HIST); const int* topi = (const int*)(p.ws + WS_TOPI); const float* rstd2 = (const float*)(p.ws + WS_RSTD2);
    int* dest = (int*)(p.ws + WS_DEST); int* row_tok = (int*)(p.ws + WS_ROWTOK); float* row_rstd = (float*)(p.ws + WS_ROWRSTD); int* blk = (int*)(p.ws + WS_BLKE);
    LAS int* cnt = (LAS int*)c.lds; LAS int* before = cnt + 32; LAS int* pstart = cnt + 64; LAS int* ea = cnt + 128;
    for (int g = blockIdx.x; g < T / 64; g += gridDim.x) {
        if (c.tid < 64) cnt[c.tid] = 0;
        __syncthreads();
        { const int e = c.tid & 31, part = c.tid >> 5; int tot = 0, bef = 0;
#pragma unroll
            for (int i = 0; i < 16; ++i) { const int gg = part * 16 + i; const int v = hist[gg * 32 + e]; tot += v; bef += (gg < g) ? v : 0; }
            atomicAdd((int*)&cnt[e], tot); atomicAdd((int*)&before[e], bef); }
        __syncthreads();
        if (c.tid == 0) { int acc = 0; for (int e = 0; e < NE; ++e) { pstart[e] = acc; acc += ((cnt[e] + 255) >> 8) << 8; } pstart[NE] = acc; }
        if (c.tid < 256) ea[c.tid] = topi[(size_t)g * 256 + c.tid];
        __syncthreads();
        LAS int* wcnt = cnt + 512;
        int e_my = 0, rank = 0;
        if (c.tid < 256) { e_my = ea[c.tid];
            for (int k = 0; k < NE; ++k) { const unsigned long long mk = __ballot(e_my == k);
                if (e_my == k) rank = __popcll(mk & ((1ull << c.lane) - 1ull));
                if (c.lane == 0) wcnt[c.wave * 32 + k] = __popcll(mk); } }
        __syncthreads();
        if (c.tid < 256) {
            for (int w = 0; w < c.wave; ++w) rank += wcnt[w * 32 + e_my];
            const int d = pstart[e_my] + before[e_my] + rank; const int tok = g * 64 + (c.tid >> 2);
            dest[(size_t)g * 256 + c.tid] = d; row_tok[d] = tok; row_rstd[d] = rstd2[tok];
        }
        if (g == 0 && c.tid < 64) {
            const int nb = pstart[NE] >> 8; if (c.tid == 0) blk[0] = nb;
            for (int bq = c.tid; bq < nb; bq += 64) { int e = 0; for (int q = 0; q < NE; ++q) e += (pstart[q + 1] <= bq * 256) ? 1 : 0; blk[64 + bq] = e < NE ? e : NE - 1; }
        }
        __syncthreads();
    }
}

__device__ __forceinline__ void phase_combine(const Params& p, const Ctx& c0) { const Ctx c = fresh_ctx(c0);
    const float* X1 = (const float*)(p.ws + WS_X1); const unsigned char* Y = (const unsigned char*)(p.ws + WS_Y); const int* dest = (const int*)(p.ws + WS_DEST); const float* topg = (const float*)(p.ws + WS_TOPG);
    for (int t = blockIdx.x * NWAVES + c.wave; t < T; t += gridDim.x * NWAVES) {
        const int4 d4 = *(const int4*)(dest + (size_t)t * 4); const float4 g4 = *(const float4*)(topg + (size_t)t * 4);
        const int dd[4] = {d4.x, d4.y, d4.z, d4.w}; const float gg[4] = {g4.x * (1.0f / Y_SCALE), g4.y * (1.0f / Y_SCALE), g4.z * (1.0f / Y_SCALE), g4.w * (1.0f / Y_SCALE)};
        f32x4 v[8]; u32x2 yw[4][4]; float ss = 0.f;
#pragma unroll
        for (int j = 0; j < 4; ++j) { v[2 * j] = *(const f32x4*)(X1 + (size_t)t * DM + j * 512 + c.lane * 8); v[2 * j + 1] = *(const f32x4*)(X1 + (size_t)t * DM + j * 512 + c.lane * 8 + 4); }
#pragma unroll
        for (int k = 0; k < 4; ++k)
#pragma unroll
            for (int j = 0; j < 4; ++j) yw[k][j] = *(const u32x2*)(Y + (size_t)dd[k] * DM + j * 512 + c.lane * 8);
#pragma unroll
        for (int k = 0; k < 4; ++k)
#pragma unroll
            for (int j = 0; j < 4; ++j) { const f32x2 a = __builtin_amdgcn_cvt_pk_f32_fp8(yw[k][j].x, false), b = __builtin_amdgcn_cvt_pk_f32_fp8(yw[k][j].x, true);
                const f32x2 cc = __builtin_amdgcn_cvt_pk_f32_fp8(yw[k][j].y, false), d = __builtin_amdgcn_cvt_pk_f32_fp8(yw[k][j].y, true);
                v[2 * j][0] += gg[k] * a[0]; v[2 * j][1] += gg[k] * a[1]; v[2 * j][2] += gg[k] * b[0]; v[2 * j][3] += gg[k] * b[1];
                v[2 * j + 1][0] += gg[k] * cc[0]; v[2 * j + 1][1] += gg[k] * cc[1]; v[2 * j + 1][2] += gg[k] * d[0]; v[2 * j + 1][3] += gg[k] * d[1]; }
#pragma unroll
        for (int j = 0; j < 8; ++j) ss += (v[j][0] * v[j][0] + v[j][1] * v[j][1]) + (v[j][2] * v[j][2] + v[j][3] * v[j][3]);
        const float rs = 1.0f / sqrtf(wave_sum(ss) * (1.0f / DM) + EPS);
#pragma unroll
        for (int j = 0; j < 8; ++j) { const int col = (j >> 1) * 512 + c.lane * 8 + (j & 1) * 4; const f32x4 w = *(const f32x4*)(p.final_norm_w + col);
            *(f32x4*)(p.out + (size_t)t * DM + col) = v[j] * rs * w; }
    }
}
__device__ __forceinline__ Ctx make_ctx(unsigned char* lds_generic) {
    Ctx c; c.lds = (LAS unsigned char*)lds_generic; c.tid = threadIdx.x; c.lane = c.tid & 63; c.wave = __builtin_amdgcn_readfirstlane(c.tid >> 6); return c;
}
__device__ __forceinline__ void phase_gemm_inproj16(const Params& p, const Ctx& c, int i0, int i1, int G, int cidx) {
    if (i0 >= i1) return;
    g8::DenseProbIn P{(const bf16_t*)(p.ws + WS_H), (const bf16_t*)(p.ws + WS_WIN), T / 256, NPROJ / 256, DM, G, cidx, i0, i1};
    g8::EpiProj E{(bf16_t*)(p.ws + WS_PROJ), (const float*)(p.ws + WS_RSTD1), (const float*)(p.ws + WS_ROPE), (float*)(p.ws + WS_KMEAN), (LAS float*)(c.lds + g8::STAGE_BYTES)};
    g8::gemm_phase(c.lds, P, E, c.wave);
}
__device__ __forceinline__ void phase_gemm_outproj(const Params& p, const Ctx& c, int i0, int i1) {
    if (i0 >= i1) return;
    g8::DenseProbOut P{(const bf16_t*)(p.ws + WS_MIXED), (const bf16_t*)(p.ws + WS_WOUT), T / 256, DM / 256, DM, (int)gridDim.x, (int)blockIdx.x, i0, i1};
    g8::EpiX1 E{p.x, (float*)(p.ws + WS_X1)};
    g8::gemm_phase(c.lds, P, E, c.wave);
}
__device__ __forceinline__ void phase_gemm_moe1(const Params& p, const Ctx& c, int i0, int i1) {
    g8::MoeProb1 P{(const bf16_t*)(p.ws + WS_H), (const bf16_t*)(p.ws + WS_WGU), (const int*)(p.ws + WS_ROWTOK), (const int*)(p.ws + WS_BLKE), DM / 2, __builtin_amdgcn_readfirstlane(*(const int*)(p.ws + WS_BLKE)), i0, i1};
    g8::EpiSwiglu E{(unsigned char*)(p.ws + WS_ACT), (const float*)(p.ws + WS_ROWRSTD), p.b_gu};
    g8::gemm_phase(c.lds, P, E, c.wave);
}
__device__ __forceinline__ void phase_gemm_moe2(const Params& p, const Ctx& c) {
    g8::MoeProb2 P{(const bf16_t*)(p.ws + WS_ACT), (const bf16_t*)(p.ws + WS_WD), (const int*)(p.ws + WS_BLKE), FF / 2, __builtin_amdgcn_readfirstlane(*(const int*)(p.ws + WS_BLKE))};
    g8::EpiDown E{(unsigned char*)(p.ws + WS_Y), p.b_d};
    g8::gemm_phase(c.lds, P, E, c.wave);
}


constexpr int CW_BAR = 4096;
__global__ void __launch_bounds__(NTHREADS, 2) fwd(Params p) {
    extern __shared__ __attribute__((aligned(16))) unsigned char lds_raw[];
    const Ctx c = make_ctx(lds_raw);
    if (c.tid < 64) ((LAS unsigned*)(c.lds + LDS_MISC))[c.tid] = 0u;
    __syncthreads();
    const XcdBarrier bar = xcd_barrier_post((unsigned*)(p.ws + WS_CTL) + CW_BAR, (volatile LAS unsigned*)(c.lds + LDS_MISC + 32));
    const att::lptr al = (att::lptr)c.lds;
#ifndef PREFIX_K
#define PREFIX_K 0
#endif
#define PIPE(KMAX) do { \
    if ((KMAX) >= 1) { \
    phase_convert(p, c); phase_norm1(p, c); \
      if ((KMAX) > 1 || (KMAX) < 12) xcd_barrier(bar); } \
    if ((KMAX) >= 2) { \
    { \
        const int bx = blockIdx.x, G = gridDim.x; \
        const int cut = (G == 256) ? (bx >> 3) % 7 : 0; \
        if (cut > 0) phase_gemm_inproj16(p, c, 0, cut, G, bx); \
        phase_convert_share(p, c, 0, CT_GU, G, bx); \
        phase_gemm_inproj16(p, c, cut, 1 << 20, G, bx); \
    } \
      if ((KMAX) > 2 || (KMAX) < 12) xcd_barrier(bar); } \
    if ((KMAX) >= 3) { \
    phase_gla_prep(p, c); att::phase_gla_state(p, al, c.wave * 64 + lane_id()); att::phase_moba_select(p, al, c.wave * 64 + lane_id()); \
      if ((KMAX) > 4 || (KMAX) < 12) xcd_barrier(bar); } \
    if ((KMAX) >= 5) { \
    att::phase_gla_scan(p, c.wave * 64 + lane_id()); \
      if ((KMAX) > 5 || (KMAX) < 12) xcd_barrier(bar); } \
    if ((KMAX) >= 6) { \
    att::phase_gla_out(p, al, c.wave * 64 + lane_id()); att::phase_moba(p, al, c.wave); \
      if ((KMAX) > 6 || (KMAX) < 12) xcd_barrier(bar); } \
    if ((KMAX) >= 7) { \
    phase_gemm_outproj(p, c, 0, 1 << 20); \
      if ((KMAX) > 7 || (KMAX) < 12) xcd_barrier(bar); } \
    if ((KMAX) >= 8) { \
    phase_norm2_router(p, c); \
      if ((KMAX) > 8 || (KMAX) < 12) xcd_barrier(bar); } \
    if ((KMAX) >= 9) { \
    phase_route(p, c); \
      if ((KMAX) > 9 || (KMAX) < 12) xcd_barrier(bar); } \
    if ((KMAX) >= 10) { \
    { \
        const int cut = 2 * ((blockIdx.x >> 3) & 7); \
        if (cut > 0) phase_gemm_moe1(p, c, 0, cut); \
        phase_convert_share(p, c, CT_GU, CT_TOTAL, (int)gridDim.x, (int)blockIdx.x); \
        phase_gemm_moe1(p, c, cut, 1 << 20); \
    } \
      if ((KMAX) > 10 || (KMAX) < 12) xcd_barrier(bar); } \
    if ((KMAX) >= 11) { \
    phase_gemm_moe2(p, c); \
      if ((KMAX) > 11 || (KMAX) < 12) xcd_barrier(bar); } \
    if ((KMAX) >= 12) { \
    phase_combine(p, c); \
      if ((KMAX) > 12 || (KMAX) < 12) xcd_barrier(bar); } \
    } while (0)
    if (PREFIX_K > 0) PIPE(PREFIX_K);
#ifndef PSET
#define PSET 0
#endif
#ifndef PSUB
#define PSUB 0xffff
#endif
    if (PSET) {
        if (PSET & 1) { phase_convert(p, c); phase_norm1(p, c); xcd_barrier(bar); }
        if (PSET & 2) { const int bx = blockIdx.x, G = gridDim.x;
            if (PSUB & 1) phase_gemm_inproj16(p, c, 0, 1 << 20, G, bx);
            if ((PSUB & 2) && (!(PSUB & 4) || ((bx >> 3) & 7) == 0)) phase_convert_share(p, c, 0, CT_GU, G, bx);
            xcd_barrier(bar); }
        if (PSET & 4) { if (PSUB & 1) { phase_gla_prep(p, c); att::phase_gla_state(p, al, c.wave * 64 + lane_id()); } if (PSUB & 2) att::phase_moba_select(p, al, c.wave * 64 + lane_id()); xcd_barrier(bar); }
        if (PSET & 16) { att::phase_gla_scan(p, c.wave * 64 + lane_id()); xcd_barrier(bar); }
        if (PSET & 32) { if (PSUB & 1) att::phase_gla_out(p, al, c.wave * 64 + lane_id()); if (PSUB & 2) att::phase_moba(p, al, c.wave); xcd_barrier(bar); }
        if (PSET & 64) { phase_gemm_outproj(p, c, 0, 1 << 20); xcd_barrier(bar); }
        if (PSET & 128) { phase_norm2_router(p, c); xcd_barrier(bar); }
        if (PSET & 256) { phase_route(p, c); xcd_barrier(bar); }
        if (PSET & 512) { if (PSUB & 1) phase_gemm_moe1(p, c, 0, 1 << 20); if (PSUB & 2) phase_convert_share(p, c, CT_GU, CT_TOTAL, (int)gridDim.x, (int)blockIdx.x); xcd_barrier(bar); }
        if (PSET & 1024) { phase_gemm_moe2(p, c); xcd_barrier(bar); }
        if (PSET & 2048) { phase_combine(p, c); xcd_barrier(bar); }
    }
    PIPE(12);
#undef PIPE
}

extern "C" void kernel_launch(void* const* d_in, const int* in_sizes, int n_in, void* d_out, int out_size, void* d_ws, size_t ws_size, hipStream_t stream) {
    static int grid = 0;
    if (grid == 0) {
        if (n_in != 15 || ws_size < WS_END) { fprintf(stderr, "kernel_launch: unexpected inputs (n_in %d, ws %zu)\n", n_in, ws_size); grid = -1; return; }
        int dev = 0, cus = 0, per_cu = 0;
        if (hipGetDevice(&dev) != hipSuccess || hipDeviceGetAttribute(&cus, hipDeviceAttributeMultiprocessorCount, dev) != hipSuccess) { grid = -1; return; }
        if (hipFuncSetAttribute((const void*)fwd, hipFuncAttributeMaxDynamicSharedMemorySize, LDS_BYTES) != hipSuccess) { fprintf(stderr, "kernel_launch: hipFuncSetAttribute failed\n"); grid = -1; return; }
        if (hipOccupancyMaxActiveBlocksPerMultiprocessor(&per_cu, (const void*)fwd, NTHREADS, LDS_BYTES) != hipSuccess || per_cu < 1) { fprintf(stderr, "kernel_launch: occupancy query says %d blocks per CU\n", per_cu); }
        (void)hipGetLastError();
        grid = cus > 0 ? cus : 256;
    }
    if (grid < 0) return;
    Params p{};
    p.x = (const float*)d_in[0]; p.attn_norm_w = (const float*)d_in[1]; p.w_in = (const float*)d_in[2]; p.gate_w2 = (const float*)d_in[3]; p.gate_b = (const float*)d_in[4];
    p.gla_norm_w = (const float*)d_in[5]; p.w_out = (const float*)d_in[6]; p.ffn_norm_w = (const float*)d_in[7]; p.router_w = (const float*)d_in[8]; p.router_b = (const float*)d_in[9];
    p.w_gu = (const float*)d_in[10]; p.b_gu = (const float*)d_in[11]; p.w_d = (const float*)d_in[12]; p.b_d = (const float*)d_in[13]; p.final_norm_w = (const float*)d_in[14];
    p.out = (float*)d_out; p.ws = (unsigned char*)d_ws;
    if (hipMemsetAsync((char*)d_ws + WS_CTL, 0, CTL_BYTES, stream) != hipSuccess) return;
    hipLaunchKernelGGL(fwd, dim3(grid), dim3(NTHREADS), LDS_BYTES, stream, p);
}
```

```cpp
#include <hip/hip_runtime.h>
#include <stdint.h>
#include <stdio.h>

#define LAS __attribute__((address_space(3)))
typedef unsigned short bf16_t;
typedef short bf16x8 __attribute__((ext_vector_type(8)));
typedef short s16x4 __attribute__((ext_vector_type(4)));
typedef float f32x2 __attribute__((ext_vector_type(2)));
typedef float f32x4 __attribute__((ext_vector_type(4)));
typedef float f32x16 __attribute__((ext_vector_type(16)));
typedef unsigned u32x2 __attribute__((ext_vector_type(2)));
typedef unsigned u32x4 __attribute__((ext_vector_type(4)));
typedef int i32x8 __attribute__((ext_vector_type(8)));

constexpr int NBATCH = 4, SEQ = 4096, T = NBATCH * SEQ, DM = 2048;
constexpr int HD = 128, MH = 8, MBLK = 256, NBLK = SEQ / MBLK;
constexpr int GH = 4, GDK = 128, GDV = 256;
constexpr int LDW_IN = 6160, NPROJ = 6144;
constexpr int C_MQ = 0, C_MK = 1024, C_MV = 2048, C_GQ = 3072, C_GK = 3584, C_GV = 4096, C_GG = 5120, C_GZ = 6144;
constexpr int NE = 32, TOPK = 4, FF = 2048, NASSIGN = T * TOPK;
constexpr int MAXBLK = (NASSIGN + NE * 255) / 256, PROWS = MAXBLK * 256;
constexpr float EPS = 1e-5f;
constexpr float ACT_SCALE = 4.0f, W_SCALE = 64.0f, F8_UNSCALE = 1.0f / (ACT_SCALE * W_SCALE);
constexpr float Y_SCALE = 16.0f;

constexpr size_t MiB = (size_t)1 << 20;
constexpr size_t WS_CTL = 0, CTL_BYTES = 64 * 1024;
constexpr size_t WS_WIN = 16 * MiB;
constexpr size_t WS_WOUT = 40 * MiB;
constexpr size_t WS_ROPE = 48 * MiB;
constexpr size_t WS_RSTD1 = 50 * MiB;
constexpr size_t WS_GZ = 51 * MiB;
constexpr size_t WS_KMEAN = 52 * MiB;
constexpr size_t WS_DEND = 52 * MiB + 512 * 1024;
constexpr size_t WS_RSTD2 = 53 * MiB;
constexpr size_t WS_SEL = 54 * MiB;
constexpr size_t WS_TOPI = 55 * MiB;
constexpr size_t WS_TOPG = 55 * MiB + 512 * 1024;
constexpr size_t WS_HIST = 56 * MiB;
constexpr size_t WS_DEST = 56 * MiB + 512 * 1024;
constexpr size_t WS_ROWTOK = 57 * MiB;
constexpr size_t WS_ROWRSTD = 57 * MiB + 512 * 1024;
constexpr size_t WS_BLKE = 58 * MiB;
constexpr size_t WS_H = 64 * MiB;
constexpr size_t WS_PROJ = 128 * MiB;
constexpr size_t WS_MIXED = 320 * MiB;
constexpr size_t WS_X1 = 384 * MiB;
constexpr size_t WS_U = 512 * MiB;
constexpr size_t WS_SJ = 544 * MiB;
constexpr size_t WS_WGU = 640 * MiB;
constexpr size_t WS_WD = 1152 * MiB;
constexpr size_t WS_ACT = 1408 * MiB;
constexpr size_t WS_Y = 1696 * MiB;
constexpr size_t WS_END = 1984 * MiB;

constexpr int NTHREADS = 512, NWAVES = 8;
constexpr int LDS_BYTES = 149504;
constexpr int LDS_MISC = LDS_BYTES - 256;

struct Params {
    const float* x; const float* attn_norm_w; const float* w_in; const float* gate_w2; const float* gate_b; const float* gla_norm_w;
    const float* w_out; const float* ffn_norm_w; const float* router_w; const float* router_b; const float* w_gu; const float* b_gu;
    const float* w_d; const float* b_d; const float* final_norm_w;
    float* out; unsigned char* ws;
};

__device__ __forceinline__ unsigned cvt_pk_bf16(float lo, float hi) { unsigned r; asm volatile("v_cvt_pk_bf16_f32 %0, %1, %2" : "=v"(r) : "v"(lo), "v"(hi)); return r; }
__device__ __forceinline__ unsigned cvt4_fp8(float a, float b, float c, float d) { unsigned w = 0u; w = __builtin_amdgcn_cvt_pk_fp8_f32(a, b, w, false); w = __builtin_amdgcn_cvt_pk_fp8_f32(c, d, w, true); return w; }
__device__ __forceinline__ float bf2f(unsigned short b) { return __uint_as_float(((unsigned)b) << 16); }
__device__ __forceinline__ float bflo(unsigned w) { return __uint_as_float(w << 16); }
__device__ __forceinline__ float bfhi(unsigned w) { return __uint_as_float(w & 0xffff0000u); }
__device__ __forceinline__ bf16x8 pack8(f32x4 a, f32x4 b) {
    u32x4 w = {cvt_pk_bf16(a[0], a[1]), cvt_pk_bf16(a[2], a[3]), cvt_pk_bf16(b[0], b[1]), cvt_pk_bf16(b[2], b[3])};
    return __builtin_bit_cast(bf16x8, w);
}
__device__ __forceinline__ float wave_sum(float v) {
#pragma unroll
    for (int o = 1; o < 64; o <<= 1) v += __shfl_xor(v, o);
    return v;
}
__device__ __forceinline__ int lane_id() { return (int)__builtin_amdgcn_mbcnt_hi(~0u, __builtin_amdgcn_mbcnt_lo(~0u, 0u)); }
#define LDS_WAIT() asm volatile("s_waitcnt lgkmcnt(0)" ::: "memory")
#define VM_WAIT() asm volatile("s_waitcnt vmcnt(0)" ::: "memory")
#define SBAR() __builtin_amdgcn_sched_barrier(0)
#define XB_TMO      128
#define XB_XCNT(j)  (256  + 64 * (j))
#define XB_XSUB(j)  (1280 + 64 * (j))
#define XB_XGEN(j)  (2304 + 64 * (j))
#define XB_TOP      3328
#define XB_TOPGEN   3392
#define XCD_BAR_WORDS 3456
#define XB_SPIN_CAP (1u << 18)

__device__ __forceinline__ unsigned xb_ld(unsigned* p)              { return __hip_atomic_load(p, __ATOMIC_RELAXED, __HIP_MEMORY_SCOPE_AGENT); }
__device__ __forceinline__ unsigned xb_add(unsigned* p, unsigned v) { return __hip_atomic_fetch_add(p, v, __ATOMIC_RELAXED, __HIP_MEMORY_SCOPE_AGENT); }
__device__ __forceinline__ unsigned xb_xcc_id() { return (unsigned)__builtin_amdgcn_s_getreg((3 << 11) | 20) & 0xFu; }
#define XB_SPIN(cond, bar) do { unsigned _sp = 0; while (cond) { __builtin_amdgcn_s_sleep(1); \
    if ((++_sp & 255u) == 0u) { if (xb_ld(&(bar)[XB_TMO])) break; if (_sp > XB_SPIN_CAP) { atomicAdd(&(bar)[XB_TMO], 1u); break; } } } } while (0)

struct XcdBarrier {
    unsigned* bar; unsigned x; bool t0;
    volatile LAS unsigned* st;
};

__device__ __forceinline__ XcdBarrier xcd_barrier_post(unsigned* bar, volatile LAS unsigned* st) {
    XcdBarrier b; b.bar = bar; b.x = xb_xcc_id(); b.st = st; b.t0 = (threadIdx.x == 0);
    if (b.t0) (void)xb_add(&bar[XB_XCNT(b.x)], 1u);
    return b;
}
__device__ __forceinline__ void xcd_barrier_complete(unsigned* bar, unsigned x, unsigned& nloc, unsigned& nx) {
    const unsigned G = gridDim.x * gridDim.y * gridDim.z;
    unsigned sum, cnt, mine, sp = 0u;
    for (;;) {
        sum = 0u; cnt = 0u; mine = 0u;
#pragma unroll
        for (unsigned j = 0; j < 16; ++j) { const unsigned c = xb_ld(&bar[XB_XCNT(j)]); sum += c; cnt += (c > 0u) ? 1u : 0u; mine = (j == x) ? c : mine; }
        if (sum == G) break;
        __builtin_amdgcn_s_sleep(1);
        if ((++sp & 255u) == 0u) { if (xb_ld(&bar[XB_TMO])) break; if (sp > XB_SPIN_CAP) { atomicAdd(&bar[XB_TMO], 1u); break; } }
    }
    nloc = mine > 0u ? mine : 1u; nx = cnt > 0u ? cnt : 1u;
}

__device__ __forceinline__ void xcd_barrier(const XcdBarrier& b) {
    asm volatile("s_waitcnt vmcnt(0)" ::: "memory");
    __syncthreads();
    if (b.t0) {
        unsigned* bar = b.bar;
        __builtin_amdgcn_s_waitcnt(0);
        unsigned nloc = b.st[0], nx = b.st[1];
        if (nloc == 0u) { xcd_barrier_complete(bar, b.x, nloc, nx); b.st[0] = nloc; b.st[1] = nx; }
        const unsigned old = xb_add(&bar[XB_XSUB(b.x)], 1u);
        const unsigned gen = old / nloc;
        if (old + 1u == (gen + 1u) * nloc) {
            __builtin_amdgcn_fence(__ATOMIC_RELEASE, "agent");
            asm volatile("s_waitcnt vmcnt(0)" ::: "memory");
            const unsigned og = xb_add(&bar[XB_TOP], 1u);
            const unsigned tg = og / nx;
            if (og + 1u == (tg + 1u) * nx) xb_add(&bar[XB_TOPGEN], 1u);
            else XB_SPIN(xb_ld(&bar[XB_TOPGEN]) == tg, bar);
            __builtin_amdgcn_fence(__ATOMIC_ACQUIRE, "agent");
            xb_add(&bar[XB_XGEN(b.x)], 1u);
            asm volatile("s_waitcnt vmcnt(0)" ::: "memory");
        } else {
            XB_SPIN(xb_ld(&bar[XB_XGEN(b.x)]) == gen, bar);
            __builtin_amdgcn_fence(__ATOMIC_ACQUIRE, "agent");
            asm volatile("s_waitcnt vmcnt(0)" ::: "memory");
        }
    }
    __syncthreads();
}

namespace g8 {
constexpr int BM = 256, BK = 64, HALF = 128, HTB = HALF * BK * 2, STAGE_BYTES = 8 * HTB, NXCD = 8, WGM = 8;
__host__ __device__ __forceinline__ int lds_byte(int r, int c) { const int st = (r >> 4) * 2 + (c >> 5), rr = r & 15, cc = c & 31, ob = rr * 64 + cc * 2; return st * 1024 + (ob ^ (((ob >> 9) & 1) << 5)); }
__host__ __device__ __forceinline__ void stage_rc(int b, int& R, int& C) { const int st = b / 1024, sb = b % 1024, swz = sb ^ (((sb >> 9) & 1) << 5); R = (st >> 1) * 16 + swz / 64; C = (st & 1) * 32 + (swz % 64) / 2; }
__host__ __device__ __forceinline__ int perm32(int rho) { const int n = rho >> 4, i = rho & 15; return 8 * (i >> 2) + 4 * n + (i & 3); }

struct Unit { int pm, pn, e; };

template <int WGM_>
__device__ __forceinline__ bool static_next(int i, int nM, int nN, int G, int c, Unit& u) {
    const int nwg = nM * nN; const long L = (long)i * G + c; if (L >= nwg) return false;
    int wgid = (int)L; { const int q = nwg / NXCD, r = nwg % NXCD, xcd = wgid % NXCD, off = wgid / NXCD; wgid = (xcd < r ? xcd * (q + 1) : r * (q + 1) + (xcd - r) * q) + off; }
    const int nig = WGM_ * nN, gid = wgid / nig, fm = gid * WGM_, gsz = (nM - fm) < WGM_ ? (nM - fm) : WGM_;
    u.pm = fm + ((wgid % nig) % gsz); u.pn = (wgid % nig) / gsz; u.e = 0; return true;
}

template <class Prob, class Epi>
__device__ __forceinline__ void gemm_phase(LAS unsigned char* lds, const Prob& P, const Epi& E, int wave_s  ) {
    int tid = wave_s * 64 + lane_id(); asm volatile("" : "+v"(tid));
    const int wid = __builtin_amdgcn_readfirstlane(tid >> 6), lane = tid & 63, wr = wid >> 2, wc = wid & 3, fr = lane & 15, fq = lane >> 4;
    const int K = P.K, nt = K / BK;
    int RA[2], CA[2]; unsigned voffB[2];
#pragma unroll
    for (int i = 0; i < 2; ++i) { int R, C; stage_rc(tid * 16 + i * 8192, R, C); const int Rb = Epi::PERM ? ((R & ~31) + perm32(R & 31)) : R;
        RA[i] = R; CA[i] = C; voffB[i] = (unsigned)(Rb * K + C) * 2u; }
    const size_t kstep = (size_t)(BK * 2);
    const size_t hstep = (size_t)HALF * K * 2;
    const unsigned ldsw = (unsigned)wid * 1024u;
    const int aoff = lds_byte(wr * 64 + fr, fq * 8), boff = lds_byte(wc * 32 + fr, fq * 8);
#define G8_SA(b, h) (((b) * 2 + (h)) * HTB)
#define G8_SB(b, h) ((4 + (b) * 2 + (h)) * HTB)
#define G8_STAGE_B(bufoff, gbase) do { _Pragma("unroll") for (int _i = 0; _i < 2; ++_i) \
        __builtin_amdgcn_global_load_lds((const unsigned*)((const char*)(gbase) + voffB[_i]), (LAS unsigned*)(lds + (bufoff) + ldsw + _i * 8192), 16, 0, 0); } while (0)
#define G8_STAGE_A(bufoff, o0, o1) do { \
        __builtin_amdgcn_global_load_lds((const unsigned*)(Ab + (o0)), (LAS unsigned*)(lds + (bufoff) + ldsw), 16, 0, 0); \
        __builtin_amdgcn_global_load_lds((const unsigned*)(Ab + (o1)), (LAS unsigned*)(lds + (bufoff) + ldsw + 8192), 16, 0, 0); } while (0)
#define G8_CAT(lo, hi) __builtin_bit_cast(i32x8, __builtin_shufflevector(lo, hi, 0, 1, 2, 3, 4, 5, 6, 7))
#define G8_LO(v) __builtin_bit_cast(bf16x8, __builtin_shufflevector(v, v, 0, 1, 2, 3))
#define G8_HI(v) __builtin_bit_cast(bf16x8, __builtin_shufflevector(v, v, 4, 5, 6, 7))
#define G8_LDA(dst, b, h) do { _Pragma("unroll") for (int m = 0; m < 4; ++m) { const u32x4 _l = *(const LAS u32x4*)(lds + G8_SA(b, h) + aoff + m * 2048), _h = *(const LAS u32x4*)(lds + G8_SA(b, h) + aoff + m * 2048 + 1024); dst[m] = G8_CAT(_l, _h); } } while (0)
#define G8_LDB(dst, b, h) do { _Pragma("unroll") for (int n = 0; n < 2; ++n) { const u32x4 _l = *(const LAS u32x4*)(lds + G8_SB(b, h) + boff + n * 2048), _h = *(const LAS u32x4*)(lds + G8_SB(b, h) + boff + n * 2048 + 1024); dst[n] = G8_CAT(_l, _h); } } while (0)
#define G8_MMA(ai, bj, At, Bt) do { __builtin_amdgcn_s_setprio(1); \
        if constexpr (Prob::FP8) { _Pragma("unroll") for (int m = 0; m < 4; ++m) _Pragma("unroll") for (int n = 0; n < 2; ++n) \
            asm volatile("v_mfma_scale_f32_16x16x128_f8f6f4 %0, %1, %2, %0, %3, %3 op_sel_hi:[0,0,0]" : "+v"(acc[ai][bj][m][n]) : "v"(Bt[n]), "v"(At[m]), "v"(f8scale)); } \
        else { _Pragma("unroll") for (int m = 0; m < 4; ++m) _Pragma("unroll") for (int n = 0; n < 2; ++n) { \
            acc[ai][bj][m][n] = __builtin_amdgcn_mfma_f32_16x16x32_bf16(G8_LO(Bt[n]), G8_LO(At[m]), acc[ai][bj][m][n], 0, 0, 0); \
            acc[ai][bj][m][n] = __builtin_amdgcn_mfma_f32_16x16x32_bf16(G8_HI(Bt[n]), G8_HI(At[m]), acc[ai][bj][m][n], 0, 0, 0); } } \
        __builtin_amdgcn_s_setprio(0); } while (0)
#define G8_WAIT_V(n) asm volatile("s_waitcnt vmcnt(" #n ")" ::: "memory")
#define G8_WAIT_L(n) asm volatile("s_waitcnt lgkmcnt(" #n ")" ::: "memory")
#define G8_BAR __builtin_amdgcn_s_barrier()
#define G8_SCHED __builtin_amdgcn_sched_barrier(0)
    Unit cur, nxt, nn; int ui = 0;
    if (!P.next(0, cur)) return;
    const int f8scale = 0x7f7f7f7f;
    f32x4 acc[2][2][4][2];
#pragma unroll
    for (int a = 0; a < 2; ++a)
#pragma unroll
        for (int b = 0; b < 2; ++b)
#pragma unroll
            for (int m = 0; m < 4; ++m)
#pragma unroll
                for (int n = 0; n < 2; ++n) acc[a][b][m][n] = (f32x4){0.f, 0.f, 0.f, 0.f};
    i32x8 At[4], B0[2], B1[2];
    const char* Ab = (const char*)P.a_base();
    unsigned aoc[2][2], aon[2][2]; int raw[2][2];
    P.a_fetch(cur, RA, raw); P.a_finish(raw, CA, aoc);
    bool has_next = P.next(1, nxt);
    if (has_next) { P.a_fetch(nxt, RA, raw); P.a_finish(raw, CA, aon); }
    else { aon[0][0] = aoc[0][0]; aon[0][1] = aoc[0][1]; aon[1][0] = aoc[1][0]; aon[1][1] = aoc[1][1]; }
    const char* cB = (const char*)P.b_ptr(cur);
    const char* nB = has_next ? (const char*)P.b_ptr(nxt) : cB;
    typename Epi::Pre pre = E.fetch(cur, wr, wc, fr, fq);
    G8_STAGE_B(G8_SB(0, 0), cB); G8_STAGE_B(G8_SB(0, 1), cB + hstep); G8_STAGE_A(G8_SA(0, 0), aoc[0][0], aoc[0][1]); G8_STAGE_A(G8_SA(0, 1), aoc[1][0], aoc[1][1]);
    if (wr == 1) G8_BAR;
    G8_WAIT_V(2); G8_BAR;
    G8_STAGE_B(G8_SB(1, 0), cB + kstep); G8_STAGE_A(G8_SA(1, 0), aoc[0][0] + 128u, aoc[0][1] + 128u); G8_STAGE_B(G8_SB(1, 1), cB + hstep + kstep);
    G8_WAIT_V(6); G8_BAR;
    for (;;) {
        for (int t = 0; t < nt; t += 2) {
            const bool last = (t == nt - 2);
            const unsigned k1 = (unsigned)(t + 1) * 128u;
            const unsigned k2 = last ? 0u : (unsigned)(t + 2) * 128u;
            const unsigned a2_00 = (last ? aon[0][0] : aoc[0][0]) + k2, a2_01 = (last ? aon[0][1] : aoc[0][1]) + k2;
            const unsigned a2_10 = (last ? aon[1][0] : aoc[1][0]) + k2, a2_11 = (last ? aon[1][1] : aoc[1][1]) + k2;
            const char* b2 = last ? nB : cB + (size_t)(t + 2) * kstep;
            const char* b3 = b2 + kstep;
            G8_LDB(B0, 0, 0); G8_LDB(B1, 0, 1); G8_SCHED; G8_LDA(At, 0, 0); G8_STAGE_A(G8_SA(1, 1), aoc[1][0] + k1, aoc[1][1] + k1);
            G8_WAIT_V(8); G8_WAIT_L(0); G8_BAR; G8_MMA(0, 0, At, B0); G8_MMA(0, 1, At, B1); G8_BAR; G8_SCHED;
            G8_LDA(At, 0, 1); G8_STAGE_B(G8_SB(0, 0), b2); G8_STAGE_B(G8_SB(0, 1), b2 + hstep); G8_STAGE_A(G8_SA(0, 0), a2_00, a2_01);
            G8_WAIT_V(8); G8_WAIT_L(0); G8_BAR; G8_MMA(1, 0, At, B0); G8_MMA(1, 1, At, B1); G8_BAR; G8_SCHED;
            G8_LDB(B0, 1, 0); G8_LDB(B1, 1, 1); G8_SCHED; G8_LDA(At, 1, 0); G8_STAGE_A(G8_SA(0, 1), a2_10, a2_11);
            G8_WAIT_V(8); G8_WAIT_L(0); G8_BAR; G8_MMA(0, 0, At, B0); G8_MMA(0, 1, At, B1); G8_BAR; G8_SCHED;
            G8_LDA(At, 1, 1); G8_STAGE_B(G8_SB(1, 0), b3); G8_STAGE_B(G8_SB(1, 1), b3 + hstep); G8_STAGE_A(G8_SA(1, 0), a2_00 + 128u, a2_01 + 128u);
            G8_WAIT_V(8); G8_WAIT_L(0); G8_BAR; G8_MMA(1, 0, At, B0); G8_MMA(1, 1, At, B1); G8_BAR; G8_SCHED;
        }
        if (wr == 0) G8_BAR;
        if constexpr (Prob::FP8) asm volatile("s_nop 15\n\ts_nop 15" ::: "memory");
        const bool has_nn = has_next && P.next(ui + 2, nn);
        if (has_nn) P.a_fetch(nn, RA, raw);
        typename Epi::Pre pren = pre; if (has_next) pren = E.fetch(nxt, wr, wc, fr, fq);
        E(acc, cur, pre, wr, wc, fr, fq); pre = pren;
        if (!has_next) break;
#pragma unroll
        for (int a = 0; a < 2; ++a)
#pragma unroll
            for (int b = 0; b < 2; ++b)
#pragma unroll
                for (int m = 0; m < 4; ++m)
#pragma unroll
                    for (int n = 0; n < 2; ++n) acc[a][b][m][n] = (f32x4){0.f, 0.f, 0.f, 0.f};
        cur = nxt; cB = nB; ++ui;
        aoc[0][0] = aon[0][0]; aoc[0][1] = aon[0][1]; aoc[1][0] = aon[1][0]; aoc[1][1] = aon[1][1];
        nxt = nn; has_next = has_nn;
        if (has_next) { P.a_finish(raw, CA, aon); nB = (const char*)P.b_ptr(nxt); }
        else { nB = cB; }
        if (wr == 1) G8_BAR;
    }
    G8_WAIT_V(0);
    G8_BAR;
#undef G8_SA
#undef G8_SB
#undef G8_STAGE_A
#undef G8_STAGE_B
#undef G8_LDA
#undef G8_LDB
#undef G8_MMA
#undef G8_CAT
#undef G8_LO
#undef G8_HI
#undef G8_WAIT_V
#undef G8_WAIT_L
#undef G8_BAR
#undef G8_SCHED
}
}
namespace g8 {
#ifndef WGM_IN
#define WGM_IN 8
#endif
#ifndef WGM_OUT
#define WGM_OUT 8
#endif
#ifndef WGM_M1
#define WGM_M1 4
#endif
#ifndef WGM_M2
#define WGM_M2 4
#endif
template <bool F8, int WG_ = 8> struct DenseProbT {
    static constexpr bool FP8 = F8;
    const bf16_t* A; const bf16_t* Bt; int nM, nN, K, G, c, i0, i1;
    __device__ __forceinline__ bool next(int i, Unit& u) const { return (i0 + i < i1) && static_next<WG_>(i0 + i, nM, nN, G, c, u); }
    __device__ __forceinline__ const void* a_base() const { return A; }
    __device__ __forceinline__ void a_fetch(const Unit& u, const int (&RA)[2], int (&raw)[2][2]) const {
#pragma unroll
        for (int h = 0; h < 2; ++h)
#pragma unroll
            for (int i = 0; i < 2; ++i) raw[h][i] = u.pm * BM + h * HALF + RA[i];
    }
    __device__ __forceinline__ void a_finish(const int (&raw)[2][2], const int (&CA)[2], unsigned (&ao)[2][2]) const {
#pragma unroll
        for (int h = 0; h < 2; ++h)
#pragma unroll
            for (int i = 0; i < 2; ++i) ao[h][i] = (unsigned)((raw[h][i] * K + CA[i]) * 2);
    }
    __device__ __forceinline__ const void* b_ptr(const Unit& u) const { return Bt + (size_t)u.pn * BM * K; }
};
typedef DenseProbT<false, WGM_IN> DenseProbIn; typedef DenseProbT<false, WGM_OUT> DenseProbOut;
struct MoeProb1 {
    static constexpr bool FP8 = true;
    const bf16_t* A; const bf16_t* Bt; const int* row_tok; const int* blk; int K; int nM; int i0, i1;
    __device__ __forceinline__ bool next(int i, Unit& u) const {
        if (i0 + i >= i1 || !static_next<WGM_M1>(i0 + i, nM, 2 * FF / BM, gridDim.x, blockIdx.x, u)) return false;
        u.e = blk[64 + u.pm]; return true; }
    __device__ __forceinline__ const void* a_base() const { return A; }
    __device__ __forceinline__ void a_fetch(const Unit& u, const int (&RA)[2], int (&raw)[2][2]) const {
#pragma unroll
        for (int h = 0; h < 2; ++h)
#pragma unroll
            for (int i = 0; i < 2; ++i) raw[h][i] = row_tok[u.pm * BM + h * HALF + RA[i]];
    }
    __device__ __forceinline__ void a_finish(const int (&raw)[2][2], const int (&CA)[2], unsigned (&ao)[2][2]) const {
#pragma unroll
        for (int h = 0; h < 2; ++h)
#pragma unroll
            for (int i = 0; i < 2; ++i) ao[h][i] = (unsigned)((raw[h][i] * K + CA[i]) * 2);
    }
    __device__ __forceinline__ const void* b_ptr(const Unit& u) const { return Bt + ((size_t)__builtin_amdgcn_readfirstlane(u.e) * (2 * FF) + (size_t)u.pn * BM) * K; }
};
struct MoeProb2 {
    static constexpr bool FP8 = true;
    const bf16_t* A; const bf16_t* Bt; const int* blk; int K; int nM;
    __device__ __forceinline__ bool next(int i, Unit& u) const {
        if (!static_next<WGM_M2>(i, nM, DM / BM, gridDim.x, blockIdx.x, u)) return false;
        u.e = blk[64 + u.pm]; return true; }
    __device__ __forceinline__ const void* a_base() const { return A; }
    __device__ __forceinline__ void a_fetch(const Unit& u, const int (&RA)[2], int (&raw)[2][2]) const {
#pragma unroll
        for (int h = 0; h < 2; ++h)
#pragma unroll
            for (int i = 0; i < 2; ++i) raw[h][i] = u.pm * BM + h * HALF + RA[i];
    }
    __device__ __forceinline__ void a_finish(const int (&raw)[2][2], const int (&CA)[2], unsigned (&ao)[2][2]) const {
#pragma unroll
        for (int h = 0; h < 2; ++h)
#pragma unroll
            for (int i = 0; i < 2; ++i) ao[h][i] = (unsigned)((raw[h][i] * K + CA[i]) * 2);
    }
    __device__ __forceinline__ const void* b_ptr(const Unit& u) const { return Bt + ((size_t)__builtin_amdgcn_readfirstlane(u.e) * DM + (size_t)u.pn * BM) * K; }
};

struct EpiProj {
    static constexpr bool PERM = true;
    bf16_t* __restrict__ O; const float* __restrict__ rstd; const float* __restrict__ rope; float* __restrict__ kmean; LAS float* red;
    struct Pre { float rs[2][4]; };
    __device__ __forceinline__ Pre fetch(const Unit& u, int wr, int wc, int fr, int fq) const {
        Pre q; const int row0 = u.pm * BM + wr * 64 + fr;
#pragma unroll
        for (int ai = 0; ai < 2; ++ai)
#pragma unroll
            for (int m = 0; m < 4; ++m) q.rs[ai][m] = rstd[row0 + ai * HALF + m * 16];
        return q; }
    __device__ __forceinline__ void operator()(const f32x4 (&acc)[2][2][4][2], const Unit& u, const Pre& q, int wr, int wc, int fr, int fq) const {
        const int row0 = u.pm * BM + wr * 64 + fr;
        if (u.pn >= 8) {
            const int col0 = u.pn * BM + wc * 32 + 8 * fq;
#pragma unroll
            for (int ai = 0; ai < 2; ++ai)
#pragma unroll
                for (int m = 0; m < 4; ++m) { const int row = row0 + ai * HALF + m * 16; bf16_t* rowp = O + (size_t)row * NPROJ + col0; const float rsc = q.rs[ai][m];
#pragma unroll
                    for (int bj = 0; bj < 2; ++bj) { const f32x4 v0 = acc[ai][bj][m][0] * rsc, v1 = acc[ai][bj][m][1] * rsc;
                        u32x4 w; w.x = cvt_pk_bf16(v0[0], v0[1]); w.y = cvt_pk_bf16(v0[2], v0[3]); w.z = cvt_pk_bf16(v1[0], v1[1]); w.w = cvt_pk_bf16(v1[2], v1[3]);
                        *(u32x4*)(rowp + bj * HALF) = w; } }
            return;
        }
        const int i0 = 32 * (wc & 1) + 8 * fq, col0 = u.pn * BM + (wc >> 1) * HD + i0;
        const bool isk = u.pn >= 4;
        f32x4 s1a = {0.f, 0.f, 0.f, 0.f}, s1b = s1a, s2a = s1a, s2b = s1a;
#pragma unroll
        for (int ai = 0; ai < 2; ++ai)
#pragma unroll
            for (int m = 0; m < 4; ++m) { const int row = row0 + ai * HALF + m * 16; const int pos = row & (SEQ - 1); bf16_t* rowp = O + (size_t)row * NPROJ + col0; const float rsc = q.rs[ai][m];
                const float* cp = rope + pos * 64 + i0; const f32x4 ca = *(const f32x4*)cp, cb = *(const f32x4*)(cp + 4), sa = *(const f32x4*)(cp + SEQ * 64), sb = *(const f32x4*)(cp + SEQ * 64 + 4);
                const f32x4 xa = acc[ai][0][m][0] * rsc, xb = acc[ai][0][m][1] * rsc, ya = acc[ai][1][m][0] * rsc, yb = acc[ai][1][m][1] * rsc;
                const f32x4 o1a = xa * ca - ya * sa, o1b = xb * cb - yb * sb, o2a = ya * ca + xa * sa, o2b = yb * cb + xb * sb;
                u32x4 w1, w2;
                w1.x = cvt_pk_bf16(o1a[0], o1a[1]); w1.y = cvt_pk_bf16(o1a[2], o1a[3]); w1.z = cvt_pk_bf16(o1b[0], o1b[1]); w1.w = cvt_pk_bf16(o1b[2], o1b[3]);
                w2.x = cvt_pk_bf16(o2a[0], o2a[1]); w2.y = cvt_pk_bf16(o2a[2], o2a[3]); w2.z = cvt_pk_bf16(o2b[0], o2b[1]); w2.w = cvt_pk_bf16(o2b[2], o2b[3]);
                *(u32x4*)rowp = w1; *(u32x4*)(rowp + 64) = w2;
                if (isk) { s1a += o1a; s1b += o1b; s2a += o2a; s2b += o2b; } }
        if (isk) {
            float sv[16] = {s1a[0], s1a[1], s1a[2], s1a[3], s1b[0], s1b[1], s1b[2], s1b[3], s2a[0], s2a[1], s2a[2], s2a[3], s2b[0], s2b[1], s2b[2], s2b[3]};
#pragma unroll
            for (int j = 0; j < 16; ++j) {
#pragma unroll
                for (int o = 1; o < 16; o <<= 1) sv[j] += __shfl_xor(sv[j], o); }
            LAS float* rp = red + (wc * 4 + fq) * 16;
            if (wr == 1 && fr == 0) {
#pragma unroll
                for (int j = 0; j < 16; j += 4) *(LAS f32x4*)(rp + j) = (f32x4){sv[j], sv[j + 1], sv[j + 2], sv[j + 3]}; }
            asm volatile("s_waitcnt lgkmcnt(0)" ::: "memory"); __builtin_amdgcn_s_barrier(); asm volatile("" ::: "memory");
            if (wr == 0 && fr == 0) {
                float* kp = kmean + ((size_t)((u.pm >> 4) * MH + 2 * (u.pn - 4) + (wc >> 1)) * NBLK + (u.pm & 15)) * HD + i0;
                const f32x4 r0 = *(const LAS f32x4*)rp, r1 = *(const LAS f32x4*)(rp + 4), r2 = *(const LAS f32x4*)(rp + 8), r3 = *(const LAS f32x4*)(rp + 12);
                const float inv = 1.0f / MBLK;
                *(f32x4*)kp = (f32x4){(sv[0] + r0[0]) * inv, (sv[1] + r0[1]) * inv, (sv[2] + r0[2]) * inv, (sv[3] + r0[3]) * inv};
                *(f32x4*)(kp + 4) = (f32x4){(sv[4] + r1[0]) * inv, (sv[5] + r1[1]) * inv, (sv[6] + r1[2]) * inv, (sv[7] + r1[3]) * inv};
                *(f32x4*)(kp + 64) = (f32x4){(sv[8] + r2[0]) * inv, (sv[9] + r2[1]) * inv, (sv[10] + r2[2]) * inv, (sv[11] + r2[3]) * inv};
                *(f32x4*)(kp + 68) = (f32x4){(sv[12] + r3[0]) * inv, (sv[13] + r3[1]) * inv, (sv[14] + r3[2]) * inv, (sv[15] + r3[3]) * inv};
            }
        }
    }
};
struct EpiX1 {
    static constexpr bool PERM = true;
    const float* __restrict__ X; bf16_t* __restrict__ O;
    struct Pre {};
    __device__ __forceinline__ Pre fetch(const Unit&, int, int, int, int) const { return Pre{}; }
    __device__ __forceinline__ void operator()(const f32x4 (&acc)[2][2][4][2], const Unit& u, const Pre&, int wr, int wc, int fr, int fq) const {
        const int row0 = u.pm * BM + wr * 64 + fr, col0 = u.pn * BM + wc * 32 + 8 * fq;
#pragma unroll
        for (int ai = 0; ai < 2; ++ai) {
            f32x4 xv[4][2][2];
#pragma unroll
            for (int m = 0; m < 4; ++m) { const size_t off = (size_t)(row0 + ai * HALF + m * 16) * DM + col0;
#pragma unroll
                for (int bj = 0; bj < 2; ++bj)
#pragma unroll
                    for (int n = 0; n < 2; ++n) xv[m][bj][n] = __builtin_nontemporal_load((const f32x4*)(X + off + bj * HALF + n * 4)); }
#pragma unroll
            for (int m = 0; m < 4; ++m) { const size_t off = (size_t)(row0 + ai * HALF + m * 16) * DM + col0;
#pragma unroll
                for (int bj = 0; bj < 2; ++bj) { const f32x4 v0 = xv[m][bj][0] + acc[ai][bj][m][0], v1 = xv[m][bj][1] + acc[ai][bj][m][1];
                    u32x4 w; w.x = cvt_pk_bf16(v0[0], v0[1]); w.y = cvt_pk_bf16(v0[2], v0[3]); w.z = cvt_pk_bf16(v1[0], v1[1]); w.w = cvt_pk_bf16(v1[2], v1[3]);
                    *(u32x4*)(O + off + bj * HALF) = w; } }
        }
    }
};
struct EpiSwiglu {
    static constexpr bool PERM = true;
    unsigned char* __restrict__ O; const float* __restrict__ row_rstd; const float* __restrict__ bgu;
    struct Pre { float rsv[2][4]; };
    __device__ __forceinline__ Pre fetch(const Unit& u, int wr, int wc, int fr, int fq) const {
        Pre q; const int row0 = u.pm * BM + wr * 64 + fr;
#pragma unroll
        for (int ai = 0; ai < 2; ++ai)
#pragma unroll
            for (int m = 0; m < 4; ++m) q.rsv[ai][m] = row_rstd[row0 + ai * HALF + m * 16];
        return q; }
    __device__ __forceinline__ void operator()(const f32x4 (&acc)[2][2][4][2], const Unit& u, const Pre& q, int wr, int wc, int fr, int fq) const {
        const int row0 = u.pm * BM + wr * 64 + fr, colg = u.pn * HALF + wc * 32 + 8 * fq;
        const float* bg = bgu + (size_t)__builtin_amdgcn_readfirstlane(u.e) * (2 * FF) + colg; const float* bu = bg + FF;
        const f32x4 bg0 = *(const f32x4*)bg, bg1 = *(const f32x4*)(bg + 4), bu0 = *(const f32x4*)bu, bu1 = *(const f32x4*)(bu + 4);
#pragma unroll
        for (int ai = 0; ai < 2; ++ai)
#pragma unroll
            for (int m = 0; m < 4; ++m) { const int row = row0 + ai * HALF + m * 16; const float rs = q.rsv[ai][m] * F8_UNSCALE;
                f32x4 g0 = acc[ai][0][m][0] * rs + bg0, g1 = acc[ai][0][m][1] * rs + bg1, u0 = acc[ai][1][m][0] * rs + bu0, u1 = acc[ai][1][m][1] * rs + bu1;
                float o[8];
#pragma unroll
                for (int j = 0; j < 8; ++j) { float g = j < 4 ? g0[j] : g1[j - 4], uu = j < 4 ? u0[j] : u1[j - 4];
                    g = fminf(g, 7.0f); uu = __builtin_amdgcn_fmed3f(uu, -7.0f, 7.0f);
                    const float sg = __builtin_amdgcn_rcpf(1.0f + __builtin_amdgcn_exp2f(g * (-1.702f * 1.4426950408889634f)));
                    o[j] = (uu * ACT_SCALE + ACT_SCALE) * (g * sg); }
                u32x2 w; w.x = cvt4_fp8(o[0], o[1], o[2], o[3]); w.y = cvt4_fp8(o[4], o[5], o[6], o[7]);
                *(u32x2*)(O + (size_t)row * FF + colg) = w; }
    }
};
struct EpiDown {
    static constexpr bool PERM = true;
    unsigned char* __restrict__ O; const float* __restrict__ bd;
    struct Pre { f32x4 bv[2][2]; };
    __device__ __forceinline__ Pre fetch(const Unit& u, int wr, int wc, int fr, int fq) const {
        Pre q; const int col0 = u.pn * BM + wc * 32 + 8 * fq;
        const float* bp = bd + (size_t)__builtin_amdgcn_readfirstlane(u.e) * DM + col0;
#pragma unroll
        for (int bj = 0; bj < 2; ++bj)
#pragma unroll
            for (int n = 0; n < 2; ++n) q.bv[bj][n] = *(const f32x4*)(bp + bj * HALF + 4 * n) * Y_SCALE;
        return q; }
    __device__ __forceinline__ void operator()(const f32x4 (&acc)[2][2][4][2], const Unit& u, const Pre& q, int wr, int wc, int fr, int fq) const {
        const int row0 = u.pm * BM + wr * 64 + fr, col0 = u.pn * BM + wc * 32 + 8 * fq;
#pragma unroll
        for (int ai = 0; ai < 2; ++ai)
#pragma unroll
            for (int m = 0; m < 4; ++m) { unsigned char* rowp = O + (size_t)(row0 + ai * HALF + m * 16) * DM + col0;
#pragma unroll
                for (int bj = 0; bj < 2; ++bj) { const f32x4 v0 = acc[ai][bj][m][0] * (F8_UNSCALE * Y_SCALE) + q.bv[bj][0], v1 = acc[ai][bj][m][1] * (F8_UNSCALE * Y_SCALE) + q.bv[bj][1];
                    u32x2 w; w.x = cvt4_fp8(v0[0], v0[1], v0[2], v0[3]); w.y = cvt4_fp8(v1[0], v1[1], v1[2], v1[3]);
                    *(u32x2*)(rowp + bj * HALF) = w; } }
    }
};
}
struct Ctx { LAS unsigned char* lds; int tid, lane, wave; };
__device__ __forceinline__ Ctx fresh_ctx(const Ctx& c0) { Ctx c; c.lds = c0.lds; int t = c0.wave * 64 + lane_id(); asm volatile("" : "+v"(t)); c.tid = t; c.lane = t & 63; c.wave = c0.wave; return c; }

__device__ __forceinline__ void transpose_item(const float* W, int ld, int K, int k0, int n0, bf16_t* WT_row0  , LAS float* scr, int lane) {
    float tv[32];
#pragma unroll
    for (int i = 0; i < 32; ++i) { const int kk = 2 * i + (lane >> 5); tv[i] = __builtin_nontemporal_load(W + (size_t)(k0 + kk) * ld + n0 + (lane & 31)); }
#pragma unroll
    for (int i = 0; i < 32; ++i) { const int kk = 2 * i + (lane >> 5); scr[kk * 33 + (lane & 31)] = tv[i]; }
    LDS_WAIT(); asm volatile("" ::: "memory");
    const int c = lane & 7;
#pragma unroll
    for (int j = 0; j < 4; ++j) { const int n = (lane >> 3) + 8 * j; const LAS float* s = scr + (8 * c) * 33 + n;
        u32x4 o; o.x = cvt_pk_bf16(s[0 * 33], s[1 * 33]); o.y = cvt_pk_bf16(s[2 * 33], s[3 * 33]); o.z = cvt_pk_bf16(s[4 * 33], s[5 * 33]); o.w = cvt_pk_bf16(s[6 * 33], s[7 * 33]);
        *(u32x4*)(WT_row0 + (size_t)n * K + k0 + 8 * c) = o; }
    LDS_WAIT(); asm volatile("" ::: "memory");
}
__device__ __forceinline__ void phase_convert(const Params& p, const Ctx& c0) { const Ctx c = fresh_ctx(c0);
    LAS float* scr = (LAS float*)(c.lds + c.wave * 18432);
    const int gw = blockIdx.x * NWAVES + c.wave, NGW = gridDim.x * NWAVES;
    bf16_t* WinT = (bf16_t*)(p.ws + WS_WIN); bf16_t* WoutT = (bf16_t*)(p.ws + WS_WOUT);
    constexpr int KB = DM / 64;
    constexpr int I_IN = KB * (NPROJ / 32), I_OUT = KB * (DM / 32), NITEMS = I_IN + I_OUT;
    for (int it = gw; it < NITEMS; it += NGW) {
        int r = it;
        if (r < I_IN) { const int nb = r % (NPROJ / 32), kb = r / (NPROJ / 32);
            const int n = 32 * nb, jj = n & 127; const int src = (n < C_MV) ? (n & ~255) + (jj >> 6) * HD + ((n >> 7) & 1) * 64 + (jj & 63) : n;
            transpose_item(p.w_in, LDW_IN, DM, 64 * kb, src, WinT + (size_t)n * DM, scr, c.lane); continue; } r -= I_IN;
        { const int nb = r % (DM / 32), kb = r / (DM / 32); transpose_item(p.w_out, DM, DM, 64 * kb, 32 * nb, WoutT + (size_t)(32 * nb) * DM, scr, c.lane); }
    }
    float* rc = (float*)(p.ws + WS_ROPE); float* rs = rc + SEQ * 64;
    for (int i = blockIdx.x * NTHREADS + c.tid; i < SEQ * 64; i += gridDim.x * NTHREADS) {
        const int pos = i >> 6, j = i & 63;
        const float inv = 1.0f / powf(10000.0f, (float)(2 * j) / 128.0f);
        const float ang = (float)pos * inv; float sn, cs; sincosf(ang, &sn, &cs); rc[i] = cs; rs[i] = sn; }
}
constexpr int CT_GU1 = (DM / 128) * (2 * FF / 256), CT_D1 = (FF / 128) * (DM / 256), CT_GU = NE * CT_GU1, CT_D = NE * CT_D1, CT_TOTAL = CT_GU + CT_D;
struct ConvTile { const float* src; unsigned char* dst; int ld; int gu; };
__device__ __forceinline__ ConvTile ctile_decode(const Params& p, int r) {
    ConvTile t;
    if (r < CT_GU) { const int e = r / CT_GU1, q = r % CT_GU1, nt = q % (2 * FF / 256), kt = q / (2 * FF / 256);
        t.src = p.w_gu + (size_t)e * DM * (2 * FF) + (size_t)(128 * kt) * (2 * FF) + 256 * nt; t.ld = 2 * FF; t.gu = 256 * nt;
        t.dst = (unsigned char*)(p.ws + WS_WGU) + (size_t)e * (2 * FF) * DM + 128 * kt; }
    else { r -= CT_GU; const int e = r / CT_D1, q = r % CT_D1, nt = q % (DM / 256), kt = q / (DM / 256);
        t.src = p.w_d + (size_t)e * FF * DM + (size_t)(128 * kt) * DM + 256 * nt; t.ld = DM; t.gu = -1;
        t.dst = (unsigned char*)(p.ws + WS_WD) + ((size_t)e * DM + 256 * nt) * FF + 128 * kt; }
    return t;
}
__device__ __forceinline__ void ctile_load(const ConvTile& t, f32x4 (&tv)[16], int wave, int lane) {
    const float* s = t.src + (size_t)(16 * wave) * t.ld + 4 * lane;
#pragma unroll
    for (int i = 0; i < 16; ++i) tv[i] = __builtin_nontemporal_load((const f32x4*)(s + (size_t)i * t.ld));
}
__device__ __forceinline__ void ctile_store(const ConvTile& t, const f32x4 (&tv)[16], LAS unsigned char* lds, int tid, int wave, int lane) {
#pragma unroll
    for (int c = 0; c < 4; ++c) { u32x4 o;
#pragma unroll
        for (int q = 0; q < 4; ++q) o[q] = cvt4_fp8(tv[4 * q][c] * W_SCALE, tv[4 * q + 1][c] * W_SCALE, tv[4 * q + 2][c] * W_SCALE, tv[4 * q + 3][c] * W_SCALE);
        const int n = 4 * lane + c; *(LAS u32x4*)(lds + n * 128 + ((wave ^ (lane & 7)) << 4)) = o; }
    asm volatile("s_waitcnt lgkmcnt(0)" ::: "memory"); __builtin_amdgcn_s_barrier();
#pragma unroll
    for (int j = 0; j < 4; ++j) { const int n = 64 * j + (tid >> 3), ch = tid & 7;
        const u32x4 o = *(const LAS u32x4*)(lds + n * 128 + ((ch ^ ((n >> 2) & 7)) << 4));
        int orow = n;
        if (t.gu >= 0) { const int ng = t.gu + n; const int nn = ng < FF ? ng : ng - FF; orow = 256 * (nn / 128) + (nn % 128) + (ng < FF ? 0 : 128); }
        *(u32x4*)(t.dst + (size_t)orow * DM + 16 * ch) = o; }
    asm volatile("s_waitcnt lgkmcnt(0)" ::: "memory"); __builtin_amdgcn_s_barrier();
}
__device__ __forceinline__ void phase_convert_share(const Params& p, const Ctx& c0, int lo, int hi, int G, int w) { const Ctx c = fresh_ctx(c0);
    for (int base = lo + w; base < hi; base += 8 * G) {
        f32x4 ta[16], tb[16];
#define CT_OK(k) (base + (k) * G < hi)
#define CT_L(k, buf) do { if (CT_OK(k)) { const ConvTile t_ = ctile_decode(p, base + (k) * G); ctile_load(t_, buf, c.wave, c.lane); } __builtin_amdgcn_sched_barrier(0); } while (0)
#define CT_S(k, buf) do { if (CT_OK(k)) { const ConvTile t_ = ctile_decode(p, base + (k) * G); ctile_store(t_, buf, c.lds, c.tid, c.wave, c.lane); } __builtin_amdgcn_sched_barrier(0); } while (0)
        CT_L(0, ta); CT_L(1, tb);
        CT_S(0, ta); CT_L(2, ta);
        CT_S(1, tb); CT_L(3, tb);
        CT_S(2, ta); CT_L(4, ta);
        CT_S(3, tb); CT_L(5, tb);
        CT_S(4, ta); CT_L(6, ta);
        CT_S(5, tb); CT_L(7, tb);
        CT_S(6, ta); CT_S(7, tb);
#undef CT_OK
#undef CT_L
#undef CT_S
    }
}

template <int NTL, int OUT8  , class XT  >
__device__ __forceinline__ void norm_skinny_half(const XT* __restrict__ xrows, const float* __restrict__ wn, const float* __restrict__ Wsk, int ldw, void* __restrict__ hrows_, void* __restrict__ hrows8_, int hk, int lane, f32x4 (&acc)[NTL], float& ss) {
    const int row = lane & 15, kq = lane >> 4;
    ss = 0.f;
#pragma unroll
    for (int t = 0; t < NTL; ++t) acc[t] = (f32x4){0.f, 0.f, 0.f, 0.f};
    for (int ks0 = 0; ks0 < 32; ks0 += 4) {
        f32x4 xa[4], xb[4], wa[4], wb[4]; float wv[4][NTL][8];
#pragma unroll
        for (int q = 0; q < 4; ++q) { const int d0 = 1024 * hk + 32 * (ks0 + q) + 8 * kq;
            if constexpr (sizeof(XT) == 2) { const u32x4 xw = *(const u32x4*)(xrows + (size_t)row * DM + d0); xa[q] = (f32x4){bflo(xw.x), bfhi(xw.x), bflo(xw.y), bfhi(xw.y)}; xb[q] = (f32x4){bflo(xw.z), bfhi(xw.z), bflo(xw.w), bfhi(xw.w)}; }
            else { xa[q] = *(const f32x4*)(xrows + (size_t)row * DM + d0); xb[q] = *(const f32x4*)(xrows + (size_t)row * DM + d0 + 4); }
            wa[q] = *(const f32x4*)(wn + d0); wb[q] = *(const f32x4*)(wn + d0 + 4);
#pragma unroll
            for (int t = 0; t < NTL; ++t)
#pragma unroll
                for (int i = 0; i < 8; ++i) wv[q][t][i] = Wsk[(size_t)(d0 + i) * ldw + t * 16 + row]; }
#pragma unroll
        for (int q = 0; q < 4; ++q) { const int d0 = 1024 * hk + 32 * (ks0 + q) + 8 * kq;
            f32x4 a = xa[q], b = xb[q];
            ss += (a[0] * a[0] + a[1] * a[1]) + (a[2] * a[2] + a[3] * a[3]) + (b[0] * b[0] + b[1] * b[1]) + (b[2] * b[2] + b[3] * b[3]);
            a = a * wa[q]; b = b * wb[q];
            u32x4 hw; hw.x = cvt_pk_bf16(a[0], a[1]); hw.y = cvt_pk_bf16(a[2], a[3]); hw.z = cvt_pk_bf16(b[0], b[1]); hw.w = cvt_pk_bf16(b[2], b[3]);
            if constexpr (OUT8 >= 1) { u32x2 f8; f8.x = cvt4_fp8(a[0] * ACT_SCALE, a[1] * ACT_SCALE, a[2] * ACT_SCALE, a[3] * ACT_SCALE); f8.y = cvt4_fp8(b[0] * ACT_SCALE, b[1] * ACT_SCALE, b[2] * ACT_SCALE, b[3] * ACT_SCALE);
                *(u32x2*)((unsigned char*)hrows8_ + (size_t)row * DM + d0) = f8; }
            if constexpr (OUT8 != 1) *(u32x4*)((bf16_t*)hrows_ + (size_t)row * DM + d0) = hw;
            const f32x4 ra = {a[0] - bflo(hw.x), a[1] - bfhi(hw.x), a[2] - bflo(hw.y), a[3] - bfhi(hw.y)}, rb = {b[0] - bflo(hw.z), b[1] - bfhi(hw.z), b[2] - bflo(hw.w), b[3] - bfhi(hw.w)};
            const bf16x8 ah = __builtin_bit_cast(bf16x8, hw), al = pack8(ra, rb);
#pragma unroll
            for (int t = 0; t < NTL; ++t) { const float* w8 = wv[q][t];
                u32x4 bw; bw.x = cvt_pk_bf16(w8[0], w8[1]); bw.y = cvt_pk_bf16(w8[2], w8[3]); bw.z = cvt_pk_bf16(w8[4], w8[5]); bw.w = cvt_pk_bf16(w8[6], w8[7]);
                const f32x4 r0 = {w8[0] - bflo(bw.x), w8[1] - bfhi(bw.x), w8[2] - bflo(bw.y), w8[3] - bfhi(bw.y)}, r1 = {w8[4] - bflo(bw.z), w8[5] - bfhi(bw.z), w8[6] - bflo(bw.w), w8[7] - bfhi(bw.w)};
                const bf16x8 bh = __builtin_bit_cast(bf16x8, bw), bl = pack8(r0, r1);
                acc[t] = __builtin_amdgcn_mfma_f32_16x16x32_bf16(ah, bh, acc[t], 0, 0, 0);
                acc[t] = __builtin_amdgcn_mfma_f32_16x16x32_bf16(al, bh, acc[t], 0, 0, 0);
                acc[t] = __builtin_amdgcn_mfma_f32_16x16x32_bf16(ah, bl, acc[t], 0, 0, 0); }
        }
    }
    ss += __shfl_xor(ss, 16); ss += __shfl_xor(ss, 32);
}

__device__ __forceinline__ void phase_norm1(const Params& p, const Ctx& c0) { const Ctx c = fresh_ctx(c0);
    bf16_t* H = (bf16_t*)(p.ws + WS_H); float* rstd = (float*)(p.ws + WS_RSTD1); float* gz = (float*)(p.ws + WS_GZ);
    const int pair = c.wave >> 1, hk = c.wave & 1;
    LAS float* scr = (LAS float*)(c.lds + pair * 4096);
    for (int u = blockIdx.x * 4 + pair; u < T / 16; u += gridDim.x * 4) {
        f32x4 acc[1]; float ss;
        norm_skinny_half<1, 0, float>(p.x + (size_t)u * 16 * DM, p.attn_norm_w, p.w_in + C_GZ, LDW_IN, H + (size_t)u * 16 * DM, nullptr, hk, c.lane, acc, ss);
        if (hk == 1) { *(LAS f32x4*)(scr + c.lane * 4) = acc[0]; if (c.lane < 16) scr[256 + c.lane] = ss; }
        __syncthreads();
        if (hk == 0) {
            const f32x4 o = *(LAS f32x4*)(scr + c.lane * 4); const float tot = ss + scr[256 + (c.lane & 15)];
            const float rs = 1.0f / sqrtf(tot * (1.0f / DM) + EPS);
            if (c.lane < 16) { rstd[u * 16 + c.lane] = rs; scr[512 + c.lane] = rs; }
            LDS_WAIT();
#pragma unroll
            for (int r = 0; r < 4; ++r) { const int row = (c.lane >> 4) * 4 + r; gz[(size_t)(u * 16 + row) * 16 + (c.lane & 15)] = (acc[0][r] + o[r]) * scr[512 + row]; }
        }
        __syncthreads();
    }
}

__device__ __forceinline__ void phase_norm2_router(const Params& p, const Ctx& c0) { const Ctx c = fresh_ctx(c0);
    bf16_t* H = (bf16_t*)(p.ws + WS_H); float* rstd = (float*)(p.ws + WS_RSTD2); const bf16_t* X1 = (const bf16_t*)(p.ws + WS_X1);
    int* topi = (int*)(p.ws + WS_TOPI); float* topg = (float*)(p.ws + WS_TOPG); int* hist = (int*)(p.ws + WS_HIST); int* row_tok = (int*)(p.ws + WS_ROWTOK);
    const int pair = c.wave >> 1, hk = c.wave & 1;
    LAS float* scr = (LAS float*)(c.lds + pair * 8192);
    LAS int* hcnt = (LAS int*)(c.lds + 65536);
    { float* row_rstd = (float*)(p.ws + WS_ROWRSTD);
      for (int i = blockIdx.x * NTHREADS + c.tid; i < PROWS; i += gridDim.x * NTHREADS) { row_tok[i] = 0; row_rstd[i] = 0.f; } }
    for (int g = blockIdx.x; g < T / 64; g += gridDim.x) {
        if (c.tid < 32) hcnt[c.tid] = 0;
        __syncthreads();
        const int u = g * 4 + pair;
        f32x4 acc[2]; float ss;
        norm_skinny_half<2, 1, bf16_t>(X1 + (size_t)u * 16 * DM, p.ffn_norm_w, p.router_w, NE, nullptr, (unsigned char*)H + (size_t)u * 16 * DM, hk, c.lane, acc, ss);
        if (hk == 1) { *(LAS f32x4*)(scr + c.lane * 4) = acc[0]; *(LAS f32x4*)(scr + 256 + c.lane * 4) = acc[1]; if (c.lane < 16) scr[512 + c.lane] = ss; }
        __syncthreads();
        if (hk == 0) {
            const f32x4 o0 = *(LAS f32x4*)(scr + c.lane * 4), o1 = *(LAS f32x4*)(scr + 256 + c.lane * 4); const float tot = ss + scr[512 + (c.lane & 15)];
            const float rs = 1.0f / sqrtf(tot * (1.0f / DM) + EPS);
            if (c.lane < 16) { rstd[u * 16 + c.lane] = rs; scr[528 + c.lane] = rs; }
            LDS_WAIT();
            const float b0 = p.router_b[c.lane & 15], b1 = p.router_b[16 + (c.lane & 15)];
#pragma unroll
            for (int r = 0; r < 4; ++r) { const int row = (c.lane >> 4) * 4 + r; const float rr = scr[528 + row];
                scr[1024 + row * 32 + (c.lane & 15)] = (acc[0][r] + o0[r]) * rr + b0; scr[1024 + row * 32 + 16 + (c.lane & 15)] = (acc[1][r] + o1[r]) * rr + b1; }
            LDS_WAIT();
            if (c.lane < 16) {
                float lv[32];
#pragma unroll
                for (int j = 0; j < 32; ++j) lv[j] = scr[1024 + c.lane * 32 + j];
                int bi[4]; float bv[4];
#pragma unroll
                for (int k = 0; k < 4; ++k) { float best = -__builtin_inff(); int bidx = 0;
#pragma unroll
                    for (int j = 0; j < 32; ++j) { const bool tk = lv[j] > best; best = tk ? lv[j] : best; bidx = tk ? j : bidx; }
                    bi[k] = bidx; bv[k] = best;
#pragma unroll
                    for (int j = 0; j < 32; ++j) lv[j] = (j == bidx) ? -__builtin_inff() : lv[j]; }
                const float e1 = __expf(bv[1] - bv[0]), e2 = __expf(bv[2] - bv[0]), e3 = __expf(bv[3] - bv[0]); const float inv = 1.0f / (1.0f + e1 + e2 + e3);
                const int tok = u * 16 + c.lane;
                *(int4*)(topi + (size_t)tok * 4) = make_int4(bi[0], bi[1], bi[2], bi[3]);
                *(float4*)(topg + (size_t)tok * 4) = make_float4(inv, e1 * inv, e2 * inv, e3 * inv);
#pragma unroll
                for (int k = 0; k < 4; ++k) atomicAdd((int*)&hcnt[bi[k]], 1);
            }
        }
        __syncthreads();
        if (c.tid < 32) hist[g * 32 + c.tid] = hcnt[c.tid];
        __syncthreads();
    }
}

__device__ __forceinline__ void phase_rope_kmean(const Params& p, const Ctx& c0) { const Ctx c = fresh_ctx(c0);
    bf16_t* proj = (bf16_t*)(p.ws + WS_PROJ); const float* rc = (const float*)(p.ws + WS_ROPE); const float* rsn = rc + SEQ * 64; float* kmean = (float*)(p.ws + WS_KMEAN);
    LAS float* red = (LAS float*)c.lds;
    const int cg = c.tid & 7, tk = c.tid >> 3;
    for (int u = blockIdx.x; u < NBATCH * MH * NBLK; u += gridDim.x) {
        const int b = u / (MH * NBLK), h = (u / NBLK) % MH, blk = u % NBLK;
        float s1[8], s2[8];
#pragma unroll
        for (int j = 0; j < 8; ++j) { s1[j] = 0.f; s2[j] = 0.f; }
        f32x4 ca[4], cb[4], sa[4], sb[4]; u32x4 t1[4][2], t2[4][2];
#pragma unroll
        for (int ps = 0; ps < 4; ++ps) {
            const int pos = blk * MBLK + ps * 64 + tk; const size_t row = (size_t)(b * SEQ + pos) * NPROJ;
            ca[ps] = *(const f32x4*)(rc + pos * 64 + 8 * cg); cb[ps] = *(const f32x4*)(rc + pos * 64 + 8 * cg + 4); sa[ps] = *(const f32x4*)(rsn + pos * 64 + 8 * cg); sb[ps] = *(const f32x4*)(rsn + pos * 64 + 8 * cg + 4);
#pragma unroll
            for (int qk = 0; qk < 2; ++qk) { const bf16_t* base = proj + row + (qk ? C_MK : C_MQ) + h * HD + 8 * cg; t1[ps][qk] = *(const u32x4*)base; t2[ps][qk] = *(const u32x4*)(base + 64); }
        }
#pragma unroll
        for (int ps = 0; ps < 4; ++ps) {
            const int pos = blk * MBLK + ps * 64 + tk; const size_t row = (size_t)(b * SEQ + pos) * NPROJ;
            const float cs[8] = {ca[ps][0], ca[ps][1], ca[ps][2], ca[ps][3], cb[ps][0], cb[ps][1], cb[ps][2], cb[ps][3]}, sn[8] = {sa[ps][0], sa[ps][1], sa[ps][2], sa[ps][3], sb[ps][0], sb[ps][1], sb[ps][2], sb[ps][3]};
#pragma unroll
            for (int qk = 0; qk < 2; ++qk) {
                bf16_t* base = proj + row + (qk ? C_MK : C_MQ) + h * HD + 8 * cg;
                float a[8], bb[8];
#pragma unroll
                for (int j = 0; j < 4; ++j) { a[2 * j] = bflo(t1[ps][qk][j]); a[2 * j + 1] = bfhi(t1[ps][qk][j]); bb[2 * j] = bflo(t2[ps][qk][j]); bb[2 * j + 1] = bfhi(t2[ps][qk][j]); }
                float o1[8], o2[8];
#pragma unroll
                for (int j = 0; j < 8; ++j) { o1[j] = a[j] * cs[j] - bb[j] * sn[j]; o2[j] = bb[j] * cs[j] + a[j] * sn[j]; }
                u32x4 w1, w2;
#pragma unroll
                for (int j = 0; j < 4; ++j) { w1[j] = cvt_pk_bf16(o1[2 * j], o1[2 * j + 1]); w2[j] = cvt_pk_bf16(o2[2 * j], o2[2 * j + 1]); }
                *(u32x4*)base = w1; *(u32x4*)(base + 64) = w2;
                if (qk) {
#pragma unroll
                    for (int j = 0; j < 8; ++j) { s1[j] += o1[j]; s2[j] += o2[j]; } }
            }
        }
#pragma unroll
        for (int j = 0; j < 8; ++j) {
#pragma unroll
            for (int o = 8; o < 64; o <<= 1) { s1[j] += __shfl_xor(s1[j], o); s2[j] += __shfl_xor(s2[j], o); } }
        if (c.lane < 8) {
#pragma unroll
            for (int j = 0; j < 8; ++j) { red[c.wave * 128 + 8 * cg + j] = s1[j]; red[c.wave * 128 + 64 + 8 * cg + j] = s2[j]; } }
        __syncthreads();
        if (c.tid < 128) { float s = 0.f;
#pragma unroll
            for (int w = 0; w < 8; ++w) s += red[w * 128 + c.tid];
            kmean[(size_t)u * HD + c.tid] = s * (1.0f / MBLK); }
        __syncthreads();
    }
}

__device__ __forceinline__ void phase_gla_prep(const Params& p, const Ctx& c0) { const Ctx c = fresh_ctx(c0);
    bf16_t* proj = (bf16_t*)(p.ws + WS_PROJ); const float* gz = (const float*)(p.ws + WS_GZ); float* dend = (float*)(p.ws + WS_DEND);
    LAS float* gzl = (LAS float*)c.lds;
    LAS float* seg = (LAS float*)(c.lds + 16384);
    const int ch = c.tid & 127, tq = __builtin_amdgcn_readfirstlane(c.tid >> 7);
    for (int u = blockIdx.x; u < NBATCH * GH * NBLK; u += gridDim.x) {
        const int b = u / (GH * NBLK), h = (u / NBLK) % GH, j = u % NBLK;
        const int tok0 = b * SEQ + j * MBLK;
        for (int i = c.tid; i < 256 * 4; i += NTHREADS) *(LAS f32x4*)(gzl + i * 4) = *(const f32x4*)(gz + (size_t)tok0 * 16 + i * 4);
        float w2[16];
#pragma unroll
        for (int r = 0; r < 16; ++r) w2[r] = p.gate_w2[r * 512 + h * GDK + ch];
        const float bias = p.gate_b[h * GDK + ch];
        __syncthreads();
        float run = 0.f; float Bv[64];
#pragma unroll
        for (int i = 0; i < 64; ++i) {
            const LAS float* g = gzl + (tq * 64 + i) * 16;
            const f32x4 g0 = *(const LAS f32x4*)g, g1 = *(const LAS f32x4*)(g + 4), g2 = *(const LAS f32x4*)(g + 8), g3 = *(const LAS f32x4*)(g + 12);
            float lg = bias;
            lg += g0[0] * w2[0] + g0[1] * w2[1] + g0[2] * w2[2] + g0[3] * w2[3]; lg += g1[0] * w2[4] + g1[1] * w2[5] + g1[2] * w2[6] + g1[3] * w2[7];
            lg += g2[0] * w2[8] + g2[1] * w2[9] + g2[2] * w2[10] + g2[3] * w2[11]; lg += g3[0] * w2[12] + g3[1] * w2[13] + g3[2] * w2[14] + g3[3] * w2[15];
            const float ls = fminf(lg, 0.f) - __logf(1.0f + __expf(-fabsf(lg)));
            run += ls * (1.0f / 16.0f); Bv[i] = run; }
        seg[tq * 128 + ch] = run;
        __syncthreads();
        float off = 0.f, tot = 0.f;
#pragma unroll
        for (int s = 0; s < 4; ++s) { const float v = seg[s * 128 + ch]; tot += v; off += (s < tq) ? v : 0.f; }
        if (tq == 0) dend[(size_t)u * GDK + ch] = __expf(tot);
        bf16_t* qp = proj + (size_t)(tok0 + tq * 64) * NPROJ + C_GQ + h * GDK + ch; bf16_t* kp = proj + (size_t)(tok0 + tq * 64) * NPROJ + C_GK + h * GDK + ch;
#pragma unroll
        for (int i0 = 0; i0 < 64; i0 += 16) {
            bf16_t qraw[16], kraw[16];
#pragma unroll
            for (int i = 0; i < 16; ++i) { qraw[i] = qp[(size_t)(i0 + i) * NPROJ]; kraw[i] = kp[(size_t)(i0 + i) * NPROJ]; }
#pragma unroll
            for (int i = 0; i < 16; ++i) { const float Bt = off + Bv[i0 + i];
                const float q = bf2f(qraw[i]), k = bf2f(kraw[i]);
                const float qt = q * __expf(Bt) * 0.08838834764831845f, kt = k * __expf(-Bt);
                qp[(size_t)(i0 + i) * NPROJ] = (bf16_t)(cvt_pk_bf16(qt, 0.f) & 0xffffu); kp[(size_t)(i0 + i) * NPROJ] = (bf16_t)(cvt_pk_bf16(kt, 0.f) & 0xffffu); }
        }
        __syncthreads();
    }
}
namespace att {
constexpr int NW = 8, QBLK = 32, KVBLK = 64, QB = 256, D = 128;
constexpr int SHM_V = KVBLK * D * 2, SHM_K = KVBLK * D * 2;
constexpr int ATT_LDS = 2 * SHM_V + 2 * SHM_K + NW * 64 * 4;
constexpr float SCALE = 0.08838834764831845f;
constexpr float THR = 8.f;
constexpr int APITCH = NPROJ, OPITCH = DM;
typedef LAS char* lptr;
typedef const LAS char* lcptr;

#define KSWZ(row, colB) ((row) * 256 + ((colB) ^ (((row) & 7) << 4)))
__device__ __forceinline__ int v_st(int k, int c) { const int kk = (k & ~0xC) | ((k & 4) << 1) | ((k & 8) >> 1); return ((kk >> 3) * 4 + (c >> 5)) * 512 + ((kk & 7) * 32 + (c & 31)) * 2; }
__device__ __forceinline__ int v_rd_base(int lane) { return ((lane & 3) << 3) | (((lane >> 2) & 3) << 6) | (((lane >> 4) & 1) << 5) | (((lane >> 5) & 1) << 8); }
constexpr int v_rd_off(int d0, int ks, int half) { return d0 * 512 + ks * 4096 + half * 2048; }
__device__ __forceinline__ int crow(int r, int hi) { return (r & 3) + 8 * (r >> 2) + 4 * hi; }
__device__ __forceinline__ bf16x8 load8(const bf16_t* p) { return *reinterpret_cast<const bf16x8*>(p); }

__device__ __forceinline__ void pack_p(const f32x16& p0, const f32x16& p1, bf16x8& pa0, bf16x8& pa1, bf16x8& pa2, bf16x8& pa3) {
#define PK4(P, B_, OUT) do { unsigned a0 = cvt_pk_bf16(P[B_+0], P[B_+1]), a1 = cvt_pk_bf16(P[B_+2], P[B_+3]);                          \
        unsigned b0 = cvt_pk_bf16(P[B_+4], P[B_+5]), b1 = cvt_pk_bf16(P[B_+6], P[B_+7]);                                             \
        auto r0 = __builtin_amdgcn_permlane32_swap(a0, b0, false, false); auto r1 = __builtin_amdgcn_permlane32_swap(a1, b1, false, false); \
        u32x4 w = {r0[0], r1[0], r0[1], r1[1]}; OUT = __builtin_bit_cast(bf16x8, w); } while (0)
    PK4(p0, 0, pa0); PK4(p0, 8, pa1); PK4(p1, 0, pa2); PK4(p1, 8, pa3);
#undef PK4
}
__device__ __forceinline__ void partialSM(f32x16& p0, f32x16& p1, float& m_reg, float& mn, float& alpha) {
    float pmax = p0[0];
#pragma unroll
    for (int r = 1; r < 16; ++r) pmax = fmaxf(pmax, p0[r]);
#pragma unroll
    for (int r = 0; r < 16; ++r) pmax = fmaxf(pmax, p1[r]);
    { auto rr = __builtin_amdgcn_permlane32_swap(__float_as_uint(pmax), __float_as_uint(pmax), false, false);
      pmax = fmaxf(__uint_as_float(rr[0]), __uint_as_float(rr[1])); }
    constexpr float C2 = 1.4426950408889634f * SCALE;
    if (__builtin_expect(__all((pmax - m_reg) * SCALE <= THR), 1)) { mn = m_reg; alpha = 1.f; }
    else { mn = fmaxf(m_reg, pmax); alpha = __builtin_amdgcn_exp2f((m_reg - mn) * C2); m_reg = mn; }
    const float mnL = -mn * C2;
#pragma unroll
    for (int r = 0; r < 16; ++r) p0[r] = fmaf(p0[r], C2, mnL);
#pragma unroll
    for (int r = 0; r < 16; ++r) p1[r] = fmaf(p1[r], C2, mnL);
#pragma unroll
    for (int r = 0; r < 16; ++r) p0[r] = __builtin_amdgcn_exp2f(p0[r]);
}
__device__ __forceinline__ void finishSM(f32x16& p0, f32x16& p1, float alpha, float& l_reg, bf16x8& pa0, bf16x8& pa1, bf16x8& pa2, bf16x8& pa3) {
#pragma unroll
    for (int r = 0; r < 16; ++r) p1[r] = __builtin_amdgcn_exp2f(p1[r]);
    float ps = 0;
#pragma unroll
    for (int r = 0; r < 16; ++r) ps += p0[r];
#pragma unroll
    for (int r = 0; r < 16; ++r) ps += p1[r];
    { auto rr = __builtin_amdgcn_permlane32_swap(__float_as_uint(ps), __float_as_uint(ps), false, false);
      ps = __uint_as_float(rr[0]) + __uint_as_float(rr[1]); }
    l_reg = l_reg * alpha + ps;
    pack_p(p0, p1, pa0, pa1, pa2, pa3);
}
template <int KB>
__device__ __forceinline__ void qkt(f32x16& p0, f32x16& p1, lcptr K_lds, int r32, int hi, const bf16x8* qr, float init = 0.f) {
#pragma unroll
    for (int r = 0; r < 16; ++r) { p0[r] = init; p1[r] = init; }
    lcptr kb[4];
#pragma unroll
    for (int dd = 0; dd < 4; ++dd) kb[dd] = K_lds + KB * SHM_K + KSWZ(r32, (dd * 16 + hi * 8) * 2);
#pragma unroll
    for (int d0 = 0; d0 < 8; ++d0) { lcptr a = kb[d0 & 3] + (d0 >> 2) * 128;
        bf16x8 b0 = *reinterpret_cast<const LAS bf16x8*>(a);
        bf16x8 b1 = *reinterpret_cast<const LAS bf16x8*>(a + 32 * 256);
        p0 = __builtin_amdgcn_mfma_f32_32x32x16_bf16(b0, qr[d0], p0, 0, 0, 0);
        p1 = __builtin_amdgcn_mfma_f32_32x32x16_bf16(b1, qr[d0], p1, 0, 0, 0); }
}
#define TRRD(dst, vb, off) asm volatile("ds_read_b64_tr_b16 %0, %1 offset:%2" : "=&v"(dst) : "v"(vb), "i"(off) : "memory")
template <int VOFF>
__device__ __forceinline__ void pv_tile(f32x16* o, int vb0, bf16x8 pa0, bf16x8 pa1, bf16x8 pa2, bf16x8 pa3) {
#define PV_D0(d0) do { s16x4 l0, l1, l2, l3, h0, h1, h2, h3; constexpr int b_ = VOFF + v_rd_off(d0, 0, 0); \
        TRRD(l0, vb0, b_); TRRD(h0, vb0, b_ + 2048); TRRD(l1, vb0, b_ + 4096); TRRD(h1, vb0, b_ + 6144); TRRD(l2, vb0, b_ + 8192); TRRD(h2, vb0, b_ + 10240); TRRD(l3, vb0, b_ + 12288); TRRD(h3, vb0, b_ + 14336); \
        asm volatile("s_waitcnt lgkmcnt(0)" ::: "memory"); SBAR(); \
        o[d0] = __builtin_amdgcn_mfma_f32_32x32x16_bf16(pa0, (bf16x8){l0[0], l0[1], l0[2], l0[3], h0[0], h0[1], h0[2], h0[3]}, o[d0], 0, 0, 0);   \
        o[d0] = __builtin_amdgcn_mfma_f32_32x32x16_bf16(pa1, (bf16x8){l1[0], l1[1], l1[2], l1[3], h1[0], h1[1], h1[2], h1[3]}, o[d0], 0, 0, 0);   \
        o[d0] = __builtin_amdgcn_mfma_f32_32x32x16_bf16(pa2, (bf16x8){l2[0], l2[1], l2[2], l2[3], h2[0], h2[1], h2[2], h2[3]}, o[d0], 0, 0, 0);   \
        o[d0] = __builtin_amdgcn_mfma_f32_32x32x16_bf16(pa3, (bf16x8){l3[0], l3[1], l3[2], l3[3], h3[0], h3[1], h3[2], h3[3]}, o[d0], 0, 0, 0); } while (0)
    PV_D0(0); PV_D0(1); PV_D0(2); PV_D0(3);
#undef PV_D0
}
template <int VOFF, int D0>
__device__ __forceinline__ void tr_frags(int vb0, bf16x8& f0, bf16x8& f1, bf16x8& f2, bf16x8& f3) {
    s16x4 l0, l1, l2, l3, h0, h1, h2, h3; constexpr int b_ = VOFF + v_rd_off(D0, 0, 0);
    TRRD(l0, vb0, b_); TRRD(h0, vb0, b_ + 2048); TRRD(l1, vb0, b_ + 4096); TRRD(h1, vb0, b_ + 6144); TRRD(l2, vb0, b_ + 8192); TRRD(h2, vb0, b_ + 10240); TRRD(l3, vb0, b_ + 12288); TRRD(h3, vb0, b_ + 14336);
    asm volatile("s_waitcnt lgkmcnt(0)" ::: "memory"); SBAR();
    f0 = (bf16x8){l0[0], l0[1], l0[2], l0[3], h0[0], h0[1], h0[2], h0[3]}; f1 = (bf16x8){l1[0], l1[1], l1[2], l1[3], h1[0], h1[1], h1[2], h1[3]};
    f2 = (bf16x8){l2[0], l2[1], l2[2], l2[3], h2[0], h2[1], h2[2], h2[3]}; f3 = (bf16x8){l3[0], l3[1], l3[2], l3[3], h3[0], h3[1], h3[2], h3[3]};
}

struct MobaRef { const bf16_t* Q; const bf16_t* K; const bf16_t* V; bf16_t* O; const unsigned* sel; int qb; };
struct MobaSeam { bf16x8 qr[8]; bf16x8 st_v0, st_v1, st_k0, st_k1; unsigned sel; };
#define AROW(p, k0, rr) ((p) + (size_t)((k0) + (rr)) * APITCH + sc)
#define VMW() asm volatile("s_waitcnt vmcnt(0)" ::: "memory")
#define VMWN(n) asm volatile("s_waitcnt vmcnt(%0)" :: "i"(n) : "memory")
#define SLOAD_H(Kp, Vp, k0) do { S.st_v0 = load8(AROW(Vp, k0, sr)); S.st_v1 = load8(AROW(Vp, k0, 32 + sr));              \
                         S.st_k0 = load8(AROW(Kp, k0, sr)); S.st_k1 = load8(AROW(Kp, k0, 32 + sr)); } while (0)
#define SWRITE_HK(bf) do { *(LAS bf16x8*)(K_lds + (bf) * SHM_K + kws) = S.st_k0; *(LAS bf16x8*)(K_lds + (bf) * SHM_K + kws + 32 * 256) = S.st_k1; } while (0)
#define SWRITE_HV(bf) do { *(LAS bf16x8*)(V_lds + (bf) * SHM_V + vst0) = S.st_v0; *(LAS bf16x8*)(V_lds + (bf) * SHM_V + vst1) = S.st_v1; } while (0)
#define SWRITE_H(bf) do { SWRITE_HV(bf); SWRITE_HK(bf); } while (0)

__device__ __forceinline__ void moba_prime(const MobaRef& cur, lptr lds, MobaSeam& S, int wave_s) {
    int tid = wave_s * 64 + lane_id(); asm volatile("" : "+v"(tid)); const int wid = __builtin_amdgcn_readfirstlane(tid >> 6), lane = tid & 63, r32 = lane & 31, hi = lane >> 5;
    const int sr = tid >> 4, sc = (tid & 15) * 8, kws = KSWZ(sr, sc * 2); lptr K_lds = lds + 2 * SHM_V;
#pragma unroll
    for (int d0 = 0; d0 < 8; ++d0) S.qr[d0] = load8(cur.Q + (size_t)(wid * QBLK + r32) * APITCH + d0 * 16 + hi * 8);
    S.sel = cur.sel[wid * QBLK + r32];
    SLOAD_H(cur.K, cur.V, 0); VMW(); SWRITE_HK(0);
    __syncthreads();
}
__device__ __forceinline__ void moba_block(const MobaRef& cur, const MobaRef& nxt, lptr lds, MobaSeam& S, int wave_s) {
    int tid = wave_s * 64 + lane_id(); asm volatile("" : "+v"(tid)); const int wid = __builtin_amdgcn_readfirstlane(tid >> 6), lane = tid & 63, r32 = lane & 31, hi = lane >> 5;
    const int qb = cur.qb, NT = 4 * (qb + 1);
    const int qlo = qb * QB + wid * QBLK, qm = qlo + r32 - 4 * hi;
    const unsigned sel = S.sel;
    lptr V_lds = lds; lptr K_lds = lds + 2 * SHM_V;
    LAS float* ws = (LAS float*)(lds + 2 * SHM_V + 2 * SHM_K) + wid * 64; LAS float* li_l = ws; LAS float* al_l = ws + 32;
    float m_reg = -1e30f, l_reg = 0; f32x16 o[4] = {};
    const int sr = tid >> 4, sc = (tid & 15) * 8, vst0 = v_st(sr, sc), vst1 = v_st(32 + sr, sc), kws = KSWZ(sr, sc * 2);
    const int vb0 = (int)(uintptr_t)V_lds + v_rd_base(lane);
    const bf16_t* Kh = cur.K; const bf16_t* Vh = cur.V;
    const float NEG = -__builtin_inff();
#define RESC(a) do { if (__any((a) < 1.f)) { if (hi == 0) al_l[r32] = (a); asm volatile("s_waitcnt lgkmcnt(0)" ::: "memory");              \
                     _Pragma("unroll") for (int d_ = 0; d_ < 4; ++d_) _Pragma("unroll") for (int r = 0; r < 16; ++r) o[d_][r] *= al_l[crow(r, hi)]; } } while (0)
#define KBASE(t) ((t) * KVBLK)
#define MASKT(P0_, P1_, t) do { const int kb_ = KBASE(t); const int jb_ = (t) >> 2;                                              \
        if (jb_ == qb) { if (kb_ + KVBLK - 1 > qlo) { const int dq_ = qm - kb_;                                                    \
            _Pragma("unroll") for (int r = 0; r < 16; ++r) { const int c_ = (r & 3) + 8 * (r >> 2);                                \
                if (dq_ - c_ < 0) P0_[r] = NEG; if (dq_ - c_ - 32 < 0) P1_[r] = NEG; } } }                                         \
        } while (0)
#define SELINIT(t) ((((t) >> 2) == qb || ((sel >> ((t) >> 2)) & 1u)) ? 0.f : NEG)
    constexpr int NQL = 9;
#define SEAM_K0() do { VMWN(NQL); SWRITE_HK(0); SBAR(); } while (0)
    f32x16 pA0, pA1, pB0, pB1; float mnA, mnB, alA, alB; bf16x8 pa0, pa1, pa2, pa3;
    SWRITE_HV(0); SBAR();
    SLOAD_H(Kh, Vh, KBASE(1));
    SBAR(); qkt<0>(pA0, pA1, K_lds, r32, hi, S.qr, SELINIT(0));
    MASKT(pA0, pA1, 0); partialSM(pA0, pA1, m_reg, mnA, alA);
    VMW(); SWRITE_H(1);
    __syncthreads();
#define HALF_STEP(PX0, PX1, mnX, alX, PY0, PY1, alY, t, KB, VB, SB) do {                                                      \
        SBAR(); qkt<KB>(PX0, PX1, K_lds, r32, hi, S.qr, SELINIT(t));                                                           \
        finishSM(PY0, PY1, alY, l_reg, pa0, pa1, pa2, pa3); SBAR();                                                           \
        if ((t) + 1 < NT) { SLOAD_H(Kh, Vh, KBASE((t) + 1)); SBAR(); }                                                        \
        pv_tile<VB * SHM_V>(o, vb0, pa0, pa1, pa2, pa3); MASKT(PX0, PX1, (t)); partialSM(PX0, PX1, m_reg, mnX, alX);          \
        __syncthreads();                                                                                                      \
        if ((t) + 1 < NT) { VMW(); SWRITE_H(SB); }                                                                            \
        RESC(alX); __syncthreads(); } while (0)
    for (int t = 1; t + 1 < NT; t += 2) {
        HALF_STEP(pB0, pB1, mnB, alB, pA0, pA1, alA, t, 1, 0, 0);
        HALF_STEP(pA0, pA1, mnA, alA, pB0, pB1, alB, t + 1, 0, 1, 1);
    }
    SBAR(); qkt<1>(pB0, pB1, K_lds, r32, hi, S.qr, SELINIT(NT - 1)); SBAR();
    SLOAD_H(nxt.K, nxt.V, 0); SBAR();
#pragma unroll
    for (int d0 = 0; d0 < 8; ++d0) S.qr[d0] = load8(nxt.Q + (size_t)(wid * QBLK + r32) * APITCH + d0 * 16 + hi * 8);
    S.sel = nxt.sel[wid * QBLK + r32];
    SBAR();
    finishSM(pA0, pA1, alA, l_reg, pa0, pa1, pa2, pa3); SBAR();
    pv_tile<0>(o, vb0, pa0, pa1, pa2, pa3);
    MASKT(pB0, pB1, NT - 1); partialSM(pB0, pB1, m_reg, mnB, alB); __syncthreads(); RESC(alB);
    finishSM(pB0, pB1, alB, l_reg, pa0, pa1, pa2, pa3); SBAR(); pv_tile<SHM_V>(o, vb0, pa0, pa1, pa2, pa3);
    SBAR(); SEAM_K0();
    if (hi == 0) li_l[r32] = l_reg; asm volatile("s_waitcnt lgkmcnt(0)" ::: "memory");
    float rli[16];
#pragma unroll
    for (int r = 0; r < 16; ++r) rli[r] = __builtin_amdgcn_rcpf(li_l[crow(r, hi)]);
    bf16_t* Ow = cur.O + (size_t)(wid * QBLK) * OPITCH;
#pragma unroll
    for (int r = 0; r < 16; ++r) { const int orow = crow(r, hi);
#pragma unroll
        for (int d0 = 0; d0 < 4; ++d0) { const float v = o[d0][r] * rli[r];
            const float vn = __shfl_xor(v, 1);
            if ((r32 & 1) == 0) *(unsigned*)(Ow + (size_t)orow * OPITCH + d0 * 32 + r32) = cvt_pk_bf16(v, vn); } }
    __syncthreads();
#undef RESC
#undef KBASE
#undef MASKT
#undef SELINIT
#undef SEAM_K0
#undef HALF_STEP
}

__device__ __forceinline__ MobaRef moba_ref(const Params& p, int bh, int qb) {
    const int b = bh / MH, h = bh % MH;
    const bf16_t* proj = (const bf16_t*)(p.ws + WS_PROJ); bf16_t* mixed = (bf16_t*)(p.ws + WS_MIXED); const unsigned* selp = (const unsigned*)(p.ws + WS_SEL);
    MobaRef r; const size_t tok0 = (size_t)b * SEQ;
    r.Q = proj + (tok0 + (size_t)qb * QB) * APITCH + C_MQ + h * HD; r.K = proj + tok0 * APITCH + C_MK + h * HD; r.V = proj + tok0 * APITCH + C_MV + h * HD;
    r.O = mixed + (tok0 + (size_t)qb * QB) * OPITCH + h * HD; r.sel = selp + (size_t)bh * SEQ + qb * QB; r.qb = qb; return r;
}
__device__ __forceinline__ void phase_moba(const Params& p, lptr lds, int wave_s) {
    const int G = gridDim.x; const int bx = blockIdx.x; const int vcu = (G % 8 == 0) ? (bx % 8) * (G / 8) + bx / 8 : bx;
    constexpr int NITEM = NBATCH * MH * 8;
    int L = vcu; if (L >= NITEM) return;
    int pass = 0;
    MobaRef cur = moba_ref(p, L >> 3, L & 7);
    MobaSeam S;
    moba_prime(cur, lds, S, wave_s);
    for (;;) {
        const bool more_pass = pass == 0, more_item = L + G < NITEM, last = !more_pass && !more_item;
        int Ln = L, passn = 1;
        if (!more_pass) { passn = 0; Ln = more_item ? L + G : L; }
        const MobaRef nxt = last ? cur : moba_ref(p, Ln >> 3, passn ? 15 - (Ln & 7) : (Ln & 7));
        moba_block(cur, nxt, lds, S, wave_s);
        if (last) break;
        cur = nxt; pass = passn; L = Ln;
    }
}
#undef SLOAD_H
#undef SWRITE_HK
#undef SWRITE_HV
#undef SWRITE_H
#undef VMWN
}
namespace att {
__device__ __forceinline__ void stage_vstyle(lptr dst, const bf16_t* src, size_t pitch, int tid) {
    const int sr = tid >> 4, sc = (tid & 15) * 8;
    const bf16x8 a = load8(src + (size_t)sr * pitch + sc), b = load8(src + (size_t)(32 + sr) * pitch + sc);
    *(LAS bf16x8*)(dst + v_st(sr, sc)) = a; *(LAS bf16x8*)(dst + v_st(32 + sr, sc)) = b;
}
__device__ __forceinline__ void stage_kstyle(lptr dst, const bf16_t* src, size_t pitch, int tid) {
    const int sr = tid >> 4, sc = (tid & 15) * 8;
    const bf16x8 a = load8(src + (size_t)sr * pitch + sc), b = load8(src + (size_t)(32 + sr) * pitch + sc);
    *(LAS bf16x8*)(dst + KSWZ(sr, sc * 2)) = a; *(LAS bf16x8*)(dst + KSWZ(sr, sc * 2) + 32 * 256) = b;
}

__device__ __forceinline__ void phase_moba_select(const Params& p, lptr lds, int tid_) { int tid = tid_; asm volatile("" : "+v"(tid));
    const bf16_t* proj = (const bf16_t*)(p.ws + WS_PROJ); const float* kmean = (const float*)(p.ws + WS_KMEAN); unsigned* selp = (unsigned*)(p.ws + WS_SEL);
    LAS float* gl = (LAS float*)lds;
    const int wave = __builtin_amdgcn_readfirstlane(tid >> 6), lane = tid & 63, row = lane & 15, kq = lane >> 4;
    for (int u = blockIdx.x; u < NBATCH * MH * NBLK; u += gridDim.x) {
        const int bh = u / NBLK, qb = u % NBLK, b = bh / MH, h = bh % MH;
        if (qb == 0) { if (tid < 256) selp[(size_t)bh * SEQ + tid] = 0u; continue; }
        const bf16_t* qsrc = proj + ((size_t)b * SEQ + qb * 256 + wave * 32) * NPROJ + C_MQ + h * HD;
        const float* km = kmean + (size_t)bh * NBLK * HD + (size_t)row * HD;
        bf16x8 a0[4], a1[4]; f32x4 k0[4], k1[4];
#pragma unroll
        for (int ks = 0; ks < 4; ++ks) { a0[ks] = load8(qsrc + (size_t)row * NPROJ + 32 * ks + 8 * kq); a1[ks] = load8(qsrc + (size_t)(16 + row) * NPROJ + 32 * ks + 8 * kq);
            k0[ks] = *(const f32x4*)(km + 32 * ks + 8 * kq); k1[ks] = *(const f32x4*)(km + 32 * ks + 8 * kq + 4); }
        f32x4 g0 = {0.f, 0.f, 0.f, 0.f}, g1 = {0.f, 0.f, 0.f, 0.f};
#pragma unroll
        for (int ks = 0; ks < 4; ++ks) {
            u32x4 bw; bw.x = cvt_pk_bf16(k0[ks][0], k0[ks][1]); bw.y = cvt_pk_bf16(k0[ks][2], k0[ks][3]); bw.z = cvt_pk_bf16(k1[ks][0], k1[ks][1]); bw.w = cvt_pk_bf16(k1[ks][2], k1[ks][3]);
            const f32x4 r0 = {k0[ks][0] - bflo(bw.x), k0[ks][1] - bfhi(bw.x), k0[ks][2] - bflo(bw.y), k0[ks][3] - bfhi(bw.y)}, r1 = {k1[ks][0] - bflo(bw.z), k1[ks][1] - bfhi(bw.z), k1[ks][2] - bflo(bw.w), k1[ks][3] - bfhi(bw.w)};
            const bf16x8 bh_ = __builtin_bit_cast(bf16x8, bw), bl_ = pack8(r0, r1);
            g0 = __builtin_amdgcn_mfma_f32_16x16x32_bf16(a0[ks], bh_, g0, 0, 0, 0); g0 = __builtin_amdgcn_mfma_f32_16x16x32_bf16(a0[ks], bl_, g0, 0, 0, 0);
            g1 = __builtin_amdgcn_mfma_f32_16x16x32_bf16(a1[ks], bh_, g1, 0, 0, 0); g1 = __builtin_amdgcn_mfma_f32_16x16x32_bf16(a1[ks], bl_, g1, 0, 0, 0); }
#pragma unroll
        for (int r = 0; r < 4; ++r) { gl[(wave * 32 + kq * 4 + r) * 16 + row] = g0[r]; gl[(wave * 32 + 16 + kq * 4 + r) * 16 + row] = g1[r]; }
        __syncthreads();
        if (tid < 256) {
            float gv[16];
#pragma unroll
            for (int n = 0; n < 16; ++n) gv[n] = (n < qb) ? gl[tid * 16 + n] : -__builtin_inff();
            unsigned m = 0u;
#pragma unroll
            for (int k = 0; k < 3; ++k) { float best = -__builtin_inff(); int bi = -1;
#pragma unroll
                for (int n = 0; n < 16; ++n) { const bool tk = gv[n] > best; best = tk ? gv[n] : best; bi = tk ? n : bi; }
                if (bi >= 0) m |= 1u << bi;
#pragma unroll
                for (int n = 0; n < 16; ++n) gv[n] = (n == bi) ? -__builtin_inff() : gv[n]; }
            selp[(size_t)bh * SEQ + qb * 256 + tid] = m;
        }
        __syncthreads();
    }
}

__device__ __forceinline__ void phase_gla_state(const Params& p, lptr lds, int tid_) { int tid = tid_; asm volatile("" : "+v"(tid));
    const bf16_t* proj = (const bf16_t*)(p.ws + WS_PROJ); const float* dend = (const float*)(p.ws + WS_DEND); float* U = (float*)(p.ws + WS_U);
    const int wid = __builtin_amdgcn_readfirstlane(tid >> 6), lane = tid & 63, r32 = lane & 31, hi = lane >> 5;
    const int dkb = wid & 3, half = wid >> 2;
    const int vb0 = (int)(uintptr_t)lds + v_rd_base(lane);
    for (int u = blockIdx.x; u < NBATCH * GH * NBLK; u += gridDim.x) {
        const int bh = u / NBLK, j = u % NBLK, b = bh / GH, h = bh % GH;
        const size_t tok0 = (size_t)b * SEQ + j * 256;
        f32x16 o[4] = {};
        for (int t = 0; t < 4; ++t) {
            __syncthreads();
            const bf16_t* rowp = proj + (tok0 + t * 64) * NPROJ;
            stage_vstyle(lds, rowp + C_GK + h * GDK, NPROJ, tid);
            stage_vstyle(lds + SHM_V, rowp + C_GV + h * GDV, NPROJ, tid);
            stage_vstyle(lds + 2 * SHM_V, rowp + C_GV + h * GDV + 128, NPROJ, tid);
            __syncthreads();
            bf16x8 a0, a1, a2, a3;
            if (dkb == 0) tr_frags<0, 0>(vb0, a0, a1, a2, a3); else if (dkb == 1) tr_frags<0, 1>(vb0, a0, a1, a2, a3); else if (dkb == 2) tr_frags<0, 2>(vb0, a0, a1, a2, a3); else tr_frags<0, 3>(vb0, a0, a1, a2, a3);
            if (half == 0) pv_tile<SHM_V>(o, vb0, a0, a1, a2, a3); else pv_tile<2 * SHM_V>(o, vb0, a0, a1, a2, a3);
        }
        float dv[16];
#pragma unroll
        for (int r = 0; r < 16; ++r) dv[r] = dend[(size_t)u * GDK + dkb * 32 + crow(r, hi)];
        float* Uo = U + (size_t)u * (GDK * GDV);
#pragma unroll
        for (int r = 0; r < 16; ++r) { const int k = dkb * 32 + crow(r, hi);
#pragma unroll
            for (int d0 = 0; d0 < 4; ++d0) Uo[(size_t)k * GDV + half * 128 + d0 * 32 + r32] = o[d0][r] * dv[r]; }
    }
    __syncthreads();
}

__device__ __forceinline__ void phase_gla_scan(const Params& p, int tid_) { int tid = tid_; asm volatile("" : "+v"(tid));
    const float* U = (const float*)(p.ws + WS_U); const float* dend = (const float*)(p.ws + WS_DEND); bf16_t* Sj = (bf16_t*)(p.ws + WS_SJ);
    constexpr int NEL = NBATCH * GH * GDK * GDV / 4;
    for (int i = blockIdx.x * NTHREADS + tid; i < NEL; i += gridDim.x * NTHREADS) {
        const int bh = i / (GDK * GDV / 4), e4 = i % (GDK * GDV / 4), k = e4 / (GDV / 4);
        f32x4 S = {0.f, 0.f, 0.f, 0.f};
        f32x4 uv[NBLK]; float dd[NBLK];
#pragma unroll
        for (int j = 0; j < NBLK; ++j) { uv[j] = *(const f32x4*)(U + ((size_t)(bh * NBLK + j) * (GDK * GDV)) + (size_t)e4 * 4); dd[j] = dend[(size_t)(bh * NBLK + j) * GDK + k]; }
#pragma unroll
        for (int j = 0; j < NBLK; ++j) {
            u32x2 w; w.x = cvt_pk_bf16(S[0], S[1]); w.y = cvt_pk_bf16(S[2], S[3]);
            *(u32x2*)(Sj + ((size_t)(bh * NBLK + j) * (GDK * GDV)) + (size_t)e4 * 4) = w;
            S = S * dd[j] + uv[j]; }
    }
}

__device__ __forceinline__ void phase_gla_out(const Params& p, lptr lds, int tid_) { int tid = tid_; asm volatile("" : "+v"(tid));
    const bf16_t* proj = (const bf16_t*)(p.ws + WS_PROJ); const bf16_t* Sj = (const bf16_t*)(p.ws + WS_SJ); bf16_t* mixed = (bf16_t*)(p.ws + WS_MIXED);
    const int wid = __builtin_amdgcn_readfirstlane(tid >> 6), lane = tid & 63, r32 = lane & 31, hi = lane >> 5;
    constexpr int BUF = 3 * SHM_V;
    const int vb0 = (int)(uintptr_t)lds + v_rd_base(lane), vb1 = vb0 + BUF;
    const int sr = tid >> 4, sc = (tid & 15) * 8;
    const int kws = KSWZ(sr, sc * 2), vst0 = v_st(sr, sc), vst1 = v_st(32 + sr, sc);
    for (int u = blockIdx.x; u < NBATCH * GH * NBLK; u += gridDim.x) {
        const int bh = u / NBLK, j = u % NBLK, b = bh / GH, h = bh % GH;
        const size_t tok0 = (size_t)b * SEQ + j * 256;
        bf16x8 qr[8];
#pragma unroll
        for (int d0 = 0; d0 < 8; ++d0) qr[d0] = load8(proj + (tok0 + wid * 32 + r32) * NPROJ + C_GQ + h * GDK + d0 * 16 + hi * 8);
        f32x16 o[8] = {};
        bf16x8 sk0, sk1, sa0, sa1, sb0, sb1;
        const bf16_t* sp = Sj + (size_t)u * (GDK * GDV);
#define GO_LOAD(s_) do { if ((s_) < 4) { const bf16_t* rp = proj + (tok0 + (s_) * 64) * NPROJ; \
            sk0 = load8(rp + (size_t)sr * NPROJ + C_GK + h * GDK + sc); sk1 = load8(rp + (size_t)(32 + sr) * NPROJ + C_GK + h * GDK + sc); \
            sa0 = load8(rp + (size_t)sr * NPROJ + C_GV + h * GDV + sc); sa1 = load8(rp + (size_t)(32 + sr) * NPROJ + C_GV + h * GDV + sc); \
            sb0 = load8(rp + (size_t)sr * NPROJ + C_GV + h * GDV + 128 + sc); sb1 = load8(rp + (size_t)(32 + sr) * NPROJ + C_GV + h * GDV + 128 + sc); } \
          else { const bf16_t* rp = sp + (size_t)((s_) - 4) * 64 * GDV; \
            sa0 = load8(rp + (size_t)sr * GDV + sc); sa1 = load8(rp + (size_t)(32 + sr) * GDV + sc); \
            sb0 = load8(rp + (size_t)sr * GDV + 128 + sc); sb1 = load8(rp + (size_t)(32 + sr) * GDV + 128 + sc); } } while (0)
#define GO_WRITE(s_, bufo) do { if ((s_) < 4) { *(LAS bf16x8*)(lds + (bufo) + kws) = sk0; *(LAS bf16x8*)(lds + (bufo) + kws + 32 * 256) = sk1; } \
            *(LAS bf16x8*)(lds + (bufo) + SHM_V + vst0) = sa0; *(LAS bf16x8*)(lds + (bufo) + SHM_V + vst1) = sa1; \
            *(LAS bf16x8*)(lds + (bufo) + 2 * SHM_V + vst0) = sb0; *(LAS bf16x8*)(lds + (bufo) + 2 * SHM_V + vst1) = sb1; } while (0)
#define GO_STEP(s_, B_) do { GO_LOAD(s_); __syncthreads(); GO_WRITE(s_, (B_) * BUF); __syncthreads(); \
            if ((s_) < 4) { if ((s_) * 64 <= wid * 32 + 31) { f32x16 p0, p1; qkt<0>(p0, p1, lds + (B_) * BUF, r32, hi, qr); \
                    const int dq = wid * 32 + r32 - 4 * hi - (s_) * 64; \
                    _Pragma("unroll") for (int r = 0; r < 16; ++r) { const int c_ = (r & 3) + 8 * (r >> 2); if (dq - c_ < 0) p0[r] = 0.f; if (dq - c_ - 32 < 0) p1[r] = 0.f; } \
                    bf16x8 pa0, pa1, pa2, pa3; pack_p(p0, p1, pa0, pa1, pa2, pa3); \
                    pv_tile<SHM_V>(o, (B_) ? vb1 : vb0, pa0, pa1, pa2, pa3); pv_tile<2 * SHM_V>(o + 4, (B_) ? vb1 : vb0, pa0, pa1, pa2, pa3); } } \
            else { pv_tile<SHM_V>(o, (B_) ? vb1 : vb0, qr[4 * ((s_) - 4)], qr[4 * ((s_) - 4) + 1], qr[4 * ((s_) - 4) + 2], qr[4 * ((s_) - 4) + 3]); \
                   pv_tile<2 * SHM_V>(o + 4, (B_) ? vb1 : vb0, qr[4 * ((s_) - 4)], qr[4 * ((s_) - 4) + 1], qr[4 * ((s_) - 4) + 2], qr[4 * ((s_) - 4) + 3]); } } while (0)
        GO_STEP(0, 0); GO_STEP(1, 0); GO_STEP(2, 0); GO_STEP(3, 0); GO_STEP(4, 0); GO_STEP(5, 0);
#undef GO_LOAD
#undef GO_WRITE
#undef GO_STEP
        int hi_e = hi, r32_e = r32; asm volatile("" : "+v"(hi_e), "+v"(r32_e));
        float wv[8];
#pragma unroll
        for (int d0 = 0; d0 < 8; ++d0) wv[d0] = p.gla_norm_w[d0 * 32 + r32_e];
        const bf16_t* ggp = proj + (tok0 + wid * 32) * NPROJ + C_GG + h * GDV + r32_e;
        bf16_t* op = mixed + (tok0 + wid * 32) * DM + 1024 + h * GDV + r32_e;
#pragma unroll
        for (int rb = 0; rb < 16; rb += 4) {
            bf16_t graw[4][8];
#pragma unroll
            for (int q = 0; q < 4; ++q)
#pragma unroll
                for (int d0 = 0; d0 < 8; ++d0) graw[q][d0] = ggp[(size_t)crow(rb + q, hi_e) * NPROJ + d0 * 32];
#pragma unroll
            for (int q = 0; q < 4; ++q) { const int r = rb + q, orow = crow(r, hi_e);
                float ss = 0.f;
#pragma unroll
                for (int d0 = 0; d0 < 8; ++d0) ss += o[d0][r] * o[d0][r];
                ss += __shfl_xor(ss, 1); ss += __shfl_xor(ss, 2); ss += __shfl_xor(ss, 4); ss += __shfl_xor(ss, 8); ss += __shfl_xor(ss, 16);
                const float rsr = 1.0f / sqrtf(ss * (1.0f / GDV) + EPS);
#pragma unroll
                for (int d0 = 0; d0 < 8; ++d0) { const float g = bf2f(graw[q][d0]); const float sg = g * __builtin_amdgcn_rcpf(1.0f + __expf(-g));
                    const float v = o[d0][r] * rsr * wv[d0] * sg; const float vn = __shfl_xor(v, 1);
                    if ((r32_e & 1) == 0) *(unsigned*)(op + (size_t)orow * DM + d0 * 32) = cvt_pk_bf16(v, vn); } }
            asm volatile("" ::: "memory"); }
    }
    __syncthreads();
}
}

__device__ __forceinline__ void phase_route(const Params& p, const Ctx& c0) { const Ctx c = fresh_ctx(c0);
    const int* hist = (const int*)(p.ws + WS_HIST); const int* topi = (const int*)(p.ws + WS_TOPI); const float* rstd2 = (const float*)(p.ws + WS_RSTD2);
    int* dest = (int*)(p.ws + WS_DEST); int* row_tok = (int*)(p.ws + WS_ROWTOK); float* row_rstd = (float*)(p.ws + WS_ROWRSTD); int* blk = (int*)(p.ws + WS_BLKE);
    LAS int* cnt = (LAS int*)c.lds; LAS int* before = cnt + 32; LAS int* pstart = cnt + 64; LAS int* ea = cnt + 128;
    for (int g = blockIdx.x; g < T / 64; g += gridDim.x) {
        if (c.tid < 64) cnt[c.tid] = 0;
        __syncthreads();
        { const int e = c.tid & 31, part = c.tid >> 5; int tot = 0, bef = 0;
#pragma unroll
            for (int i = 0; i < 16; ++i) { const int gg = part * 16 + i; const int v = hist[gg * 32 + e]; tot += v; bef += (gg < g) ? v : 0; }
            atomicAdd((int*)&cnt[e], tot); atomicAdd((int*)&before[e], bef); }
        __syncthreads();
        if (c.tid == 0) { int acc = 0; for (int e = 0; e < NE; ++e) { pstart[e] = acc; acc += ((cnt[e] + 255) >> 8) << 8; } pstart[NE] = acc; }
        if (c.tid < 256) ea[c.tid] = topi[(size_t)g * 256 + c.tid];
        __syncthreads();
        LAS int* wcnt = cnt + 512;
        int e_my = 0, rank = 0;
        if (c.tid < 256) { e_my = ea[c.tid];
            for (int k = 0; k < NE; ++k) { const unsigned long long mk = __ballot(e_my == k);
                if (e_my == k) rank = __popcll(mk & ((1ull << c.lane) - 1ull));
                if (c.lane == 0) wcnt[c.wave * 32 + k] = __popcll(mk); } }
        __syncthreads();
        if (c.tid < 256) {
            for (int w = 0; w < c.wave; ++w) rank += wcnt[w * 32 + e_my];
            const int d = pstart[e_my] + before[e_my] + rank; const int tok = g * 64 + (c.tid >> 2);
            dest[(size_t)g * 256 + c.tid] = d; row_tok[d] = tok; row_rstd[d] = rstd2[tok];
        }
        if (g == 0 && c.tid < 64) {
            const int nb = pstart[NE] >> 8; if (c.tid == 0) blk[0] = nb;
            for (int bq = c.tid; bq < nb; bq += 64) { int e = 0; for (int q = 0; q < NE; ++q) e += (pstart[q + 1] <= bq * 256) ? 1 : 0; blk[64 + bq] = e < NE ? e : NE - 1; }
        }
        __syncthreads();
    }
}

__device__ __forceinline__ void phase_combine(const Params& p, const Ctx& c0) { const Ctx c = fresh_ctx(c0);
    const bf16_t* X1 = (const bf16_t*)(p.ws + WS_X1); const unsigned char* Y = (const unsigned char*)(p.ws + WS_Y); const int* dest = (const int*)(p.ws + WS_DEST); const float* topg = (const float*)(p.ws + WS_TOPG);
    for (int t = blockIdx.x * NWAVES + c.wave; t < T; t += gridDim.x * NWAVES) {
        const int4 d4 = *(const int4*)(dest + (size_t)t * 4); const float4 g4 = *(const float4*)(topg + (size_t)t * 4);
        const int dd[4] = {d4.x, d4.y, d4.z, d4.w}; const float gg[4] = {g4.x * (1.0f / Y_SCALE), g4.y * (1.0f / Y_SCALE), g4.z * (1.0f / Y_SCALE), g4.w * (1.0f / Y_SCALE)};
        f32x4 v[8]; u32x2 yw[4][4]; float ss = 0.f;
#pragma unroll
        for (int j = 0; j < 4; ++j) { const u32x4 xw = *(const u32x4*)(X1 + (size_t)t * DM + j * 512 + c.lane * 8); v[2 * j] = (f32x4){bflo(xw.x), bfhi(xw.x), bflo(xw.y), bfhi(xw.y)}; v[2 * j + 1] = (f32x4){bflo(xw.z), bfhi(xw.z), bflo(xw.w), bfhi(xw.w)}; }
#pragma unroll
        for (int k = 0; k < 4; ++k)
#pragma unroll
            for (int j = 0; j < 4; ++j) yw[k][j] = *(const u32x2*)(Y + (size_t)dd[k] * DM + j * 512 + c.lane * 8);
#pragma unroll
        for (int k = 0; k < 4; ++k)
#pragma unroll
            for (int j = 0; j < 4; ++j) { const f32x2 a = __builtin_amdgcn_cvt_pk_f32_fp8(yw[k][j].x, false), b = __builtin_amdgcn_cvt_pk_f32_fp8(yw[k][j].x, true);
                const f32x2 cc = __builtin_amdgcn_cvt_pk_f32_fp8(yw[k][j].y, false), d = __builtin_amdgcn_cvt_pk_f32_fp8(yw[k][j].y, true);
                v[2 * j][0] += gg[k] * a[0]; v[2 * j][1] += gg[k] * a[1]; v[2 * j][2] += gg[k] * b[0]; v[2 * j][3] += gg[k] * b[1];
                v[2 * j + 1][0] += gg[k] * cc[0]; v[2 * j + 1][1] += gg[k] * cc[1]; v[2 * j + 1][2] += gg[k] * d[0]; v[2 * j + 1][3] += gg[k] * d[1]; }
#pragma unroll
        for (int j = 0; j < 8; ++j) ss += (v[j][0] * v[j][0] + v[j][1] * v[j][1]) + (v[j][2] * v[j][2] + v[j][3] * v[j][3]);
        const float rs = 1.0f / sqrtf(wave_sum(ss) * (1.0f / DM) + EPS);
#pragma unroll
        for (int j = 0; j < 8; ++j) { const int col = (j >> 1) * 512 + c.lane * 8 + (j & 1) * 4; const f32x4 w = *(const f32x4*)(p.final_norm_w + col);
            *(f32x4*)(p.out + (size_t)t * DM + col) = v[j] * rs * w; }
    }
}
__device__ __forceinline__ Ctx make_ctx(unsigned char* lds_generic) {
    Ctx c; c.lds = (LAS unsigned char*)lds_generic; c.tid = threadIdx.x; c.lane = c.tid & 63; c.wave = __builtin_amdgcn_readfirstlane(c.tid >> 6); return c;
}
__device__ __forceinline__ void phase_gemm_inproj16(const Params& p, const Ctx& c, int i0, int i1, int G, int cidx) {
    if (i0 >= i1) return;
    g8::DenseProbIn P{(const bf16_t*)(p.ws + WS_H), (const bf16_t*)(p.ws + WS_WIN), T / 256, NPROJ / 256, DM, G, cidx, i0, i1};
    g8::EpiProj E{(bf16_t*)(p.ws + WS_PROJ), (const float*)(p.ws + WS_RSTD1), (const float*)(p.ws + WS_ROPE), (float*)(p.ws + WS_KMEAN), (LAS float*)(c.lds + g8::STAGE_BYTES)};
    g8::gemm_phase(c.lds, P, E, c.wave);
}
__device__ __forceinline__ void phase_gemm_outproj(const Params& p, const Ctx& c, int i0, int i1) {
    if (i0 >= i1) return;
    g8::DenseProbOut P{(const bf16_t*)(p.ws + WS_MIXED), (const bf16_t*)(p.ws + WS_WOUT), T / 256, DM / 256, DM, (int)gridDim.x, (int)blockIdx.x, i0, i1};
    g8::EpiX1 E{p.x, (bf16_t*)(p.ws + WS_X1)};
    g8::gemm_phase(c.lds, P, E, c.wave);
}
__device__ __forceinline__ void phase_gemm_moe1(const Params& p, const Ctx& c, int i0, int i1) {
    g8::MoeProb1 P{(const bf16_t*)(p.ws + WS_H), (const bf16_t*)(p.ws + WS_WGU), (const int*)(p.ws + WS_ROWTOK), (const int*)(p.ws + WS_BLKE), DM / 2, __builtin_amdgcn_readfirstlane(*(const int*)(p.ws + WS_BLKE)), i0, i1};
    g8::EpiSwiglu E{(unsigned char*)(p.ws + WS_ACT), (const float*)(p.ws + WS_ROWRSTD), p.b_gu};
    g8::gemm_phase(c.lds, P, E, c.wave);
}
__device__ __forceinline__ void phase_gemm_moe2(const Params& p, const Ctx& c) {
    g8::MoeProb2 P{(const bf16_t*)(p.ws + WS_ACT), (const bf16_t*)(p.ws + WS_WD), (const int*)(p.ws + WS_BLKE), FF / 2, __builtin_amdgcn_readfirstlane(*(const int*)(p.ws + WS_BLKE))};
    g8::EpiDown E{(unsigned char*)(p.ws + WS_Y), p.b_d};
    g8::gemm_phase(c.lds, P, E, c.wave);
}


constexpr int CW_BAR = 4096;
__global__ void __launch_bounds__(NTHREADS, 2) fwd(Params p) {
    extern __shared__ __attribute__((aligned(16))) unsigned char lds_raw[];
    const Ctx c = make_ctx(lds_raw);
    if (c.tid < 64) ((LAS unsigned*)(c.lds + LDS_MISC))[c.tid] = 0u;
    __syncthreads();
    const XcdBarrier bar = xcd_barrier_post((unsigned*)(p.ws + WS_CTL) + CW_BAR, (volatile LAS unsigned*)(c.lds + LDS_MISC + 32));
    const att::lptr al = (att::lptr)c.lds;
#ifndef PREFIX_K
#define PREFIX_K 0
#endif
#define PIPE(KMAX) do { \
    if ((KMAX) >= 1) { \
    phase_convert(p, c); phase_norm1(p, c); \
      if ((KMAX) > 1 || (KMAX) < 12) xcd_barrier(bar); } \
    if ((KMAX) >= 2) { \
    { \
        const int bx = blockIdx.x, G = gridDim.x; \
        const int cut = (G == 256) ? (bx >> 3) % 7 : 0; \
        if (cut > 0) phase_gemm_inproj16(p, c, 0, cut, G, bx); \
        phase_convert_share(p, c, 0, CT_GU, G, bx); \
        phase_gemm_inproj16(p, c, cut, 1 << 20, G, bx); \
    } \
      if ((KMAX) > 2 || (KMAX) < 12) xcd_barrier(bar); } \
    if ((KMAX) >= 3) { \
    phase_gla_prep(p, c); att::phase_gla_state(p, al, c.wave * 64 + lane_id()); att::phase_moba_select(p, al, c.wave * 64 + lane_id()); \
      if ((KMAX) > 4 || (KMAX) < 12) xcd_barrier(bar); } \
    if ((KMAX) >= 5) { \
    att::phase_gla_scan(p, c.wave * 64 + lane_id()); \
      if ((KMAX) > 5 || (KMAX) < 12) xcd_barrier(bar); } \
    if ((KMAX) >= 6) { \
    att::phase_gla_out(p, al, c.wave * 64 + lane_id()); att::phase_moba(p, al, c.wave); \
      if ((KMAX) > 6 || (KMAX) < 12) xcd_barrier(bar); } \
    if ((KMAX) >= 7) { \
    phase_gemm_outproj(p, c, 0, 1 << 20); \
      if ((KMAX) > 7 || (KMAX) < 12) xcd_barrier(bar); } \
    if ((KMAX) >= 8) { \
    phase_norm2_router(p, c); \
      if ((KMAX) > 8 || (KMAX) < 12) xcd_barrier(bar); } \
    if ((KMAX) >= 9) { \
    phase_route(p, c); \
      if ((KMAX) > 9 || (KMAX) < 12) xcd_barrier(bar); } \
    if ((KMAX) >= 10) { \
    { \
        const int cut = 2 * ((blockIdx.x >> 3) & 7); \
        if (cut > 0) phase_gemm_moe1(p, c, 0, cut); \
        phase_convert_share(p, c, CT_GU, CT_TOTAL, (int)gridDim.x, (int)blockIdx.x); \
        phase_gemm_moe1(p, c, cut, 1 << 20); \
    } \
      if ((KMAX) > 10 || (KMAX) < 12) xcd_barrier(bar); } \
    if ((KMAX) >= 11) { \
    phase_gemm_moe2(p, c); \
      if ((KMAX) > 11 || (KMAX) < 12) xcd_barrier(bar); } \
    if ((KMAX) >= 12) { \
    phase_combine(p, c); \
      if ((KMAX) > 12 || (KMAX) < 12) xcd_barrier(bar); } \
    } while (0)
    if (PREFIX_K > 0) PIPE(PREFIX_K);
#ifndef PSET
#define PSET 0
#endif
#ifndef PSUB
#define PSUB 0xffff
#endif
    if (PSET) {
        if (PSET & 1) { phase_convert(p, c); phase_norm1(p, c); xcd_barrier(bar); }
        if (PSET & 2) { const int bx = blockIdx.x, G = gridDim.x;
            if (PSUB & 1) phase_gemm_inproj16(p, c, 0, 1 << 20, G, bx);
            if ((PSUB & 2) && (!(PSUB & 4) || ((bx >> 3) & 7) == 0)) phase_convert_share(p, c, 0, CT_GU, G, bx);
            xcd_barrier(bar); }
        if (PSET & 4) { if (PSUB & 1) { phase_gla_prep(p, c); att::phase_gla_state(p, al, c.wave * 64 + lane_id()); } if (PSUB & 2) att::phase_moba_select(p, al, c.wave * 64 + lane_id()); xcd_barrier(bar); }
        if (PSET & 16) { att::phase_gla_scan(p, c.wave * 64 + lane_id()); xcd_barrier(bar); }
        if (PSET & 32) { if (PSUB & 1) att::phase_gla_out(p, al, c.wave * 64 + lane_id()); if (PSUB & 2) att::phase_moba(p, al, c.wave); xcd_barrier(bar); }
        if (PSET & 64) { phase_gemm_outproj(p, c, 0, 1 << 20); xcd_barrier(bar); }
        if (PSET & 128) { phase_norm2_router(p, c); xcd_barrier(bar); }
        if (PSET & 256) { phase_route(p, c); xcd_barrier(bar); }
        if (PSET & 512) { if (PSUB & 1) phase_gemm_moe1(p, c, 0, 1 << 20); if (PSUB & 2) phase_convert_share(p, c, CT_GU, CT_TOTAL, (int)gridDim.x, (int)blockIdx.x); xcd_barrier(bar); }
        if (PSET & 1024) { phase_gemm_moe2(p, c); xcd_barrier(bar); }
        if (PSET & 2048) { phase_combine(p, c); xcd_barrier(bar); }
    }
    PIPE(12);
#undef PIPE
}

extern "C" void kernel_launch(void* const* d_in, const int* in_sizes, int n_in, void* d_out, int out_size, void* d_ws, size_t ws_size, hipStream_t stream) {
    static int grid = 0;
    if (grid == 0) {
        if (n_in != 15 || ws_size < WS_END) { fprintf(stderr, "kernel_launch: unexpected inputs (n_in %d, ws %zu)\n", n_in, ws_size); grid = -1; return; }
        int dev = 0, cus = 0, per_cu = 0;
        if (hipGetDevice(&dev) != hipSuccess || hipDeviceGetAttribute(&cus, hipDeviceAttributeMultiprocessorCount, dev) != hipSuccess) { grid = -1; return; }
        if (hipFuncSetAttribute((const void*)fwd, hipFuncAttributeMaxDynamicSharedMemorySize, LDS_BYTES) != hipSuccess) { fprintf(stderr, "kernel_launch: hipFuncSetAttribute failed\n"); grid = -1; return; }
        if (hipOccupancyMaxActiveBlocksPerMultiprocessor(&per_cu, (const void*)fwd, NTHREADS, LDS_BYTES) != hipSuccess || per_cu < 1) { fprintf(stderr, "kernel_launch: occupancy query says %d blocks per CU\n", per_cu); }
        (void)hipGetLastError();
        grid = cus > 0 ? cus : 256;
    }
    if (grid < 0) return;
    Params p{};
    p.x = (const float*)d_in[0]; p.attn_norm_w = (const float*)d_in[1]; p.w_in = (const float*)d_in[2]; p.gate_w2 = (const float*)d_in[3]; p.gate_b = (const float*)d_in[4];
    p.gla_norm_w = (const float*)d_in[5]; p.w_out = (const float*)d_in[6]; p.ffn_norm_w = (const float*)d_in[7]; p.router_w = (const float*)d_in[8]; p.router_b = (const float*)d_in[9];
    p.w_gu = (const float*)d_in[10]; p.b_gu = (const float*)d_in[11]; p.w_d = (const float*)d_in[12]; p.b_d = (const float*)d_in[13]; p.final_norm_w = (const float*)d_in[14];
    p.out = (float*)d_out; p.ws = (unsigned char*)d_ws;
    if (hipMemsetAsync((char*)d_ws + WS_CTL, 0, CTL_BYTES, stream) != hipSuccess) return;
    hipLaunchKernelGGL(fwd, dim3(grid), dim3(NTHREADS), LDS_BYTES, stream, p);
}
```
